# Optimizing an MI355X kernel written in HIP

```python
import jax, jax.numpy as jnp
from jax import lax
import numpy as np

D_MODEL = 1024
BATCH = 8
SEQ = 8192
DEPTH = 2

HEAD_DIM = 64
ATTN_WIDTH = D_MODEL // 2
N_ATTN_HEADS = ATTN_WIDTH // HEAD_DIM
N_KV_HEADS = 2
GQA_GROUP = N_ATTN_HEADS // N_KV_HEADS
KV_WIDTH = N_KV_HEADS * HEAD_DIM
N_BRANCH = 3
MLP_WIDTH = D_MODEL - ATTN_WIDTH
MLP_GROUP_DIM = 64
N_MLP_GROUPS = MLP_WIDTH // MLP_GROUP_DIM
MIX_WIDTH = ATTN_WIDTH + MLP_WIDTH
IN_SIZES = (ATTN_WIDTH, KV_WIDTH, KV_WIDTH, KV_WIDTH, KV_WIDTH, KV_WIDTH, KV_WIDTH,
            N_BRANCH * N_ATTN_HEADS, MLP_WIDTH, MLP_WIDTH)
IN_WIDTH = sum(IN_SIZES)
CMP_LEN = 32
CMP_STRIDE = 16
CMP_HIDDEN = 256
SLC_LEN = 64
SLC_TOPK = 16
WINDOW = 512
QBLK = 64
CHUNK = 128
D_FF = -(-8 * D_MODEL // (3 * 256)) * 256
ALPHA = (2.0 * DEPTH) ** 0.25
BETA = (8.0 * DEPTH) ** -0.25
LN_EPS = 1e-5
NEG = -1e30
FORCED_SCORE = 1e6

kernel_name = "hymba_nsa_gmlp_deepnorm_adaln"


def layer_norm(x, g, b):
    xf = x.astype(jnp.float32)
    mu = xf.mean(-1, keepdims=True)
    var = jnp.square(xf - mu).mean(-1, keepdims=True)
    return ((xf - mu) * lax.rsqrt(var + LN_EPS) * g + b).astype(x.dtype)


def rms_norm(x, g):
    xf = x.astype(jnp.float32)
    return (xf * lax.rsqrt(jnp.square(xf).mean(-1, keepdims=True) + LN_EPS) * g).astype(x.dtype)


def masked_softmax(s, mask):
    return jax.nn.softmax(jnp.where(mask, s.astype(jnp.float32), NEG), axis=-1)


def alibi_slopes():
    h = jnp.arange(1, N_ATTN_HEADS + 1, dtype=jnp.float32)
    return jnp.exp2(-8.0 * h / N_ATTN_HEADS)


def compress(tok, pos, w1, w2):
    B, S = tok.shape[:2]
    ch = tok.reshape(B, S // CMP_STRIDE, CMP_STRIDE, N_KV_HEADS, HEAD_DIM)
    blk = jnp.concatenate([ch[:, :-1], ch[:, 1:]], axis=2)
    blk = blk + pos[None, None, :, None, :]
    nc = blk.shape[1]
    blk = jnp.moveaxis(blk, 3, 2).reshape(B, nc, N_KV_HEADS, CMP_LEN * HEAD_DIM)
    return jax.nn.gelu(blk @ w1) @ w2


def nsa_mixer(q, k_cmp, v_cmp, k_slc, v_slc, k_win, v_win, gates):
    B, S = q.shape[:2]
    nc = k_cmp.shape[1]
    nslc = S // SLC_LEN
    topk = min(SLC_TOPK, nslc)
    nqb = S // QBLK
    q = (q * HEAD_DIM ** -0.5).reshape(B, S, N_KV_HEADS, GQA_GROUP, HEAD_DIM)
    gates = gates.reshape(B, S, N_KV_HEADS, GQA_GROUP, N_BRANCH)
    slopes = alibi_slopes().reshape(N_KV_HEADS, GQA_GROUP)
    cstart = CMP_STRIDE * jnp.arange(nc)
    cmp_end = cstart + CMP_LEN - 1
    sstart = SLC_LEN * jnp.arange(nslc)
    overlap = ((cstart[:, None] <= sstart[None, :] + SLC_LEN - 1)
               & (cmp_end[:, None] >= sstart[None, :])).astype(jnp.float32)
    ks_t = jnp.transpose(k_slc, (0, 2, 1, 3))
    vs_t = jnp.transpose(v_slc, (0, 2, 1, 3))
    pad = ((0, 0), (WINDOW, 0), (0, 0), (0, 0))
    kw_pad = jnp.pad(k_win, pad)
    vw_pad = jnp.pad(v_win, pad)
    jj = jnp.arange(nslc)
    n_sel = topk * SLC_LEN

    def block(i):
        t0 = i * QBLK
        t = t0 + jnp.arange(QBLK)
        qb = lax.dynamic_slice_in_dim(q, t0, QBLK, axis=1)
        gb = lax.dynamic_slice_in_dim(gates, t0, QBLK, axis=1)
        d_c = (t[:, None] - cmp_end[None, :]).astype(jnp.float32)
        ok_c = d_c >= 0
        s_c = jnp.einsum('bqkgd,bnkd->bkgqn', qb, k_cmp).astype(jnp.float32) \
            - slopes[:, :, None, None] * d_c
        p_c = masked_softmax(s_c, ok_c) * ok_c.any(-1)[:, None]
        o_c = jnp.einsum('bkgqn,bnkd->bqkgd', p_c.astype(v_cmp.dtype), v_cmp)
        imp = jnp.einsum('bkgqn,nj->bkqj', p_c, overlap)
        cur = t // SLC_LEN
        ok_j = sstart[None, :] <= t[:, None]
        forced = (jj[None, :] == 0) | (jj[None, :] == cur[:, None]) | (jj[None, :] == cur[:, None] - 1)
        score = jnp.where(ok_j & forced, FORCED_SCORE, jnp.where(ok_j, imp, NEG))
        _, sel = lax.top_k(score, topk)
        tok = (sel[..., None] * SLC_LEN + jnp.arange(SLC_LEN)).reshape(B, N_KV_HEADS, QBLK * n_sel)
        kg = jnp.take_along_axis(ks_t, tok[..., None], axis=2).reshape(B, N_KV_HEADS, QBLK, n_sel, HEAD_DIM)
        vg = jnp.take_along_axis(vs_t, tok[..., None], axis=2).reshape(B, N_KV_HEADS, QBLK, n_sel, HEAD_DIM)
        tok = tok.reshape(B, N_KV_HEADS, QBLK, n_sel)
        d_s = (t[None, None, :, None] - tok).astype(jnp.float32)[:, :, None]
        s_s = jnp.einsum('bqkgd,bkqld->bkgql', qb, kg).astype(jnp.float32) \
            - slopes[None, :, :, None, None] * d_s
        p_s = masked_softmax(s_s, d_s >= 0)
        o_s = jnp.einsum('bkgql,bkqld->bqkgd', p_s.astype(vg.dtype), vg)
        kwb = lax.dynamic_slice_in_dim(kw_pad, t0, QBLK + WINDOW, axis=1)
        vwb = lax.dynamic_slice_in_dim(vw_pad, t0, QBLK + WINDOW, axis=1)
        spos = t0 - WINDOW + jnp.arange(QBLK + WINDOW)
        d_w = t[:, None] - spos[None, :]
        ok_w = (d_w >= 0) & (d_w < WINDOW) & (spos[None, :] >= 0)
        s_w = jnp.einsum('bqkgd,bskd->bkgqs', qb, kwb).astype(jnp.float32) \
            - slopes[:, :, None, None] * d_w.astype(jnp.float32)
        p_w = masked_softmax(s_w, ok_w)
        o_w = jnp.einsum('bkgqs,bskd->bqkgd', p_w.astype(vwb.dtype), vwb)
        g = jax.nn.sigmoid(gb.astype(jnp.float32))
        o = g[..., 0:1] * o_c + g[..., 1:2] * o_s + g[..., 2:3] * o_w
        return o.astype(q.dtype)

    out = lax.map(block, jnp.arange(nqb))
    return jnp.moveaxis(out, 0, 1).reshape(B, S, ATTN_WIDTH)


def gmlp_mixer(u, v, vn_g, vn_b, w_s, b_s):
    B, S, _ = u.shape
    v = v.reshape(B, S, N_MLP_GROUPS, MLP_GROUP_DIM)
    v = layer_norm(v, vn_g.reshape(N_MLP_GROUPS, MLP_GROUP_DIM), vn_b.reshape(N_MLP_GROUPS, MLP_GROUP_DIM))
    v = v.reshape(B, S // CHUNK, CHUNK, N_MLP_GROUPS, MLP_GROUP_DIM)
    causal = jnp.tril(jnp.ones((CHUNK, CHUNK), dtype=bool))
    w = jnp.where(causal[None], w_s, 0)
    sv = jnp.einsum('gts,bnsgd->bntgd', w, v) + b_s.T[:, :, None]
    return u * sv.reshape(B, S, MLP_WIDTH)


def hybrid_layer(x, c_act, w_ada, b_ada, w_in, cmp_pos, cmp_w1, cmp_w2, vn_g, vn_b,
                 w_s, b_s, out_g, w_o, ln1_g, ln1_b, w1, w3, w2, ln2_g, ln2_b):
    B, S, _ = x.shape
    mod = (c_act @ w_ada + b_ada)[:, None, :]
    sh1, sc1, g1, sh2, sc2, g2 = jnp.split(mod, 6, axis=-1)
    h = x * (1 + sc1) + sh1
    proj = h @ w_in
    offs = np.cumsum(np.array(IN_SIZES))[:-1].tolist()
    q, kc, vc, ksl, vsl, kwn, vwn, gt, u, v = jnp.split(proj, offs, axis=-1)
    kvs = lambda a: a.reshape(B, S, N_KV_HEADS, HEAD_DIM)
    k_cmp = compress(kvs(kc), cmp_pos[0], cmp_w1[0], cmp_w2[0])
    v_cmp = compress(kvs(vc), cmp_pos[1], cmp_w1[1], cmp_w2[1])
    o_attn = nsa_mixer(q.reshape(B, S, N_ATTN_HEADS, HEAD_DIM), k_cmp, v_cmp,
                       kvs(ksl), kvs(vsl), kvs(kwn), kvs(vwn),
                       gt.reshape(B, S, N_ATTN_HEADS, N_BRANCH))
    o_mlp = gmlp_mixer(jax.nn.gelu(u), jax.nn.gelu(v), vn_g, vn_b, w_s, b_s)
    y = jnp.concatenate([o_attn, o_mlp], axis=-1).reshape(B, S, MIX_WIDTH // HEAD_DIM, HEAD_DIM)
    y = rms_norm(y, out_g.reshape(MIX_WIDTH // HEAD_DIM, HEAD_DIM)).reshape(B, S, MIX_WIDTH) @ w_o
    x = layer_norm(ALPHA * x + (1 + g1) * y, ln1_g, ln1_b)
    h = x * (1 + sc2) + sh2
    f = (jax.nn.silu(h @ w1) * (h @ w3)) @ w2
    return layer_norm(ALPHA * x + (1 + g2) * f, ln2_g, ln2_b)


def setup_inputs(seed: int = 0) -> dict:
    key = jax.random.key(seed)
    ks = jax.random.split(key, 21)
    L = DEPTH
    nrm = lambda k, shape, s: jax.random.normal(k, shape, jnp.float32) * s
    return {
        "x": nrm(ks[0], (BATCH, SEQ, D_MODEL), 1.0),
        "c": nrm(ks[1], (BATCH, D_MODEL), 1.0),
        "w_ada": nrm(ks[2], (L, D_MODEL, 6 * D_MODEL), 0.1 * D_MODEL ** -0.5),
        "b_ada": nrm(ks[3], (L, 6 * D_MODEL), 0.02),
        "w_in": nrm(ks[4], (L, D_MODEL, IN_WIDTH), D_MODEL ** -0.5),
        "cmp_pos": nrm(ks[5], (L, 2, CMP_LEN, HEAD_DIM), 0.02),
        "cmp_w1": nrm(ks[6], (L, 2, CMP_LEN * HEAD_DIM, CMP_HIDDEN), (CMP_LEN * HEAD_DIM) ** -0.5),
        "cmp_w2": nrm(ks[7], (L, 2, CMP_HIDDEN, HEAD_DIM), CMP_HIDDEN ** -0.5),
        "vn_g": 1.0 + nrm(ks[8], (L, MLP_WIDTH), 0.02),
        "vn_b": nrm(ks[9], (L, MLP_WIDTH), 0.02),
        "w_s": nrm(ks[10], (L, N_MLP_GROUPS, CHUNK, CHUNK), CHUNK ** -0.5),
        "b_s": 1.0 + nrm(ks[11], (L, N_MLP_GROUPS, CHUNK), 0.02),
        "out_g": 1.0 + nrm(ks[12], (L, MIX_WIDTH), 0.02),
        "w_o": nrm(ks[13], (L, MIX_WIDTH, D_MODEL), BETA * MIX_WIDTH ** -0.5),
        "ln1_g": 1.0 + nrm(ks[14], (L, D_MODEL), 0.02),
        "ln1_b": nrm(ks[15], (L, D_MODEL), 0.02),
        "w1": nrm(ks[16], (L, D_MODEL, D_FF), D_MODEL ** -0.5),
        "w3": nrm(ks[17], (L, D_MODEL, D_FF), D_MODEL ** -0.5),
        "w2": nrm(ks[18], (L, D_FF, D_MODEL), BETA * D_FF ** -0.5),
        "ln2_g": 1.0 + nrm(ks[19], (L, D_MODEL), 0.02),
        "ln2_b": nrm(ks[20], (L, D_MODEL), 0.02),
    }


def reference(x, c, w_ada, b_ada, w_in, cmp_pos, cmp_w1, cmp_w2, vn_g, vn_b, w_s, b_s,
              out_g, w_o, ln1_g, ln1_b, w1, w3, w2, ln2_g, ln2_b):
    c_act = jax.nn.silu(c)
    for l in range(DEPTH):
        x = hybrid_layer(x, c_act, w_ada[l], b_ada[l], w_in[l], cmp_pos[l], cmp_w1[l], cmp_w2[l],
                         vn_g[l], vn_b[l], w_s[l], b_s[l], out_g[l], w_o[l],
                         ln1_g[l], ln1_b[l], w1[l], w3[l], w2[l], ln2_g[l], ln2_b[l])
    return x
```

```cpp
#define STOP_AFTER 0
#include <hip/hip_runtime.h>
#include <hip/hip_cooperative_groups.h>
#include <cstdio>
namespace cg = cooperative_groups;

typedef unsigned short u16;
using bf16x8 = __attribute__((ext_vector_type(8))) short;
using f32x4 = __attribute__((ext_vector_type(4))) float;
#define DI __device__ __forceinline__
#define MFMA16(a, b, c) __builtin_amdgcn_mfma_f32_16x16x32_bf16((a), (b), (c), 0, 0, 0)

constexpr int S = 8192, TOK = 65536;
constexpr int INW = 2328, INP = 2432;
constexpr float ALPHA = 1.41421356237f;
constexpr float LOG2E = 1.4426950408889634f;
constexpr float QSCALE = 0.125f * LOG2E;
constexpr float NEGB = -1e30f, MINIT = -30000.f;
constexpr float EPS = 1e-5f;

constexpr size_t SZ_WTIN = (size_t)INP * 1024 * 2;
constexpr size_t SZ_WTO = (size_t)1024 * 1024 * 2;
constexpr size_t SZ_WT13 = (size_t)5632 * 1024 * 2;
constexpr size_t SZ_WT2 = (size_t)1024 * 2816 * 2;
constexpr size_t SZ_WTC1 = (size_t)256 * 2048 * 2;
constexpr size_t SZ_WTC2 = (size_t)128 * 256 * 2;
constexpr size_t OFF_WTIN = 0;
constexpr size_t OFF_WTO = OFF_WTIN + 2 * SZ_WTIN;
constexpr size_t OFF_WT13 = OFF_WTO + 2 * SZ_WTO;
constexpr size_t OFF_WT2 = OFF_WT13 + 2 * SZ_WT13;
constexpr size_t OFF_WTC1 = OFF_WT2 + 2 * SZ_WT2;
constexpr size_t OFF_WTC2 = OFF_WTC1 + 4 * SZ_WTC1;
constexpr size_t OFF_MODP = OFF_WTC2 + 4 * SZ_WTC2;
constexpr size_t SZ_MOD = (size_t)2 * 8 * 6144 * 4;
constexpr size_t OFF_MOD = OFF_MODP + 16 * SZ_MOD;
constexpr size_t SZ_CMP = (size_t)8 * 2 * 512 * 64 * 2;
constexpr size_t OFF_KCMP = OFF_MOD + SZ_MOD;
constexpr size_t OFF_VCMPT = OFF_KCMP + SZ_CMP;
constexpr size_t OFF_X1 = OFF_VCMPT + SZ_CMP;
constexpr size_t OFF_H = OFF_X1 + (size_t)TOK * 1024 * 4;
constexpr size_t OFF_A = OFF_H + (size_t)TOK * 1024 * 2;
constexpr size_t SZ_KV = (size_t)TOK * 128 * 2;
constexpr size_t A_Q = 0;
constexpr size_t A_KC = A_Q + (size_t)TOK * 512 * 2;
constexpr size_t A_VC = A_KC + SZ_KV;
constexpr size_t A_KS = A_VC + SZ_KV;
constexpr size_t A_VST = A_KS + SZ_KV;
constexpr size_t A_KW = A_VST + SZ_KV;
constexpr size_t A_VWT = A_KW + SZ_KV;
constexpr size_t A_G = A_VWT + SZ_KV;
constexpr size_t A_U = A_G + (size_t)TOK * 24 * 4;
constexpr size_t A_VGT = A_U + (size_t)TOK * 512 * 2;
constexpr size_t A_AC = A_VGT + (size_t)TOK * 512 * 2;
constexpr size_t A_HC = A_AC + (size_t)2 * 8192 * 2048 * 2;
constexpr size_t A_END = A_HC + (size_t)2 * 8192 * 256 * 2;

struct Params {
  const float *x, *c, *w_ada, *b_ada, *w_in, *cmp_pos, *cmp_w1, *cmp_w2, *vn_g, *vn_b, *w_s, *b_s, *out_g, *w_o,
      *ln1_g, *ln1_b, *w1, *w3, *w2, *ln2_g, *ln2_b;
  float* out;
  char* ws;
};

DI u16 f2bf(float x) { unsigned u = __float_as_uint(x); u += 0x7fffu + ((u >> 16) & 1u); return (u16)(u >> 16); }
DI float bf2f(u16 h) { return __uint_as_float(((unsigned)h) << 16); }
DI unsigned pack2(float a, float b) { return (unsigned)f2bf(a) | ((unsigned)f2bf(b) << 16); }
DI float gelu_t(float x) { float u = 1.5957691216f * (x + 0.044715f * x * x * x); return x / (1.f + __expf(-u)); }
DI float sigm(float x) { return 1.f / (1.f + __expf(-x)); }
DI float ex2(float x) { return __builtin_amdgcn_exp2f(x); }
DI int otid() { int t = threadIdx.x; asm volatile("" : "+v"(t)); return t; }

template <int MODE> DI int map_row(int n) {
  if (MODE == 1) return n < 1280 ? n : (n < 1304 ? n + 1024 : n - 24);
  if (MODE == 2) return (n >> 5) * 64 + (n & 31);
  if (MODE == 3) return (n >> 5) * 64 + 32 + (n & 31);
  return n;
}

template <int MODE>
DI void conv_tile(const float* __restrict__ W, int K, int N, u16* __restrict__ Wt, int ldk, int tile, float* tl) {
  const int tiles_n = (N + 63) / 64;
  const int tk = tile / tiles_n, tn = tile % tiles_n;
  const int k0 = tk * 64, n0 = tn * 64;
  const int tid = otid();
#pragma unroll
  for (int i = 0; i < 16; ++i) {
    int idx = tid + 256 * i;
    int r = idx >> 6, c = idx & 63;
    int n = n0 + c;
    tl[r * 65 + c] = (n < N) ? W[(long)(k0 + r) * N + n] : 0.f;
  }
  __syncthreads();
  const int nl = tid >> 2, kc = tid & 3;
  const int n = n0 + nl;
  if (n < N) {
    const int row = map_row<MODE>(n);
    unsigned pk[8];
#pragma unroll
    for (int i = 0; i < 8; ++i) pk[i] = pack2(tl[(kc * 16 + 2 * i) * 65 + nl], tl[(kc * 16 + 2 * i + 1) * 65 + nl]);
    uint4* dst = (uint4*)(Wt + (long)row * ldk + k0 + kc * 16);
    dst[0] = make_uint4(pk[0], pk[1], pk[2], pk[3]);
    dst[1] = make_uint4(pk[4], pk[5], pk[6], pk[7]);
  }
  __syncthreads();
}

DI void phase0a(const Params& p, char* smem) {
  char* ws = p.ws;
  const int tid = threadIdx.x;
  constexpr int PER_LAYER = 592 + 256 + 704 * 3 + 128 * 2 + 4 * 2;
  constexpr int NCONV = 2 * PER_LAYER;
  constexpr int NTOT = NCONV + 768 + 2;
  for (int it = blockIdx.x; it < NTOT; it += gridDim.x) {
    if (it < NCONV) {
      const int l = it / PER_LAYER;
      const int li = it % PER_LAYER;
      int base = 0;
#define SEG(MODE, SRC, DST, K_, N_, LDK)                                                   \
  {                                                                                        \
    const int nt_ = ((K_) / 64) * (((N_) + 63) / 64);                                      \
    if (li >= base && li < base + nt_) conv_tile<MODE>(SRC, K_, N_, DST, LDK, li - base, (float*)smem); \
    base += nt_;                                                                           \
  }
      SEG(1, p.w_in + (size_t)l * 1024 * INW, (u16*)(ws + OFF_WTIN + l * SZ_WTIN), 1024, INW, 1024)
      SEG(0, p.w_o + (size_t)l * 1024 * 1024, (u16*)(ws + OFF_WTO + l * SZ_WTO), 1024, 1024, 1024)
      SEG(2, p.w1 + (size_t)l * 1024 * 2816, (u16*)(ws + OFF_WT13 + l * SZ_WT13), 1024, 2816, 1024)
      SEG(3, p.w3 + (size_t)l * 1024 * 2816, (u16*)(ws + OFF_WT13 + l * SZ_WT13), 1024, 2816, 1024)
      SEG(0, p.w2 + (size_t)l * 2816 * 1024, (u16*)(ws + OFF_WT2 + l * SZ_WT2), 2816, 1024, 2816)
      SEG(0, p.cmp_w1 + (size_t)(l * 2 + 0) * 2048 * 256, (u16*)(ws + OFF_WTC1 + (l * 2 + 0) * SZ_WTC1), 2048, 256, 2048)
      SEG(0, p.cmp_w1 + (size_t)(l * 2 + 1) * 2048 * 256, (u16*)(ws + OFF_WTC1 + (l * 2 + 1) * SZ_WTC1), 2048, 256, 2048)
      SEG(0, p.cmp_w2 + (size_t)(l * 2 + 0) * 256 * 64, (u16*)(ws + OFF_WTC2 + (l * 2 + 0) * SZ_WTC2), 256, 64, 256)
      SEG(0, p.cmp_w2 + (size_t)(l * 2 + 1) * 256 * 64, (u16*)(ws + OFF_WTC2 + (l * 2 + 1) * SZ_WTC2), 256, 64, 256)
#undef SEG
    } else if (it < NCONV + 768) {
      const int idx = it - NCONV;
      const int l = idx / 384, r = idx % 384, nb = r / 16, kc = r % 16;
      float* cs = (float*)smem;
      for (int i = tid; i < 512; i += 256) {
        int b = i >> 6, k = i & 63;
        float cv = p.c[b * 1024 + kc * 64 + k];
        cs[i] = cv * sigm(cv);
      }
      __syncthreads();
      const int n = nb * 256 + tid;
      float acc[8];
#pragma unroll
      for (int b = 0; b < 8; ++b) acc[b] = 0.f;
      const float* wp = p.w_ada + ((size_t)l * 1024 + kc * 64) * 6144 + n;
#pragma unroll 8
      for (int k = 0; k < 64; ++k) {
        float wv = wp[(size_t)k * 6144];
#pragma unroll
        for (int b = 0; b < 8; ++b) acc[b] += cs[b * 64 + k] * wv;
      }
      float* modp = (float*)(ws + OFF_MODP);
#pragma unroll
      for (int b = 0; b < 8; ++b) modp[(size_t)((kc * 2 + l) * 8 + b) * 6144 + n] = acc[b];
      __syncthreads();
    } else {
      const int l = it - NCONV - 768;
      uint4* dst = (uint4*)(ws + OFF_WTIN + l * SZ_WTIN + (size_t)INW * 1024 * 2);
      const int n16 = (INP - INW) * 1024 * 2 / 16;
      for (int i = tid; i < n16; i += 256) dst[i] = make_uint4(0, 0, 0, 0);
    }
  }
}

DI void phase0b(const Params& p) {
  const float* modp = (const float*)(p.ws + OFF_MODP);
  float* mod = (float*)(p.ws + OFF_MOD);
  const int n = 2 * 8 * 6144;
  for (int i = blockIdx.x * 256 + threadIdx.x; i < n; i += gridDim.x * 256) {
    int l = i / (8 * 6144), c = i % 6144;
    float a = p.b_ada[l * 6144 + c];
#pragma unroll
    for (int kc = 0; kc < 16; ++kc) a += modp[(size_t)kc * n + i];
    mod[i] = a;
  }
}

DI void phase_mod_x(const Params& p) {
  const float* mod = (const float*)(p.ws + OFF_MOD);
  u16* H = (u16*)(p.ws + OFF_H);
  const long nchunk = (long)TOK * 1024 / 8;
  for (long i = (long)blockIdx.x * 256 + otid(); i < nchunk; i += (long)gridDim.x * 256) {
    long e = i * 8;
    int col = (int)(e & 1023);
    int b = (int)(e >> 23);
    const float4* xp = (const float4*)(p.x + e);
    const float4* sh = (const float4*)(mod + (size_t)b * 6144 + 0 + col);
    const float4* sc = (const float4*)(mod + (size_t)b * 6144 + 1024 + col);
    float4 x0 = xp[0], x1 = xp[1], s0 = sc[0], s1 = sc[1], h0 = sh[0], h1 = sh[1];
    uint4 o;
    o.x = pack2(x0.x * (1.f + s0.x) + h0.x, x0.y * (1.f + s0.y) + h0.y);
    o.y = pack2(x0.z * (1.f + s0.z) + h0.z, x0.w * (1.f + s0.w) + h0.w);
    o.z = pack2(x1.x * (1.f + s1.x) + h1.x, x1.y * (1.f + s1.y) + h1.y);
    o.w = pack2(x1.z * (1.f + s1.z) + h1.z, x1.w * (1.f + s1.w) + h1.w);
    *(uint4*)(H + e) = o;
  }
}

template <class Epi>
DI void gemm_phase(const u16* __restrict__ A, int lda, const u16* __restrict__ Bt, int ldb, int ntm, int ntn, int K,
                           int vb, int nvb, char* smem, Epi epi) {
  if (vb < 0 || vb >= nvb) return;
  const int tid = otid(), lane = tid & 63, w = tid >> 6, wm = w >> 1, wn = w & 1;
  const int lr = lane & 15, lg = lane >> 4;
  const int ntiles = ntm * ntn;
  const int nk = K / 64;
  for (int tile = vb; tile < ntiles; tile += nvb) {
    const int tm = tile / ntn, tn = tile % ntn;
    const u16* Ap = A + (size_t)tm * 128 * lda;
    const u16* Bp = Bt + (size_t)tn * 128 * ldb;
    f32x4 acc[4][4];
#pragma unroll
    for (int i = 0; i < 4; ++i)
#pragma unroll
      for (int j = 0; j < 4; ++j) acc[i][j] = f32x4{0.f, 0.f, 0.f, 0.f};
    uint4 ra[4], rb[4];
#pragma unroll
    for (int i = 0; i < 4; ++i) {
      int idx = tid + 256 * i, r = idx >> 3, ch = idx & 7;
      ra[i] = *(const uint4*)(Ap + (size_t)r * lda + ch * 8);
      rb[i] = *(const uint4*)(Bp + (size_t)r * ldb + ch * 8);
    }
#pragma unroll
    for (int i = 0; i < 4; ++i) {
      int idx = tid + 256 * i, r = idx >> 3, ch = idx & 7;
      *(uint4*)(smem + r * 128 + ((ch ^ (r & 7)) << 4)) = ra[i];
      *(uint4*)(smem + 16384 + r * 128 + ((ch ^ (r & 7)) << 4)) = rb[i];
    }
    __syncthreads();
    for (int kt = 0; kt < nk; ++kt) {
      const bool more = (kt + 1 < nk);
      if (more) {
#pragma unroll
        for (int i = 0; i < 4; ++i) {
          int idx = tid + 256 * i, r = idx >> 3, ch = idx & 7;
          ra[i] = *(const uint4*)(Ap + (size_t)r * lda + (kt + 1) * 64 + ch * 8);
          rb[i] = *(const uint4*)(Bp + (size_t)r * ldb + (kt + 1) * 64 + ch * 8);
        }
      }
      const char* sA = smem + (kt & 1) * 32768;
      const char* sB = sA + 16384;
#pragma unroll
      for (int s = 0; s < 2; ++s) {
        bf16x8 af[4], bfr[4];
#pragma unroll
        for (int mi = 0; mi < 4; ++mi) {
          int r = wm * 64 + mi * 16 + lr;
          af[mi] = *(const bf16x8*)(sA + r * 128 + (((s * 4 + lg) ^ (r & 7)) << 4));
        }
#pragma unroll
        for (int ni = 0; ni < 4; ++ni) {
          int r = wn * 64 + ni * 16 + lr;
          bfr[ni] = *(const bf16x8*)(sB + r * 128 + (((s * 4 + lg) ^ (r & 7)) << 4));
        }
#pragma unroll
        for (int mi = 0; mi < 4; ++mi)
#pragma unroll
          for (int ni = 0; ni < 4; ++ni) acc[mi][ni] = MFMA16(af[mi], bfr[ni], acc[mi][ni]);
      }
      if (more) {
        char* dA = smem + ((kt + 1) & 1) * 32768;
#pragma unroll
        for (int i = 0; i < 4; ++i) {
          int idx = tid + 256 * i, r = idx >> 3, ch = idx & 7;
          *(uint4*)(dA + r * 128 + ((ch ^ (r & 7)) << 4)) = ra[i];
          *(uint4*)(dA + 16384 + r * 128 + ((ch ^ (r & 7)) << 4)) = rb[i];
        }
      }
      __syncthreads();
    }
    epi(tm, tn, wm, wn, lr, lg, acc);
  }
}

DI void ln_rows(float* buf, const float* __restrict__ g, const float* __restrict__ bt, const float* __restrict__ modl,
                        int sh_off, int sc_off, u16* H) {
  const int tid_ = otid();
  const int lane = tid_ & 63, w = tid_ >> 6;
  for (int row = blockIdx.x * 4 + w; row < TOK; row += gridDim.x * 4) {
    float4* rp = (float4*)(buf + (size_t)row * 1024);
    float4 v[4];
    float s = 0.f;
#pragma unroll
    for (int i = 0; i < 4; ++i) { v[i] = rp[lane + 64 * i]; s += v[i].x + v[i].y + v[i].z + v[i].w; }
#pragma unroll
    for (int o = 32; o >= 1; o >>= 1) s += __shfl_xor(s, o);
    const float mu = s * (1.f / 1024.f);
    float q = 0.f;
#pragma unroll
    for (int i = 0; i < 4; ++i) {
      float a = v[i].x - mu, b = v[i].y - mu, c = v[i].z - mu, d = v[i].w - mu;
      q += a * a + b * b + c * c + d * d;
    }
#pragma unroll
    for (int o = 32; o >= 1; o >>= 1) q += __shfl_xor(q, o);
    const float rs = rsqrtf(q * (1.f / 1024.f) + EPS);
    const int b = row >> 13;
#pragma unroll
    for (int i = 0; i < 4; ++i) {
      const int col = (lane + 64 * i) * 4;
      float4 gg = *(const float4*)(g + col), bb = *(const float4*)(bt + col);
      float4 y;
      y.x = (v[i].x - mu) * rs * gg.x + bb.x;
      y.y = (v[i].y - mu) * rs * gg.y + bb.y;
      y.z = (v[i].z - mu) * rs * gg.z + bb.z;
      y.w = (v[i].w - mu) * rs * gg.w + bb.w;
      rp[lane + 64 * i] = y;
      if (H) {
        float4 sh = *(const float4*)(modl + (size_t)b * 6144 + sh_off + col);
        float4 sc = *(const float4*)(modl + (size_t)b * 6144 + sc_off + col);
        uint2 o2;
        o2.x = pack2(y.x * (1.f + sc.x) + sh.x, y.y * (1.f + sc.y) + sh.y);
        o2.y = pack2(y.z * (1.f + sc.z) + sh.z, y.w * (1.f + sc.w) + sh.w);
        *(uint2*)(H + (size_t)row * 1024 + col) = o2;
      }
    }
  }
}

DI void build_ac(const Params& p, int l) {
  const u16* KC = (const u16*)(p.ws + OFF_A + A_KC);
  const u16* VC = (const u16*)(p.ws + OFF_A + A_VC);
  u16* AC = (u16*)(p.ws + OFF_A + A_AC);
  const long nchunk = (long)2 * 8192 * 256;
  for (long i = (long)blockIdx.x * 256 + otid(); i < nchunk; i += (long)gridDim.x * 256) {
    const int which = (int)(i >> 21);
    const int rem = (int)(i & ((1 << 21) - 1));
    const int row = rem >> 8, ck = rem & 255;
    const int r = ck >> 3, d0 = (ck & 7) * 8;
    const int bk = row >> 9, n = row & 511;
    const int b = bk >> 1, kvh = bk & 1;
    int t = 16 * n + r;
    if (t > S - 1) t = S - 1;
    const u16* src = (which ? VC : KC) + ((size_t)b * S + t) * 128 + kvh * 64 + d0;
    uint4 v = *(const uint4*)src;
    const float4* pp = (const float4*)(p.cmp_pos + ((size_t)(l * 2 + which) * 32 + r) * 64 + d0);
    float4 p0 = pp[0], p1 = pp[1];
    uint4 o;
    o.x = pack2(bf2f(v.x & 0xffff) + p0.x, bf2f(v.x >> 16) + p0.y);
    o.y = pack2(bf2f(v.y & 0xffff) + p0.z, bf2f(v.y >> 16) + p0.w);
    o.z = pack2(bf2f(v.z & 0xffff) + p1.x, bf2f(v.z >> 16) + p1.y);
    o.w = pack2(bf2f(v.w & 0xffff) + p1.z, bf2f(v.w >> 16) + p1.w);
    *(uint4*)(AC + ((size_t)which * 8192 + row) * 2048 + r * 64 + d0) = o;
  }
}

DI void gmlp_item(const Params& p, int l, int item) {
  const int b = item >> 9, c = (item >> 3) & 63, grp = item & 7;
  const int tid_ = otid();
  const int lane = tid_ & 63, w = tid_ >> 6, lr = lane & 15, lg = lane >> 4;
  const float* wsp = p.w_s + (size_t)(l * 8 + grp) * 128 * 128;
  const u16* vgt = (const u16*)(p.ws + OFF_A + A_VGT) + (size_t)(b * 8 + grp) * 64 * S + c * 128;
  const u16* U = (const u16*)(p.ws + OFF_A + A_U);
  u16* OM = (u16*)(p.ws + OFF_H);
  f32x4 acc[4][2];
#pragma unroll
  for (int i = 0; i < 4; ++i)
#pragma unroll
    for (int j = 0; j < 2; ++j) acc[i][j] = f32x4{0.f, 0.f, 0.f, 0.f};
#pragma unroll
  for (int ks = 0; ks < 4; ++ks) {
    const int s0 = ks * 32 + lg * 8;
    bf16x8 af[4];
#pragma unroll
    for (int dt = 0; dt < 4; ++dt) af[dt] = *(const bf16x8*)(vgt + (size_t)(dt * 16 + lr) * S + s0);
#pragma unroll
    for (int nt = 0; nt < 2; ++nt) {
      const int t = w * 32 + nt * 16 + lr;
      const float4* wp = (const float4*)(wsp + t * 128 + s0);
      float4 a0 = wp[0], a1 = wp[1];
      unsigned pw[4];
      pw[0] = pack2((s0 + 0 <= t) ? a0.x : 0.f, (s0 + 1 <= t) ? a0.y : 0.f);
      pw[1] = pack2((s0 + 2 <= t) ? a0.z : 0.f, (s0 + 3 <= t) ? a0.w : 0.f);
      pw[2] = pack2((s0 + 4 <= t) ? a1.x : 0.f, (s0 + 5 <= t) ? a1.y : 0.f);
      pw[3] = pack2((s0 + 6 <= t) ? a1.z : 0.f, (s0 + 7 <= t) ? a1.w : 0.f);
      bf16x8 bw = __builtin_bit_cast(bf16x8, make_uint4(pw[0], pw[1], pw[2], pw[3]));
#pragma unroll
      for (int dt = 0; dt < 4; ++dt) acc[dt][nt] = MFMA16(af[dt], bw, acc[dt][nt]);
    }
  }
#pragma unroll
  for (int nt = 0; nt < 2; ++nt) {
    const int t = w * 32 + nt * 16 + lr;
    const size_t tok = (size_t)b * S + c * 128 + t;
    const float bias = p.b_s[(l * 8 + grp) * 128 + t];
    float val[4][4];
    float ss = 0.f;
#pragma unroll
    for (int dt = 0; dt < 4; ++dt) {
      const int d = dt * 16 + lg * 4;
      const uint2 uu = *(const uint2*)(U + tok * 512 + grp * 64 + d);
      const float u0 = bf2f(uu.x & 0xffff), u1 = bf2f(uu.x >> 16), u2 = bf2f(uu.y & 0xffff), u3 = bf2f(uu.y >> 16);
      val[dt][0] = u0 * (acc[dt][nt][0] + bias);
      val[dt][1] = u1 * (acc[dt][nt][1] + bias);
      val[dt][2] = u2 * (acc[dt][nt][2] + bias);
      val[dt][3] = u3 * (acc[dt][nt][3] + bias);
#pragma unroll
      for (int j = 0; j < 4; ++j) ss += val[dt][j] * val[dt][j];
    }
    ss += __shfl_xor(ss, 16);
    ss += __shfl_xor(ss, 32);
    const float r = rsqrtf(ss * (1.f / 64.f) + EPS);
#pragma unroll
    for (int dt = 0; dt < 4; ++dt) {
      const int d = dt * 16 + lg * 4;
      const float4 gg = *(const float4*)(p.out_g + l * 1024 + 512 + grp * 64 + d);
      uint2 st;
      st.x = pack2(val[dt][0] * r * gg.x, val[dt][1] * r * gg.y);
      st.y = pack2(val[dt][2] * r * gg.z, val[dt][3] * r * gg.w);
      *(uint2*)(OM + tok * 1024 + 512 + grp * 64 + d) = st;
    }
  }
}

constexpr int SM_K = 0, SM_V = 8192, SM_IMP = 8192 + 8704, SM_SEL = SM_IMP + 64 * 132 * 4, SM_UNI = SM_SEL + 1024;

DI void load_k_tile(const u16* __restrict__ src, int stride, char* sK, int tid) {
#pragma unroll
  for (int i = 0; i < 2; ++i) {
    int idx = tid + 256 * i, r = idx >> 3, ch = idx & 7;
    uint4 v = *(const uint4*)(src + (size_t)r * stride + ch * 8);
    *(uint4*)(sK + r * 128 + ((ch ^ (r & 7)) << 4)) = v;
  }
}
DI void load_vt_tile(const u16* __restrict__ src, int stride, char* sV, int tid) {
#pragma unroll
  for (int i = 0; i < 2; ++i) {
    int idx = tid + 256 * i, d = idx >> 3, ch = idx & 7;
    uint4 v = *(const uint4*)(src + (size_t)d * stride + ch * 8);
    uint2* dst = (uint2*)(sV + d * 136 + ch * 16);
    dst[0] = make_uint2(v.x, v.y);
    dst[1] = make_uint2(v.z, v.w);
  }
}

template <int MODE>
DI void half_step(const char* sK, const char* sV, int half, int lr, int lg, const bf16x8 (&qf)[2][2], const float (&slope)[2],
                  float (&m)[2], float (&lsum)[2], f32x4 (&o)[2][4], const float (&posf)[2][4], const bool (&valid)[2][4],
                  float (&psum)[2][4]) {
  bf16x8 kf[2][2];
#pragma unroll
  for (int kt2 = 0; kt2 < 2; ++kt2) {
    const int r = half * 32 + kt2 * 16 + lr;
    kf[kt2][0] = *(const bf16x8*)(sK + r * 128 + (((lg) ^ (r & 7)) << 4));
    kf[kt2][1] = *(const bf16x8*)(sK + r * 128 + (((4 + lg) ^ (r & 7)) << 4));
  }
  if (MODE == 1) {
#pragma unroll
    for (int a = 0; a < 2; ++a)
#pragma unroll
      for (int j = 0; j < 4; ++j) psum[a][j] = 0.f;
  }
  bf16x8 pf[2];
#pragma unroll
  for (int h = 0; h < 2; ++h) {
    f32x4 s[2];
#pragma unroll
    for (int kt2 = 0; kt2 < 2; ++kt2) {
      f32x4 z = f32x4{0.f, 0.f, 0.f, 0.f};
      z = MFMA16(kf[kt2][0], qf[h][0], z);
      z = MFMA16(kf[kt2][1], qf[h][1], z);
      s[kt2] = z;
    }
    float mx = NEGB;
#pragma unroll
    for (int kt2 = 0; kt2 < 2; ++kt2)
#pragma unroll
      for (int j = 0; j < 4; ++j) {
        float v = valid[kt2][j] ? (s[kt2][j] + slope[h] * posf[kt2][j]) : NEGB;
        s[kt2][j] = v;
        mx = fmaxf(mx, v);
      }
    if (MODE != 1) {
      mx = fmaxf(mx, __shfl_xor(mx, 16));
      mx = fmaxf(mx, __shfl_xor(mx, 32));
      const float mn = fmaxf(m[h], mx);
      const float alpha = ex2(m[h] - mn);
      m[h] = mn;
      float ps = 0.f;
#pragma unroll
      for (int kt2 = 0; kt2 < 2; ++kt2)
#pragma unroll
        for (int j = 0; j < 4; ++j) {
          float pv = ex2(s[kt2][j] - mn);
          s[kt2][j] = pv;
          ps += pv;
        }
      lsum[h] = lsum[h] * alpha + ps;
      if (MODE == 2) {
#pragma unroll
        for (int dt = 0; dt < 4; ++dt) o[h][dt] *= alpha;
      }
    } else {
#pragma unroll
      for (int kt2 = 0; kt2 < 2; ++kt2)
#pragma unroll
        for (int j = 0; j < 4; ++j) {
          float pv = ex2(s[kt2][j] - m[h]) * lsum[h];
          s[kt2][j] = pv;
          psum[kt2][j] += pv;
        }
    }
    if (MODE != 0) {
      uint4 pk = make_uint4(pack2(s[0][0], s[0][1]), pack2(s[0][2], s[0][3]), pack2(s[1][0], s[1][1]), pack2(s[1][2], s[1][3]));
      pf[h] = __builtin_bit_cast(bf16x8, pk);
    }
  }
  if (MODE != 0) {
#pragma unroll
    for (int dt = 0; dt < 4; ++dt) {
      const char* base = sV + (dt * 16 + lr) * 136 + half * 64 + lg * 8;
      uint2 a = *(const uint2*)(base);
      uint2 c = *(const uint2*)(base + 32);
      bf16x8 vf = __builtin_bit_cast(bf16x8, make_uint4(a.x, a.y, c.x, c.y));
#pragma unroll
      for (int h = 0; h < 2; ++h) o[h][dt] = MFMA16(vf, pf[h], o[h][dt]);
    }
  }
}

DI void attn_item(const Params& p, int l, int b, int kvh, int qh, char* smem) {
  char* sK = smem + SM_K;
  char* sV = smem + SM_V;
  float* sImp = (float*)(smem + SM_IMP);
  unsigned* sSel = (unsigned*)(smem + SM_SEL);
  unsigned* sUni = (unsigned*)(smem + SM_UNI);
  const char* wsA = p.ws + OFF_A;
  const u16* Q = (const u16*)(wsA + A_Q);
  const u16* KS = (const u16*)(wsA + A_KS);
  const u16* VST = (const u16*)(wsA + A_VST);
  const u16* KW = (const u16*)(wsA + A_KW);
  const u16* VWT = (const u16*)(wsA + A_VWT);
  const float* G = (const float*)(wsA + A_G);
  const u16* KCMP = (const u16*)(p.ws + OFF_KCMP);
  const u16* VCMPT = (const u16*)(p.ws + OFF_VCMPT);
  u16* OM = (u16*)(p.ws + OFF_H);

  const int tid = otid(), lane = tid & 63, w = tid >> 6, lr = lane & 15, lg = lane >> 4;
  const int hp = w >> 1;
  const int t0 = qh * 32;
  const int cur = qh >> 1;
  const int tql = 16 * (w & 1) + lr;
  const size_t tokq = (size_t)b * S + t0 + tql;
  const int bk = b * 2 + kvh;
  const int hg0 = kvh * 4 + hp * 2;

  bf16x8 qf[2][2];
  float slope[2];
#pragma unroll
  for (int h = 0; h < 2; ++h) {
    const u16* qp = Q + tokq * 512 + (hg0 + h) * 64 + lg * 8;
    qf[h][0] = *(const bf16x8*)qp;
    qf[h][1] = *(const bf16x8*)(qp + 32);
    slope[h] = ex2(-(float)(hg0 + h + 1)) * LOG2E;
  }
  float m[2], ls[2];
  f32x4 o[2][4], otot[2][4];
  float psum[2][4];
#pragma unroll
  for (int h = 0; h < 2; ++h) {
    m[h] = MINIT;
    ls[h] = 0.f;
#pragma unroll
    for (int dt = 0; dt < 4; ++dt) o[h][dt] = f32x4{0.f, 0.f, 0.f, 0.f};
  }

  const int amax = qh >> 5;
  const u16* kc_base = KCMP + (size_t)bk * 512 * 64;
  const u16* vc_base = VCMPT + (size_t)bk * 64 * 512;
  for (int a = 0; a <= amax; ++a) {
    __syncthreads();
    load_k_tile(kc_base + (size_t)a * 64 * 64, 64, sK, tid);
    __syncthreads();
#pragma unroll
    for (int half = 0; half < 2; ++half) {
      float posf[2][4];
      bool valid[2][4];
#pragma unroll
      for (int kt2 = 0; kt2 < 2; ++kt2)
#pragma unroll
        for (int j = 0; j < 4; ++j) {
          int n = a * 64 + half * 32 + kt2 * 16 + lg * 4 + j;
          int rel = 16 * n + 31 - t0;
          posf[kt2][j] = (float)rel;
          valid[kt2][j] = rel <= tql;
        }
      half_step<0>(sK, sV, half, lr, lg, qf, slope, m, ls, o, posf, valid, psum);
    }
  }
#pragma unroll
  for (int h = 0; h < 2; ++h) {
    float x = ls[h];
    x += __shfl_xor(x, 16);
    x += __shfl_xor(x, 32);
    ls[h] = x > 0.f ? 1.f / x : 0.f;
  }
  float carry = 0.f;
  float* myImp = sImp + hp * (32 * 132);
  for (int a = 0; a <= amax; ++a) {
    __syncthreads();
    load_k_tile(kc_base + (size_t)a * 64 * 64, 64, sK, tid);
    load_vt_tile(vc_base + a * 64, 512, sV, tid);
    __syncthreads();
#pragma unroll
    for (int half = 0; half < 2; ++half) {
      float posf[2][4];
      bool valid[2][4];
#pragma unroll
      for (int kt2 = 0; kt2 < 2; ++kt2)
#pragma unroll
        for (int j = 0; j < 4; ++j) {
          int n = a * 64 + half * 32 + kt2 * 16 + lg * 4 + j;
          int rel = 16 * n + 31 - t0;
          posf[kt2][j] = (float)rel;
          valid[kt2][j] = rel <= tql;
        }
      half_step<1>(sK, sV, half, lr, lg, qf, slope, m, ls, o, posf, valid, psum);
      float prev = carry;
#pragma unroll
      for (int kt2 = 0; kt2 < 2; ++kt2) {
        float sum4 = psum[kt2][0] + psum[kt2][1] + psum[kt2][2] + psum[kt2][3];
        float p3 = psum[kt2][3];
        float up = __shfl(p3, (lane + 48) & 63);
        float wrap = __shfl(prev, (lane + 48) & 63);
        float spill = lg > 0 ? up : wrap;
        int j = a * 16 + half * 8 + kt2 * 4 + lg;
        myImp[tql * 132 + j] = sum4 + spill;
        prev = p3;
      }
      carry = prev;
    }
  }
#pragma unroll
  for (int h = 0; h < 2; ++h) {
    const float g0 = G[tokq * 24 + (hg0 + h) * 3 + 0];
#pragma unroll
    for (int dt = 0; dt < 4; ++dt) {
      otot[h][dt] = o[h][dt] * g0;
      o[h][dt] = f32x4{0.f, 0.f, 0.f, 0.f};
    }
    m[h] = MINIT;
    ls[h] = 0.f;
  }
  if (tid < 4) sUni[tid] = 0u;
  __syncthreads();
  if (tid < 128) {
    const int q = tid >> 2, sub = tid & 3;
    unsigned mk[4] = {0u, 0u, 0u, 0u};
    if (cur < 16) {
      mk[0] = (1u << (cur + 1)) - 1u;
    } else {
      float v[32];
#pragma unroll
      for (int i = 0; i < 32; ++i) {
        int j = sub + 4 * i;
        v[i] = (j >= 1 && j <= cur - 2) ? (sImp[q * 132 + j] + sImp[32 * 132 + q * 132 + j]) : -1.f;
      }
      for (int round = 0; round < 13; ++round) {
        float bv = v[0];
        int bi = 0;
#pragma unroll
        for (int i = 1; i < 32; ++i)
          if (v[i] > bv) { bv = v[i]; bi = i; }
        int bj = sub + 4 * bi;
#pragma unroll
        for (int off = 1; off <= 2; off <<= 1) {
          float ov = __shfl_xor(bv, off);
          int oj = __shfl_xor(bj, off);
          if (ov > bv || (ov == bv && oj < bj)) { bv = ov; bj = oj; }
        }
#pragma unroll
        for (int i = 0; i < 32; ++i)
          if (sub + 4 * i == bj) v[i] = -2.f;
#pragma unroll
        for (int wd = 0; wd < 4; ++wd) mk[wd] |= ((bj >> 5) == wd) ? (1u << (bj & 31)) : 0u;
      }
      const int f1 = cur, f2 = cur - 1;
      mk[0] |= 1u;
#pragma unroll
      for (int wd = 0; wd < 4; ++wd) {
        mk[wd] |= ((f1 >> 5) == wd) ? (1u << (f1 & 31)) : 0u;
        mk[wd] |= ((f2 >> 5) == wd) ? (1u << (f2 & 31)) : 0u;
      }
    }
    if (sub == 0) {
#pragma unroll
      for (int wd = 0; wd < 4; ++wd) {
        sSel[q * 4 + wd] = mk[wd];
        atomicOr(&sUni[wd], mk[wd]);
      }
    }
  }
  __syncthreads();
  for (int j = 0; j <= cur; ++j) {
    const unsigned uw = sUni[j >> 5];
    if (!((uw >> (j & 31)) & 1u)) continue;
    __syncthreads();
    load_k_tile(KS + ((size_t)b * S + j * 64) * 128 + kvh * 64, 128, sK, tid);
    load_vt_tile(VST + (size_t)bk * 64 * S + j * 64, S, sV, tid);
    __syncthreads();
    const bool selbit = (sSel[tql * 4 + (j >> 5)] >> (j & 31)) & 1u;
#pragma unroll
    for (int half = 0; half < 2; ++half) {
      float posf[2][4];
      bool valid[2][4];
#pragma unroll
      for (int kt2 = 0; kt2 < 2; ++kt2)
#pragma unroll
        for (int jj = 0; jj < 4; ++jj) {
          int rel = j * 64 - t0 + half * 32 + kt2 * 16 + lg * 4 + jj;
          posf[kt2][jj] = (float)rel;
          valid[kt2][jj] = selbit && (rel <= tql);
        }
      half_step<2>(sK, sV, half, lr, lg, qf, slope, m, ls, o, posf, valid, psum);
    }
  }
#pragma unroll
  for (int h = 0; h < 2; ++h) {
    float x = ls[h];
    x += __shfl_xor(x, 16);
    x += __shfl_xor(x, 32);
    const float f = (x > 0.f ? 1.f / x : 0.f) * G[tokq * 24 + (hg0 + h) * 3 + 1];
#pragma unroll
    for (int dt = 0; dt < 4; ++dt) {
      otot[h][dt] += o[h][dt] * f;
      o[h][dt] = f32x4{0.f, 0.f, 0.f, 0.f};
    }
    m[h] = MINIT;
    ls[h] = 0.f;
  }
  for (int j = (cur >= 8 ? cur - 8 : 0); j <= cur; ++j) {
    __syncthreads();
    load_k_tile(KW + ((size_t)b * S + j * 64) * 128 + kvh * 64, 128, sK, tid);
    load_vt_tile(VWT + (size_t)bk * 64 * S + j * 64, S, sV, tid);
    __syncthreads();
#pragma unroll
    for (int half = 0; half < 2; ++half) {
      float posf[2][4];
      bool valid[2][4];
#pragma unroll
      for (int kt2 = 0; kt2 < 2; ++kt2)
#pragma unroll
        for (int jj = 0; jj < 4; ++jj) {
          int rel = j * 64 - t0 + half * 32 + kt2 * 16 + lg * 4 + jj;
          posf[kt2][jj] = (float)rel;
          valid[kt2][jj] = (rel <= tql) && (tql - rel < 512);
        }
      half_step<2>(sK, sV, half, lr, lg, qf, slope, m, ls, o, posf, valid, psum);
    }
  }
#pragma unroll
  for (int h = 0; h < 2; ++h) {
    float x = ls[h];
    x += __shfl_xor(x, 16);
    x += __shfl_xor(x, 32);
    const float f = (x > 0.f ? 1.f / x : 0.f) * G[tokq * 24 + (hg0 + h) * 3 + 2];
    float ss = 0.f;
#pragma unroll
    for (int dt = 0; dt < 4; ++dt) {
      otot[h][dt] += o[h][dt] * f;
#pragma unroll
      for (int jj = 0; jj < 4; ++jj) ss += otot[h][dt][jj] * otot[h][dt][jj];
    }
    ss += __shfl_xor(ss, 16);
    ss += __shfl_xor(ss, 32);
    const float r = rsqrtf(ss * (1.f / 64.f) + EPS);
#pragma unroll
    for (int dt = 0; dt < 4; ++dt) {
      const int d = dt * 16 + lg * 4;
      const float4 gg = *(const float4*)(p.out_g + l * 1024 + (hg0 + h) * 64 + d);
      uint2 st;
      st.x = pack2(otot[h][dt][0] * r * gg.x, otot[h][dt][1] * r * gg.y);
      st.y = pack2(otot[h][dt][2] * r * gg.z, otot[h][dt][3] * r * gg.w);
      *(uint2*)(OM + tokq * 1024 + (hg0 + h) * 64 + d) = st;
    }
  }
}

DI void gsync(cg::grid_group& g) {
  __threadfence();
  g.sync();
  __threadfence();
}


#ifndef STOP_AFTER
#define STOP_AFTER 0
#endif
#define DUMP_BF16_AND_STOP(ptr)                                                                   \
  {                                                                                               \
    const u16* s_ = (const u16*)(ptr);                                                            \
    for (size_t i = (size_t)bid * 256 + threadIdx.x; i < (size_t)TOK * 1024; i += (size_t)nb * 256) \
      p.out[i] = bf2f(s_[i]);                                                                     \
    return;                                                                                       \
  }
#define DUMP_F32_AND_STOP(ptr)                                                                    \
  {                                                                                               \
    const float* s_ = (const float*)(ptr);                                                        \
    for (size_t i = (size_t)bid * 256 + threadIdx.x; i < (size_t)TOK * 1024; i += (size_t)nb * 256) \
      p.out[i] = s_[i];                                                                           \
    return;                                                                                       \
  }
__global__ void __launch_bounds__(256, 2) mega(Params p) {
  __shared__ __attribute__((aligned(16))) char smem[65536];
  cg::grid_group grid = cg::this_grid();
  char* ws = p.ws;
  const int nb = gridDim.x, bid = blockIdx.x;
  float* X1 = (float*)(ws + OFF_X1);
  u16* H = (u16*)(ws + OFF_H);
  char* wsA = ws + OFF_A;
  const float* mod = (const float*)(ws + OFF_MOD);

#ifdef ZERO_WS
  {
    uint4* z = (uint4*)ws;
    const size_t n16 = (OFF_A + A_END) / 16;
    for (size_t i = (size_t)bid * 256 + threadIdx.x; i < n16; i += (size_t)nb * 256) z[i] = make_uint4(0, 0, 0, 0);
    uint4* zo = (uint4*)p.out;
    const size_t m16 = (size_t)TOK * 1024 * 4 / 16;
    for (size_t i = (size_t)bid * 256 + threadIdx.x; i < m16; i += (size_t)nb * 256) zo[i] = make_uint4(0, 0, 0, 0);
  }
  gsync(grid);
#endif
  phase0a(p, smem);
  gsync(grid);
  phase0b(p);
  gsync(grid);
  phase_mod_x(p);
  gsync(grid);

  for (int l = 0; l < 2; ++l) {
    const float* modl = mod + (size_t)l * 8 * 6144;
    const float* xin = (l == 0) ? p.x : p.out;
    {
      u16* Qo = (u16*)(wsA + A_Q);
      u16* KCo = (u16*)(wsA + A_KC);
      u16* VCo = (u16*)(wsA + A_VC);
      u16* KSo = (u16*)(wsA + A_KS);
      u16* VSTo = (u16*)(wsA + A_VST);
      u16* KWo = (u16*)(wsA + A_KW);
      u16* VWTo = (u16*)(wsA + A_VWT);
      float* Go = (float*)(wsA + A_G);
      u16* Uo = (u16*)(wsA + A_U);
      u16* VGTo = (u16*)(wsA + A_VGT);
      const float* vng = p.vn_g + l * 512;
      const float* vnb = p.vn_b + l * 512;
      auto epi = [&](int tm, int tn, int wm, int wn, int lr, int lg, f32x4(&acc)[4][4]) {
        const int row0 = tm * 128 + wm * 64;
        const int b = row0 >> 13;
        const int s0 = row0 & (S - 1);
        if (tn < 4 || tn == 4 || tn == 5 || tn == 6 || tn == 8 || (tn >= 10 && tn < 14)) {
          u16* dst;
          int ld, cb;
          float sc = 1.f;
          bool g = false;
          if (tn < 4) { dst = Qo; ld = 512; cb = tn * 128; sc = QSCALE; }
          else if (tn == 4) { dst = KCo; ld = 128; cb = 0; }
          else if (tn == 5) { dst = VCo; ld = 128; cb = 0; }
          else if (tn == 6) { dst = KSo; ld = 128; cb = 0; }
          else if (tn == 8) { dst = KWo; ld = 128; cb = 0; }
          else { dst = Uo; ld = 512; cb = (tn - 10) * 128; g = true; }
#pragma unroll
          for (int mi = 0; mi < 4; ++mi)
#pragma unroll
            for (int ni = 0; ni < 4; ++ni)
#pragma unroll
              for (int j = 0; j < 4; ++j) {
                const size_t row = (size_t)row0 + mi * 16 + lg * 4 + j;
                float v = acc[mi][ni][j];
                v = g ? gelu_t(v) : v * sc;
                dst[row * ld + cb + wn * 64 + ni * 16 + lr] = f2bf(v);
              }
        } else if (tn == 7 || tn == 9) {
          u16* dst = (tn == 7) ? VSTo : VWTo;
#pragma unroll
          for (int mi = 0; mi < 4; ++mi)
#pragma unroll
            for (int ni = 0; ni < 4; ++ni) {
              const int d = ni * 16 + lr;
              uint2 st;
              st.x = pack2(acc[mi][ni][0], acc[mi][ni][1]);
              st.y = pack2(acc[mi][ni][2], acc[mi][ni][3]);
              *(uint2*)(dst + ((size_t)(b * 2 + wn) * 64 + d) * S + s0 + mi * 16 + lg * 4) = st;
            }
        } else if (tn >= 14 && tn < 18) {
          const int grp = (tn - 14) * 2 + wn;
          float vg[4], vb[4];
#pragma unroll
          for (int ni = 0; ni < 4; ++ni) { vg[ni] = vng[grp * 64 + ni * 16 + lr]; vb[ni] = vnb[grp * 64 + ni * 16 + lr]; }
#pragma unroll
          for (int mi = 0; mi < 4; ++mi) {
            float vv[4][4];
#pragma unroll
            for (int ni = 0; ni < 4; ++ni)
#pragma unroll
              for (int j = 0; j < 4; ++j) vv[ni][j] = gelu_t(acc[mi][ni][j]);
#pragma unroll
            for (int j = 0; j < 4; ++j) {
              float s1 = vv[0][j] + vv[1][j] + vv[2][j] + vv[3][j];
              s1 += __shfl_xor(s1, 1); s1 += __shfl_xor(s1, 2); s1 += __shfl_xor(s1, 4); s1 += __shfl_xor(s1, 8);
              const float mu = s1 * (1.f / 64.f);
              float s2 = 0.f;
#pragma unroll
              for (int ni = 0; ni < 4; ++ni) { float dd = vv[ni][j] - mu; s2 += dd * dd; }
              s2 += __shfl_xor(s2, 1); s2 += __shfl_xor(s2, 2); s2 += __shfl_xor(s2, 4); s2 += __shfl_xor(s2, 8);
              const float rs = rsqrtf(s2 * (1.f / 64.f) + EPS);
#pragma unroll
              for (int ni = 0; ni < 4; ++ni) vv[ni][j] = (vv[ni][j] - mu) * rs * vg[ni] + vb[ni];
            }
#pragma unroll
            for (int ni = 0; ni < 4; ++ni) {
              const int d = ni * 16 + lr;
              uint2 st;
              st.x = pack2(vv[ni][0], vv[ni][1]);
              st.y = pack2(vv[ni][2], vv[ni][3]);
              *(uint2*)(VGTo + ((size_t)(b * 8 + grp) * 64 + d) * S + s0 + mi * 16 + lg * 4) = st;
            }
          }
        } else {
          if (wn == 0) {
#pragma unroll
            for (int mi = 0; mi < 4; ++mi)
#pragma unroll
              for (int ni = 0; ni < 2; ++ni)
#pragma unroll
                for (int j = 0; j < 4; ++j) {
                  const int c = ni * 16 + lr;
                  const size_t row = (size_t)row0 + mi * 16 + lg * 4 + j;
                  if (c < 24) Go[row * 24 + c] = sigm(acc[mi][ni][j]);
                }
          }
        }
      };
      gemm_phase(H, 1024, (const u16*)(ws + OFF_WTIN + l * SZ_WTIN), 1024, 512, 19, 1024, bid, nb, smem, epi);
    }
    gsync(grid);
    if (STOP_AFTER == 1 && l == 0) DUMP_BF16_AND_STOP(wsA)
    if (STOP_AFTER == 11 && l == 0) DUMP_BF16_AND_STOP(wsA + A_KW)
    if (STOP_AFTER == 12 && l == 0) DUMP_BF16_AND_STOP(wsA + A_U)
    build_ac(p, l);
    gsync(grid);
    {
      const int ng = (nb >= 512) ? 256 : nb / 2;
      for (int which = 0; which < 2; ++which) {
        u16* HC = (u16*)(wsA + A_HC) + (size_t)which * 8192 * 256;
        auto epi = [&](int tm, int tn, int wm, int wn, int lr, int lg, f32x4(&acc)[4][4]) {
          const int row0 = tm * 128 + wm * 64, col0 = tn * 128 + wn * 64;
#pragma unroll
          for (int mi = 0; mi < 4; ++mi)
#pragma unroll
            for (int ni = 0; ni < 4; ++ni)
#pragma unroll
              for (int j = 0; j < 4; ++j)
                HC[(size_t)(row0 + mi * 16 + lg * 4 + j) * 256 + col0 + ni * 16 + lr] = f2bf(gelu_t(acc[mi][ni][j]));
        };
        const int half = ng / 2;
        const int vb = (bid < ng) ? (which == 0 ? (bid < half ? bid : -1) : (bid >= half ? bid - half : -1)) : -1;
        gemm_phase((const u16*)(wsA + A_AC) + (size_t)which * 8192 * 2048, 2048,
                   (const u16*)(ws + OFF_WTC1 + (l * 2 + which) * SZ_WTC1), 2048, 64, 2, 2048, vb, half, smem, epi);
      }
      if (bid >= ng)
        for (int it = bid - ng; it < 4096; it += nb - ng) gmlp_item(p, l, it);
    }
    gsync(grid);
    {
      for (int which = 0; which < 2; ++which) {
        u16* KCMP = (u16*)(ws + OFF_KCMP);
        u16* VCMPT = (u16*)(ws + OFF_VCMPT);
        auto epi = [&](int tm, int tn, int wm, int wn, int lr, int lg, f32x4(&acc)[4][4]) {
          if (wn != 0) return;
          const int row0 = tm * 128 + wm * 64;
#pragma unroll
          for (int mi = 0; mi < 4; ++mi)
#pragma unroll
            for (int ni = 0; ni < 4; ++ni) {
              const int d = ni * 16 + lr;
              const int rb = row0 + mi * 16 + lg * 4;
              if (which == 0) {
#pragma unroll
                for (int j = 0; j < 4; ++j) KCMP[(size_t)(rb + j) * 64 + d] = f2bf(acc[mi][ni][j]);
              } else {
                uint2 st;
                st.x = pack2(acc[mi][ni][0], acc[mi][ni][1]);
                st.y = pack2(acc[mi][ni][2], acc[mi][ni][3]);
                *(uint2*)(VCMPT + ((size_t)(rb >> 9) * 64 + d) * 512 + (rb & 511)) = st;
              }
            }
        };
        const int vb = (which == 0) ? bid : (bid + nb - 64) % nb;
        gemm_phase((const u16*)(wsA + A_HC) + (size_t)which * 8192 * 256, 256,
                   (const u16*)(ws + OFF_WTC2 + (l * 2 + which) * SZ_WTC2), 256, 64, 1, 256, vb, nb, smem, epi);
      }
    }
    gsync(grid);
    if (STOP_AFTER == 4 && l == 0) DUMP_BF16_AND_STOP(ws + OFF_KCMP)
    for (int r = 0; r * nb < 4096; ++r) {
      const int pos = (r & 1) ? (nb - 1 - bid) : bid;
      const int idx = r * nb + pos;
      if (idx < 4096) {
        const int qh = 255 - (idx >> 4);
        const int rem = idx & 15;
        attn_item(p, l, rem >> 1, rem & 1, qh, smem);
      }
    }
    gsync(grid);
    if (STOP_AFTER == 5 && l == 0) DUMP_BF16_AND_STOP(H)
    if ((STOP_AFTER == 51 || STOP_AFTER == 52) && l == 0) {
      for (size_t i = (size_t)bid * 256 + threadIdx.x; i < (size_t)TOK * 1024; i += (size_t)nb * 256) {
        const int col = (int)(i & 1023);
        const bool keep = (STOP_AFTER == 51) ? (col < 512) : (col >= 512);
        p.out[i] = keep ? bf2f(H[i]) : 0.f;
      }
      return;
    }
    {
      auto epi = [&](int tm, int tn, int wm, int wn, int lr, int lg, f32x4(&acc)[4][4]) {
        const int row0 = tm * 128 + wm * 64, col0 = tn * 128 + wn * 64;
        const int b = row0 >> 13;
#pragma unroll
        for (int ni = 0; ni < 4; ++ni) {
          const int col = col0 + ni * 16 + lr;
          const float g1 = 1.f + modl[(size_t)b * 6144 + 2048 + col];
#pragma unroll
          for (int mi = 0; mi < 4; ++mi)
#pragma unroll
            for (int j = 0; j < 4; ++j) {
              const size_t row = (size_t)row0 + mi * 16 + lg * 4 + j;
              X1[row * 1024 + col] = ALPHA * xin[row * 1024 + col] + g1 * acc[mi][ni][j];
            }
        }
      };
      gemm_phase(H, 1024, (const u16*)(ws + OFF_WTO + l * SZ_WTO), 1024, 512, 8, 1024, bid, nb, smem, epi);
    }
    gsync(grid);
    ln_rows(X1, p.ln1_g + l * 1024, p.ln1_b + l * 1024, modl, 3072, 4096, H);
    gsync(grid);
    if (STOP_AFTER == 7 && l == 0) DUMP_F32_AND_STOP(X1)
    {
      u16* HH = (u16*)(wsA);
      auto epi = [&](int tm, int tn, int wm, int wn, int lr, int lg, f32x4(&acc)[4][4]) {
        const int row0 = tm * 128 + wm * 64;
        const int cb = tn * 64 + wn * 32;
#pragma unroll
        for (int mi = 0; mi < 4; ++mi)
#pragma unroll
          for (int ni = 0; ni < 2; ++ni)
#pragma unroll
            for (int j = 0; j < 4; ++j) {
              const size_t row = (size_t)row0 + mi * 16 + lg * 4 + j;
              const float a = acc[mi][ni][j], bb = acc[mi][ni + 2][j];
              HH[row * 2816 + cb + ni * 16 + lr] = f2bf(a * sigm(a) * bb);
            }
      };
      gemm_phase(H, 1024, (const u16*)(ws + OFF_WT13 + l * SZ_WT13), 1024, 512, 44, 1024, bid, nb, smem, epi);
    }
    gsync(grid);
    if (STOP_AFTER == 8 && l == 0) DUMP_BF16_AND_STOP(wsA)
    {
      const u16* HH = (const u16*)(wsA);
      float* outp = p.out;
      auto epi = [&](int tm, int tn, int wm, int wn, int lr, int lg, f32x4(&acc)[4][4]) {
        const int row0 = tm * 128 + wm * 64, col0 = tn * 128 + wn * 64;
        const int b = row0 >> 13;
#pragma unroll
        for (int ni = 0; ni < 4; ++ni) {
          const int col = col0 + ni * 16 + lr;
          const float g2 = 1.f + modl[(size_t)b * 6144 + 5120 + col];
#pragma unroll
          for (int mi = 0; mi < 4; ++mi)
#pragma unroll
            for (int j = 0; j < 4; ++j) {
              const size_t row = (size_t)row0 + mi * 16 + lg * 4 + j;
              outp[row * 1024 + col] = ALPHA * X1[row * 1024 + col] + g2 * acc[mi][ni][j];
            }
        }
      };
      gemm_phase(HH, 2816, (const u16*)(ws + OFF_WT2 + l * SZ_WT2), 2816, 512, 8, 2816, bid, nb, smem, epi);
    }
    gsync(grid);
    if (l == 0) {
      ln_rows(p.out, p.ln2_g, p.ln2_b, mod + (size_t)8 * 6144, 0, 1024, H);
      gsync(grid);
    } else {
      ln_rows(p.out, p.ln2_g + 1024, p.ln2_b + 1024, nullptr, 0, 0, nullptr);
    }
  }
}

extern "C" void kernel_launch(void* const* d_in, const int* in_sizes, int n_in, void* d_out, int out_size, void* d_ws,
                              size_t ws_size, hipStream_t stream) {
  static int grid_blocks = 0;
  if (!grid_blocks) {
    int dev = 0, cus = 0, per_cu = 0;
    (void)hipGetDevice(&dev);
    (void)hipDeviceGetAttribute(&cus, hipDeviceAttributeMultiprocessorCount, dev);
    (void)hipOccupancyMaxActiveBlocksPerMultiprocessor(&per_cu, mega, 256, 0);
    if (per_cu > 2) per_cu = 2;
    if (per_cu < 1) per_cu = 1;
    grid_blocks = cus * per_cu;
  }
  Params p{};
  const float* const* in = (const float* const*)d_in;
  p.x = in[0]; p.c = in[1]; p.w_ada = in[2]; p.b_ada = in[3]; p.w_in = in[4]; p.cmp_pos = in[5]; p.cmp_w1 = in[6];
  p.cmp_w2 = in[7]; p.vn_g = in[8]; p.vn_b = in[9]; p.w_s = in[10]; p.b_s = in[11]; p.out_g = in[12]; p.w_o = in[13];
  p.ln1_g = in[14]; p.ln1_b = in[15]; p.w1 = in[16]; p.w3 = in[17]; p.w2 = in[18]; p.ln2_g = in[19]; p.ln2_b = in[20];
  p.out = (float*)d_out;
  p.ws = (char*)d_ws;
  void* args[] = {&p};
  hipError_t e = hipLaunchCooperativeKernel((void*)mega, dim3(grid_blocks), dim3(256), args, 0, stream);
  if (e != hipSuccess) fprintf(stderr, "cooperative launch failed: %s (grid %d)\n", hipGetErrorString(e), grid_blocks);
}
```

```cpp
#define STOP_AFTER 0
#include <hip/hip_runtime.h>
#include <hip/hip_cooperative_groups.h>
#include <cstdio>
namespace cg = cooperative_groups;

typedef unsigned short u16;
using bf16x8 = __attribute__((ext_vector_type(8))) short;
using f32x4 = __attribute__((ext_vector_type(4))) float;
using u32x4 = __attribute__((ext_vector_type(4))) unsigned;
#define DI __device__ __forceinline__
#define MFMA16(a, b, c) __builtin_amdgcn_mfma_f32_16x16x32_bf16((a), (b), (c), 0, 0, 0)

constexpr int S = 8192, TOK = 65536;
constexpr int INW = 2328, INP = 2432;
constexpr float ALPHA = 1.41421356237f;
constexpr float LOG2E = 1.4426950408889634f;
constexpr float QSCALE = 0.125f * LOG2E;
constexpr float NEGB = -1e30f, MINIT = -30000.f;
constexpr float EPS = 1e-5f;

constexpr size_t SZ_WTIN = (size_t)INP * 1024 * 2;
constexpr size_t SZ_WTO = (size_t)1024 * 1024 * 2;
constexpr size_t SZ_WT13 = (size_t)5632 * 1024 * 2;
constexpr size_t SZ_WT2 = (size_t)1024 * 2816 * 2;
constexpr size_t SZ_WTC1 = (size_t)256 * 2048 * 2;
constexpr size_t SZ_WTC2 = (size_t)128 * 256 * 2;
constexpr size_t OFF_WTIN = 0;
constexpr size_t OFF_WTO = OFF_WTIN + 2 * SZ_WTIN;
constexpr size_t OFF_WT13 = OFF_WTO + 2 * SZ_WTO;
constexpr size_t OFF_WT2 = OFF_WT13 + 2 * SZ_WT13;
constexpr size_t OFF_WTC1 = OFF_WT2 + 2 * SZ_WT2;
constexpr size_t OFF_WTC2 = OFF_WTC1 + 4 * SZ_WTC1;
constexpr size_t OFF_MODP = OFF_WTC2 + 4 * SZ_WTC2;
constexpr size_t SZ_MOD = (size_t)2 * 8 * 6144 * 4;
constexpr size_t OFF_MOD = OFF_MODP + 16 * SZ_MOD;
constexpr size_t SZ_CMP = (size_t)8 * 2 * 512 * 64 * 2;
constexpr size_t OFF_KCMP = OFF_MOD + SZ_MOD;
constexpr size_t OFF_VCMPT = OFF_KCMP + SZ_CMP;
constexpr size_t OFF_X1 = OFF_VCMPT + SZ_CMP;
constexpr size_t OFF_H = OFF_X1 + (size_t)TOK * 1024 * 4;
constexpr size_t OFF_A = OFF_H + (size_t)TOK * 1024 * 2;
constexpr size_t SZ_KV = (size_t)TOK * 128 * 2;
constexpr size_t A_Q = 0;
constexpr size_t A_KC = A_Q + (size_t)TOK * 512 * 2;
constexpr size_t A_VC = A_KC + SZ_KV;
constexpr size_t A_KS = A_VC + SZ_KV;
constexpr size_t A_VST = A_KS + SZ_KV;
constexpr size_t A_KW = A_VST + SZ_KV;
constexpr size_t A_VWT = A_KW + SZ_KV;
constexpr size_t A_G = A_VWT + SZ_KV;
constexpr size_t A_U = A_G + (size_t)TOK * 24 * 4;
constexpr size_t A_VGT = A_U + (size_t)TOK * 512 * 2;
constexpr size_t A_AC = A_VGT + (size_t)TOK * 512 * 2;
constexpr size_t A_HC = A_AC + (size_t)2 * 8192 * 2048 * 2;
constexpr size_t A_END = A_HC + (size_t)2 * 8192 * 256 * 2;

struct Params {
  const float *x, *c, *w_ada, *b_ada, *w_in, *cmp_pos, *cmp_w1, *cmp_w2, *vn_g, *vn_b, *w_s, *b_s, *out_g, *w_o,
      *ln1_g, *ln1_b, *w1, *w3, *w2, *ln2_g, *ln2_b;
  float* out;
  char* ws;
};

DI u16 f2bf(float x) { unsigned u = __float_as_uint(x); u += 0x7fffu + ((u >> 16) & 1u); return (u16)(u >> 16); }
DI float bf2f(u16 h) { return __uint_as_float(((unsigned)h) << 16); }
DI unsigned pack2(float a, float b) { return (unsigned)f2bf(a) | ((unsigned)f2bf(b) << 16); }
DI float gelu_t(float x) { float u = 1.5957691216f * (x + 0.044715f * x * x * x); return x / (1.f + __expf(-u)); }
DI float sigm(float x) { return 1.f / (1.f + __expf(-x)); }
DI float ex2(float x) { return __builtin_amdgcn_exp2f(x); }
DI int otid() { int t = threadIdx.x; asm volatile("" : "+v"(t)); return t; }

template <int MODE> DI int map_row(int n) {
  if (MODE == 1) return n < 1280 ? n : (n < 1304 ? n + 1024 : n - 24);
  if (MODE == 2) return (n >> 5) * 64 + (n & 31);
  if (MODE == 3) return (n >> 5) * 64 + 32 + (n & 31);
  return n;
}

template <int MODE>
DI void conv_tile(const float* __restrict__ W, int K, int N, u16* __restrict__ Wt, int ldk, int tile, float* tl) {
  const int tiles_n = (N + 63) / 64;
  const int tk = tile / tiles_n, tn = tile % tiles_n;
  const int k0 = tk * 64, n0 = tn * 64;
  const int tid = otid();
#pragma unroll
  for (int i = 0; i < 16; ++i) {
    int idx = tid + 256 * i;
    int r = idx >> 6, c = idx & 63;
    int n = n0 + c;
    tl[r * 65 + c] = (n < N) ? W[(long)(k0 + r) * N + n] : 0.f;
  }
  __syncthreads();
  const int nl = tid >> 2, kc = tid & 3;
  const int n = n0 + nl;
  if (n < N) {
    const int row = map_row<MODE>(n);
    unsigned pk[8];
#pragma unroll
    for (int i = 0; i < 8; ++i) pk[i] = pack2(tl[(kc * 16 + 2 * i) * 65 + nl], tl[(kc * 16 + 2 * i + 1) * 65 + nl]);
    uint4* dst = (uint4*)(Wt + (long)row * ldk + k0 + kc * 16);
    dst[0] = make_uint4(pk[0], pk[1], pk[2], pk[3]);
    dst[1] = make_uint4(pk[4], pk[5], pk[6], pk[7]);
  }
  __syncthreads();
}

DI void phase0a(const Params& p, char* smem) {
  char* ws = p.ws;
  const int tid = threadIdx.x;
  constexpr int PER_LAYER = 592 + 256 + 704 * 3 + 128 * 2 + 4 * 2;
  constexpr int NCONV = 2 * PER_LAYER;
  constexpr int NTOT = NCONV + 768 + 2;
  for (int it = blockIdx.x; it < NTOT; it += gridDim.x) {
    if (it < NCONV) {
      const int l = it / PER_LAYER;
      const int li = it % PER_LAYER;
      int base = 0;
#define SEG(MODE, SRC, DST, K_, N_, LDK)                                                   \
  {                                                                                        \
    const int nt_ = ((K_) / 64) * (((N_) + 63) / 64);                                      \
    if (li >= base && li < base + nt_) conv_tile<MODE>(SRC, K_, N_, DST, LDK, li - base, (float*)smem); \
    base += nt_;                                                                           \
  }
      SEG(1, p.w_in + (size_t)l * 1024 * INW, (u16*)(ws + OFF_WTIN + l * SZ_WTIN), 1024, INW, 1024)
      SEG(0, p.w_o + (size_t)l * 1024 * 1024, (u16*)(ws + OFF_WTO + l * SZ_WTO), 1024, 1024, 1024)
      SEG(2, p.w1 + (size_t)l * 1024 * 2816, (u16*)(ws + OFF_WT13 + l * SZ_WT13), 1024, 2816, 1024)
      SEG(3, p.w3 + (size_t)l * 1024 * 2816, (u16*)(ws + OFF_WT13 + l * SZ_WT13), 1024, 2816, 1024)
      SEG(0, p.w2 + (size_t)l * 2816 * 1024, (u16*)(ws + OFF_WT2 + l * SZ_WT2), 2816, 1024, 2816)
      SEG(0, p.cmp_w1 + (size_t)(l * 2 + 0) * 2048 * 256, (u16*)(ws + OFF_WTC1 + (l * 2 + 0) * SZ_WTC1), 2048, 256, 2048)
      SEG(0, p.cmp_w1 + (size_t)(l * 2 + 1) * 2048 * 256, (u16*)(ws + OFF_WTC1 + (l * 2 + 1) * SZ_WTC1), 2048, 256, 2048)
      SEG(0, p.cmp_w2 + (size_t)(l * 2 + 0) * 256 * 64, (u16*)(ws + OFF_WTC2 + (l * 2 + 0) * SZ_WTC2), 256, 64, 256)
      SEG(0, p.cmp_w2 + (size_t)(l * 2 + 1) * 256 * 64, (u16*)(ws + OFF_WTC2 + (l * 2 + 1) * SZ_WTC2), 256, 64, 256)
#undef SEG
    } else if (it < NCONV + 768) {
      const int idx = it - NCONV;
      const int l = idx / 384, r = idx % 384, nb = r / 16, kc = r % 16;
      float* cs = (float*)smem;
      for (int i = tid; i < 512; i += 256) {
        int b = i >> 6, k = i & 63;
        float cv = p.c[b * 1024 + kc * 64 + k];
        cs[i] = cv * sigm(cv);
      }
      __syncthreads();
      const int n = nb * 256 + tid;
      float acc[8];
#pragma unroll
      for (int b = 0; b < 8; ++b) acc[b] = 0.f;
      const float* wp = p.w_ada + ((size_t)l * 1024 + kc * 64) * 6144 + n;
#pragma unroll 8
      for (int k = 0; k < 64; ++k) {
        float wv = wp[(size_t)k * 6144];
#pragma unroll
        for (int b = 0; b < 8; ++b) acc[b] += cs[b * 64 + k] * wv;
      }
      float* modp = (float*)(ws + OFF_MODP);
#pragma unroll
      for (int b = 0; b < 8; ++b) modp[(size_t)((kc * 2 + l) * 8 + b) * 6144 + n] = acc[b];
      __syncthreads();
    } else {
      const int l = it - NCONV - 768;
      uint4* dst = (uint4*)(ws + OFF_WTIN + l * SZ_WTIN + (size_t)INW * 1024 * 2);
      const int n16 = (INP - INW) * 1024 * 2 / 16;
      for (int i = tid; i < n16; i += 256) dst[i] = make_uint4(0, 0, 0, 0);
    }
  }
}

DI void phase0b(const Params& p) {
  const float* modp = (const float*)(p.ws + OFF_MODP);
  float* mod = (float*)(p.ws + OFF_MOD);
  const int n = 2 * 8 * 6144;
  for (int i = blockIdx.x * 256 + threadIdx.x; i < n; i += gridDim.x * 256) {
    int l = i / (8 * 6144), c = i % 6144;
    float a = p.b_ada[l * 6144 + c];
#pragma unroll
    for (int kc = 0; kc < 16; ++kc) a += modp[(size_t)kc * n + i];
    mod[i] = a;
  }
}

DI void phase_mod_x(const Params& p) {
  const float* mod = (const float*)(p.ws + OFF_MOD);
  u16* H = (u16*)(p.ws + OFF_H);
  const long nchunk = (long)TOK * 1024 / 8;
  for (long i = (long)blockIdx.x * 256 + otid(); i < nchunk; i += (long)gridDim.x * 256) {
    long e = i * 8;
    int col = (int)(e & 1023);
    int b = (int)(e >> 23);
    const float4* xp = (const float4*)(p.x + e);
    const float4* sh = (const float4*)(mod + (size_t)b * 6144 + 0 + col);
    const float4* sc = (const float4*)(mod + (size_t)b * 6144 + 1024 + col);
    float4 x0 = xp[0], x1 = xp[1], s0 = sc[0], s1 = sc[1], h0 = sh[0], h1 = sh[1];
    uint4 o;
    o.x = pack2(x0.x * (1.f + s0.x) + h0.x, x0.y * (1.f + s0.y) + h0.y);
    o.y = pack2(x0.z * (1.f + s0.z) + h0.z, x0.w * (1.f + s0.w) + h0.w);
    o.z = pack2(x1.x * (1.f + s1.x) + h1.x, x1.y * (1.f + s1.y) + h1.y);
    o.w = pack2(x1.z * (1.f + s1.z) + h1.z, x1.w * (1.f + s1.w) + h1.w);
    *(uint4*)(H + e) = o;
  }
}

struct Stg { u32x4 a0, a1, a2, a3, b0, b1, b2, b3; };
DI void g_load(Stg& s, const u16* __restrict__ Ap, int lda, const u16* __restrict__ Bp, int ldb, int kt, int tid) {
  const int ch = tid & 7, r = tid >> 3;
  const u16* ap = Ap + (size_t)r * lda + kt * 64 + ch * 8;
  const u16* bp = Bp + (size_t)r * ldb + kt * 64 + ch * 8;
  s.a0 = *(const u32x4*)(ap);
  s.a1 = *(const u32x4*)(ap + (size_t)32 * lda);
  s.a2 = *(const u32x4*)(ap + (size_t)64 * lda);
  s.a3 = *(const u32x4*)(ap + (size_t)96 * lda);
  s.b0 = *(const u32x4*)(bp);
  s.b1 = *(const u32x4*)(bp + (size_t)32 * ldb);
  s.b2 = *(const u32x4*)(bp + (size_t)64 * ldb);
  s.b3 = *(const u32x4*)(bp + (size_t)96 * ldb);
}
DI void g_store(char* d_, const Stg& s, int tid) {
  const int ch = tid & 7, r = tid >> 3;
  char* pa = d_ + r * 128 + ((ch ^ (r & 7)) << 4);
  *(u32x4*)(pa) = s.a0;
  *(u32x4*)(pa + 4096) = s.a1;
  *(u32x4*)(pa + 8192) = s.a2;
  *(u32x4*)(pa + 12288) = s.a3;
  *(u32x4*)(pa + 16384) = s.b0;
  *(u32x4*)(pa + 16384 + 4096) = s.b1;
  *(u32x4*)(pa + 16384 + 8192) = s.b2;
  *(u32x4*)(pa + 16384 + 12288) = s.b3;
}
template <bool SWAP>
DI void g_compute(const char* sA, f32x4 (&acc)[4][4], int wm, int wn, int lr, int lg) {
  const char* sB = sA + 16384;
#pragma unroll
  for (int s = 0; s < 2; ++s) {
    bf16x8 af[4], bfr[4];
#pragma unroll
    for (int mi = 0; mi < 4; ++mi) {
      const int r = wm * 64 + mi * 16 + lr;
      af[mi] = *(const bf16x8*)(sA + r * 128 + (((s * 4 + lg) ^ (r & 7)) << 4));
    }
#pragma unroll
    for (int ni = 0; ni < 4; ++ni) {
      const int r = wn * 64 + ni * 16 + lr;
      bfr[ni] = *(const bf16x8*)(sB + r * 128 + (((s * 4 + lg) ^ (r & 7)) << 4));
    }
#pragma unroll
    for (int mi = 0; mi < 4; ++mi)
#pragma unroll
      for (int ni = 0; ni < 4; ++ni)
        acc[mi][ni] = SWAP ? MFMA16(bfr[ni], af[mi], acc[mi][ni]) : MFMA16(af[mi], bfr[ni], acc[mi][ni]);
  }
}

template <bool SWAP, class Epi>
DI void gemm_tile(const u16* __restrict__ Ap, int lda, const u16* __restrict__ Bp, int ldb, int nk, int tm, int tn, int tid,
                  char* smem, Epi epi) {
  const int lane = tid & 63, w = tid >> 6, wm = w >> 1, wn = w & 1;
  const int lr = lane & 15, lg = lane >> 4;
  f32x4 acc[4][4];
#pragma unroll
  for (int i = 0; i < 4; ++i)
#pragma unroll
    for (int j = 0; j < 4; ++j) acc[i][j] = f32x4{0.f, 0.f, 0.f, 0.f};
  Stg r0, r1;
  g_load(r0, Ap, lda, Bp, ldb, 0, tid);
  if (nk > 1) g_load(r1, Ap, lda, Bp, ldb, 1, tid);
  g_store(smem, r0, tid);
  __syncthreads();
  if (nk > 2) g_load(r0, Ap, lda, Bp, ldb, 2, tid);
  for (int kt = 0; kt < nk; kt += 2) {
    g_compute<SWAP>(smem, acc, wm, wn, lr, lg);
    if (kt + 1 < nk) g_store(smem + 32768, r1, tid);
    __syncthreads();
    if (kt + 3 < nk) g_load(r1, Ap, lda, Bp, ldb, kt + 3, tid);
    if (kt + 1 >= nk) break;
    g_compute<SWAP>(smem + 32768, acc, wm, wn, lr, lg);
    if (kt + 2 < nk) g_store(smem, r0, tid);
    __syncthreads();
    if (kt + 4 < nk) g_load(r0, Ap, lda, Bp, ldb, kt + 4, tid);
  }
  epi(SWAP, tm, tn, wm, wn, lr, lg, acc);
}

template <class Sel, class Epi>
DI void gemm_phase(const u16* __restrict__ A, int lda, const u16* __restrict__ Bt, int ldb, int ntm, int ntn, int K,
                   int vb, int nvb, char* smem, Sel swapsel, Epi epi) {
  if (vb < 0 || vb >= nvb) return;
  const int tid = otid();
  const int ntiles = ntm * ntn;
  const int nk = K / 64;
  int GM = nvb / ntn;
  if (GM < 1) GM = 1;
  if (GM > ntm) GM = ntm;
  const int gtiles = GM * ntn;
  const int q0 = ((nvb & 7) == 0) ? ((vb & 7) * (nvb >> 3) + (vb >> 3)) : vb;
  for (int q = q0; q < ntiles; q += nvb) {
    const int g = q / gtiles;
    const int i = q - g * gtiles;
    const int gsz = (ntm - g * GM < GM) ? (ntm - g * GM) : GM;
    const int tn = i / gsz;
    const int tm = g * GM + (i - tn * gsz);
    const u16* Ap = A + (size_t)tm * 128 * lda;
    const u16* Bp = Bt + (size_t)tn * 128 * ldb;
    if (swapsel(tn)) gemm_tile<true>(Ap, lda, Bp, ldb, nk, tm, tn, tid, smem, epi);
    else gemm_tile<false>(Ap, lda, Bp, ldb, nk, tm, tn, tid, smem, epi);
  }
}

DI void ln_rows(float* buf, const float* __restrict__ g, const float* __restrict__ bt, const float* __restrict__ modl,
                        int sh_off, int sc_off, u16* H) {
  const int tid_ = otid();
  const int lane = tid_ & 63, w = tid_ >> 6;
  for (int row = blockIdx.x * 4 + w; row < TOK; row += gridDim.x * 4) {
    float4* rp = (float4*)(buf + (size_t)row * 1024);
    float4 v[4];
    float s = 0.f;
#pragma unroll
    for (int i = 0; i < 4; ++i) { v[i] = rp[lane + 64 * i]; s += v[i].x + v[i].y + v[i].z + v[i].w; }
#pragma unroll
    for (int o = 32; o >= 1; o >>= 1) s += __shfl_xor(s, o);
    const float mu = s * (1.f / 1024.f);
    float q = 0.f;
#pragma unroll
    for (int i = 0; i < 4; ++i) {
      float a = v[i].x - mu, b = v[i].y - mu, c = v[i].z - mu, d = v[i].w - mu;
      q += a * a + b * b + c * c + d * d;
    }
#pragma unroll
    for (int o = 32; o >= 1; o >>= 1) q += __shfl_xor(q, o);
    const float rs = rsqrtf(q * (1.f / 1024.f) + EPS);
    const int b = row >> 13;
#pragma unroll
    for (int i = 0; i < 4; ++i) {
      const int col = (lane + 64 * i) * 4;
      float4 gg = *(const float4*)(g + col), bb = *(const float4*)(bt + col);
      float4 y;
      y.x = (v[i].x - mu) * rs * gg.x + bb.x;
      y.y = (v[i].y - mu) * rs * gg.y + bb.y;
      y.z = (v[i].z - mu) * rs * gg.z + bb.z;
      y.w = (v[i].w - mu) * rs * gg.w + bb.w;
      rp[lane + 64 * i] = y;
      if (H) {
        float4 sh = *(const float4*)(modl + (size_t)b * 6144 + sh_off + col);
        float4 sc = *(const float4*)(modl + (size_t)b * 6144 + sc_off + col);
        uint2 o2;
        o2.x = pack2(y.x * (1.f + sc.x) + sh.x, y.y * (1.f + sc.y) + sh.y);
        o2.y = pack2(y.z * (1.f + sc.z) + sh.z, y.w * (1.f + sc.w) + sh.w);
        *(uint2*)(H + (size_t)row * 1024 + col) = o2;
      }
    }
  }
}

DI void build_ac(const Params& p, int l) {
  const u16* KC = (const u16*)(p.ws + OFF_A + A_KC);
  const u16* VC = (const u16*)(p.ws + OFF_A + A_VC);
  u16* AC = (u16*)(p.ws + OFF_A + A_AC);
  const long nchunk = (long)2 * 8192 * 256;
  for (long i = (long)blockIdx.x * 256 + otid(); i < nchunk; i += (long)gridDim.x * 256) {
    const int which = (int)(i >> 21);
    const int rem = (int)(i & ((1 << 21) - 1));
    const int row = rem >> 8, ck = rem & 255;
    const int r = ck >> 3, d0 = (ck & 7) * 8;
    const int bk = row >> 9, n = row & 511;
    const int b = bk >> 1, kvh = bk & 1;
    int t = 16 * n + r;
    if (t > S - 1) t = S - 1;
    const u16* src = (which ? VC : KC) + ((size_t)b * S + t) * 128 + kvh * 64 + d0;
    uint4 v = *(const uint4*)src;
    const float4* pp = (const float4*)(p.cmp_pos + ((size_t)(l * 2 + which) * 32 + r) * 64 + d0);
    float4 p0 = pp[0], p1 = pp[1];
    uint4 o;
    o.x = pack2(bf2f(v.x & 0xffff) + p0.x, bf2f(v.x >> 16) + p0.y);
    o.y = pack2(bf2f(v.y & 0xffff) + p0.z, bf2f(v.y >> 16) + p0.w);
    o.z = pack2(bf2f(v.z & 0xffff) + p1.x, bf2f(v.z >> 16) + p1.y);
    o.w = pack2(bf2f(v.w & 0xffff) + p1.z, bf2f(v.w >> 16) + p1.w);
    *(uint4*)(AC + ((size_t)which * 8192 + row) * 2048 + r * 64 + d0) = o;
  }
}

DI void gmlp_item(const Params& p, int l, int item) {
  const int b = item >> 9, c = (item >> 3) & 63, grp = item & 7;
  const int tid_ = otid();
  const int lane = tid_ & 63, w = tid_ >> 6, lr = lane & 15, lg = lane >> 4;
  const float* wsp = p.w_s + (size_t)(l * 8 + grp) * 128 * 128;
  const u16* vgt = (const u16*)(p.ws + OFF_A + A_VGT) + (size_t)(b * 8 + grp) * 64 * S + c * 128;
  const u16* U = (const u16*)(p.ws + OFF_A + A_U);
  u16* OM = (u16*)(p.ws + OFF_H);
  f32x4 acc[4][2];
#pragma unroll
  for (int i = 0; i < 4; ++i)
#pragma unroll
    for (int j = 0; j < 2; ++j) acc[i][j] = f32x4{0.f, 0.f, 0.f, 0.f};
#pragma unroll
  for (int ks = 0; ks < 4; ++ks) {
    const int s0 = ks * 32 + lg * 8;
    bf16x8 af[4];
#pragma unroll
    for (int dt = 0; dt < 4; ++dt) af[dt] = *(const bf16x8*)(vgt + (size_t)(dt * 16 + lr) * S + s0);
#pragma unroll
    for (int nt = 0; nt < 2; ++nt) {
      const int t = w * 32 + nt * 16 + lr;
      const float4* wp = (const float4*)(wsp + t * 128 + s0);
      float4 a0 = wp[0], a1 = wp[1];
      unsigned pw[4];
      pw[0] = pack2((s0 + 0 <= t) ? a0.x : 0.f, (s0 + 1 <= t) ? a0.y : 0.f);
      pw[1] = pack2((s0 + 2 <= t) ? a0.z : 0.f, (s0 + 3 <= t) ? a0.w : 0.f);
      pw[2] = pack2((s0 + 4 <= t) ? a1.x : 0.f, (s0 + 5 <= t) ? a1.y : 0.f);
      pw[3] = pack2((s0 + 6 <= t) ? a1.z : 0.f, (s0 + 7 <= t) ? a1.w : 0.f);
      bf16x8 bw = __builtin_bit_cast(bf16x8, make_uint4(pw[0], pw[1], pw[2], pw[3]));
#pragma unroll
      for (int dt = 0; dt < 4; ++dt) acc[dt][nt] = MFMA16(af[dt], bw, acc[dt][nt]);
    }
  }
#pragma unroll
  for (int nt = 0; nt < 2; ++nt) {
    const int t = w * 32 + nt * 16 + lr;
    const size_t tok = (size_t)b * S + c * 128 + t;
    const float bias = p.b_s[(l * 8 + grp) * 128 + t];
    float val[4][4];
    float ss = 0.f;
#pragma unroll
    for (int dt = 0; dt < 4; ++dt) {
      const int d = dt * 16 + lg * 4;
      const uint2 uu = *(const uint2*)(U + tok * 512 + grp * 64 + d);
      const float u0 = bf2f(uu.x & 0xffff), u1 = bf2f(uu.x >> 16), u2 = bf2f(uu.y & 0xffff), u3 = bf2f(uu.y >> 16);
      val[dt][0] = u0 * (acc[dt][nt][0] + bias);
      val[dt][1] = u1 * (acc[dt][nt][1] + bias);
      val[dt][2] = u2 * (acc[dt][nt][2] + bias);
      val[dt][3] = u3 * (acc[dt][nt][3] + bias);
#pragma unroll
      for (int j = 0; j < 4; ++j) ss += val[dt][j] * val[dt][j];
    }
    ss += __shfl_xor(ss, 16);
    ss += __shfl_xor(ss, 32);
    const float r = rsqrtf(ss * (1.f / 64.f) + EPS);
#pragma unroll
    for (int dt = 0; dt < 4; ++dt) {
      const int d = dt * 16 + lg * 4;
      const float4 gg = *(const float4*)(p.out_g + l * 1024 + 512 + grp * 64 + d);
      uint2 st;
      st.x = pack2(val[dt][0] * r * gg.x, val[dt][1] * r * gg.y);
      st.y = pack2(val[dt][2] * r * gg.z, val[dt][3] * r * gg.w);
      *(uint2*)(OM + tok * 1024 + 512 + grp * 64 + d) = st;
    }
  }
}

constexpr int SM_K = 0, SM_V = 8192, SM_IMP = 8192 + 8704, SM_SEL = SM_IMP + 64 * 132 * 4, SM_UNI = SM_SEL + 1024;

DI void load_k_tile(const u16* __restrict__ src, int stride, char* sK, int tid) {
#pragma unroll
  for (int i = 0; i < 2; ++i) {
    int idx = tid + 256 * i, r = idx >> 3, ch = idx & 7;
    uint4 v = *(const uint4*)(src + (size_t)r * stride + ch * 8);
    *(uint4*)(sK + r * 128 + ((ch ^ (r & 7)) << 4)) = v;
  }
}
DI void load_vt_tile(const u16* __restrict__ src, int stride, char* sV, int tid) {
#pragma unroll
  for (int i = 0; i < 2; ++i) {
    int idx = tid + 256 * i, d = idx >> 3, ch = idx & 7;
    uint4 v = *(const uint4*)(src + (size_t)d * stride + ch * 8);
    uint2* dst = (uint2*)(sV + d * 136 + ch * 16);
    dst[0] = make_uint2(v.x, v.y);
    dst[1] = make_uint2(v.z, v.w);
  }
}

template <int MODE>
DI void half_step(const char* sK, const char* sV, int half, int lr, int lg, const bf16x8 (&qf)[2][2], const float (&slope)[2],
                  float (&m)[2], float (&lsum)[2], f32x4 (&o)[2][4], const float (&posf)[2][4], const bool (&valid)[2][4],
                  float (&psum)[2][4]) {
  bf16x8 kf[2][2];
#pragma unroll
  for (int kt2 = 0; kt2 < 2; ++kt2) {
    const int r = half * 32 + kt2 * 16 + lr;
    kf[kt2][0] = *(const bf16x8*)(sK + r * 128 + (((lg) ^ (r & 7)) << 4));
    kf[kt2][1] = *(const bf16x8*)(sK + r * 128 + (((4 + lg) ^ (r & 7)) << 4));
  }
  if (MODE == 1) {
#pragma unroll
    for (int a = 0; a < 2; ++a)
#pragma unroll
      for (int j = 0; j < 4; ++j) psum[a][j] = 0.f;
  }
  bf16x8 pf[2];
#pragma unroll
  for (int h = 0; h < 2; ++h) {
    f32x4 s[2];
#pragma unroll
    for (int kt2 = 0; kt2 < 2; ++kt2) {
      f32x4 z = f32x4{0.f, 0.f, 0.f, 0.f};
      z = MFMA16(kf[kt2][0], qf[h][0], z);
      z = MFMA16(kf[kt2][1], qf[h][1], z);
      s[kt2] = z;
    }
    float mx = NEGB;
#pragma unroll
    for (int kt2 = 0; kt2 < 2; ++kt2)
#pragma unroll
      for (int j = 0; j < 4; ++j) {
        float v = valid[kt2][j] ? (s[kt2][j] + slope[h] * posf[kt2][j]) : NEGB;
        s[kt2][j] = v;
        mx = fmaxf(mx, v);
      }
    if (MODE != 1) {
      mx = fmaxf(mx, __shfl_xor(mx, 16));
      mx = fmaxf(mx, __shfl_xor(mx, 32));
      const float mn = fmaxf(m[h], mx);
      const float alpha = ex2(m[h] - mn);
      m[h] = mn;
      float ps = 0.f;
#pragma unroll
      for (int kt2 = 0; kt2 < 2; ++kt2)
#pragma unroll
        for (int j = 0; j < 4; ++j) {
          float pv = ex2(s[kt2][j] - mn);
          s[kt2][j] = pv;
          ps += pv;
        }
      lsum[h] = lsum[h] * alpha + ps;
      if (MODE == 2) {
#pragma unroll
        for (int dt = 0; dt < 4; ++dt) o[h][dt] *= alpha;
      }
    } else {
#pragma unroll
      for (int kt2 = 0; kt2 < 2; ++kt2)
#pragma unroll
        for (int j = 0; j < 4; ++j) {
          float pv = ex2(s[kt2][j] - m[h]) * lsum[h];
          s[kt2][j] = pv;
          psum[kt2][j] += pv;
        }
    }
    if (MODE != 0) {
      uint4 pk = make_uint4(pack2(s[0][0], s[0][1]), pack2(s[0][2], s[0][3]), pack2(s[1][0], s[1][1]), pack2(s[1][2], s[1][3]));
      pf[h] = __builtin_bit_cast(bf16x8, pk);
    }
  }
  if (MODE != 0) {
#pragma unroll
    for (int dt = 0; dt < 4; ++dt) {
      const char* base = sV + (dt * 16 + lr) * 136 + half * 64 + lg * 8;
      uint2 a = *(const uint2*)(base);
      uint2 c = *(const uint2*)(base + 32);
      bf16x8 vf = __builtin_bit_cast(bf16x8, make_uint4(a.x, a.y, c.x, c.y));
#pragma unroll
      for (int h = 0; h < 2; ++h) o[h][dt] = MFMA16(vf, pf[h], o[h][dt]);
    }
  }
}

DI void attn_item(const Params& p, int l, int b, int kvh, int qh, char* smem) {
  char* sK = smem + SM_K;
  char* sV = smem + SM_V;
  float* sImp = (float*)(smem + SM_IMP);
  unsigned* sSel = (unsigned*)(smem + SM_SEL);
  unsigned* sUni = (unsigned*)(smem + SM_UNI);
  const char* wsA = p.ws + OFF_A;
  const u16* Q = (const u16*)(wsA + A_Q);
  const u16* KS = (const u16*)(wsA + A_KS);
  const u16* VST = (const u16*)(wsA + A_VST);
  const u16* KW = (const u16*)(wsA + A_KW);
  const u16* VWT = (const u16*)(wsA + A_VWT);
  const float* G = (const float*)(wsA + A_G);
  const u16* KCMP = (const u16*)(p.ws + OFF_KCMP);
  const u16* VCMPT = (const u16*)(p.ws + OFF_VCMPT);
  u16* OM = (u16*)(p.ws + OFF_H);

  const int tid = otid(), lane = tid & 63, w = tid >> 6, lr = lane & 15, lg = lane >> 4;
  const int hp = w >> 1;
  const int t0 = qh * 32;
  const int cur = qh >> 1;
  const int tql = 16 * (w & 1) + lr;
  const size_t tokq = (size_t)b * S + t0 + tql;
  const int bk = b * 2 + kvh;
  const int hg0 = kvh * 4 + hp * 2;

  bf16x8 qf[2][2];
  float slope[2];
#pragma unroll
  for (int h = 0; h < 2; ++h) {
    const u16* qp = Q + tokq * 512 + (hg0 + h) * 64 + lg * 8;
    qf[h][0] = *(const bf16x8*)qp;
    qf[h][1] = *(const bf16x8*)(qp + 32);
    slope[h] = ex2(-(float)(hg0 + h + 1)) * LOG2E;
  }
  float m[2], ls[2];
  f32x4 o[2][4], otot[2][4];
  float psum[2][4];
#pragma unroll
  for (int h = 0; h < 2; ++h) {
    m[h] = MINIT;
    ls[h] = 0.f;
#pragma unroll
    for (int dt = 0; dt < 4; ++dt) o[h][dt] = f32x4{0.f, 0.f, 0.f, 0.f};
  }

  const int amax = qh >> 5;
  const u16* kc_base = KCMP + (size_t)bk * 512 * 64;
  const u16* vc_base = VCMPT + (size_t)bk * 64 * 512;
  for (int a = 0; a <= amax; ++a) {
    __syncthreads();
    load_k_tile(kc_base + (size_t)a * 64 * 64, 64, sK, tid);
    __syncthreads();
#pragma unroll
    for (int half = 0; half < 2; ++half) {
      float posf[2][4];
      bool valid[2][4];
#pragma unroll
      for (int kt2 = 0; kt2 < 2; ++kt2)
#pragma unroll
        for (int j = 0; j < 4; ++j) {
          int n = a * 64 + half * 32 + kt2 * 16 + lg * 4 + j;
          int rel = 16 * n + 31 - t0;
          posf[kt2][j] = (float)rel;
          valid[kt2][j] = rel <= tql;
        }
      half_step<0>(sK, sV, half, lr, lg, qf, slope, m, ls, o, posf, valid, psum);
    }
  }
#pragma unroll
  for (int h = 0; h < 2; ++h) {
    float x = ls[h];
    x += __shfl_xor(x, 16);
    x += __shfl_xor(x, 32);
    ls[h] = x > 0.f ? 1.f / x : 0.f;
  }
  float carry = 0.f;
  float* myImp = sImp + hp * (32 * 132);
  for (int a = 0; a <= amax; ++a) {
    __syncthreads();
    load_k_tile(kc_base + (size_t)a * 64 * 64, 64, sK, tid);
    load_vt_tile(vc_base + a * 64, 512, sV, tid);
    __syncthreads();
#pragma unroll
    for (int half = 0; half < 2; ++half) {
      float posf[2][4];
      bool valid[2][4];
#pragma unroll
      for (int kt2 = 0; kt2 < 2; ++kt2)
#pragma unroll
        for (int j = 0; j < 4; ++j) {
          int n = a * 64 + half * 32 + kt2 * 16 + lg * 4 + j;
          int rel = 16 * n + 31 - t0;
          posf[kt2][j] = (float)rel;
          valid[kt2][j] = rel <= tql;
        }
      half_step<1>(sK, sV, half, lr, lg, qf, slope, m, ls, o, posf, valid, psum);
      float prev = carry;
#pragma unroll
      for (int kt2 = 0; kt2 < 2; ++kt2) {
        float sum4 = psum[kt2][0] + psum[kt2][1] + psum[kt2][2] + psum[kt2][3];
        float p3 = psum[kt2][3];
        float up = __shfl(p3, (lane + 48) & 63);
        float wrap = __shfl(prev, (lane + 48) & 63);
        float spill = lg > 0 ? up : wrap;
        int j = a * 16 + half * 8 + kt2 * 4 + lg;
        myImp[tql * 132 + j] = sum4 + spill;
        prev = p3;
      }
      carry = prev;
    }
  }
#pragma unroll
  for (int h = 0; h < 2; ++h) {
    const float g0 = G[tokq * 24 + (hg0 + h) * 3 + 0];
#pragma unroll
    for (int dt = 0; dt < 4; ++dt) {
      otot[h][dt] = o[h][dt] * g0;
      o[h][dt] = f32x4{0.f, 0.f, 0.f, 0.f};
    }
    m[h] = MINIT;
    ls[h] = 0.f;
  }
  if (tid < 4) sUni[tid] = 0u;
  __syncthreads();
  if (tid < 128) {
    const int q = tid >> 2, sub = tid & 3;
    unsigned mk[4] = {0u, 0u, 0u, 0u};
    if (cur < 16) {
      mk[0] = (1u << (cur + 1)) - 1u;
    } else {
      float v[32];
#pragma unroll
      for (int i = 0; i < 32; ++i) {
        int j = sub + 4 * i;
        v[i] = (j >= 1 && j <= cur - 2) ? (sImp[q * 132 + j] + sImp[32 * 132 + q * 132 + j]) : -1.f;
      }
      for (int round = 0; round < 13; ++round) {
        float bv = v[0];
        int bi = 0;
#pragma unroll
        for (int i = 1; i < 32; ++i)
          if (v[i] > bv) { bv = v[i]; bi = i; }
        int bj = sub + 4 * bi;
#pragma unroll
        for (int off = 1; off <= 2; off <<= 1) {
          float ov = __shfl_xor(bv, off);
          int oj = __shfl_xor(bj, off);
          if (ov > bv || (ov == bv && oj < bj)) { bv = ov; bj = oj; }
        }
#pragma unroll
        for (int i = 0; i < 32; ++i)
          if (sub + 4 * i == bj) v[i] = -2.f;
#pragma unroll
        for (int wd = 0; wd < 4; ++wd) mk[wd] |= ((bj >> 5) == wd) ? (1u << (bj & 31)) : 0u;
      }
      const int f1 = cur, f2 = cur - 1;
      mk[0] |= 1u;
#pragma unroll
      for (int wd = 0; wd < 4; ++wd) {
        mk[wd] |= ((f1 >> 5) == wd) ? (1u << (f1 & 31)) : 0u;
        mk[wd] |= ((f2 >> 5) == wd) ? (1u << (f2 & 31)) : 0u;
      }
    }
    if (sub == 0) {
#pragma unroll
      for (int wd = 0; wd < 4; ++wd) {
        sSel[q * 4 + wd] = mk[wd];
        atomicOr(&sUni[wd], mk[wd]);
      }
    }
  }
  __syncthreads();
  for (int j = 0; j <= cur; ++j) {
    const unsigned uw = sUni[j >> 5];
    if (!((uw >> (j & 31)) & 1u)) continue;
    __syncthreads();
    load_k_tile(KS + ((size_t)b * S + j * 64) * 128 + kvh * 64, 128, sK, tid);
    load_vt_tile(VST + (size_t)bk * 64 * S + j * 64, S, sV, tid);
    __syncthreads();
    const bool selbit = (sSel[tql * 4 + (j >> 5)] >> (j & 31)) & 1u;
#pragma unroll
    for (int half = 0; half < 2; ++half) {
      float posf[2][4];
      bool valid[2][4];
#pragma unroll
      for (int kt2 = 0; kt2 < 2; ++kt2)
#pragma unroll
        for (int jj = 0; jj < 4; ++jj) {
          int rel = j * 64 - t0 + half * 32 + kt2 * 16 + lg * 4 + jj;
          posf[kt2][jj] = (float)rel;
          valid[kt2][jj] = selbit && (rel <= tql);
        }
      half_step<2>(sK, sV, half, lr, lg, qf, slope, m, ls, o, posf, valid, psum);
    }
  }
#pragma unroll
  for (int h = 0; h < 2; ++h) {
    float x = ls[h];
    x += __shfl_xor(x, 16);
    x += __shfl_xor(x, 32);
    const float f = (x > 0.f ? 1.f / x : 0.f) * G[tokq * 24 + (hg0 + h) * 3 + 1];
#pragma unroll
    for (int dt = 0; dt < 4; ++dt) {
      otot[h][dt] += o[h][dt] * f;
      o[h][dt] = f32x4{0.f, 0.f, 0.f, 0.f};
    }
    m[h] = MINIT;
    ls[h] = 0.f;
  }
  for (int j = (cur >= 8 ? cur - 8 : 0); j <= cur; ++j) {
    __syncthreads();
    load_k_tile(KW + ((size_t)b * S + j * 64) * 128 + kvh * 64, 128, sK, tid);
    load_vt_tile(VWT + (size_t)bk * 64 * S + j * 64, S, sV, tid);
    __syncthreads();
#pragma unroll
    for (int half = 0; half < 2; ++half) {
      float posf[2][4];
      bool valid[2][4];
#pragma unroll
      for (int kt2 = 0; kt2 < 2; ++kt2)
#pragma unroll
        for (int jj = 0; jj < 4; ++jj) {
          int rel = j * 64 - t0 + half * 32 + kt2 * 16 + lg * 4 + jj;
          posf[kt2][jj] = (float)rel;
          valid[kt2][jj] = (rel <= tql) && (tql - rel < 512);
        }
      half_step<2>(sK, sV, half, lr, lg, qf, slope, m, ls, o, posf, valid, psum);
    }
  }
#pragma unroll
  for (int h = 0; h < 2; ++h) {
    float x = ls[h];
    x += __shfl_xor(x, 16);
    x += __shfl_xor(x, 32);
    const float f = (x > 0.f ? 1.f / x : 0.f) * G[tokq * 24 + (hg0 + h) * 3 + 2];
    float ss = 0.f;
#pragma unroll
    for (int dt = 0; dt < 4; ++dt) {
      otot[h][dt] += o[h][dt] * f;
#pragma unroll
      for (int jj = 0; jj < 4; ++jj) ss += otot[h][dt][jj] * otot[h][dt][jj];
    }
    ss += __shfl_xor(ss, 16);
    ss += __shfl_xor(ss, 32);
    const float r = rsqrtf(ss * (1.f / 64.f) + EPS);
#pragma unroll
    for (int dt = 0; dt < 4; ++dt) {
      const int d = dt * 16 + lg * 4;
      const float4 gg = *(const float4*)(p.out_g + l * 1024 + (hg0 + h) * 64 + d);
      uint2 st;
      st.x = pack2(otot[h][dt][0] * r * gg.x, otot[h][dt][1] * r * gg.y);
      st.y = pack2(otot[h][dt][2] * r * gg.z, otot[h][dt][3] * r * gg.w);
      *(uint2*)(OM + tokq * 1024 + (hg0 + h) * 64 + d) = st;
    }
  }
}

DI void gsync(cg::grid_group& g) {
  __threadfence();
  g.sync();
  __threadfence();
}


#ifndef STOP_AFTER
#define STOP_AFTER 0
#endif
#define DUMP_BF16_AND_STOP(ptr)                                                                   \
  {                                                                                               \
    const u16* s_ = (const u16*)(ptr);                                                            \
    for (size_t i = (size_t)bid * 256 + threadIdx.x; i < (size_t)TOK * 1024; i += (size_t)nb * 256) \
      p.out[i] = bf2f(s_[i]);                                                                     \
    return;                                                                                       \
  }
#define DUMP_F32_AND_STOP(ptr)                                                                    \
  {                                                                                               \
    const float* s_ = (const float*)(ptr);                                                        \
    for (size_t i = (size_t)bid * 256 + threadIdx.x; i < (size_t)TOK * 1024; i += (size_t)nb * 256) \
      p.out[i] = s_[i];                                                                           \
    return;                                                                                       \
  }
__global__ void __launch_bounds__(256, 2) mega(Params p) {
  __shared__ __attribute__((aligned(16))) char smem[65536];
  cg::grid_group grid = cg::this_grid();
  char* ws = p.ws;
  const int nb = gridDim.x, bid = blockIdx.x;
  float* X1 = (float*)(ws + OFF_X1);
  u16* H = (u16*)(ws + OFF_H);
  char* wsA = ws + OFF_A;
  const float* mod = (const float*)(ws + OFF_MOD);

#ifdef ZERO_WS
  {
    uint4* z = (uint4*)ws;
    const size_t n16 = (OFF_A + A_END) / 16;
    for (size_t i = (size_t)bid * 256 + threadIdx.x; i < n16; i += (size_t)nb * 256) z[i] = make_uint4(0, 0, 0, 0);
    uint4* zo = (uint4*)p.out;
    const size_t m16 = (size_t)TOK * 1024 * 4 / 16;
    for (size_t i = (size_t)bid * 256 + threadIdx.x; i < m16; i += (size_t)nb * 256) zo[i] = make_uint4(0, 0, 0, 0);
  }
  gsync(grid);
#endif
  phase0a(p, smem);
  gsync(grid);
  phase0b(p);
  gsync(grid);
  phase_mod_x(p);
  gsync(grid);

  for (int l = 0; l < 2; ++l) {
    const float* modl = mod + (size_t)l * 8 * 6144;
    const float* xin = (l == 0) ? p.x : p.out;
    {
      u16* Qo = (u16*)(wsA + A_Q);
      u16* KCo = (u16*)(wsA + A_KC);
      u16* VCo = (u16*)(wsA + A_VC);
      u16* KSo = (u16*)(wsA + A_KS);
      u16* VSTo = (u16*)(wsA + A_VST);
      u16* KWo = (u16*)(wsA + A_KW);
      u16* VWTo = (u16*)(wsA + A_VWT);
      float* Go = (float*)(wsA + A_G);
      u16* Uo = (u16*)(wsA + A_U);
      u16* VGTo = (u16*)(wsA + A_VGT);
      const float* vng = p.vn_g + l * 512;
      const float* vnb = p.vn_b + l * 512;
      auto sel1 = [](int tn) { return !(tn == 7 || tn == 9 || (tn >= 14 && tn < 18)); };
      auto epi = [&](bool swp, int tm, int tn, int wm, int wn, int lr, int lg, f32x4(&acc)[4][4]) {
        const int row0 = tm * 128 + wm * 64;
        const int b = row0 >> 13;
        const int s0 = row0 & (S - 1);
        if (swp) {
          if (tn == 18) {
            if (wn == 0) {
#pragma unroll
              for (int mi = 0; mi < 4; ++mi)
#pragma unroll
                for (int ni = 0; ni < 2; ++ni) {
                  const int c = ni * 16 + lg * 4;
                  const size_t row = (size_t)row0 + mi * 16 + lr;
                  if (c < 24)
                    *(float4*)(Go + row * 24 + c) =
                        make_float4(sigm(acc[mi][ni][0]), sigm(acc[mi][ni][1]), sigm(acc[mi][ni][2]), sigm(acc[mi][ni][3]));
                }
            }
          } else {
            u16* dst;
            int ld, cb;
            float sc = 1.f;
            bool g = false;
            if (tn < 4) { dst = Qo; ld = 512; cb = tn * 128; sc = QSCALE; }
            else if (tn == 4) { dst = KCo; ld = 128; cb = 0; }
            else if (tn == 5) { dst = VCo; ld = 128; cb = 0; }
            else if (tn == 6) { dst = KSo; ld = 128; cb = 0; }
            else if (tn == 8) { dst = KWo; ld = 128; cb = 0; }
            else { dst = Uo; ld = 512; cb = (tn - 10) * 128; g = true; }
#pragma unroll
            for (int mi = 0; mi < 4; ++mi)
#pragma unroll
              for (int ni = 0; ni < 4; ++ni) {
                const size_t row = (size_t)row0 + mi * 16 + lr;
                float v[4];
#pragma unroll
                for (int j = 0; j < 4; ++j) v[j] = g ? gelu_t(acc[mi][ni][j]) : acc[mi][ni][j] * sc;
                uint2 st;
                st.x = pack2(v[0], v[1]);
                st.y = pack2(v[2], v[3]);
                *(uint2*)(dst + row * ld + cb + wn * 64 + ni * 16 + lg * 4) = st;
              }
          }
        } else if (tn == 7 || tn == 9) {
          u16* dst = (tn == 7) ? VSTo : VWTo;
#pragma unroll
          for (int mi = 0; mi < 4; ++mi)
#pragma unroll
            for (int ni = 0; ni < 4; ++ni) {
              const int d = ni * 16 + lr;
              uint2 st;
              st.x = pack2(acc[mi][ni][0], acc[mi][ni][1]);
              st.y = pack2(acc[mi][ni][2], acc[mi][ni][3]);
              *(uint2*)(dst + ((size_t)(b * 2 + wn) * 64 + d) * S + s0 + mi * 16 + lg * 4) = st;
            }
        } else {
          const int grp = (tn - 14) * 2 + wn;
          float vg[4], vb[4];
#pragma unroll
          for (int ni = 0; ni < 4; ++ni) { vg[ni] = vng[grp * 64 + ni * 16 + lr]; vb[ni] = vnb[grp * 64 + ni * 16 + lr]; }
#pragma unroll
          for (int mi = 0; mi < 4; ++mi) {
            float vv[4][4];
#pragma unroll
            for (int ni = 0; ni < 4; ++ni)
#pragma unroll
              for (int j = 0; j < 4; ++j) vv[ni][j] = gelu_t(acc[mi][ni][j]);
#pragma unroll
            for (int j = 0; j < 4; ++j) {
              float s1 = vv[0][j] + vv[1][j] + vv[2][j] + vv[3][j];
              s1 += __shfl_xor(s1, 1); s1 += __shfl_xor(s1, 2); s1 += __shfl_xor(s1, 4); s1 += __shfl_xor(s1, 8);
              const float mu = s1 * (1.f / 64.f);
              float s2 = 0.f;
#pragma unroll
              for (int ni = 0; ni < 4; ++ni) { float dd = vv[ni][j] - mu; s2 += dd * dd; }
              s2 += __shfl_xor(s2, 1); s2 += __shfl_xor(s2, 2); s2 += __shfl_xor(s2, 4); s2 += __shfl_xor(s2, 8);
              const float rs = rsqrtf(s2 * (1.f / 64.f) + EPS);
#pragma unroll
              for (int ni = 0; ni < 4; ++ni) vv[ni][j] = (vv[ni][j] - mu) * rs * vg[ni] + vb[ni];
            }
#pragma unroll
            for (int ni = 0; ni < 4; ++ni) {
              const int d = ni * 16 + lr;
              uint2 st;
              st.x = pack2(vv[ni][0], vv[ni][1]);
              st.y = pack2(vv[ni][2], vv[ni][3]);
              *(uint2*)(VGTo + ((size_t)(b * 8 + grp) * 64 + d) * S + s0 + mi * 16 + lg * 4) = st;
            }
          }
        }
      };
      gemm_phase(H, 1024, (const u16*)(ws + OFF_WTIN + l * SZ_WTIN), 1024, 512, 19, 1024, bid, nb, smem, sel1, epi);
    }
    gsync(grid);
    if (STOP_AFTER == 1 && l == 0) DUMP_BF16_AND_STOP(wsA)
    if (STOP_AFTER == 11 && l == 0) DUMP_BF16_AND_STOP(wsA + A_KW)
    if (STOP_AFTER == 12 && l == 0) DUMP_BF16_AND_STOP(wsA + A_U)
    build_ac(p, l);
    gsync(grid);
    {
      const int ng = (nb >= 512) ? 256 : nb / 2;
      for (int which = 0; which < 2; ++which) {
        u16* HC = (u16*)(wsA + A_HC) + (size_t)which * 8192 * 256;
        auto selT = [](int) { return true; };
        auto epi = [&](bool swp, int tm, int tn, int wm, int wn, int lr, int lg, f32x4(&acc)[4][4]) {
          const int row0 = tm * 128 + wm * 64, col0 = tn * 128 + wn * 64;
#pragma unroll
          for (int mi = 0; mi < 4; ++mi)
#pragma unroll
            for (int ni = 0; ni < 4; ++ni) {
              uint2 st;
              st.x = pack2(gelu_t(acc[mi][ni][0]), gelu_t(acc[mi][ni][1]));
              st.y = pack2(gelu_t(acc[mi][ni][2]), gelu_t(acc[mi][ni][3]));
              *(uint2*)(HC + (size_t)(row0 + mi * 16 + lr) * 256 + col0 + ni * 16 + lg * 4) = st;
            }
        };
        const int half = ng / 2;
        const int vb = (bid < ng) ? (which == 0 ? (bid < half ? bid : -1) : (bid >= half ? bid - half : -1)) : -1;
        gemm_phase((const u16*)(wsA + A_AC) + (size_t)which * 8192 * 2048, 2048,
                   (const u16*)(ws + OFF_WTC1 + (l * 2 + which) * SZ_WTC1), 2048, 64, 2, 2048, vb, half, smem, selT, epi);
      }
      if (bid >= ng)
        for (int it = bid - ng; it < 4096; it += nb - ng) gmlp_item(p, l, it);
    }
    gsync(grid);
    {
      for (int which = 0; which < 2; ++which) {
        u16* KCMP = (u16*)(ws + OFF_KCMP);
        u16* VCMPT = (u16*)(ws + OFF_VCMPT);
        auto selW = [which](int) { return which == 0; };
        auto epi = [&](bool swp, int tm, int tn, int wm, int wn, int lr, int lg, f32x4(&acc)[4][4]) {
          if (wn != 0) return;
          const int row0 = tm * 128 + wm * 64;
#pragma unroll
          for (int mi = 0; mi < 4; ++mi)
#pragma unroll
            for (int ni = 0; ni < 4; ++ni) {
              uint2 st;
              st.x = pack2(acc[mi][ni][0], acc[mi][ni][1]);
              st.y = pack2(acc[mi][ni][2], acc[mi][ni][3]);
              if (swp) {
                *(uint2*)(KCMP + (size_t)(row0 + mi * 16 + lr) * 64 + ni * 16 + lg * 4) = st;
              } else {
                const int d = ni * 16 + lr;
                const int rb = row0 + mi * 16 + lg * 4;
                *(uint2*)(VCMPT + ((size_t)(rb >> 9) * 64 + d) * 512 + (rb & 511)) = st;
              }
            }
        };
        const int vb = (which == 0) ? bid : (bid + nb - 64) % nb;
        gemm_phase((const u16*)(wsA + A_HC) + (size_t)which * 8192 * 256, 256,
                   (const u16*)(ws + OFF_WTC2 + (l * 2 + which) * SZ_WTC2), 256, 64, 1, 256, vb, nb, smem, selW, epi);
      }
    }
    gsync(grid);
    if (STOP_AFTER == 4 && l == 0) DUMP_BF16_AND_STOP(ws + OFF_KCMP)
#ifndef REP_P5
#define REP_P5 1
#endif
    for (int rep = 0; rep < REP_P5; ++rep) {
    for (int r = 0; r * nb < 4096; ++r) {
      const int pos = (r & 1) ? (nb - 1 - bid) : bid;
      const int idx = r * nb + pos;
      if (idx < 4096) {
        const int qh = 255 - (idx >> 4);
        const int rem = idx & 15;
        attn_item(p, l, rem >> 1, rem & 1, qh, smem);
      }
    }
    gsync(grid);
    }
    if (STOP_AFTER == 5 && l == 0) DUMP_BF16_AND_STOP(H)
    if ((STOP_AFTER == 51 || STOP_AFTER == 52) && l == 0) {
      for (size_t i = (size_t)bid * 256 + threadIdx.x; i < (size_t)TOK * 1024; i += (size_t)nb * 256) {
        const int col = (int)(i & 1023);
        const bool keep = (STOP_AFTER == 51) ? (col < 512) : (col >= 512);
        p.out[i] = keep ? bf2f(H[i]) : 0.f;
      }
      return;
    }
    {
      auto selT = [](int) { return true; };
      auto epi = [&](bool swp, int tm, int tn, int wm, int wn, int lr, int lg, f32x4(&acc)[4][4]) {
        const int row0 = tm * 128 + wm * 64, col0 = tn * 128 + wn * 64;
        const int b = row0 >> 13;
#pragma unroll
        for (int ni = 0; ni < 4; ++ni) {
          const int col = col0 + ni * 16 + lg * 4;
          const float4 g1 = *(const float4*)(modl + (size_t)b * 6144 + 2048 + col);
#pragma unroll
          for (int mi = 0; mi < 4; ++mi) {
            const size_t row = (size_t)row0 + mi * 16 + lr;
            const float4 xv = *(const float4*)(xin + row * 1024 + col);
            float4 o4;
            o4.x = ALPHA * xv.x + (1.f + g1.x) * acc[mi][ni][0];
            o4.y = ALPHA * xv.y + (1.f + g1.y) * acc[mi][ni][1];
            o4.z = ALPHA * xv.z + (1.f + g1.z) * acc[mi][ni][2];
            o4.w = ALPHA * xv.w + (1.f + g1.w) * acc[mi][ni][3];
            *(float4*)(X1 + row * 1024 + col) = o4;
          }
        }
      };
      gemm_phase(H, 1024, (const u16*)(ws + OFF_WTO + l * SZ_WTO), 1024, 512, 8, 1024, bid, nb, smem, selT, epi);
    }
    gsync(grid);
    ln_rows(X1, p.ln1_g + l * 1024, p.ln1_b + l * 1024, modl, 3072, 4096, H);
    gsync(grid);
    if (STOP_AFTER == 7 && l == 0) DUMP_F32_AND_STOP(X1)
    {
      u16* HH = (u16*)(wsA);
      auto selT = [](int) { return true; };
      auto epi = [&](bool swp, int tm, int tn, int wm, int wn, int lr, int lg, f32x4(&acc)[4][4]) {
        const int row0 = tm * 128 + wm * 64;
        const int cb = tn * 64 + wn * 32;
#pragma unroll
        for (int mi = 0; mi < 4; ++mi)
#pragma unroll
          for (int ni = 0; ni < 2; ++ni) {
            const size_t row = (size_t)row0 + mi * 16 + lr;
            float v[4];
#pragma unroll
            for (int j = 0; j < 4; ++j) {
              const float a = acc[mi][ni][j], bb = acc[mi][ni + 2][j];
              v[j] = a * sigm(a) * bb;
            }
            uint2 st;
            st.x = pack2(v[0], v[1]);
            st.y = pack2(v[2], v[3]);
            *(uint2*)(HH + row * 2816 + cb + ni * 16 + lg * 4) = st;
          }
      };
      gemm_phase(H, 1024, (const u16*)(ws + OFF_WT13 + l * SZ_WT13), 1024, 512, 44, 1024, bid, nb, smem, selT, epi);
    }
    gsync(grid);
    if (STOP_AFTER == 8 && l == 0) DUMP_BF16_AND_STOP(wsA)
    {
      const u16* HH = (const u16*)(wsA);
      float* outp = p.out;
      auto selT = [](int) { return true; };
      auto epi = [&](bool swp, int tm, int tn, int wm, int wn, int lr, int lg, f32x4(&acc)[4][4]) {
        const int row0 = tm * 128 + wm * 64, col0 = tn * 128 + wn * 64;
        const int b = row0 >> 13;
#pragma unroll
        for (int ni = 0; ni < 4; ++ni) {
          const int col = col0 + ni * 16 + lg * 4;
          const float4 g2 = *(const float4*)(modl + (size_t)b * 6144 + 5120 + col);
#pragma unroll
          for (int mi = 0; mi < 4; ++mi) {
            const size_t row = (size_t)row0 + mi * 16 + lr;
            const float4 xv = *(const float4*)(X1 + row * 1024 + col);
            float4 o4;
            o4.x = ALPHA * xv.x + (1.f + g2.x) * acc[mi][ni][0];
            o4.y = ALPHA * xv.y + (1.f + g2.y) * acc[mi][ni][1];
            o4.z = ALPHA * xv.z + (1.f + g2.z) * acc[mi][ni][2];
            o4.w = ALPHA * xv.w + (1.f + g2.w) * acc[mi][ni][3];
            *(float4*)(outp + row * 1024 + col) = o4;
          }
        }
      };
      gemm_phase(HH, 2816, (const u16*)(ws + OFF_WT2 + l * SZ_WT2), 2816, 512, 8, 2816, bid, nb, smem, selT, epi);
    }
    gsync(grid);
    if (l == 0) {
      ln_rows(p.out, p.ln2_g, p.ln2_b, mod + (size_t)8 * 6144, 0, 1024, H);
      gsync(grid);
    } else {
      ln_rows(p.out, p.ln2_g + 1024, p.ln2_b + 1024, nullptr, 0, 0, nullptr);
    }
  }
}

extern "C" void kernel_launch(void* const* d_in, const int* in_sizes, int n_in, void* d_out, int out_size, void* d_ws,
                              size_t ws_size, hipStream_t stream) {
  static int grid_blocks = 0;
  if (!grid_blocks) {
    int dev = 0, cus = 0, per_cu = 0;
    (void)hipGetDevice(&dev);
    (void)hipDeviceGetAttribute(&cus, hipDeviceAttributeMultiprocessorCount, dev);
    (void)hipOccupancyMaxActiveBlocksPerMultiprocessor(&per_cu, mega, 256, 0);
    if (per_cu > 2) per_cu = 2;
    if (per_cu < 1) per_cu = 1;
    grid_blocks = cus * per_cu;
  }
  Params p{};
  const float* const* in = (const float* const*)d_in;
  p.x = in[0]; p.c = in[1]; p.w_ada = in[2]; p.b_ada = in[3]; p.w_in = in[4]; p.cmp_pos = in[5]; p.cmp_w1 = in[6];
  p.cmp_w2 = in[7]; p.vn_g = in[8]; p.vn_b = in[9]; p.w_s = in[10]; p.b_s = in[11]; p.out_g = in[12]; p.w_o = in[13];
  p.ln1_g = in[14]; p.ln1_b = in[15]; p.w1 = in[16]; p.w3 = in[17]; p.w2 = in[18]; p.ln2_g = in[19]; p.ln2_b = in[20];
  p.out = (float*)d_out;
  p.ws = (char*)d_ws;
  void* args[] = {&p};
  hipError_t e = hipLaunchCooperativeKernel((void*)mega, dim3(grid_blocks), dim3(256), args, 0, stream);
  if (e != hipSuccess) fprintf(stderr, "cooperative launch failed: %s (grid %d)\n", hipGetErrorString(e), grid_blocks);
}
```

```cpp
#define STOP_AFTER 0
#include <hip/hip_runtime.h>
#include <hip/hip_cooperative_groups.h>
#include <cstdio>
namespace cg = cooperative_groups;

typedef unsigned short u16;
using bf16x8 = __attribute__((ext_vector_type(8))) short;
using f32x4 = __attribute__((ext_vector_type(4))) float;
using u32x4 = __attribute__((ext_vector_type(4))) unsigned;
#define DI __device__ __forceinline__
#define MFMA16(a, b, c) __builtin_amdgcn_mfma_f32_16x16x32_bf16((a), (b), (c), 0, 0, 0)

constexpr int S = 8192, TOK = 65536;
constexpr int INW = 2328, INP = 2432;
constexpr float ALPHA = 1.41421356237f;
constexpr float LOG2E = 1.4426950408889634f;
constexpr float QSCALE = 0.125f * LOG2E;
constexpr float NEGB = -1e30f, MINIT = -30000.f;
constexpr float EPS = 1e-5f;

constexpr size_t SZ_WTIN = (size_t)INP * 1024 * 2;
constexpr size_t SZ_WTO = (size_t)1024 * 1024 * 2;
constexpr size_t SZ_WT13 = (size_t)5632 * 1024 * 2;
constexpr size_t SZ_WT2 = (size_t)1024 * 2816 * 2;
constexpr size_t SZ_WTC1 = (size_t)256 * 2048 * 2;
constexpr size_t SZ_WTC2 = (size_t)128 * 256 * 2;
constexpr size_t OFF_WTIN = 0;
constexpr size_t OFF_WTO = OFF_WTIN + 2 * SZ_WTIN;
constexpr size_t OFF_WT13 = OFF_WTO + 2 * SZ_WTO;
constexpr size_t OFF_WT2 = OFF_WT13 + 2 * SZ_WT13;
constexpr size_t OFF_WTC1 = OFF_WT2 + 2 * SZ_WT2;
constexpr size_t OFF_WTC2 = OFF_WTC1 + 4 * SZ_WTC1;
constexpr size_t OFF_MODP = OFF_WTC2 + 4 * SZ_WTC2;
constexpr size_t SZ_MOD = (size_t)2 * 8 * 6144 * 4;
constexpr size_t OFF_MOD = OFF_MODP + 16 * SZ_MOD;
constexpr size_t SZ_CMP = (size_t)8 * 2 * 512 * 64 * 2;
constexpr size_t OFF_CB1P = OFF_MOD + SZ_MOD;
constexpr size_t OFF_CB1 = OFF_CB1P + 16 * 4 * 256 * 4;
constexpr size_t OFF_KCMP = OFF_CB1 + 4 * 256 * 4;
constexpr size_t OFF_VCMPT = OFF_KCMP + SZ_CMP;
constexpr size_t OFF_X1 = OFF_VCMPT + SZ_CMP;
constexpr size_t OFF_H = OFF_X1 + (size_t)TOK * 1024 * 4;
constexpr size_t OFF_A = OFF_H + (size_t)TOK * 1024 * 2;
constexpr size_t SZ_KV = (size_t)TOK * 128 * 2;
constexpr size_t A_Q = 0;
constexpr size_t A_KC = A_Q + (size_t)TOK * 512 * 2;
constexpr size_t A_VC = A_KC + SZ_KV;
constexpr size_t A_KS = A_VC + SZ_KV;
constexpr size_t A_VST = A_KS + SZ_KV;
constexpr size_t A_KW = A_VST + SZ_KV;
constexpr size_t A_VWT = A_KW + SZ_KV;
constexpr size_t A_G = A_VWT + SZ_KV;
constexpr size_t A_U = A_G + (size_t)TOK * 24 * 4;
constexpr size_t A_VGT = A_U + (size_t)TOK * 512 * 2;
constexpr size_t A_AC = A_VGT + (size_t)TOK * 512 * 2;
constexpr size_t A_HC = A_AC + (size_t)2 * 8192 * 2048 * 2;
constexpr size_t A_END = A_HC + (size_t)2 * 8192 * 256 * 2;

struct Params {
  const float *x, *c, *w_ada, *b_ada, *w_in, *cmp_pos, *cmp_w1, *cmp_w2, *vn_g, *vn_b, *w_s, *b_s, *out_g, *w_o,
      *ln1_g, *ln1_b, *w1, *w3, *w2, *ln2_g, *ln2_b;
  float* out;
  char* ws;
};

DI u16 f2bf(float x) { unsigned u = __float_as_uint(x); u += 0x7fffu + ((u >> 16) & 1u); return (u16)(u >> 16); }
DI float bf2f(u16 h) { return __uint_as_float(((unsigned)h) << 16); }
DI unsigned pack2(float a, float b) { return (unsigned)f2bf(a) | ((unsigned)f2bf(b) << 16); }
DI float gelu_t(float x) { float u = 1.5957691216f * (x + 0.044715f * x * x * x); return x / (1.f + __expf(-u)); }
DI float sigm(float x) { return 1.f / (1.f + __expf(-x)); }
DI float ex2(float x) { return __builtin_amdgcn_exp2f(x); }
DI int otid() { int t = threadIdx.x; asm volatile("" : "+v"(t)); return t; }

template <int MODE> DI int map_row(int n) {
  if (MODE == 1) return n < 1280 ? n : (n < 1304 ? n + 1024 : n - 24);
  if (MODE == 2) return (n >> 5) * 64 + (n & 31);
  if (MODE == 3) return (n >> 5) * 64 + 32 + (n & 31);
  return n;
}

template <int MODE>
DI void conv_tile(const float* __restrict__ W, int K, int N, u16* __restrict__ Wt, int ldk, int tile, float* tl) {
  const int tiles_n = (N + 63) / 64;
  const int tk = tile / tiles_n, tn = tile % tiles_n;
  const int k0 = tk * 64, n0 = tn * 64;
  const int tid = otid();
#pragma unroll
  for (int i = 0; i < 16; ++i) {
    int idx = tid + 256 * i;
    int r = idx >> 6, c = idx & 63;
    int n = n0 + c;
    tl[r * 65 + c] = (n < N) ? W[(long)(k0 + r) * N + n] : 0.f;
  }
  __syncthreads();
  const int nl = tid >> 2, kc = tid & 3;
  const int n = n0 + nl;
  if (n < N) {
    const int row = map_row<MODE>(n);
    unsigned pk[8];
#pragma unroll
    for (int i = 0; i < 8; ++i) pk[i] = pack2(tl[(kc * 16 + 2 * i) * 65 + nl], tl[(kc * 16 + 2 * i + 1) * 65 + nl]);
    uint4* dst = (uint4*)(Wt + (long)row * ldk + k0 + kc * 16);
    dst[0] = make_uint4(pk[0], pk[1], pk[2], pk[3]);
    dst[1] = make_uint4(pk[4], pk[5], pk[6], pk[7]);
  }
  __syncthreads();
}

DI void phase0a(const Params& p, char* smem) {
  char* ws = p.ws;
  const int tid = threadIdx.x;
  constexpr int PER_LAYER = 592 + 256 + 704 * 3 + 128 * 2 + 4 * 2;
  constexpr int NCONV = 2 * PER_LAYER;
  constexpr int NTOT = NCONV + 768 + 2 + 64;
  for (int it = blockIdx.x; it < NTOT; it += gridDim.x) {
    if (it < NCONV) {
      const int l = it / PER_LAYER;
      const int li = it % PER_LAYER;
      int base = 0;
#define SEG(MODE, SRC, DST, K_, N_, LDK)                                                   \
  {                                                                                        \
    const int nt_ = ((K_) / 64) * (((N_) + 63) / 64);                                      \
    if (li >= base && li < base + nt_) conv_tile<MODE>(SRC, K_, N_, DST, LDK, li - base, (float*)smem); \
    base += nt_;                                                                           \
  }
      SEG(1, p.w_in + (size_t)l * 1024 * INW, (u16*)(ws + OFF_WTIN + l * SZ_WTIN), 1024, INW, 1024)
      SEG(0, p.w_o + (size_t)l * 1024 * 1024, (u16*)(ws + OFF_WTO + l * SZ_WTO), 1024, 1024, 1024)
      SEG(2, p.w1 + (size_t)l * 1024 * 2816, (u16*)(ws + OFF_WT13 + l * SZ_WT13), 1024, 2816, 1024)
      SEG(3, p.w3 + (size_t)l * 1024 * 2816, (u16*)(ws + OFF_WT13 + l * SZ_WT13), 1024, 2816, 1024)
      SEG(0, p.w2 + (size_t)l * 2816 * 1024, (u16*)(ws + OFF_WT2 + l * SZ_WT2), 2816, 1024, 2816)
      SEG(0, p.cmp_w1 + (size_t)(l * 2 + 0) * 2048 * 256, (u16*)(ws + OFF_WTC1 + (l * 2 + 0) * SZ_WTC1), 2048, 256, 2048)
      SEG(0, p.cmp_w1 + (size_t)(l * 2 + 1) * 2048 * 256, (u16*)(ws + OFF_WTC1 + (l * 2 + 1) * SZ_WTC1), 2048, 256, 2048)
      SEG(0, p.cmp_w2 + (size_t)(l * 2 + 0) * 256 * 64, (u16*)(ws + OFF_WTC2 + (l * 2 + 0) * SZ_WTC2), 256, 64, 256)
      SEG(0, p.cmp_w2 + (size_t)(l * 2 + 1) * 256 * 64, (u16*)(ws + OFF_WTC2 + (l * 2 + 1) * SZ_WTC2), 256, 64, 256)
#undef SEG
    } else if (it < NCONV + 768) {
      const int idx = it - NCONV;
      const int l = idx / 384, r = idx % 384, nb = r / 16, kc = r % 16;
      float* cs = (float*)smem;
      for (int i = tid; i < 512; i += 256) {
        int b = i >> 6, k = i & 63;
        float cv = p.c[b * 1024 + kc * 64 + k];
        cs[i] = cv * sigm(cv);
      }
      __syncthreads();
      const int n = nb * 256 + tid;
      float acc[8];
#pragma unroll
      for (int b = 0; b < 8; ++b) acc[b] = 0.f;
      const float* wp = p.w_ada + ((size_t)l * 1024 + kc * 64) * 6144 + n;
#pragma unroll 8
      for (int k = 0; k < 64; ++k) {
        float wv = wp[(size_t)k * 6144];
#pragma unroll
        for (int b = 0; b < 8; ++b) acc[b] += cs[b * 64 + k] * wv;
      }
      float* modp = (float*)(ws + OFF_MODP);
#pragma unroll
      for (int b = 0; b < 8; ++b) modp[(size_t)((kc * 2 + l) * 8 + b) * 6144 + n] = acc[b];
      __syncthreads();
    } else if (it < NCONV + 768 + 2) {
      const int l = it - NCONV - 768;
      uint4* dst = (uint4*)(ws + OFF_WTIN + l * SZ_WTIN + (size_t)INW * 1024 * 2);
      const int n16 = (INP - INW) * 1024 * 2 / 16;
      for (int i = tid; i < n16; i += 256) dst[i] = make_uint4(0, 0, 0, 0);
    } else {
      const int idx = it - NCONV - 768 - 2;
      const int lw = idx >> 4, kc = idx & 15;
      const float* pos = p.cmp_pos + (size_t)lw * 2048 + kc * 128;
      const float* w1p = p.cmp_w1 + ((size_t)lw * 2048 + kc * 128) * 256 + tid;
      float a = 0.f;
#pragma unroll 8
      for (int k = 0; k < 128; ++k) a += pos[k] * w1p[(size_t)k * 256];
      ((float*)(ws + OFF_CB1P))[(kc * 4 + lw) * 256 + tid] = a;
    }
  }
}

DI void phase0b(const Params& p) {
  const float* modp = (const float*)(p.ws + OFF_MODP);
  float* mod = (float*)(p.ws + OFF_MOD);
  const int n = 2 * 8 * 6144;
  for (int i = blockIdx.x * 256 + threadIdx.x; i < n; i += gridDim.x * 256) {
    int l = i / (8 * 6144), c = i % 6144;
    float a = p.b_ada[l * 6144 + c];
#pragma unroll
    for (int kc = 0; kc < 16; ++kc) a += modp[(size_t)kc * n + i];
    mod[i] = a;
  }
  const float* cbp = (const float*)(p.ws + OFF_CB1P);
  float* cb = (float*)(p.ws + OFF_CB1);
  for (int i = blockIdx.x * 256 + threadIdx.x; i < 1024; i += gridDim.x * 256) {
    float a = 0.f;
#pragma unroll
    for (int kc = 0; kc < 16; ++kc) a += cbp[kc * 1024 + i];
    cb[i] = a;
  }
}

DI void phase_mod_x(const Params& p) {
  const float* mod = (const float*)(p.ws + OFF_MOD);
  u16* H = (u16*)(p.ws + OFF_H);
  const long nchunk = (long)TOK * 1024 / 8;
  for (long i = (long)blockIdx.x * 256 + otid(); i < nchunk; i += (long)gridDim.x * 256) {
    long e = i * 8;
    int col = (int)(e & 1023);
    int b = (int)(e >> 23);
    const float4* xp = (const float4*)(p.x + e);
    const float4* sh = (const float4*)(mod + (size_t)b * 6144 + 0 + col);
    const float4* sc = (const float4*)(mod + (size_t)b * 6144 + 1024 + col);
    float4 x0 = xp[0], x1 = xp[1], s0 = sc[0], s1 = sc[1], h0 = sh[0], h1 = sh[1];
    uint4 o;
    o.x = pack2(x0.x * (1.f + s0.x) + h0.x, x0.y * (1.f + s0.y) + h0.y);
    o.y = pack2(x0.z * (1.f + s0.z) + h0.z, x0.w * (1.f + s0.w) + h0.w);
    o.z = pack2(x1.x * (1.f + s1.x) + h1.x, x1.y * (1.f + s1.y) + h1.y);
    o.w = pack2(x1.z * (1.f + s1.z) + h1.z, x1.w * (1.f + s1.w) + h1.w);
    *(uint4*)(H + e) = o;
  }
}

struct Stg { u32x4 a0, a1, a2, a3, b0, b1, b2, b3; };
DI void g_load(Stg& s, const u16* __restrict__ Ap, int lda, const u16* __restrict__ Bp, int ldb, int kt, int tid, int ksa) {
  const int ch = tid & 7, r = tid >> 3;
  const u16* ap = Ap + (size_t)r * lda + kt * ksa + ch * 8;
  const u16* bp = Bp + (size_t)r * ldb + kt * 64 + ch * 8;
  s.a0 = *(const u32x4*)(ap);
  s.a1 = *(const u32x4*)(ap + (size_t)32 * lda);
  s.a2 = *(const u32x4*)(ap + (size_t)64 * lda);
  s.a3 = *(const u32x4*)(ap + (size_t)96 * lda);
  s.b0 = *(const u32x4*)(bp);
  s.b1 = *(const u32x4*)(bp + (size_t)32 * ldb);
  s.b2 = *(const u32x4*)(bp + (size_t)64 * ldb);
  s.b3 = *(const u32x4*)(bp + (size_t)96 * ldb);
}
DI void g_store(char* d_, const Stg& s, int tid) {
  const int ch = tid & 7, r = tid >> 3;
  char* pa = d_ + r * 128 + ((ch ^ (r & 7)) << 4);
  *(u32x4*)(pa) = s.a0;
  *(u32x4*)(pa + 4096) = s.a1;
  *(u32x4*)(pa + 8192) = s.a2;
  *(u32x4*)(pa + 12288) = s.a3;
  *(u32x4*)(pa + 16384) = s.b0;
  *(u32x4*)(pa + 16384 + 4096) = s.b1;
  *(u32x4*)(pa + 16384 + 8192) = s.b2;
  *(u32x4*)(pa + 16384 + 12288) = s.b3;
}
template <bool SWAP>
DI void g_compute(const char* sA, f32x4 (&acc)[4][4], int wm, int wn, int lr, int lg) {
  const char* sB = sA + 16384;
#pragma unroll
  for (int s = 0; s < 2; ++s) {
    bf16x8 af[4], bfr[4];
#pragma unroll
    for (int mi = 0; mi < 4; ++mi) {
      const int r = wm * 64 + mi * 16 + lr;
      af[mi] = *(const bf16x8*)(sA + r * 128 + (((s * 4 + lg) ^ (r & 7)) << 4));
    }
#pragma unroll
    for (int ni = 0; ni < 4; ++ni) {
      const int r = wn * 64 + ni * 16 + lr;
      bfr[ni] = *(const bf16x8*)(sB + r * 128 + (((s * 4 + lg) ^ (r & 7)) << 4));
    }
#pragma unroll
    for (int mi = 0; mi < 4; ++mi)
#pragma unroll
      for (int ni = 0; ni < 4; ++ni)
        acc[mi][ni] = SWAP ? MFMA16(bfr[ni], af[mi], acc[mi][ni]) : MFMA16(af[mi], bfr[ni], acc[mi][ni]);
  }
}

template <bool SWAP, class Epi>
DI void gemm_tile(const u16* __restrict__ Ap, int lda, const u16* __restrict__ Bp, int ldb, int nk, int tm, int tn, int tid,
                  char* smem, Epi epi, int ksa = 64) {
  const int lane = tid & 63, w = tid >> 6, wm = w >> 1, wn = w & 1;
  const int lr = lane & 15, lg = lane >> 4;
  f32x4 acc[4][4];
#pragma unroll
  for (int i = 0; i < 4; ++i)
#pragma unroll
    for (int j = 0; j < 4; ++j) acc[i][j] = f32x4{0.f, 0.f, 0.f, 0.f};
  Stg r0, r1;
  g_load(r0, Ap, lda, Bp, ldb, 0, tid, ksa);
  if (nk > 1) g_load(r1, Ap, lda, Bp, ldb, 1, tid, ksa);
  g_store(smem, r0, tid);
  __syncthreads();
  if (nk > 2) g_load(r0, Ap, lda, Bp, ldb, 2, tid, ksa);
  for (int kt = 0; kt < nk; kt += 2) {
    g_compute<SWAP>(smem, acc, wm, wn, lr, lg);
    if (kt + 1 < nk) g_store(smem + 32768, r1, tid);
    __syncthreads();
    if (kt + 3 < nk) g_load(r1, Ap, lda, Bp, ldb, kt + 3, tid, ksa);
    if (kt + 1 >= nk) break;
    g_compute<SWAP>(smem + 32768, acc, wm, wn, lr, lg);
    if (kt + 2 < nk) g_store(smem, r0, tid);
    __syncthreads();
    if (kt + 4 < nk) g_load(r0, Ap, lda, Bp, ldb, kt + 4, tid, ksa);
  }
  epi(SWAP, tm, tn, wm, wn, lr, lg, acc);
}

template <class AB, class Sel, class Epi>
DI void gemm_phase_g(AB abase, int lda, int ksa, const u16* __restrict__ Bt, int ldb, int ntm, int ntn, int K, int vb, int nvb,
                     char* smem, Sel swapsel, Epi epi) {
  if (vb < 0 || vb >= nvb) return;
  const int ntiles = ntm * ntn;
  const int nk = K / 64;
  int GM = nvb / ntn;
  if (GM < 1) GM = 1;
  if (GM > ntm) GM = ntm;
  const int gtiles = GM * ntn;
  const int q0 = ((nvb & 7) == 0) ? ((vb & 7) * (nvb >> 3) + (vb >> 3)) : vb;
  for (int q = q0; q < ntiles; q += nvb) {
    const int g = q / gtiles;
    const int i = q - g * gtiles;
    const int gsz = (ntm - g * GM < GM) ? (ntm - g * GM) : GM;
    const int tn = i / gsz;
    const int tm = g * GM + (i - tn * gsz);
    const u16* Ap = abase(tm);
    const u16* Bp = Bt + (size_t)tn * 128 * ldb;
    const int tid = otid();
    if (swapsel(tn)) gemm_tile<true>(Ap, lda, Bp, ldb, nk, tm, tn, tid, smem, epi, ksa);
    else gemm_tile<false>(Ap, lda, Bp, ldb, nk, tm, tn, tid, smem, epi, ksa);
  }
}
template <class Sel, class Epi>
DI void gemm_phase(const u16* __restrict__ A, int lda, const u16* __restrict__ Bt, int ldb, int ntm, int ntn, int K,
                   int vb, int nvb, char* smem, Sel swapsel, Epi epi) {
  auto ab = [=](int tm) { return A + (size_t)tm * 128 * lda; };
  gemm_phase_g(ab, lda, 64, Bt, ldb, ntm, ntn, K, vb, nvb, smem, swapsel, epi);
}
template <class Epi, class Post>
DI void gemm_rowblock_phase(const u16* __restrict__ A, int lda, const u16* __restrict__ Bt, int ldb, int ntm, int ntn, int K,
                            int vb, int nvb, char* smem, Epi epi, Post post) {
  const int nk = K / 64;
  for (int tm = vb; tm < ntm; tm += nvb) {
    const u16* Ap = A + (size_t)tm * 128 * lda;
    for (int tn = 0; tn < ntn; ++tn) {
      const int tid = otid();
      gemm_tile<true>(Ap, lda, Bt + (size_t)tn * 128 * ldb, ldb, nk, tm, tn, tid, smem, epi, 64);
    }
    asm volatile("s_waitcnt vmcnt(0)" ::: "memory");
    __syncthreads();
    post(tm);
  }
}

DI void ln_rows(float* buf, const float* __restrict__ g, const float* __restrict__ bt, const float* __restrict__ modl,
                        int sh_off, int sc_off, u16* H) {
  const int tid_ = otid();
  const int lane = tid_ & 63, w = tid_ >> 6;
  for (int row = blockIdx.x * 4 + w; row < TOK; row += gridDim.x * 4) {
    float4* rp = (float4*)(buf + (size_t)row * 1024);
    float4 v[4];
    float s = 0.f;
#pragma unroll
    for (int i = 0; i < 4; ++i) { v[i] = rp[lane + 64 * i]; s += v[i].x + v[i].y + v[i].z + v[i].w; }
#pragma unroll
    for (int o = 32; o >= 1; o >>= 1) s += __shfl_xor(s, o);
    const float mu = s * (1.f / 1024.f);
    float q = 0.f;
#pragma unroll
    for (int i = 0; i < 4; ++i) {
      float a = v[i].x - mu, b = v[i].y - mu, c = v[i].z - mu, d = v[i].w - mu;
      q += a * a + b * b + c * c + d * d;
    }
#pragma unroll
    for (int o = 32; o >= 1; o >>= 1) q += __shfl_xor(q, o);
    const float rs = rsqrtf(q * (1.f / 1024.f) + EPS);
    const int b = row >> 13;
#pragma unroll
    for (int i = 0; i < 4; ++i) {
      const int col = (lane + 64 * i) * 4;
      float4 gg = *(const float4*)(g + col), bb = *(const float4*)(bt + col);
      float4 y;
      y.x = (v[i].x - mu) * rs * gg.x + bb.x;
      y.y = (v[i].y - mu) * rs * gg.y + bb.y;
      y.z = (v[i].z - mu) * rs * gg.z + bb.z;
      y.w = (v[i].w - mu) * rs * gg.w + bb.w;
      rp[lane + 64 * i] = y;
      if (H) {
        float4 sh = *(const float4*)(modl + (size_t)b * 6144 + sh_off + col);
        float4 sc = *(const float4*)(modl + (size_t)b * 6144 + sc_off + col);
        uint2 o2;
        o2.x = pack2(y.x * (1.f + sc.x) + sh.x, y.y * (1.f + sc.y) + sh.y);
        o2.y = pack2(y.z * (1.f + sc.z) + sh.z, y.w * (1.f + sc.w) + sh.w);
        *(uint2*)(H + (size_t)row * 1024 + col) = o2;
      }
    }
  }
}

DI void ln_block(float* buf, int row0, const float* __restrict__ g, const float* __restrict__ bt,
                 const float* __restrict__ modl, int sh_off, int sc_off, u16* H) {
  const int tid_ = otid();
  const int lane = tid_ & 63, w = tid_ >> 6;
  for (int rr = 0; rr < 32; ++rr) {
    const int row = row0 + w * 32 + rr;
    f32x4* rp = (f32x4*)(buf + (size_t)row * 1024);
    f32x4 v[4];
    float s = 0.f;
#pragma unroll
    for (int i = 0; i < 4; ++i) { v[i] = __builtin_nontemporal_load(rp + lane + 64 * i); s += v[i][0] + v[i][1] + v[i][2] + v[i][3]; }
#pragma unroll
    for (int o = 32; o >= 1; o >>= 1) s += __shfl_xor(s, o);
    const float mu = s * (1.f / 1024.f);
    float q = 0.f;
#pragma unroll
    for (int i = 0; i < 4; ++i)
#pragma unroll
      for (int k = 0; k < 4; ++k) { float a = v[i][k] - mu; q += a * a; }
#pragma unroll
    for (int o = 32; o >= 1; o >>= 1) q += __shfl_xor(q, o);
    const float rs = rsqrtf(q * (1.f / 1024.f) + EPS);
    const int b = row >> 13;
#pragma unroll
    for (int i = 0; i < 4; ++i) {
      const int col = (lane + 64 * i) * 4;
      const float4 gg = *(const float4*)(g + col), bb = *(const float4*)(bt + col);
      f32x4 y;
      y[0] = (v[i][0] - mu) * rs * gg.x + bb.x;
      y[1] = (v[i][1] - mu) * rs * gg.y + bb.y;
      y[2] = (v[i][2] - mu) * rs * gg.z + bb.z;
      y[3] = (v[i][3] - mu) * rs * gg.w + bb.w;
      rp[lane + 64 * i] = y;
      if (H) {
        const float4 sh = *(const float4*)(modl + (size_t)b * 6144 + sh_off + col);
        const float4 sc = *(const float4*)(modl + (size_t)b * 6144 + sc_off + col);
        uint2 o2;
        o2.x = pack2(y[0] * (1.f + sc.x) + sh.x, y[1] * (1.f + sc.y) + sh.y);
        o2.y = pack2(y[2] * (1.f + sc.z) + sh.z, y[3] * (1.f + sc.w) + sh.w);
        *(uint2*)(H + (size_t)row * 1024 + col) = o2;
      }
    }
  }
}

DI void gmlp_item(const Params& p, int l, int item) {
  const int b = item >> 9, c = (item >> 3) & 63, grp = item & 7;
  const int tid_ = otid();
  const int lane = tid_ & 63, w = tid_ >> 6, lr = lane & 15, lg = lane >> 4;
  const float* wsp = p.w_s + (size_t)(l * 8 + grp) * 128 * 128;
  const u16* vgt = (const u16*)(p.ws + OFF_A + A_VGT) + (size_t)(b * 8 + grp) * 64 * S + c * 128;
  const u16* U = (const u16*)(p.ws + OFF_A + A_U);
  u16* OM = (u16*)(p.ws + OFF_H);
  f32x4 acc[4][2];
#pragma unroll
  for (int i = 0; i < 4; ++i)
#pragma unroll
    for (int j = 0; j < 2; ++j) acc[i][j] = f32x4{0.f, 0.f, 0.f, 0.f};
#pragma unroll
  for (int ks = 0; ks < 4; ++ks) {
    const int s0 = ks * 32 + lg * 8;
    bf16x8 af[4];
#pragma unroll
    for (int dt = 0; dt < 4; ++dt) af[dt] = *(const bf16x8*)(vgt + (size_t)(dt * 16 + lr) * S + s0);
#pragma unroll
    for (int nt = 0; nt < 2; ++nt) {
      const int t = w * 32 + nt * 16 + lr;
      const float4* wp = (const float4*)(wsp + t * 128 + s0);
      float4 a0 = wp[0], a1 = wp[1];
      unsigned pw[4];
      pw[0] = pack2((s0 + 0 <= t) ? a0.x : 0.f, (s0 + 1 <= t) ? a0.y : 0.f);
      pw[1] = pack2((s0 + 2 <= t) ? a0.z : 0.f, (s0 + 3 <= t) ? a0.w : 0.f);
      pw[2] = pack2((s0 + 4 <= t) ? a1.x : 0.f, (s0 + 5 <= t) ? a1.y : 0.f);
      pw[3] = pack2((s0 + 6 <= t) ? a1.z : 0.f, (s0 + 7 <= t) ? a1.w : 0.f);
      bf16x8 bw = __builtin_bit_cast(bf16x8, make_uint4(pw[0], pw[1], pw[2], pw[3]));
#pragma unroll
      for (int dt = 0; dt < 4; ++dt) acc[dt][nt] = MFMA16(af[dt], bw, acc[dt][nt]);
    }
  }
#pragma unroll
  for (int nt = 0; nt < 2; ++nt) {
    const int t = w * 32 + nt * 16 + lr;
    const size_t tok = (size_t)b * S + c * 128 + t;
    const float bias = p.b_s[(l * 8 + grp) * 128 + t];
    float val[4][4];
    float ss = 0.f;
#pragma unroll
    for (int dt = 0; dt < 4; ++dt) {
      const int d = dt * 16 + lg * 4;
      const uint2 uu = *(const uint2*)(U + tok * 512 + grp * 64 + d);
      const float u0 = bf2f(uu.x & 0xffff), u1 = bf2f(uu.x >> 16), u2 = bf2f(uu.y & 0xffff), u3 = bf2f(uu.y >> 16);
      val[dt][0] = u0 * (acc[dt][nt][0] + bias);
      val[dt][1] = u1 * (acc[dt][nt][1] + bias);
      val[dt][2] = u2 * (acc[dt][nt][2] + bias);
      val[dt][3] = u3 * (acc[dt][nt][3] + bias);
#pragma unroll
      for (int j = 0; j < 4; ++j) ss += val[dt][j] * val[dt][j];
    }
    ss += __shfl_xor(ss, 16);
    ss += __shfl_xor(ss, 32);
    const float r = rsqrtf(ss * (1.f / 64.f) + EPS);
#pragma unroll
    for (int dt = 0; dt < 4; ++dt) {
      const int d = dt * 16 + lg * 4;
      const float4 gg = *(const float4*)(p.out_g + l * 1024 + 512 + grp * 64 + d);
      uint2 st;
      st.x = pack2(val[dt][0] * r * gg.x, val[dt][1] * r * gg.y);
      st.y = pack2(val[dt][2] * r * gg.z, val[dt][3] * r * gg.w);
      *(uint2*)(OM + tok * 1024 + 512 + grp * 64 + d) = st;
    }
  }
}

constexpr int SM_K = 0, SM_V = 8192, SM_IMP = 8192 + 8704, SM_SEL = SM_IMP + 64 * 132 * 4, SM_UNI = SM_SEL + 1024;

DI void load_k_tile(const u16* __restrict__ src, int stride, char* sK, int tid) {
#pragma unroll
  for (int i = 0; i < 2; ++i) {
    int idx = tid + 256 * i, r = idx >> 3, ch = idx & 7;
    uint4 v = *(const uint4*)(src + (size_t)r * stride + ch * 8);
    *(uint4*)(sK + r * 128 + ((ch ^ (r & 7)) << 4)) = v;
  }
}
DI void load_vt_tile(const u16* __restrict__ src, int stride, char* sV, int tid) {
#pragma unroll
  for (int i = 0; i < 2; ++i) {
    int idx = tid + 256 * i, d = idx >> 3, ch = idx & 7;
    uint4 v = *(const uint4*)(src + (size_t)d * stride + ch * 8);
    uint2* dst = (uint2*)(sV + d * 136 + ch * 16);
    dst[0] = make_uint2(v.x, v.y);
    dst[1] = make_uint2(v.z, v.w);
  }
}

template <int MODE>
DI void half_step(const char* sK, const char* sV, int half, int lr, int lg, const bf16x8 (&qf)[2][2], const float (&slope)[2],
                  float (&m)[2], float (&lsum)[2], f32x4 (&o)[2][4], const float (&posf)[2][4], const bool (&valid)[2][4],
                  float (&psum)[2][4]) {
  bf16x8 kf[2][2];
#pragma unroll
  for (int kt2 = 0; kt2 < 2; ++kt2) {
    const int r = half * 32 + kt2 * 16 + lr;
    kf[kt2][0] = *(const bf16x8*)(sK + r * 128 + (((lg) ^ (r & 7)) << 4));
    kf[kt2][1] = *(const bf16x8*)(sK + r * 128 + (((4 + lg) ^ (r & 7)) << 4));
  }
  if (MODE == 1) {
#pragma unroll
    for (int a = 0; a < 2; ++a)
#pragma unroll
      for (int j = 0; j < 4; ++j) psum[a][j] = 0.f;
  }
  bf16x8 pf[2];
#pragma unroll
  for (int h = 0; h < 2; ++h) {
    f32x4 s[2];
#pragma unroll
    for (int kt2 = 0; kt2 < 2; ++kt2) {
      f32x4 z = f32x4{0.f, 0.f, 0.f, 0.f};
      z = MFMA16(kf[kt2][0], qf[h][0], z);
      z = MFMA16(kf[kt2][1], qf[h][1], z);
      s[kt2] = z;
    }
    float mx = NEGB;
#pragma unroll
    for (int kt2 = 0; kt2 < 2; ++kt2)
#pragma unroll
      for (int j = 0; j < 4; ++j) {
        float v = valid[kt2][j] ? (s[kt2][j] + slope[h] * posf[kt2][j]) : NEGB;
        s[kt2][j] = v;
        mx = fmaxf(mx, v);
      }
    if (MODE != 1) {
      mx = fmaxf(mx, __shfl_xor(mx, 16));
      mx = fmaxf(mx, __shfl_xor(mx, 32));
      const float mn = fmaxf(m[h], mx);
      const float alpha = ex2(m[h] - mn);
      m[h] = mn;
      float ps = 0.f;
#pragma unroll
      for (int kt2 = 0; kt2 < 2; ++kt2)
#pragma unroll
        for (int j = 0; j < 4; ++j) {
          float pv = ex2(s[kt2][j] - mn);
          s[kt2][j] = pv;
          ps += pv;
        }
      lsum[h] = lsum[h] * alpha + ps;
      if (MODE == 2) {
#pragma unroll
        for (int dt = 0; dt < 4; ++dt) o[h][dt] *= alpha;
      }
    } else {
#pragma unroll
      for (int kt2 = 0; kt2 < 2; ++kt2)
#pragma unroll
        for (int j = 0; j < 4; ++j) {
          float pv = ex2(s[kt2][j] - m[h]) * lsum[h];
          s[kt2][j] = pv;
          psum[kt2][j] += pv;
        }
    }
    if (MODE != 0) {
      uint4 pk = make_uint4(pack2(s[0][0], s[0][1]), pack2(s[0][2], s[0][3]), pack2(s[1][0], s[1][1]), pack2(s[1][2], s[1][3]));
      pf[h] = __builtin_bit_cast(bf16x8, pk);
    }
  }
  if (MODE != 0) {
#pragma unroll
    for (int dt = 0; dt < 4; ++dt) {
      const char* base = sV + (dt * 16 + lr) * 136 + half * 64 + lg * 8;
      uint2 a = *(const uint2*)(base);
      uint2 c = *(const uint2*)(base + 32);
      bf16x8 vf = __builtin_bit_cast(bf16x8, make_uint4(a.x, a.y, c.x, c.y));
#pragma unroll
      for (int h = 0; h < 2; ++h) o[h][dt] = MFMA16(vf, pf[h], o[h][dt]);
    }
  }
}

DI void attn_item(const Params& p, int l, int b, int kvh, int qh, char* smem) {
  char* sK = smem + SM_K;
  char* sV = smem + SM_V;
  float* sImp = (float*)(smem + SM_IMP);
  unsigned* sSel = (unsigned*)(smem + SM_SEL);
  unsigned* sUni = (unsigned*)(smem + SM_UNI);
  const char* wsA = p.ws + OFF_A;
  const u16* Q = (const u16*)(wsA + A_Q);
  const u16* KS = (const u16*)(wsA + A_KS);
  const u16* VST = (const u16*)(wsA + A_VST);
  const u16* KW = (const u16*)(wsA + A_KW);
  const u16* VWT = (const u16*)(wsA + A_VWT);
  const float* G = (const float*)(wsA + A_G);
  const u16* KCMP = (const u16*)(p.ws + OFF_KCMP);
  const u16* VCMPT = (const u16*)(p.ws + OFF_VCMPT);
  u16* OM = (u16*)(p.ws + OFF_H);

  const int tid = otid(), lane = tid & 63, w = tid >> 6, lr = lane & 15, lg = lane >> 4;
  const int hp = w >> 1;
  const int t0 = qh * 32;
  const int cur = qh >> 1;
  const int tql = 16 * (w & 1) + lr;
  const size_t tokq = (size_t)b * S + t0 + tql;
  const int bk = b * 2 + kvh;
  const int hg0 = kvh * 4 + hp * 2;

  bf16x8 qf[2][2];
  float slope[2];
#pragma unroll
  for (int h = 0; h < 2; ++h) {
    const u16* qp = Q + tokq * 512 + (hg0 + h) * 64 + lg * 8;
    qf[h][0] = *(const bf16x8*)qp;
    qf[h][1] = *(const bf16x8*)(qp + 32);
    slope[h] = ex2(-(float)(hg0 + h + 1)) * LOG2E;
  }
  float m[2], ls[2];
  f32x4 o[2][4], otot[2][4];
  float psum[2][4];
#pragma unroll
  for (int h = 0; h < 2; ++h) {
    m[h] = MINIT;
    ls[h] = 0.f;
#pragma unroll
    for (int dt = 0; dt < 4; ++dt) o[h][dt] = f32x4{0.f, 0.f, 0.f, 0.f};
  }

  const int amax = qh >> 5;
  const u16* kc_base = KCMP + (size_t)bk * 512 * 64;
  const u16* vc_base = VCMPT + (size_t)bk * 64 * 512;
  for (int a = 0; a <= amax; ++a) {
    __syncthreads();
    load_k_tile(kc_base + (size_t)a * 64 * 64, 64, sK, tid);
    __syncthreads();
#pragma unroll
    for (int half = 0; half < 2; ++half) {
      float posf[2][4];
      bool valid[2][4];
#pragma unroll
      for (int kt2 = 0; kt2 < 2; ++kt2)
#pragma unroll
        for (int j = 0; j < 4; ++j) {
          int n = a * 64 + half * 32 + kt2 * 16 + lg * 4 + j;
          int rel = 16 * n + 31 - t0;
          posf[kt2][j] = (float)rel;
          valid[kt2][j] = rel <= tql;
        }
      half_step<0>(sK, sV, half, lr, lg, qf, slope, m, ls, o, posf, valid, psum);
    }
  }
#pragma unroll
  for (int h = 0; h < 2; ++h) {
    float x = ls[h];
    x += __shfl_xor(x, 16);
    x += __shfl_xor(x, 32);
    ls[h] = x > 0.f ? 1.f / x : 0.f;
  }
  float carry = 0.f;
  float* myImp = sImp + hp * (32 * 132);
  for (int a = 0; a <= amax; ++a) {
    __syncthreads();
    load_k_tile(kc_base + (size_t)a * 64 * 64, 64, sK, tid);
    load_vt_tile(vc_base + a * 64, 512, sV, tid);
    __syncthreads();
#pragma unroll
    for (int half = 0; half < 2; ++half) {
      float posf[2][4];
      bool valid[2][4];
#pragma unroll
      for (int kt2 = 0; kt2 < 2; ++kt2)
#pragma unroll
        for (int j = 0; j < 4; ++j) {
          int n = a * 64 + half * 32 + kt2 * 16 + lg * 4 + j;
          int rel = 16 * n + 31 - t0;
          posf[kt2][j] = (float)rel;
          valid[kt2][j] = rel <= tql;
        }
      half_step<1>(sK, sV, half, lr, lg, qf, slope, m, ls, o, posf, valid, psum);
      float prev = carry;
#pragma unroll
      for (int kt2 = 0; kt2 < 2; ++kt2) {
        float sum4 = psum[kt2][0] + psum[kt2][1] + psum[kt2][2] + psum[kt2][3];
        float p3 = psum[kt2][3];
        float up = __shfl(p3, (lane + 48) & 63);
        float wrap = __shfl(prev, (lane + 48) & 63);
        float spill = lg > 0 ? up : wrap;
        int j = a * 16 + half * 8 + kt2 * 4 + lg;
        myImp[tql * 132 + j] = sum4 + spill;
        prev = p3;
      }
      carry = prev;
    }
  }
#pragma unroll
  for (int h = 0; h < 2; ++h) {
    const float g0 = G[tokq * 24 + (hg0 + h) * 3 + 0];
#pragma unroll
    for (int dt = 0; dt < 4; ++dt) {
      otot[h][dt] = o[h][dt] * g0;
      o[h][dt] = f32x4{0.f, 0.f, 0.f, 0.f};
    }
    m[h] = MINIT;
    ls[h] = 0.f;
  }
  if (tid < 4) sUni[tid] = 0u;
  __syncthreads();
  if (tid < 128) {
    const int q = tid >> 2, sub = tid & 3;
    unsigned mk[4] = {0u, 0u, 0u, 0u};
    if (cur < 16) {
      mk[0] = (1u << (cur + 1)) - 1u;
    } else {
      float v[32];
#pragma unroll
      for (int i = 0; i < 32; ++i) {
        int j = sub + 4 * i;
        v[i] = (j >= 1 && j <= cur - 2) ? (sImp[q * 132 + j] + sImp[32 * 132 + q * 132 + j]) : -1.f;
      }
      for (int round = 0; round < 13; ++round) {
        float bv = v[0];
        int bi = 0;
#pragma unroll
        for (int i = 1; i < 32; ++i)
          if (v[i] > bv) { bv = v[i]; bi = i; }
        int bj = sub + 4 * bi;
#pragma unroll
        for (int off = 1; off <= 2; off <<= 1) {
          float ov = __shfl_xor(bv, off);
          int oj = __shfl_xor(bj, off);
          if (ov > bv || (ov == bv && oj < bj)) { bv = ov; bj = oj; }
        }
#pragma unroll
        for (int i = 0; i < 32; ++i)
          if (sub + 4 * i == bj) v[i] = -2.f;
#pragma unroll
        for (int wd = 0; wd < 4; ++wd) mk[wd] |= ((bj >> 5) == wd) ? (1u << (bj & 31)) : 0u;
      }
      const int f1 = cur, f2 = cur - 1;
      mk[0] |= 1u;
#pragma unroll
      for (int wd = 0; wd < 4; ++wd) {
        mk[wd] |= ((f1 >> 5) == wd) ? (1u << (f1 & 31)) : 0u;
        mk[wd] |= ((f2 >> 5) == wd) ? (1u << (f2 & 31)) : 0u;
      }
    }
    if (sub == 0) {
#pragma unroll
      for (int wd = 0; wd < 4; ++wd) {
        sSel[q * 4 + wd] = mk[wd];
        atomicOr(&sUni[wd], mk[wd]);
      }
    }
  }
  __syncthreads();
  for (int j = 0; j <= cur; ++j) {
    const unsigned uw = sUni[j >> 5];
    if (!((uw >> (j & 31)) & 1u)) continue;
    __syncthreads();
    load_k_tile(KS + ((size_t)b * S + j * 64) * 128 + kvh * 64, 128, sK, tid);
    load_vt_tile(VST + (size_t)bk * 64 * S + j * 64, S, sV, tid);
    __syncthreads();
    const bool selbit = (sSel[tql * 4 + (j >> 5)] >> (j & 31)) & 1u;
#pragma unroll
    for (int half = 0; half < 2; ++half) {
      float posf[2][4];
      bool valid[2][4];
#pragma unroll
      for (int kt2 = 0; kt2 < 2; ++kt2)
#pragma unroll
        for (int jj = 0; jj < 4; ++jj) {
          int rel = j * 64 - t0 + half * 32 + kt2 * 16 + lg * 4 + jj;
          posf[kt2][jj] = (float)rel;
          valid[kt2][jj] = selbit && (rel <= tql);
        }
      half_step<2>(sK, sV, half, lr, lg, qf, slope, m, ls, o, posf, valid, psum);
    }
  }
#pragma unroll
  for (int h = 0; h < 2; ++h) {
    float x = ls[h];
    x += __shfl_xor(x, 16);
    x += __shfl_xor(x, 32);
    const float f = (x > 0.f ? 1.f / x : 0.f) * G[tokq * 24 + (hg0 + h) * 3 + 1];
#pragma unroll
    for (int dt = 0; dt < 4; ++dt) {
      otot[h][dt] += o[h][dt] * f;
      o[h][dt] = f32x4{0.f, 0.f, 0.f, 0.f};
    }
    m[h] = MINIT;
    ls[h] = 0.f;
  }
  for (int j = (cur >= 8 ? cur - 8 : 0); j <= cur; ++j) {
    __syncthreads();
    load_k_tile(KW + ((size_t)b * S + j * 64) * 128 + kvh * 64, 128, sK, tid);
    load_vt_tile(VWT + (size_t)bk * 64 * S + j * 64, S, sV, tid);
    __syncthreads();
#pragma unroll
    for (int half = 0; half < 2; ++half) {
      float posf[2][4];
      bool valid[2][4];
#pragma unroll
      for (int kt2 = 0; kt2 < 2; ++kt2)
#pragma unroll
        for (int jj = 0; jj < 4; ++jj) {
          int rel = j * 64 - t0 + half * 32 + kt2 * 16 + lg * 4 + jj;
          posf[kt2][jj] = (float)rel;
          valid[kt2][jj] = (rel <= tql) && (tql - rel < 512);
        }
      half_step<2>(sK, sV, half, lr, lg, qf, slope, m, ls, o, posf, valid, psum);
    }
  }
#pragma unroll
  for (int h = 0; h < 2; ++h) {
    float x = ls[h];
    x += __shfl_xor(x, 16);
    x += __shfl_xor(x, 32);
    const float f = (x > 0.f ? 1.f / x : 0.f) * G[tokq * 24 + (hg0 + h) * 3 + 2];
    float ss = 0.f;
#pragma unroll
    for (int dt = 0; dt < 4; ++dt) {
      otot[h][dt] += o[h][dt] * f;
#pragma unroll
      for (int jj = 0; jj < 4; ++jj) ss += otot[h][dt][jj] * otot[h][dt][jj];
    }
    ss += __shfl_xor(ss, 16);
    ss += __shfl_xor(ss, 32);
    const float r = rsqrtf(ss * (1.f / 64.f) + EPS);
#pragma unroll
    for (int dt = 0; dt < 4; ++dt) {
      const int d = dt * 16 + lg * 4;
      const float4 gg = *(const float4*)(p.out_g + l * 1024 + (hg0 + h) * 64 + d);
      uint2 st;
      st.x = pack2(otot[h][dt][0] * r * gg.x, otot[h][dt][1] * r * gg.y);
      st.y = pack2(otot[h][dt][2] * r * gg.z, otot[h][dt][3] * r * gg.w);
      *(uint2*)(OM + tokq * 1024 + (hg0 + h) * 64 + d) = st;
    }
  }
}

DI void gsync(cg::grid_group& g) {
  asm volatile("s_waitcnt vmcnt(0)" ::: "memory");
  g.sync();
  __builtin_amdgcn_fence(__ATOMIC_ACQUIRE, "agent");
  asm volatile("s_waitcnt vmcnt(0)" ::: "memory");
}


#ifndef STOP_AFTER
#define STOP_AFTER 0
#endif
#define DUMP_BF16_AND_STOP(ptr)                                                                   \
  {                                                                                               \
    const u16* s_ = (const u16*)(ptr);                                                            \
    for (size_t i = (size_t)bid * 256 + threadIdx.x; i < (size_t)TOK * 1024; i += (size_t)nb * 256) \
      p.out[i] = bf2f(s_[i]);                                                                     \
    return;                                                                                       \
  }
#define DUMP_F32_AND_STOP(ptr)                                                                    \
  {                                                                                               \
    const float* s_ = (const float*)(ptr);                                                        \
    for (size_t i = (size_t)bid * 256 + threadIdx.x; i < (size_t)TOK * 1024; i += (size_t)nb * 256) \
      p.out[i] = s_[i];                                                                           \
    return;                                                                                       \
  }
__global__ void __launch_bounds__(256, 2) mega(Params p) {
  __shared__ __attribute__((aligned(16))) char smem[65536];
  cg::grid_group grid = cg::this_grid();
  char* ws = p.ws;
  const int nb = gridDim.x, bid = blockIdx.x;
  float* X1 = (float*)(ws + OFF_X1);
  u16* H = (u16*)(ws + OFF_H);
  char* wsA = ws + OFF_A;
  const float* mod = (const float*)(ws + OFF_MOD);

#ifdef ZERO_WS
  {
    uint4* z = (uint4*)ws;
    const size_t n16 = (OFF_A + A_END) / 16;
    for (size_t i = (size_t)bid * 256 + threadIdx.x; i < n16; i += (size_t)nb * 256) z[i] = make_uint4(0, 0, 0, 0);
    uint4* zo = (uint4*)p.out;
    const size_t m16 = (size_t)TOK * 1024 * 4 / 16;
    for (size_t i = (size_t)bid * 256 + threadIdx.x; i < m16; i += (size_t)nb * 256) zo[i] = make_uint4(0, 0, 0, 0);
  }
  gsync(grid);
#endif
  phase0a(p, smem);
  gsync(grid);
  phase0b(p);
  gsync(grid);
  phase_mod_x(p);
  gsync(grid);

  for (int l = 0; l < 2; ++l) {
    const float* modl = mod + (size_t)l * 8 * 6144;
    const float* xin = (l == 0) ? p.x : p.out;
    {
      u16* Qo = (u16*)(wsA + A_Q);
      u16* KCo = (u16*)(wsA + A_KC);
      u16* VCo = (u16*)(wsA + A_VC);
      u16* KSo = (u16*)(wsA + A_KS);
      u16* VSTo = (u16*)(wsA + A_VST);
      u16* KWo = (u16*)(wsA + A_KW);
      u16* VWTo = (u16*)(wsA + A_VWT);
      float* Go = (float*)(wsA + A_G);
      u16* Uo = (u16*)(wsA + A_U);
      u16* VGTo = (u16*)(wsA + A_VGT);
      const float* vng = p.vn_g + l * 512;
      const float* vnb = p.vn_b + l * 512;
      auto sel1 = [](int tn) { return !(tn == 7 || tn == 9 || (tn >= 14 && tn < 18)); };
      auto epi = [&](bool swp, int tm, int tn, int wm, int wn, int lr, int lg, f32x4(&acc)[4][4]) {
        const int row0 = tm * 128 + wm * 64;
        const int b = row0 >> 13;
        const int s0 = row0 & (S - 1);
        if (swp) {
          if (tn == 18) {
            if (wn == 0) {
#pragma unroll
              for (int mi = 0; mi < 4; ++mi)
#pragma unroll
                for (int ni = 0; ni < 2; ++ni) {
                  const int c = ni * 16 + lg * 4;
                  const size_t row = (size_t)row0 + mi * 16 + lr;
                  if (c < 24)
                    *(float4*)(Go + row * 24 + c) =
                        make_float4(sigm(acc[mi][ni][0]), sigm(acc[mi][ni][1]), sigm(acc[mi][ni][2]), sigm(acc[mi][ni][3]));
                }
            }
          } else {
            u16* dst;
            int ld, cb;
            float sc = 1.f;
            bool g = false;
            if (tn < 4) { dst = Qo; ld = 512; cb = tn * 128; sc = QSCALE; }
            else if (tn == 4) { dst = KCo; ld = 128; cb = 0; }
            else if (tn == 5) { dst = VCo; ld = 128; cb = 0; }
            else if (tn == 6) { dst = KSo; ld = 128; cb = 0; }
            else if (tn == 8) { dst = KWo; ld = 128; cb = 0; }
            else { dst = Uo; ld = 512; cb = (tn - 10) * 128; g = true; }
#pragma unroll
            for (int mi = 0; mi < 4; ++mi)
#pragma unroll
              for (int ni = 0; ni < 4; ++ni) {
                const size_t row = (size_t)row0 + mi * 16 + lr;
                float v[4];
#pragma unroll
                for (int j = 0; j < 4; ++j) v[j] = g ? gelu_t(acc[mi][ni][j]) : acc[mi][ni][j] * sc;
                uint2 st;
                st.x = pack2(v[0], v[1]);
                st.y = pack2(v[2], v[3]);
                *(uint2*)(dst + row * ld + cb + wn * 64 + ni * 16 + lg * 4) = st;
              }
          }
        } else if (tn == 7 || tn == 9) {
          u16* dst = (tn == 7) ? VSTo : VWTo;
#pragma unroll
          for (int mi = 0; mi < 4; ++mi)
#pragma unroll
            for (int ni = 0; ni < 4; ++ni) {
              const int d = ni * 16 + lr;
              uint2 st;
              st.x = pack2(acc[mi][ni][0], acc[mi][ni][1]);
              st.y = pack2(acc[mi][ni][2], acc[mi][ni][3]);
              *(uint2*)(dst + ((size_t)(b * 2 + wn) * 64 + d) * S + s0 + mi * 16 + lg * 4) = st;
            }
        } else {
          const int grp = (tn - 14) * 2 + wn;
          float vg[4], vb[4];
#pragma unroll
          for (int ni = 0; ni < 4; ++ni) { vg[ni] = vng[grp * 64 + ni * 16 + lr]; vb[ni] = vnb[grp * 64 + ni * 16 + lr]; }
#pragma unroll
          for (int mi = 0; mi < 4; ++mi) {
            float vv[4][4];
#pragma unroll
            for (int ni = 0; ni < 4; ++ni)
#pragma unroll
              for (int j = 0; j < 4; ++j) vv[ni][j] = gelu_t(acc[mi][ni][j]);
#pragma unroll
            for (int j = 0; j < 4; ++j) {
              float s1 = vv[0][j] + vv[1][j] + vv[2][j] + vv[3][j];
              s1 += __shfl_xor(s1, 1); s1 += __shfl_xor(s1, 2); s1 += __shfl_xor(s1, 4); s1 += __shfl_xor(s1, 8);
              const float mu = s1 * (1.f / 64.f);
              float s2 = 0.f;
#pragma unroll
              for (int ni = 0; ni < 4; ++ni) { float dd = vv[ni][j] - mu; s2 += dd * dd; }
              s2 += __shfl_xor(s2, 1); s2 += __shfl_xor(s2, 2); s2 += __shfl_xor(s2, 4); s2 += __shfl_xor(s2, 8);
              const float rs = rsqrtf(s2 * (1.f / 64.f) + EPS);
#pragma unroll
              for (int ni = 0; ni < 4; ++ni) vv[ni][j] = (vv[ni][j] - mu) * rs * vg[ni] + vb[ni];
            }
#pragma unroll
            for (int ni = 0; ni < 4; ++ni) {
              const int d = ni * 16 + lr;
              uint2 st;
              st.x = pack2(vv[ni][0], vv[ni][1]);
              st.y = pack2(vv[ni][2], vv[ni][3]);
              *(uint2*)(VGTo + ((size_t)(b * 8 + grp) * 64 + d) * S + s0 + mi * 16 + lg * 4) = st;
            }
          }
        }
      };
      gemm_phase(H, 1024, (const u16*)(ws + OFF_WTIN + l * SZ_WTIN), 1024, 512, 19, 1024, bid, nb, smem, sel1, epi);
    }
    gsync(grid);
    if (STOP_AFTER == 1 && l == 0) DUMP_BF16_AND_STOP(wsA)
    if (STOP_AFTER == 11 && l == 0) DUMP_BF16_AND_STOP(wsA + A_KW)
    if (STOP_AFTER == 12 && l == 0) DUMP_BF16_AND_STOP(wsA + A_U)
    {
      const int ng = (nb >= 256) ? 256 : nb;
      const int half = ng / 2;
      for (int which = 0; which < 2; ++which) {
        u16* HC = (u16*)(wsA + A_HC) + (size_t)which * 8192 * 256;
        const float* cb1 = (const float*)(ws + OFF_CB1) + (l * 2 + which) * 256;
        const u16* src_tok = (const u16*)(wsA + (which ? A_VC : A_KC));
        auto selT = [](int) { return true; };
        auto ab = [=](int tm) {
          const int bk = tm >> 2, n0 = (tm & 3) * 128;
          return src_tok + ((size_t)(bk >> 1) * S + 16 * n0) * 128 + (bk & 1) * 64;
        };
        auto epi = [&](bool swp, int tm, int tn, int wm, int wn, int lr, int lg, f32x4(&acc)[4][4]) {
          const int row0 = tm * 128 + wm * 64, col0 = tn * 128 + wn * 64;
#pragma unroll
          for (int ni = 0; ni < 4; ++ni) {
            const float4 cb = *(const float4*)(cb1 + col0 + ni * 16 + lg * 4);
#pragma unroll
            for (int mi = 0; mi < 4; ++mi) {
              uint2 st;
              st.x = pack2(gelu_t(acc[mi][ni][0] + cb.x), gelu_t(acc[mi][ni][1] + cb.y));
              st.y = pack2(gelu_t(acc[mi][ni][2] + cb.z), gelu_t(acc[mi][ni][3] + cb.w));
              *(uint2*)(HC + (size_t)(row0 + mi * 16 + lr) * 256 + col0 + ni * 16 + lg * 4) = st;
            }
          }
        };
        const int vb = (bid < ng) ? (which == 0 ? (bid < half ? bid : -1) : (bid >= half ? bid - half : -1)) : -1;
        gemm_phase_g(ab, 2048, 128, (const u16*)(ws + OFF_WTC1 + (l * 2 + which) * SZ_WTC1), 2048, 64, 2, 2048, vb, half, smem,
                     selT, epi);
      }
    }
    gsync(grid);
    {
      for (int which = 0; which < 2; ++which) {
        u16* KCMP = (u16*)(ws + OFF_KCMP);
        u16* VCMPT = (u16*)(ws + OFF_VCMPT);
        auto selW = [which](int) { return which == 0; };
        auto epi = [&](bool swp, int tm, int tn, int wm, int wn, int lr, int lg, f32x4(&acc)[4][4]) {
          if (wn != 0) return;
          const int row0 = tm * 128 + wm * 64;
#pragma unroll
          for (int mi = 0; mi < 4; ++mi)
#pragma unroll
            for (int ni = 0; ni < 4; ++ni) {
              uint2 st;
              st.x = pack2(acc[mi][ni][0], acc[mi][ni][1]);
              st.y = pack2(acc[mi][ni][2], acc[mi][ni][3]);
              if (swp) {
                *(uint2*)(KCMP + (size_t)(row0 + mi * 16 + lr) * 64 + ni * 16 + lg * 4) = st;
              } else {
                const int d = ni * 16 + lr;
                const int rb = row0 + mi * 16 + lg * 4;
                *(uint2*)(VCMPT + ((size_t)(rb >> 9) * 64 + d) * 512 + (rb & 511)) = st;
              }
            }
        };
        const int vb = (which == 0) ? bid : (bid + nb - 64) % nb;
        gemm_phase((const u16*)(wsA + A_HC) + (size_t)which * 8192 * 256, 256,
                   (const u16*)(ws + OFF_WTC2 + (l * 2 + which) * SZ_WTC2), 256, 64, 1, 256, vb, nb, smem, selW, epi);
      }
    }
    gsync(grid);
    if (STOP_AFTER == 4 && l == 0) DUMP_BF16_AND_STOP(ws + OFF_KCMP)
    for (int r = 0; r * nb < 4096; ++r) {
      const int pos = (r & 1) ? (nb - 1 - bid) : bid;
      const int idx = r * nb + pos;
      if (idx < 4096) {
        const int qh = 255 - (idx >> 4);
        const int rem = idx & 15;
        attn_item(p, l, rem >> 1, rem & 1, qh, smem);
      }
    }
    for (int it = nb - 1 - bid; it < 4096; it += nb) gmlp_item(p, l, it);
    gsync(grid);
    if (STOP_AFTER == 5 && l == 0) DUMP_BF16_AND_STOP(H)
    if ((STOP_AFTER == 51 || STOP_AFTER == 52) && l == 0) {
      for (size_t i = (size_t)bid * 256 + threadIdx.x; i < (size_t)TOK * 1024; i += (size_t)nb * 256) {
        const int col = (int)(i & 1023);
        const bool keep = (STOP_AFTER == 51) ? (col < 512) : (col >= 512);
        p.out[i] = keep ? bf2f(H[i]) : 0.f;
      }
      return;
    }
    {
      auto selT = [](int) { return true; };
      auto epi = [&](bool swp, int tm, int tn, int wm, int wn, int lr, int lg, f32x4(&acc)[4][4]) {
        const int row0 = tm * 128 + wm * 64, col0 = tn * 128 + wn * 64;
        const int b = row0 >> 13;
#pragma unroll
        for (int ni = 0; ni < 4; ++ni) {
          const int col = col0 + ni * 16 + lg * 4;
          const float4 g1 = *(const float4*)(modl + (size_t)b * 6144 + 2048 + col);
#pragma unroll
          for (int mi = 0; mi < 4; ++mi) {
            const size_t row = (size_t)row0 + mi * 16 + lr;
            const float4 xv = *(const float4*)(xin + row * 1024 + col);
            float4 o4;
            o4.x = ALPHA * xv.x + (1.f + g1.x) * acc[mi][ni][0];
            o4.y = ALPHA * xv.y + (1.f + g1.y) * acc[mi][ni][1];
            o4.z = ALPHA * xv.z + (1.f + g1.z) * acc[mi][ni][2];
            o4.w = ALPHA * xv.w + (1.f + g1.w) * acc[mi][ni][3];
            *(float4*)(X1 + row * 1024 + col) = o4;
          }
        }
      };
      auto post = [&](int tm) { ln_block(X1, tm * 128, p.ln1_g + l * 1024, p.ln1_b + l * 1024, modl, 3072, 4096, H); };
      gemm_rowblock_phase(H, 1024, (const u16*)(ws + OFF_WTO + l * SZ_WTO), 1024, 512, 8, 1024, bid, nb, smem, epi, post);
    }
    gsync(grid);
    if (STOP_AFTER == 7 && l == 0) DUMP_F32_AND_STOP(X1)
    {
      u16* HH = (u16*)(wsA);
      auto selT = [](int) { return true; };
      auto epi = [&](bool swp, int tm, int tn, int wm, int wn, int lr, int lg, f32x4(&acc)[4][4]) {
        const int row0 = tm * 128 + wm * 64;
        const int cb = tn * 64 + wn * 32;
#pragma unroll
        for (int mi = 0; mi < 4; ++mi)
#pragma unroll
          for (int ni = 0; ni < 2; ++ni) {
            const size_t row = (size_t)row0 + mi * 16 + lr;
            float v[4];
#pragma unroll
            for (int j = 0; j < 4; ++j) {
              const float a = acc[mi][ni][j], bb = acc[mi][ni + 2][j];
              v[j] = a * sigm(a) * bb;
            }
            uint2 st;
            st.x = pack2(v[0], v[1]);
            st.y = pack2(v[2], v[3]);
            *(uint2*)(HH + row * 2816 + cb + ni * 16 + lg * 4) = st;
          }
      };
      gemm_phase(H, 1024, (const u16*)(ws + OFF_WT13 + l * SZ_WT13), 1024, 512, 44, 1024, bid, nb, smem, selT, epi);
    }
    gsync(grid);
    if (STOP_AFTER == 8 && l == 0) DUMP_BF16_AND_STOP(wsA)
    {
      const u16* HH = (const u16*)(wsA);
      float* outp = p.out;
      auto selT = [](int) { return true; };
      auto epi = [&](bool swp, int tm, int tn, int wm, int wn, int lr, int lg, f32x4(&acc)[4][4]) {
        const int row0 = tm * 128 + wm * 64, col0 = tn * 128 + wn * 64;
        const int b = row0 >> 13;
#pragma unroll
        for (int ni = 0; ni < 4; ++ni) {
          const int col = col0 + ni * 16 + lg * 4;
          const float4 g2 = *(const float4*)(modl + (size_t)b * 6144 + 5120 + col);
#pragma unroll
          for (int mi = 0; mi < 4; ++mi) {
            const size_t row = (size_t)row0 + mi * 16 + lr;
            const float4 xv = *(const float4*)(X1 + row * 1024 + col);
            float4 o4;
            o4.x = ALPHA * xv.x + (1.f + g2.x) * acc[mi][ni][0];
            o4.y = ALPHA * xv.y + (1.f + g2.y) * acc[mi][ni][1];
            o4.z = ALPHA * xv.z + (1.f + g2.z) * acc[mi][ni][2];
            o4.w = ALPHA * xv.w + (1.f + g2.w) * acc[mi][ni][3];
            *(float4*)(outp + row * 1024 + col) = o4;
          }
        }
      };
      auto post = [&](int tm) {
        if (l == 0) ln_block(outp, tm * 128, p.ln2_g, p.ln2_b, mod + (size_t)8 * 6144, 0, 1024, H);
        else ln_block(outp, tm * 128, p.ln2_g + 1024, p.ln2_b + 1024, nullptr, 0, 0, nullptr);
      };
      gemm_rowblock_phase(HH, 2816, (const u16*)(ws + OFF_WT2 + l * SZ_WT2), 2816, 512, 8, 2816, bid, nb, smem, epi, post);
    }
    if (l == 0) gsync(grid);
  }
}

extern "C" void kernel_launch(void* const* d_in, const int* in_sizes, int n_in, void* d_out, int out_size, void* d_ws,
                              size_t ws_size, hipStream_t stream) {
  static int grid_blocks = 0;
  if (!grid_blocks) {
    int dev = 0, cus = 0, per_cu = 0;
    (void)hipGetDevice(&dev);
    (void)hipDeviceGetAttribute(&cus, hipDeviceAttributeMultiprocessorCount, dev);
    (void)hipOccupancyMaxActiveBlocksPerMultiprocessor(&per_cu, mega, 256, 0);
    if (per_cu > 2) per_cu = 2;
    if (per_cu < 1) per_cu = 1;
    grid_blocks = cus * per_cu;
  }
  Params p{};
  const float* const* in = (const float* const*)d_in;
  p.x = in[0]; p.c = in[1]; p.w_ada = in[2]; p.b_ada = in[3]; p.w_in = in[4]; p.cmp_pos = in[5]; p.cmp_w1 = in[6];
  p.cmp_w2 = in[7]; p.vn_g = in[8]; p.vn_b = in[9]; p.w_s = in[10]; p.b_s = in[11]; p.out_g = in[12]; p.w_o = in[13];
  p.ln1_g = in[14]; p.ln1_b = in[15]; p.w1 = in[16]; p.w3 = in[17]; p.w2 = in[18]; p.ln2_g = in[19]; p.ln2_b = in[20];
  p.out = (float*)d_out;
  p.ws = (char*)d_ws;
  void* args[] = {&p};
  hipError_t e = hipLaunchCooperativeKernel((void*)mega, dim3(grid_blocks), dim3(256), args, 0, stream);
  if (e != hipSuccess) fprintf(stderr, "cooperative launch failed: %s (grid %d)\n", hipGetErrorString(e), grid_blocks);
}
```

```cpp
#define STOP_AFTER 0
#include <hip/hip_runtime.h>
#include <hip/hip_cooperative_groups.h>
#include <cstdio>
namespace cg = cooperative_groups;

typedef unsigned short u16;
using bf16x8 = __attribute__((ext_vector_type(8))) short;
using f32x4 = __attribute__((ext_vector_type(4))) float;
using u32x4 = __attribute__((ext_vector_type(4))) unsigned;
#define DI __device__ __forceinline__
#define MFMA16(a, b, c) __builtin_amdgcn_mfma_f32_16x16x32_bf16((a), (b), (c), 0, 0, 0)

constexpr int S = 8192, TOK = 65536;
constexpr int INW = 2328, INP = 2432;
constexpr float ALPHA = 1.41421356237f;
constexpr float LOG2E = 1.4426950408889634f;
constexpr float QSCALE = 0.125f * LOG2E;
constexpr float NEGB = -1e30f, MINIT = -30000.f;
constexpr float EPS = 1e-5f;

constexpr size_t SZ_WTIN = (size_t)INP * 1024 * 2;
constexpr size_t SZ_WTO = (size_t)1024 * 1024 * 2;
constexpr size_t SZ_WT13 = (size_t)5632 * 1024 * 2;
constexpr size_t SZ_WT2 = (size_t)1024 * 2816 * 2;
constexpr size_t SZ_WTC1 = (size_t)256 * 2048 * 2;
constexpr size_t SZ_WTC2 = (size_t)128 * 256 * 2;
constexpr size_t OFF_WTIN = 0;
constexpr size_t OFF_WTO = OFF_WTIN + 2 * SZ_WTIN;
constexpr size_t OFF_WT13 = OFF_WTO + 2 * SZ_WTO;
constexpr size_t OFF_WT2 = OFF_WT13 + 2 * SZ_WT13;
constexpr size_t OFF_WTC1 = OFF_WT2 + 2 * SZ_WT2;
constexpr size_t OFF_WTC2 = OFF_WTC1 + 4 * SZ_WTC1;
constexpr size_t OFF_MODP = OFF_WTC2 + 4 * SZ_WTC2;
constexpr size_t SZ_MOD = (size_t)2 * 8 * 6144 * 4;
constexpr size_t OFF_MOD = OFF_MODP + 16 * SZ_MOD;
constexpr size_t SZ_CMP = (size_t)8 * 2 * 512 * 64 * 2;
constexpr size_t OFF_CB1P = OFF_MOD + SZ_MOD;
constexpr size_t OFF_CB1 = OFF_CB1P + 16 * 4 * 256 * 4;
constexpr size_t OFF_KCMP = OFF_CB1 + 4 * 256 * 4;
constexpr size_t OFF_VCMPT = OFF_KCMP + SZ_CMP;
constexpr size_t OFF_X1 = OFF_VCMPT + SZ_CMP;
constexpr size_t OFF_H = OFF_X1 + (size_t)TOK * 1024 * 4;
constexpr size_t OFF_A = OFF_H + (size_t)TOK * 1024 * 2;
constexpr size_t SZ_KV = (size_t)TOK * 128 * 2;
constexpr size_t A_Q = 0;
constexpr size_t A_KC = A_Q + (size_t)TOK * 512 * 2;
constexpr size_t A_VC = A_KC + SZ_KV;
constexpr size_t A_KS = A_VC + SZ_KV;
constexpr size_t A_VST = A_KS + SZ_KV;
constexpr size_t A_KW = A_VST + SZ_KV;
constexpr size_t A_VWT = A_KW + SZ_KV;
constexpr size_t A_G = A_VWT + SZ_KV;
constexpr size_t A_U = A_G + (size_t)TOK * 24 * 4;
constexpr size_t A_VGT = A_U + (size_t)TOK * 512 * 2;
constexpr size_t A_AC = A_VGT + (size_t)TOK * 512 * 2;
constexpr size_t A_HC = A_AC + (size_t)2 * 8192 * 2048 * 2;
constexpr size_t A_END = A_HC + (size_t)2 * 8192 * 256 * 2;

struct Params {
  const float *x, *c, *w_ada, *b_ada, *w_in, *cmp_pos, *cmp_w1, *cmp_w2, *vn_g, *vn_b, *w_s, *b_s, *out_g, *w_o,
      *ln1_g, *ln1_b, *w1, *w3, *w2, *ln2_g, *ln2_b;
  float* out;
  char* ws;
};

DI u16 f2bf(float x) { unsigned u = __float_as_uint(x); u += 0x7fffu + ((u >> 16) & 1u); return (u16)(u >> 16); }
DI float bf2f(u16 h) { return __uint_as_float(((unsigned)h) << 16); }
DI unsigned pack2(float a, float b) { return (unsigned)f2bf(a) | ((unsigned)f2bf(b) << 16); }
DI float gelu_t(float x) { float u = 1.5957691216f * (x + 0.044715f * x * x * x); return x / (1.f + __expf(-u)); }
DI float sigm(float x) { return 1.f / (1.f + __expf(-x)); }
DI float ex2(float x) { return __builtin_amdgcn_exp2f(x); }
DI int otid() { int t = threadIdx.x; asm volatile("" : "+v"(t)); return t; }

template <int MODE> DI int map_row(int n) {
  if (MODE == 1) return n < 1280 ? n : (n < 1304 ? n + 1024 : n - 24);
  if (MODE == 2) return (n >> 5) * 64 + (n & 31);
  if (MODE == 3) return (n >> 5) * 64 + 32 + (n & 31);
  return n;
}

template <int MODE>
DI void conv_tile(const float* __restrict__ W, int K, int N, u16* __restrict__ Wt, int ldk, int tile, float* tl) {
  const int tiles_n = (N + 63) / 64;
  const int tk = tile / tiles_n, tn = tile % tiles_n;
  const int k0 = tk * 64, n0 = tn * 64;
  const int tid = otid();
#pragma unroll
  for (int i = 0; i < 16; ++i) {
    int idx = tid + 256 * i;
    int r = idx >> 6, c = idx & 63;
    int n = n0 + c;
    tl[r * 65 + c] = (n < N) ? W[(long)(k0 + r) * N + n] : 0.f;
  }
  __syncthreads();
  const int nl = tid >> 2, kc = tid & 3;
  const int n = n0 + nl;
  if (n < N) {
    const int row = map_row<MODE>(n);
    unsigned pk[8];
#pragma unroll
    for (int i = 0; i < 8; ++i) pk[i] = pack2(tl[(kc * 16 + 2 * i) * 65 + nl], tl[(kc * 16 + 2 * i + 1) * 65 + nl]);
    uint4* dst = (uint4*)(Wt + (long)row * ldk + k0 + kc * 16);
    dst[0] = make_uint4(pk[0], pk[1], pk[2], pk[3]);
    dst[1] = make_uint4(pk[4], pk[5], pk[6], pk[7]);
  }
  __syncthreads();
}

DI void phase0a(const Params& p, char* smem) {
  char* ws = p.ws;
  const int tid = threadIdx.x;
  constexpr int PER_LAYER = 592 + 256 + 704 * 3 + 128 * 2 + 4 * 2;
  constexpr int NCONV = 2 * PER_LAYER;
  constexpr int NTOT = NCONV + 768 + 2 + 64;
  for (int it = blockIdx.x; it < NTOT; it += gridDim.x) {
    if (it < NCONV) {
      const int l = it / PER_LAYER;
      const int li = it % PER_LAYER;
      int base = 0;
#define SEG(MODE, SRC, DST, K_, N_, LDK)                                                   \
  {                                                                                        \
    const int nt_ = ((K_) / 64) * (((N_) + 63) / 64);                                      \
    if (li >= base && li < base + nt_) conv_tile<MODE>(SRC, K_, N_, DST, LDK, li - base, (float*)smem); \
    base += nt_;                                                                           \
  }
      SEG(1, p.w_in + (size_t)l * 1024 * INW, (u16*)(ws + OFF_WTIN + l * SZ_WTIN), 1024, INW, 1024)
      SEG(0, p.w_o + (size_t)l * 1024 * 1024, (u16*)(ws + OFF_WTO + l * SZ_WTO), 1024, 1024, 1024)
      SEG(2, p.w1 + (size_t)l * 1024 * 2816, (u16*)(ws + OFF_WT13 + l * SZ_WT13), 1024, 2816, 1024)
      SEG(3, p.w3 + (size_t)l * 1024 * 2816, (u16*)(ws + OFF_WT13 + l * SZ_WT13), 1024, 2816, 1024)
      SEG(0, p.w2 + (size_t)l * 2816 * 1024, (u16*)(ws + OFF_WT2 + l * SZ_WT2), 2816, 1024, 2816)
      SEG(0, p.cmp_w1 + (size_t)(l * 2 + 0) * 2048 * 256, (u16*)(ws + OFF_WTC1 + (l * 2 + 0) * SZ_WTC1), 2048, 256, 2048)
      SEG(0, p.cmp_w1 + (size_t)(l * 2 + 1) * 2048 * 256, (u16*)(ws + OFF_WTC1 + (l * 2 + 1) * SZ_WTC1), 2048, 256, 2048)
      SEG(0, p.cmp_w2 + (size_t)(l * 2 + 0) * 256 * 64, (u16*)(ws + OFF_WTC2 + (l * 2 + 0) * SZ_WTC2), 256, 64, 256)
      SEG(0, p.cmp_w2 + (size_t)(l * 2 + 1) * 256 * 64, (u16*)(ws + OFF_WTC2 + (l * 2 + 1) * SZ_WTC2), 256, 64, 256)
#undef SEG
    } else if (it < NCONV + 768) {
      const int idx = it - NCONV;
      const int l = idx / 384, r = idx % 384, nb = r / 16, kc = r % 16;
      float* cs = (float*)smem;
      for (int i = tid; i < 512; i += 256) {
        int b = i >> 6, k = i & 63;
        float cv = p.c[b * 1024 + kc * 64 + k];
        cs[i] = cv * sigm(cv);
      }
      __syncthreads();
      const int n = nb * 256 + tid;
      float acc[8];
#pragma unroll
      for (int b = 0; b < 8; ++b) acc[b] = 0.f;
      const float* wp = p.w_ada + ((size_t)l * 1024 + kc * 64) * 6144 + n;
#pragma unroll 8
      for (int k = 0; k < 64; ++k) {
        float wv = wp[(size_t)k * 6144];
#pragma unroll
        for (int b = 0; b < 8; ++b) acc[b] += cs[b * 64 + k] * wv;
      }
      float* modp = (float*)(ws + OFF_MODP);
#pragma unroll
      for (int b = 0; b < 8; ++b) modp[(size_t)((kc * 2 + l) * 8 + b) * 6144 + n] = acc[b];
      __syncthreads();
    } else if (it < NCONV + 768 + 2) {
      const int l = it - NCONV - 768;
      uint4* dst = (uint4*)(ws + OFF_WTIN + l * SZ_WTIN + (size_t)INW * 1024 * 2);
      const int n16 = (INP - INW) * 1024 * 2 / 16;
      for (int i = tid; i < n16; i += 256) dst[i] = make_uint4(0, 0, 0, 0);
    } else {
      const int idx = it - NCONV - 768 - 2;
      const int lw = idx >> 4, kc = idx & 15;
      const float* pos = p.cmp_pos + (size_t)lw * 2048 + kc * 128;
      const float* w1p = p.cmp_w1 + ((size_t)lw * 2048 + kc * 128) * 256 + tid;
      float a = 0.f;
#pragma unroll 8
      for (int k = 0; k < 128; ++k) a += pos[k] * w1p[(size_t)k * 256];
      ((float*)(ws + OFF_CB1P))[(kc * 4 + lw) * 256 + tid] = a;
    }
  }
}

DI void phase0b(const Params& p) {
  const float* modp = (const float*)(p.ws + OFF_MODP);
  float* mod = (float*)(p.ws + OFF_MOD);
  const int n = 2 * 8 * 6144;
  for (int i = blockIdx.x * 256 + threadIdx.x; i < n; i += gridDim.x * 256) {
    int l = i / (8 * 6144), c = i % 6144;
    float a = p.b_ada[l * 6144 + c];
#pragma unroll
    for (int kc = 0; kc < 16; ++kc) a += modp[(size_t)kc * n + i];
    mod[i] = a;
  }
  const float* cbp = (const float*)(p.ws + OFF_CB1P);
  float* cb = (float*)(p.ws + OFF_CB1);
  for (int i = blockIdx.x * 256 + threadIdx.x; i < 1024; i += gridDim.x * 256) {
    float a = 0.f;
#pragma unroll
    for (int kc = 0; kc < 16; ++kc) a += cbp[kc * 1024 + i];
    cb[i] = a;
  }
}

DI void phase_mod_x(const Params& p) {
  const float* mod = (const float*)(p.ws + OFF_MOD);
  u16* H = (u16*)(p.ws + OFF_H);
  const long nchunk = (long)TOK * 1024 / 8;
  for (long i = (long)blockIdx.x * 256 + otid(); i < nchunk; i += (long)gridDim.x * 256) {
    long e = i * 8;
    int col = (int)(e & 1023);
    int b = (int)(e >> 23);
    const float4* xp = (const float4*)(p.x + e);
    const float4* sh = (const float4*)(mod + (size_t)b * 6144 + 0 + col);
    const float4* sc = (const float4*)(mod + (size_t)b * 6144 + 1024 + col);
    float4 x0 = xp[0], x1 = xp[1], s0 = sc[0], s1 = sc[1], h0 = sh[0], h1 = sh[1];
    uint4 o;
    o.x = pack2(x0.x * (1.f + s0.x) + h0.x, x0.y * (1.f + s0.y) + h0.y);
    o.y = pack2(x0.z * (1.f + s0.z) + h0.z, x0.w * (1.f + s0.w) + h0.w);
    o.z = pack2(x1.x * (1.f + s1.x) + h1.x, x1.y * (1.f + s1.y) + h1.y);
    o.w = pack2(x1.z * (1.f + s1.z) + h1.z, x1.w * (1.f + s1.w) + h1.w);
    *(uint4*)(H + e) = o;
  }
}

struct Stg { u32x4 a0, a1, a2, a3, b0, b1, b2, b3; };
DI void g_load(Stg& s, const u16* __restrict__ Ap, int lda, const u16* __restrict__ Bp, int ldb, int kt, int tid, int ksa) {
  const int ch = tid & 7, r = tid >> 3;
  const u16* ap = Ap + (size_t)r * lda + kt * ksa + ch * 8;
  const u16* bp = Bp + (size_t)r * ldb + kt * 64 + ch * 8;
  s.a0 = *(const u32x4*)(ap);
  s.a1 = *(const u32x4*)(ap + (size_t)32 * lda);
  s.a2 = *(const u32x4*)(ap + (size_t)64 * lda);
  s.a3 = *(const u32x4*)(ap + (size_t)96 * lda);
  s.b0 = *(const u32x4*)(bp);
  s.b1 = *(const u32x4*)(bp + (size_t)32 * ldb);
  s.b2 = *(const u32x4*)(bp + (size_t)64 * ldb);
  s.b3 = *(const u32x4*)(bp + (size_t)96 * ldb);
}
DI void g_store(char* d_, const Stg& s, int tid) {
  const int ch = tid & 7, r = tid >> 3;
  char* pa = d_ + r * 128 + ((ch ^ (r & 7)) << 4);
  *(u32x4*)(pa) = s.a0;
  *(u32x4*)(pa + 4096) = s.a1;
  *(u32x4*)(pa + 8192) = s.a2;
  *(u32x4*)(pa + 12288) = s.a3;
  *(u32x4*)(pa + 16384) = s.b0;
  *(u32x4*)(pa + 16384 + 4096) = s.b1;
  *(u32x4*)(pa + 16384 + 8192) = s.b2;
  *(u32x4*)(pa + 16384 + 12288) = s.b3;
}
template <bool SWAP>
DI void g_compute(const char* sA, f32x4 (&acc)[4][4], int wm, int wn, int lr, int lg) {
  const char* sB = sA + 16384;
#pragma unroll
  for (int s = 0; s < 2; ++s) {
    bf16x8 af[4], bfr[4];
#pragma unroll
    for (int mi = 0; mi < 4; ++mi) {
      const int r = wm * 64 + mi * 16 + lr;
      af[mi] = *(const bf16x8*)(sA + r * 128 + (((s * 4 + lg) ^ (r & 7)) << 4));
    }
#pragma unroll
    for (int ni = 0; ni < 4; ++ni) {
      const int r = wn * 64 + ni * 16 + lr;
      bfr[ni] = *(const bf16x8*)(sB + r * 128 + (((s * 4 + lg) ^ (r & 7)) << 4));
    }
#pragma unroll
    for (int mi = 0; mi < 4; ++mi)
#pragma unroll
      for (int ni = 0; ni < 4; ++ni)
        acc[mi][ni] = SWAP ? MFMA16(bfr[ni], af[mi], acc[mi][ni]) : MFMA16(af[mi], bfr[ni], acc[mi][ni]);
  }
}

template <bool SWAP, class Epi>
DI void gemm_tile(const u16* __restrict__ Ap, int lda, const u16* __restrict__ Bp, int ldb, int nk, int tm, int tn, int tid,
                  char* smem, Epi epi, int ksa = 64) {
  const int lane = tid & 63, w = tid >> 6, wm = w >> 1, wn = w & 1;
  const int lr = lane & 15, lg = lane >> 4;
  f32x4 acc[4][4];
#pragma unroll
  for (int i = 0; i < 4; ++i)
#pragma unroll
    for (int j = 0; j < 4; ++j) acc[i][j] = f32x4{0.f, 0.f, 0.f, 0.f};
  Stg r0, r1;
  g_load(r0, Ap, lda, Bp, ldb, 0, tid, ksa);
  if (nk > 1) g_load(r1, Ap, lda, Bp, ldb, 1, tid, ksa);
  g_store(smem, r0, tid);
  __syncthreads();
  if (nk > 2) g_load(r0, Ap, lda, Bp, ldb, 2, tid, ksa);
  for (int kt = 0; kt < nk; kt += 2) {
    g_compute<SWAP>(smem, acc, wm, wn, lr, lg);
    if (kt + 1 < nk) g_store(smem + 32768, r1, tid);
    __syncthreads();
    if (kt + 3 < nk) g_load(r1, Ap, lda, Bp, ldb, kt + 3, tid, ksa);
    if (kt + 1 >= nk) break;
    g_compute<SWAP>(smem + 32768, acc, wm, wn, lr, lg);
    if (kt + 2 < nk) g_store(smem, r0, tid);
    __syncthreads();
    if (kt + 4 < nk) g_load(r0, Ap, lda, Bp, ldb, kt + 4, tid, ksa);
  }
  epi(SWAP, tm, tn, wm, wn, lr, lg, acc);
}

template <class AB, class Sel, class Epi>
DI void gemm_phase_g(AB abase, int lda, int ksa, const u16* __restrict__ Bt, int ldb, int ntm, int ntn, int K, int vb, int nvb,
                     char* smem, Sel swapsel, Epi epi) {
  if (vb < 0 || vb >= nvb) return;
  const int ntiles = ntm * ntn;
  const int nk = K / 64;
  int GM = nvb / ntn;
  if (GM < 1) GM = 1;
  if (GM > ntm) GM = ntm;
  const int gtiles = GM * ntn;
  const int q0 = ((nvb & 7) == 0) ? ((vb & 7) * (nvb >> 3) + (vb >> 3)) : vb;
  for (int q = q0; q < ntiles; q += nvb) {
    const int g = q / gtiles;
    const int i = q - g * gtiles;
    const int gsz = (ntm - g * GM < GM) ? (ntm - g * GM) : GM;
    const int tn = i / gsz;
    const int tm = g * GM + (i - tn * gsz);
    const u16* Ap = abase(tm);
    const u16* Bp = Bt + (size_t)tn * 128 * ldb;
    const int tid = otid();
    if (swapsel(tn)) gemm_tile<true>(Ap, lda, Bp, ldb, nk, tm, tn, tid, smem, epi, ksa);
    else gemm_tile<false>(Ap, lda, Bp, ldb, nk, tm, tn, tid, smem, epi, ksa);
  }
}
template <class Sel, class Epi>
DI void gemm_phase(const u16* __restrict__ A, int lda, const u16* __restrict__ Bt, int ldb, int ntm, int ntn, int K,
                   int vb, int nvb, char* smem, Sel swapsel, Epi epi) {
  auto ab = [=](int tm) { return A + (size_t)tm * 128 * lda; };
  gemm_phase_g(ab, lda, 64, Bt, ldb, ntm, ntn, K, vb, nvb, smem, swapsel, epi);
}
template <class Epi, class Post>
DI void gemm_rowblock_phase(const u16* __restrict__ A, int lda, const u16* __restrict__ Bt, int ldb, int ntm, int ntn, int K,
                            int vb, int nvb, char* smem, Epi epi, Post post) {
  const int nk = K / 64;
  for (int tm = vb; tm < ntm; tm += nvb) {
    const u16* Ap = A + (size_t)tm * 128 * lda;
    for (int tn = 0; tn < ntn; ++tn) {
      const int tid = otid();
      gemm_tile<true>(Ap, lda, Bt + (size_t)tn * 128 * ldb, ldb, nk, tm, tn, tid, smem, epi, 64);
    }
    asm volatile("s_waitcnt vmcnt(0)" ::: "memory");
    __syncthreads();
    post(tm);
  }
}

DI void ln_rows(float* buf, const float* __restrict__ g, const float* __restrict__ bt, const float* __restrict__ modl,
                        int sh_off, int sc_off, u16* H) {
  const int tid_ = otid();
  const int lane = tid_ & 63, w = tid_ >> 6;
  for (int row = blockIdx.x * 4 + w; row < TOK; row += gridDim.x * 4) {
    float4* rp = (float4*)(buf + (size_t)row * 1024);
    float4 v[4];
    float s = 0.f;
#pragma unroll
    for (int i = 0; i < 4; ++i) { v[i] = rp[lane + 64 * i]; s += v[i].x + v[i].y + v[i].z + v[i].w; }
#pragma unroll
    for (int o = 32; o >= 1; o >>= 1) s += __shfl_xor(s, o);
    const float mu = s * (1.f / 1024.f);
    float q = 0.f;
#pragma unroll
    for (int i = 0; i < 4; ++i) {
      float a = v[i].x - mu, b = v[i].y - mu, c = v[i].z - mu, d = v[i].w - mu;
      q += a * a + b * b + c * c + d * d;
    }
#pragma unroll
    for (int o = 32; o >= 1; o >>= 1) q += __shfl_xor(q, o);
    const float rs = rsqrtf(q * (1.f / 1024.f) + EPS);
    const int b = row >> 13;
#pragma unroll
    for (int i = 0; i < 4; ++i) {
      const int col = (lane + 64 * i) * 4;
      float4 gg = *(const float4*)(g + col), bb = *(const float4*)(bt + col);
      float4 y;
      y.x = (v[i].x - mu) * rs * gg.x + bb.x;
      y.y = (v[i].y - mu) * rs * gg.y + bb.y;
      y.z = (v[i].z - mu) * rs * gg.z + bb.z;
      y.w = (v[i].w - mu) * rs * gg.w + bb.w;
      rp[lane + 64 * i] = y;
      if (H) {
        float4 sh = *(const float4*)(modl + (size_t)b * 6144 + sh_off + col);
        float4 sc = *(const float4*)(modl + (size_t)b * 6144 + sc_off + col);
        uint2 o2;
        o2.x = pack2(y.x * (1.f + sc.x) + sh.x, y.y * (1.f + sc.y) + sh.y);
        o2.y = pack2(y.z * (1.f + sc.z) + sh.z, y.w * (1.f + sc.w) + sh.w);
        *(uint2*)(H + (size_t)row * 1024 + col) = o2;
      }
    }
  }
}

DI void ln_block(float* buf, int row0, const float* __restrict__ g, const float* __restrict__ bt,
                 const float* __restrict__ modl, int sh_off, int sc_off, u16* H) {
  const int tid_ = otid();
  const int lane = tid_ & 63, w = tid_ >> 6;
  for (int rr = 0; rr < 32; ++rr) {
    const int row = row0 + w * 32 + rr;
    f32x4* rp = (f32x4*)(buf + (size_t)row * 1024);
    f32x4 v[4];
    float s = 0.f;
#pragma unroll
    for (int i = 0; i < 4; ++i) { v[i] = __builtin_nontemporal_load(rp + lane + 64 * i); s += v[i][0] + v[i][1] + v[i][2] + v[i][3]; }
#pragma unroll
    for (int o = 32; o >= 1; o >>= 1) s += __shfl_xor(s, o);
    const float mu = s * (1.f / 1024.f);
    float q = 0.f;
#pragma unroll
    for (int i = 0; i < 4; ++i)
#pragma unroll
      for (int k = 0; k < 4; ++k) { float a = v[i][k] - mu; q += a * a; }
#pragma unroll
    for (int o = 32; o >= 1; o >>= 1) q += __shfl_xor(q, o);
    const float rs = rsqrtf(q * (1.f / 1024.f) + EPS);
    const int b = row >> 13;
#pragma unroll
    for (int i = 0; i < 4; ++i) {
      const int col = (lane + 64 * i) * 4;
      const float4 gg = *(const float4*)(g + col), bb = *(const float4*)(bt + col);
      f32x4 y;
      y[0] = (v[i][0] - mu) * rs * gg.x + bb.x;
      y[1] = (v[i][1] - mu) * rs * gg.y + bb.y;
      y[2] = (v[i][2] - mu) * rs * gg.z + bb.z;
      y[3] = (v[i][3] - mu) * rs * gg.w + bb.w;
      rp[lane + 64 * i] = y;
      if (H) {
        const float4 sh = *(const float4*)(modl + (size_t)b * 6144 + sh_off + col);
        const float4 sc = *(const float4*)(modl + (size_t)b * 6144 + sc_off + col);
        uint2 o2;
        o2.x = pack2(y[0] * (1.f + sc.x) + sh.x, y[1] * (1.f + sc.y) + sh.y);
        o2.y = pack2(y[2] * (1.f + sc.z) + sh.z, y[3] * (1.f + sc.w) + sh.w);
        *(uint2*)(H + (size_t)row * 1024 + col) = o2;
      }
    }
  }
}

DI void gmlp_item(const Params& p, int l, int item) {
  const int b = item >> 9, c = (item >> 3) & 63, grp = item & 7;
  const int tid_ = otid();
  const int lane = tid_ & 63, w = tid_ >> 6, lr = lane & 15, lg = lane >> 4;
  const float* wsp = p.w_s + (size_t)(l * 8 + grp) * 128 * 128;
  const u16* vgt = (const u16*)(p.ws + OFF_A + A_VGT) + (size_t)(b * 8 + grp) * 64 * S + c * 128;
  const u16* U = (const u16*)(p.ws + OFF_A + A_U);
  u16* OM = (u16*)(p.ws + OFF_H);
  f32x4 acc[4][2];
#pragma unroll
  for (int i = 0; i < 4; ++i)
#pragma unroll
    for (int j = 0; j < 2; ++j) acc[i][j] = f32x4{0.f, 0.f, 0.f, 0.f};
#pragma unroll
  for (int ks = 0; ks < 4; ++ks) {
    const int s0 = ks * 32 + lg * 8;
    bf16x8 af[4];
#pragma unroll
    for (int dt = 0; dt < 4; ++dt) af[dt] = *(const bf16x8*)(vgt + (size_t)(dt * 16 + lr) * S + s0);
#pragma unroll
    for (int nt = 0; nt < 2; ++nt) {
      const int t = w * 32 + nt * 16 + lr;
      const float4* wp = (const float4*)(wsp + t * 128 + s0);
      float4 a0 = wp[0], a1 = wp[1];
      unsigned pw[4];
      pw[0] = pack2((s0 + 0 <= t) ? a0.x : 0.f, (s0 + 1 <= t) ? a0.y : 0.f);
      pw[1] = pack2((s0 + 2 <= t) ? a0.z : 0.f, (s0 + 3 <= t) ? a0.w : 0.f);
      pw[2] = pack2((s0 + 4 <= t) ? a1.x : 0.f, (s0 + 5 <= t) ? a1.y : 0.f);
      pw[3] = pack2((s0 + 6 <= t) ? a1.z : 0.f, (s0 + 7 <= t) ? a1.w : 0.f);
      bf16x8 bw = __builtin_bit_cast(bf16x8, make_uint4(pw[0], pw[1], pw[2], pw[3]));
#pragma unroll
      for (int dt = 0; dt < 4; ++dt) acc[dt][nt] = MFMA16(af[dt], bw, acc[dt][nt]);
    }
  }
#pragma unroll
  for (int nt = 0; nt < 2; ++nt) {
    const int t = w * 32 + nt * 16 + lr;
    const size_t tok = (size_t)b * S + c * 128 + t;
    const float bias = p.b_s[(l * 8 + grp) * 128 + t];
    float val[4][4];
    float ss = 0.f;
#pragma unroll
    for (int dt = 0; dt < 4; ++dt) {
      const int d = dt * 16 + lg * 4;
      const uint2 uu = *(const uint2*)(U + tok * 512 + grp * 64 + d);
      const float u0 = bf2f(uu.x & 0xffff), u1 = bf2f(uu.x >> 16), u2 = bf2f(uu.y & 0xffff), u3 = bf2f(uu.y >> 16);
      val[dt][0] = u0 * (acc[dt][nt][0] + bias);
      val[dt][1] = u1 * (acc[dt][nt][1] + bias);
      val[dt][2] = u2 * (acc[dt][nt][2] + bias);
      val[dt][3] = u3 * (acc[dt][nt][3] + bias);
#pragma unroll
      for (int j = 0; j < 4; ++j) ss += val[dt][j] * val[dt][j];
    }
    ss += __shfl_xor(ss, 16);
    ss += __shfl_xor(ss, 32);
    const float r = rsqrtf(ss * (1.f / 64.f) + EPS);
#pragma unroll
    for (int dt = 0; dt < 4; ++dt) {
      const int d = dt * 16 + lg * 4;
      const float4 gg = *(const float4*)(p.out_g + l * 1024 + 512 + grp * 64 + d);
      uint2 st;
      st.x = pack2(val[dt][0] * r * gg.x, val[dt][1] * r * gg.y);
      st.y = pack2(val[dt][2] * r * gg.z, val[dt][3] * r * gg.w);
      *(uint2*)(OM + tok * 1024 + 512 + grp * 64 + d) = st;
    }
  }
}

constexpr int SM_K = 0, SM_V = 8192, SM_IMP = 8192 + 8704, SM_SEL = SM_IMP + 64 * 132 * 4, SM_UNI = SM_SEL + 1024;

struct KVr { u32x4 k0, k1, v0, v1; };
DI void kv_load_k(KVr& t, const u16* __restrict__ src, int stride, int tid) {
  const int r = tid >> 3, ch = tid & 7;
  t.k0 = *(const u32x4*)(src + (size_t)r * stride + ch * 8);
  t.k1 = *(const u32x4*)(src + (size_t)(r + 32) * stride + ch * 8);
}
DI void kv_load_v(KVr& t, const u16* __restrict__ src, int stride, int tid) {
  const int d = tid >> 3, ch = tid & 7;
  t.v0 = *(const u32x4*)(src + (size_t)d * stride + ch * 8);
  t.v1 = *(const u32x4*)(src + (size_t)(d + 32) * stride + ch * 8);
}
DI void kv_store_k(const KVr& t, char* sK, int tid) {
  const int r = tid >> 3, ch = tid & 7;
  char* pk = sK + r * 128 + ((ch ^ (r & 7)) << 4);
  *(u32x4*)(pk) = t.k0;
  *(u32x4*)(pk + 4096) = t.k1;
}
DI void kv_store_v(const KVr& t, char* sV, int tid) {
  const int d = tid >> 3, ch = tid & 7;
  uint2* d0 = (uint2*)(sV + d * 136 + ch * 16);
  d0[0] = make_uint2(t.v0[0], t.v0[1]);
  d0[1] = make_uint2(t.v0[2], t.v0[3]);
  uint2* d1 = (uint2*)(sV + (d + 32) * 136 + ch * 16);
  d1[0] = make_uint2(t.v1[0], t.v1[1]);
  d1[1] = make_uint2(t.v1[2], t.v1[3]);
}
DI int next_set_bit(const unsigned* uni, int from) {
  int res = 1000;
#pragma unroll
  for (int wd = 3; wd >= 0; --wd) {
    unsigned mw = uni[wd];
    const int lo = from - wd * 32;
    if (lo >= 32) mw = 0u;
    else if (lo > 0) mw &= (~0u) << lo;
    if (mw) res = wd * 32 + __ffs(mw) - 1;
  }
  return __builtin_amdgcn_readfirstlane(res);
}

template <int MODE>
DI void half_step(const char* sK, const char* sV, int half, int lr, int lg, const bf16x8 (&qf)[2][2], const float (&slope)[2],
                  float (&m)[2], float (&lsum)[2], f32x4 (&o)[2][4], const float (&posf)[2][4], const bool (&valid)[2][4],
                  float (&psum)[2][4]) {
  bf16x8 kf[2][2];
#pragma unroll
  for (int kt2 = 0; kt2 < 2; ++kt2) {
    const int r = half * 32 + kt2 * 16 + lr;
    kf[kt2][0] = *(const bf16x8*)(sK + r * 128 + (((lg) ^ (r & 7)) << 4));
    kf[kt2][1] = *(const bf16x8*)(sK + r * 128 + (((4 + lg) ^ (r & 7)) << 4));
  }
  if (MODE == 1) {
#pragma unroll
    for (int a = 0; a < 2; ++a)
#pragma unroll
      for (int j = 0; j < 4; ++j) psum[a][j] = 0.f;
  }
  bf16x8 pf[2];
#pragma unroll
  for (int h = 0; h < 2; ++h) {
    f32x4 s[2];
#pragma unroll
    for (int kt2 = 0; kt2 < 2; ++kt2) {
      f32x4 z = f32x4{0.f, 0.f, 0.f, 0.f};
      z = MFMA16(kf[kt2][0], qf[h][0], z);
      z = MFMA16(kf[kt2][1], qf[h][1], z);
      s[kt2] = z;
    }
    float mx = NEGB;
#pragma unroll
    for (int kt2 = 0; kt2 < 2; ++kt2)
#pragma unroll
      for (int j = 0; j < 4; ++j) {
        float v = valid[kt2][j] ? (s[kt2][j] + slope[h] * posf[kt2][j]) : NEGB;
        s[kt2][j] = v;
        mx = fmaxf(mx, v);
      }
    if (MODE != 1) {
      mx = fmaxf(mx, __shfl_xor(mx, 16));
      mx = fmaxf(mx, __shfl_xor(mx, 32));
      const float mn = fmaxf(m[h], mx);
      const float alpha = ex2(m[h] - mn);
      m[h] = mn;
      float ps = 0.f;
#pragma unroll
      for (int kt2 = 0; kt2 < 2; ++kt2)
#pragma unroll
        for (int j = 0; j < 4; ++j) {
          float pv = ex2(s[kt2][j] - mn);
          s[kt2][j] = pv;
          ps += pv;
        }
      lsum[h] = lsum[h] * alpha + ps;
      if (MODE == 2) {
#pragma unroll
        for (int dt = 0; dt < 4; ++dt) o[h][dt] *= alpha;
      }
    } else {
#pragma unroll
      for (int kt2 = 0; kt2 < 2; ++kt2)
#pragma unroll
        for (int j = 0; j < 4; ++j) {
          float pv = ex2(s[kt2][j] - m[h]) * lsum[h];
          s[kt2][j] = pv;
          psum[kt2][j] += pv;
        }
    }
    if (MODE != 0) {
      uint4 pk = make_uint4(pack2(s[0][0], s[0][1]), pack2(s[0][2], s[0][3]), pack2(s[1][0], s[1][1]), pack2(s[1][2], s[1][3]));
      pf[h] = __builtin_bit_cast(bf16x8, pk);
    }
  }
  if (MODE != 0) {
#pragma unroll
    for (int dt = 0; dt < 4; ++dt) {
      const char* base = sV + (dt * 16 + lr) * 136 + half * 64 + lg * 8;
      uint2 a = *(const uint2*)(base);
      uint2 c = *(const uint2*)(base + 32);
      bf16x8 vf = __builtin_bit_cast(bf16x8, make_uint4(a.x, a.y, c.x, c.y));
#pragma unroll
      for (int h = 0; h < 2; ++h) o[h][dt] = MFMA16(vf, pf[h], o[h][dt]);
    }
  }
}

DI void attn_item(const Params& p, int l, int b, int kvh, int qh, char* smem) {
  char* sK = smem + SM_K;
  char* sV = smem + SM_V;
  float* sImp = (float*)(smem + SM_IMP);
  unsigned* sSel = (unsigned*)(smem + SM_SEL);
  unsigned* sUni = (unsigned*)(smem + SM_UNI);
  const char* wsA = p.ws + OFF_A;
  const u16* Q = (const u16*)(wsA + A_Q);
  const u16* KS = (const u16*)(wsA + A_KS);
  const u16* VST = (const u16*)(wsA + A_VST);
  const u16* KW = (const u16*)(wsA + A_KW);
  const u16* VWT = (const u16*)(wsA + A_VWT);
  const float* G = (const float*)(wsA + A_G);
  const u16* KCMP = (const u16*)(p.ws + OFF_KCMP);
  const u16* VCMPT = (const u16*)(p.ws + OFF_VCMPT);
  u16* OM = (u16*)(p.ws + OFF_H);

  const int tid = otid(), lane = tid & 63, w = tid >> 6, lr = lane & 15, lg = lane >> 4;
  const int hp = w >> 1;
  const int t0 = qh * 32;
  const int cur = qh >> 1;
  const int tql = 16 * (w & 1) + lr;
  const size_t tokq = (size_t)b * S + t0 + tql;
  const int bk = b * 2 + kvh;
  const int hg0 = kvh * 4 + hp * 2;

  bf16x8 qf[2][2];
  float slope[2];
#pragma unroll
  for (int h = 0; h < 2; ++h) {
    const u16* qp = Q + tokq * 512 + (hg0 + h) * 64 + lg * 8;
    qf[h][0] = *(const bf16x8*)qp;
    qf[h][1] = *(const bf16x8*)(qp + 32);
    slope[h] = ex2(-(float)(hg0 + h + 1)) * LOG2E;
  }
  float m[2], ls[2];
  f32x4 o[2][4], otot[2][4];
  float psum[2][4];
#pragma unroll
  for (int h = 0; h < 2; ++h) {
    m[h] = MINIT;
    ls[h] = 0.f;
#pragma unroll
    for (int dt = 0; dt < 4; ++dt) o[h][dt] = f32x4{0.f, 0.f, 0.f, 0.f};
  }

  const int amax = qh >> 5;
  const u16* kc_base = KCMP + (size_t)bk * 512 * 64;
  const u16* vc_base = VCMPT + (size_t)bk * 64 * 512;
  KVr tl;
  kv_load_k(tl, kc_base, 64, tid);
  for (int a = 0; a <= amax; ++a) {
    __syncthreads();
    kv_store_k(tl, sK, tid);
    __syncthreads();
    if (a < amax) kv_load_k(tl, kc_base + (size_t)(a + 1) * 64 * 64, 64, tid);
    else { kv_load_k(tl, kc_base, 64, tid); kv_load_v(tl, vc_base, 512, tid); }
#pragma unroll
    for (int half = 0; half < 2; ++half) {
      float posf[2][4];
      bool valid[2][4];
#pragma unroll
      for (int kt2 = 0; kt2 < 2; ++kt2)
#pragma unroll
        for (int j = 0; j < 4; ++j) {
          int n = a * 64 + half * 32 + kt2 * 16 + lg * 4 + j;
          int rel = 16 * n + 31 - t0;
          posf[kt2][j] = (float)rel;
          valid[kt2][j] = rel <= tql;
        }
      half_step<0>(sK, sV, half, lr, lg, qf, slope, m, ls, o, posf, valid, psum);
    }
  }
#pragma unroll
  for (int h = 0; h < 2; ++h) {
    float x = ls[h];
    x += __shfl_xor(x, 16);
    x += __shfl_xor(x, 32);
    ls[h] = x > 0.f ? 1.f / x : 0.f;
  }
  float carry = 0.f;
  float* myImp = sImp + hp * (32 * 132);
  for (int a = 0; a <= amax; ++a) {
    __syncthreads();
    kv_store_k(tl, sK, tid);
    kv_store_v(tl, sV, tid);
    __syncthreads();
    if (a < amax) {
      kv_load_k(tl, kc_base + (size_t)(a + 1) * 64 * 64, 64, tid);
      kv_load_v(tl, vc_base + (a + 1) * 64, 512, tid);
    }
#pragma unroll
    for (int half = 0; half < 2; ++half) {
      float posf[2][4];
      bool valid[2][4];
#pragma unroll
      for (int kt2 = 0; kt2 < 2; ++kt2)
#pragma unroll
        for (int j = 0; j < 4; ++j) {
          int n = a * 64 + half * 32 + kt2 * 16 + lg * 4 + j;
          int rel = 16 * n + 31 - t0;
          posf[kt2][j] = (float)rel;
          valid[kt2][j] = rel <= tql;
        }
      half_step<1>(sK, sV, half, lr, lg, qf, slope, m, ls, o, posf, valid, psum);
      float prev = carry;
#pragma unroll
      for (int kt2 = 0; kt2 < 2; ++kt2) {
        float sum4 = psum[kt2][0] + psum[kt2][1] + psum[kt2][2] + psum[kt2][3];
        float p3 = psum[kt2][3];
        float up = __shfl(p3, (lane + 48) & 63);
        float wrap = __shfl(prev, (lane + 48) & 63);
        float spill = lg > 0 ? up : wrap;
        int j = a * 16 + half * 8 + kt2 * 4 + lg;
        myImp[tql * 132 + j] = sum4 + spill;
        prev = p3;
      }
      carry = prev;
    }
  }
#pragma unroll
  for (int h = 0; h < 2; ++h) {
    const float g0 = G[tokq * 24 + (hg0 + h) * 3 + 0];
#pragma unroll
    for (int dt = 0; dt < 4; ++dt) {
      otot[h][dt] = o[h][dt] * g0;
      o[h][dt] = f32x4{0.f, 0.f, 0.f, 0.f};
    }
    m[h] = MINIT;
    ls[h] = 0.f;
  }
  if (tid < 4) sUni[tid] = 0u;
  __syncthreads();
  if (tid < 128) {
    const int q = tid >> 2, sub = tid & 3;
    unsigned mk[4] = {0u, 0u, 0u, 0u};
    if (cur < 16) {
      mk[0] = (1u << (cur + 1)) - 1u;
    } else {
      float v[32];
#pragma unroll
      for (int i = 0; i < 32; ++i) {
        int j = sub + 4 * i;
        v[i] = (j >= 1 && j <= cur - 2) ? (sImp[q * 132 + j] + sImp[32 * 132 + q * 132 + j]) : -1.f;
      }
      for (int round = 0; round < 13; ++round) {
        float bv = v[0];
        int bi = 0;
#pragma unroll
        for (int i = 1; i < 32; ++i)
          if (v[i] > bv) { bv = v[i]; bi = i; }
        int bj = sub + 4 * bi;
#pragma unroll
        for (int off = 1; off <= 2; off <<= 1) {
          float ov = __shfl_xor(bv, off);
          int oj = __shfl_xor(bj, off);
          if (ov > bv || (ov == bv && oj < bj)) { bv = ov; bj = oj; }
        }
#pragma unroll
        for (int i = 0; i < 32; ++i)
          if (sub + 4 * i == bj) v[i] = -2.f;
#pragma unroll
        for (int wd = 0; wd < 4; ++wd) mk[wd] |= ((bj >> 5) == wd) ? (1u << (bj & 31)) : 0u;
      }
      const int f1 = cur, f2 = cur - 1;
      mk[0] |= 1u;
#pragma unroll
      for (int wd = 0; wd < 4; ++wd) {
        mk[wd] |= ((f1 >> 5) == wd) ? (1u << (f1 & 31)) : 0u;
        mk[wd] |= ((f2 >> 5) == wd) ? (1u << (f2 & 31)) : 0u;
      }
    }
    if (sub == 0) {
#pragma unroll
      for (int wd = 0; wd < 4; ++wd) {
        sSel[q * 4 + wd] = mk[wd];
        atomicOr(&sUni[wd], mk[wd]);
      }
    }
  }
  __syncthreads();
  const int jw0 = (cur >= 8 ? cur - 8 : 0);
  {
    int j = next_set_bit(sUni, 0);
    kv_load_k(tl, KS + ((size_t)b * S + j * 64) * 128 + kvh * 64, 128, tid);
    kv_load_v(tl, VST + (size_t)bk * 64 * S + j * 64, S, tid);
    while (j <= cur) {
      __syncthreads();
      kv_store_k(tl, sK, tid);
      kv_store_v(tl, sV, tid);
      __syncthreads();
      const int jn = next_set_bit(sUni, j + 1);
      if (jn <= cur) {
        kv_load_k(tl, KS + ((size_t)b * S + jn * 64) * 128 + kvh * 64, 128, tid);
        kv_load_v(tl, VST + (size_t)bk * 64 * S + jn * 64, S, tid);
      } else {
        kv_load_k(tl, KW + ((size_t)b * S + jw0 * 64) * 128 + kvh * 64, 128, tid);
        kv_load_v(tl, VWT + (size_t)bk * 64 * S + jw0 * 64, S, tid);
      }
      const bool selbit = (sSel[tql * 4 + (j >> 5)] >> (j & 31)) & 1u;
#pragma unroll
      for (int half = 0; half < 2; ++half) {
        float posf[2][4];
        bool valid[2][4];
#pragma unroll
        for (int kt2 = 0; kt2 < 2; ++kt2)
#pragma unroll
          for (int jj = 0; jj < 4; ++jj) {
            int rel = j * 64 - t0 + half * 32 + kt2 * 16 + lg * 4 + jj;
            posf[kt2][jj] = (float)rel;
            valid[kt2][jj] = selbit && (rel <= tql);
          }
        half_step<2>(sK, sV, half, lr, lg, qf, slope, m, ls, o, posf, valid, psum);
      }
      j = jn;
    }
  }
#pragma unroll
  for (int h = 0; h < 2; ++h) {
    float x = ls[h];
    x += __shfl_xor(x, 16);
    x += __shfl_xor(x, 32);
    const float f = (x > 0.f ? 1.f / x : 0.f) * G[tokq * 24 + (hg0 + h) * 3 + 1];
#pragma unroll
    for (int dt = 0; dt < 4; ++dt) {
      otot[h][dt] += o[h][dt] * f;
      o[h][dt] = f32x4{0.f, 0.f, 0.f, 0.f};
    }
    m[h] = MINIT;
    ls[h] = 0.f;
  }
  for (int j = jw0; j <= cur; ++j) {
    __syncthreads();
    kv_store_k(tl, sK, tid);
    kv_store_v(tl, sV, tid);
    __syncthreads();
    if (j < cur) {
      kv_load_k(tl, KW + ((size_t)b * S + (j + 1) * 64) * 128 + kvh * 64, 128, tid);
      kv_load_v(tl, VWT + (size_t)bk * 64 * S + (j + 1) * 64, S, tid);
    }
#pragma unroll
    for (int half = 0; half < 2; ++half) {
      float posf[2][4];
      bool valid[2][4];
#pragma unroll
      for (int kt2 = 0; kt2 < 2; ++kt2)
#pragma unroll
        for (int jj = 0; jj < 4; ++jj) {
          int rel = j * 64 - t0 + half * 32 + kt2 * 16 + lg * 4 + jj;
          posf[kt2][jj] = (float)rel;
          valid[kt2][jj] = (rel <= tql) && (tql - rel < 512);
        }
      half_step<2>(sK, sV, half, lr, lg, qf, slope, m, ls, o, posf, valid, psum);
    }
  }
#pragma unroll
  for (int h = 0; h < 2; ++h) {
    float x = ls[h];
    x += __shfl_xor(x, 16);
    x += __shfl_xor(x, 32);
    const float f = (x > 0.f ? 1.f / x : 0.f) * G[tokq * 24 + (hg0 + h) * 3 + 2];
    float ss = 0.f;
#pragma unroll
    for (int dt = 0; dt < 4; ++dt) {
      otot[h][dt] += o[h][dt] * f;
#pragma unroll
      for (int jj = 0; jj < 4; ++jj) ss += otot[h][dt][jj] * otot[h][dt][jj];
    }
    ss += __shfl_xor(ss, 16);
    ss += __shfl_xor(ss, 32);
    const float r = rsqrtf(ss * (1.f / 64.f) + EPS);
#pragma unroll
    for (int dt = 0; dt < 4; ++dt) {
      const int d = dt * 16 + lg * 4;
      const float4 gg = *(const float4*)(p.out_g + l * 1024 + (hg0 + h) * 64 + d);
      uint2 st;
      st.x = pack2(otot[h][dt][0] * r * gg.x, otot[h][dt][1] * r * gg.y);
      st.y = pack2(otot[h][dt][2] * r * gg.z, otot[h][dt][3] * r * gg.w);
      *(uint2*)(OM + tokq * 1024 + (hg0 + h) * 64 + d) = st;
    }
  }
}

DI void gsync(cg::grid_group& g) {
  asm volatile("s_waitcnt vmcnt(0)" ::: "memory");
  g.sync();
  __builtin_amdgcn_fence(__ATOMIC_ACQUIRE, "agent");
  asm volatile("s_waitcnt vmcnt(0)" ::: "memory");
}


#ifndef STOP_AFTER
#define STOP_AFTER 0
#endif
#define DUMP_BF16_AND_STOP(ptr)                                                                   \
  {                                                                                               \
    const u16* s_ = (const u16*)(ptr);                                                            \
    for (size_t i = (size_t)bid * 256 + threadIdx.x; i < (size_t)TOK * 1024; i += (size_t)nb * 256) \
      p.out[i] = bf2f(s_[i]);                                                                     \
    return;                                                                                       \
  }
#define DUMP_F32_AND_STOP(ptr)                                                                    \
  {                                                                                               \
    const float* s_ = (const float*)(ptr);                                                        \
    for (size_t i = (size_t)bid * 256 + threadIdx.x; i < (size_t)TOK * 1024; i += (size_t)nb * 256) \
      p.out[i] = s_[i];                                                                           \
    return;                                                                                       \
  }
__global__ void __launch_bounds__(256, 2) mega(Params p) {
  __shared__ __attribute__((aligned(16))) char smem[65536];
  cg::grid_group grid = cg::this_grid();
  char* ws = p.ws;
  const int nb = gridDim.x, bid = blockIdx.x;
  float* X1 = (float*)(ws + OFF_X1);
  u16* H = (u16*)(ws + OFF_H);
  char* wsA = ws + OFF_A;
  const float* mod = (const float*)(ws + OFF_MOD);

#ifdef ZERO_WS
  {
    uint4* z = (uint4*)ws;
    const size_t n16 = (OFF_A + A_END) / 16;
    for (size_t i = (size_t)bid * 256 + threadIdx.x; i < n16; i += (size_t)nb * 256) z[i] = make_uint4(0, 0, 0, 0);
    uint4* zo = (uint4*)p.out;
    const size_t m16 = (size_t)TOK * 1024 * 4 / 16;
    for (size_t i = (size_t)bid * 256 + threadIdx.x; i < m16; i += (size_t)nb * 256) zo[i] = make_uint4(0, 0, 0, 0);
  }
  gsync(grid);
#endif
  phase0a(p, smem);
  gsync(grid);
  phase0b(p);
  gsync(grid);
  phase_mod_x(p);
  gsync(grid);

  for (int l = 0; l < 2; ++l) {
    const float* modl = mod + (size_t)l * 8 * 6144;
    const float* xin = (l == 0) ? p.x : p.out;
    {
      u16* Qo = (u16*)(wsA + A_Q);
      u16* KCo = (u16*)(wsA + A_KC);
      u16* VCo = (u16*)(wsA + A_VC);
      u16* KSo = (u16*)(wsA + A_KS);
      u16* VSTo = (u16*)(wsA + A_VST);
      u16* KWo = (u16*)(wsA + A_KW);
      u16* VWTo = (u16*)(wsA + A_VWT);
      float* Go = (float*)(wsA + A_G);
      u16* Uo = (u16*)(wsA + A_U);
      u16* VGTo = (u16*)(wsA + A_VGT);
      const float* vng = p.vn_g + l * 512;
      const float* vnb = p.vn_b + l * 512;
      auto sel1 = [](int tn) { return !(tn == 7 || tn == 9 || (tn >= 14 && tn < 18)); };
      auto epi = [&](bool swp, int tm, int tn, int wm, int wn, int lr, int lg, f32x4(&acc)[4][4]) {
        const int row0 = tm * 128 + wm * 64;
        const int b = row0 >> 13;
        const int s0 = row0 & (S - 1);
        if (swp) {
          if (tn == 18) {
            if (wn == 0) {
#pragma unroll
              for (int mi = 0; mi < 4; ++mi)
#pragma unroll
                for (int ni = 0; ni < 2; ++ni) {
                  const int c = ni * 16 + lg * 4;
                  const size_t row = (size_t)row0 + mi * 16 + lr;
                  if (c < 24)
                    *(float4*)(Go + row * 24 + c) =
                        make_float4(sigm(acc[mi][ni][0]), sigm(acc[mi][ni][1]), sigm(acc[mi][ni][2]), sigm(acc[mi][ni][3]));
                }
            }
          } else {
            u16* dst;
            int ld, cb;
            float sc = 1.f;
            bool g = false;
            if (tn < 4) { dst = Qo; ld = 512; cb = tn * 128; sc = QSCALE; }
            else if (tn == 4) { dst = KCo; ld = 128; cb = 0; }
            else if (tn == 5) { dst = VCo; ld = 128; cb = 0; }
            else if (tn == 6) { dst = KSo; ld = 128; cb = 0; }
            else if (tn == 8) { dst = KWo; ld = 128; cb = 0; }
            else { dst = Uo; ld = 512; cb = (tn - 10) * 128; g = true; }
#pragma unroll
            for (int mi = 0; mi < 4; ++mi)
#pragma unroll
              for (int ni = 0; ni < 4; ++ni) {
                const size_t row = (size_t)row0 + mi * 16 + lr;
                float v[4];
#pragma unroll
                for (int j = 0; j < 4; ++j) v[j] = g ? gelu_t(acc[mi][ni][j]) : acc[mi][ni][j] * sc;
                uint2 st;
                st.x = pack2(v[0], v[1]);
                st.y = pack2(v[2], v[3]);
                *(uint2*)(dst + row * ld + cb + wn * 64 + ni * 16 + lg * 4) = st;
              }
          }
        } else if (tn == 7 || tn == 9) {
          u16* dst = (tn == 7) ? VSTo : VWTo;
#pragma unroll
          for (int mi = 0; mi < 4; ++mi)
#pragma unroll
            for (int ni = 0; ni < 4; ++ni) {
              const int d = ni * 16 + lr;
              uint2 st;
              st.x = pack2(acc[mi][ni][0], acc[mi][ni][1]);
              st.y = pack2(acc[mi][ni][2], acc[mi][ni][3]);
              *(uint2*)(dst + ((size_t)(b * 2 + wn) * 64 + d) * S + s0 + mi * 16 + lg * 4) = st;
            }
        } else {
          const int grp = (tn - 14) * 2 + wn;
          float vg[4], vb[4];
#pragma unroll
          for (int ni = 0; ni < 4; ++ni) { vg[ni] = vng[grp * 64 + ni * 16 + lr]; vb[ni] = vnb[grp * 64 + ni * 16 + lr]; }
#pragma unroll
          for (int mi = 0; mi < 4; ++mi) {
            float vv[4][4];
#pragma unroll
            for (int ni = 0; ni < 4; ++ni)
#pragma unroll
              for (int j = 0; j < 4; ++j) vv[ni][j] = gelu_t(acc[mi][ni][j]);
#pragma unroll
            for (int j = 0; j < 4; ++j) {
              float s1 = vv[0][j] + vv[1][j] + vv[2][j] + vv[3][j];
              s1 += __shfl_xor(s1, 1); s1 += __shfl_xor(s1, 2); s1 += __shfl_xor(s1, 4); s1 += __shfl_xor(s1, 8);
              const float mu = s1 * (1.f / 64.f);
              float s2 = 0.f;
#pragma unroll
              for (int ni = 0; ni < 4; ++ni) { float dd = vv[ni][j] - mu; s2 += dd * dd; }
              s2 += __shfl_xor(s2, 1); s2 += __shfl_xor(s2, 2); s2 += __shfl_xor(s2, 4); s2 += __shfl_xor(s2, 8);
              const float rs = rsqrtf(s2 * (1.f / 64.f) + EPS);
#pragma unroll
              for (int ni = 0; ni < 4; ++ni) vv[ni][j] = (vv[ni][j] - mu) * rs * vg[ni] + vb[ni];
            }
#pragma unroll
            for (int ni = 0; ni < 4; ++ni) {
              const int d = ni * 16 + lr;
              uint2 st;
              st.x = pack2(vv[ni][0], vv[ni][1]);
              st.y = pack2(vv[ni][2], vv[ni][3]);
              *(uint2*)(VGTo + ((size_t)(b * 8 + grp) * 64 + d) * S + s0 + mi * 16 + lg * 4) = st;
            }
          }
        }
      };
      gemm_phase(H, 1024, (const u16*)(ws + OFF_WTIN + l * SZ_WTIN), 1024, 512, 19, 1024, bid, nb, smem, sel1, epi);
    }
    gsync(grid);
    if (STOP_AFTER == 1 && l == 0) DUMP_BF16_AND_STOP(wsA)
    if (STOP_AFTER == 11 && l == 0) DUMP_BF16_AND_STOP(wsA + A_KW)
    if (STOP_AFTER == 12 && l == 0) DUMP_BF16_AND_STOP(wsA + A_U)
    {
      const int ng = (nb >= 256) ? 256 : nb;
      const int half = ng / 2;
      for (int which = 0; which < 2; ++which) {
        u16* HC = (u16*)(wsA + A_HC) + (size_t)which * 8192 * 256;
        const float* cb1 = (const float*)(ws + OFF_CB1) + (l * 2 + which) * 256;
        const u16* src_tok = (const u16*)(wsA + (which ? A_VC : A_KC));
        auto selT = [](int) { return true; };
        auto ab = [=](int tm) {
          const int bk = tm >> 2, n0 = (tm & 3) * 128;
          return src_tok + ((size_t)(bk >> 1) * S + 16 * n0) * 128 + (bk & 1) * 64;
        };
        auto epi = [&](bool swp, int tm, int tn, int wm, int wn, int lr, int lg, f32x4(&acc)[4][4]) {
          const int row0 = tm * 128 + wm * 64, col0 = tn * 128 + wn * 64;
#pragma unroll
          for (int ni = 0; ni < 4; ++ni) {
            const float4 cb = *(const float4*)(cb1 + col0 + ni * 16 + lg * 4);
#pragma unroll
            for (int mi = 0; mi < 4; ++mi) {
              uint2 st;
              st.x = pack2(gelu_t(acc[mi][ni][0] + cb.x), gelu_t(acc[mi][ni][1] + cb.y));
              st.y = pack2(gelu_t(acc[mi][ni][2] + cb.z), gelu_t(acc[mi][ni][3] + cb.w));
              *(uint2*)(HC + (size_t)(row0 + mi * 16 + lr) * 256 + col0 + ni * 16 + lg * 4) = st;
            }
          }
        };
        const int vb = (bid < ng) ? (which == 0 ? (bid < half ? bid : -1) : (bid >= half ? bid - half : -1)) : -1;
        gemm_phase_g(ab, 2048, 128, (const u16*)(ws + OFF_WTC1 + (l * 2 + which) * SZ_WTC1), 2048, 64, 2, 2048, vb, half, smem,
                     selT, epi);
      }
    }
    gsync(grid);
    {
      for (int which = 0; which < 2; ++which) {
        u16* KCMP = (u16*)(ws + OFF_KCMP);
        u16* VCMPT = (u16*)(ws + OFF_VCMPT);
        auto selW = [which](int) { return which == 0; };
        auto epi = [&](bool swp, int tm, int tn, int wm, int wn, int lr, int lg, f32x4(&acc)[4][4]) {
          if (wn != 0) return;
          const int row0 = tm * 128 + wm * 64;
#pragma unroll
          for (int mi = 0; mi < 4; ++mi)
#pragma unroll
            for (int ni = 0; ni < 4; ++ni) {
              uint2 st;
              st.x = pack2(acc[mi][ni][0], acc[mi][ni][1]);
              st.y = pack2(acc[mi][ni][2], acc[mi][ni][3]);
              if (swp) {
                *(uint2*)(KCMP + (size_t)(row0 + mi * 16 + lr) * 64 + ni * 16 + lg * 4) = st;
              } else {
                const int d = ni * 16 + lr;
                const int rb = row0 + mi * 16 + lg * 4;
                *(uint2*)(VCMPT + ((size_t)(rb >> 9) * 64 + d) * 512 + (rb & 511)) = st;
              }
            }
        };
        const int vb = (which == 0) ? bid : (bid + nb - 64) % nb;
        gemm_phase((const u16*)(wsA + A_HC) + (size_t)which * 8192 * 256, 256,
                   (const u16*)(ws + OFF_WTC2 + (l * 2 + which) * SZ_WTC2), 256, 64, 1, 256, vb, nb, smem, selW, epi);
      }
    }
    gsync(grid);
    if (STOP_AFTER == 4 && l == 0) DUMP_BF16_AND_STOP(ws + OFF_KCMP)
    for (int r = 0; r * nb < 4096; ++r) {
      const int pos = (r & 1) ? (nb - 1 - bid) : bid;
      const int idx = r * nb + pos;
      if (idx < 4096) {
        const int qh = 255 - (idx >> 4);
        const int rem = idx & 15;
        attn_item(p, l, rem >> 1, rem & 1, qh, smem);
      }
    }
    for (int it = nb - 1 - bid; it < 4096; it += nb) gmlp_item(p, l, it);
    gsync(grid);
    if (STOP_AFTER == 5 && l == 0) DUMP_BF16_AND_STOP(H)
    if ((STOP_AFTER == 51 || STOP_AFTER == 52) && l == 0) {
      for (size_t i = (size_t)bid * 256 + threadIdx.x; i < (size_t)TOK * 1024; i += (size_t)nb * 256) {
        const int col = (int)(i & 1023);
        const bool keep = (STOP_AFTER == 51) ? (col < 512) : (col >= 512);
        p.out[i] = keep ? bf2f(H[i]) : 0.f;
      }
      return;
    }
    {
      auto selT = [](int) { return true; };
      auto epi = [&](bool swp, int tm, int tn, int wm, int wn, int lr, int lg, f32x4(&acc)[4][4]) {
        const int row0 = tm * 128 + wm * 64, col0 = tn * 128 + wn * 64;
        const int b = row0 >> 13;
#pragma unroll
        for (int ni = 0; ni < 4; ++ni) {
          const int col = col0 + ni * 16 + lg * 4;
          const float4 g1 = *(const float4*)(modl + (size_t)b * 6144 + 2048 + col);
#pragma unroll
          for (int mi = 0; mi < 4; ++mi) {
            const size_t row = (size_t)row0 + mi * 16 + lr;
            const float4 xv = *(const float4*)(xin + row * 1024 + col);
            float4 o4;
            o4.x = ALPHA * xv.x + (1.f + g1.x) * acc[mi][ni][0];
            o4.y = ALPHA * xv.y + (1.f + g1.y) * acc[mi][ni][1];
            o4.z = ALPHA * xv.z + (1.f + g1.z) * acc[mi][ni][2];
            o4.w = ALPHA * xv.w + (1.f + g1.w) * acc[mi][ni][3];
            *(float4*)(X1 + row * 1024 + col) = o4;
          }
        }
      };
      auto post = [&](int tm) { ln_block(X1, tm * 128, p.ln1_g + l * 1024, p.ln1_b + l * 1024, modl, 3072, 4096, H); };
      gemm_rowblock_phase(H, 1024, (const u16*)(ws + OFF_WTO + l * SZ_WTO), 1024, 512, 8, 1024, bid, nb, smem, epi, post);
    }
    gsync(grid);
    if (STOP_AFTER == 7 && l == 0) DUMP_F32_AND_STOP(X1)
    {
      u16* HH = (u16*)(wsA);
      auto selT = [](int) { return true; };
      auto epi = [&](bool swp, int tm, int tn, int wm, int wn, int lr, int lg, f32x4(&acc)[4][4]) {
        const int row0 = tm * 128 + wm * 64;
        const int cb = tn * 64 + wn * 32;
#pragma unroll
        for (int mi = 0; mi < 4; ++mi)
#pragma unroll
          for (int ni = 0; ni < 2; ++ni) {
            const size_t row = (size_t)row0 + mi * 16 + lr;
            float v[4];
#pragma unroll
            for (int j = 0; j < 4; ++j) {
              const float a = acc[mi][ni][j], bb = acc[mi][ni + 2][j];
              v[j] = a * sigm(a) * bb;
            }
            uint2 st;
            st.x = pack2(v[0], v[1]);
            st.y = pack2(v[2], v[3]);
            *(uint2*)(HH + row * 2816 + cb + ni * 16 + lg * 4) = st;
          }
      };
      gemm_phase(H, 1024, (const u16*)(ws + OFF_WT13 + l * SZ_WT13), 1024, 512, 44, 1024, bid, nb, smem, selT, epi);
    }
    gsync(grid);
    if (STOP_AFTER == 8 && l == 0) DUMP_BF16_AND_STOP(wsA)
    {
      const u16* HH = (const u16*)(wsA);
      float* outp = p.out;
      auto selT = [](int) { return true; };
      auto epi = [&](bool swp, int tm, int tn, int wm, int wn, int lr, int lg, f32x4(&acc)[4][4]) {
        const int row0 = tm * 128 + wm * 64, col0 = tn * 128 + wn * 64;
        const int b = row0 >> 13;
#pragma unroll
        for (int ni = 0; ni < 4; ++ni) {
          const int col = col0 + ni * 16 + lg * 4;
          const float4 g2 = *(const float4*)(modl + (size_t)b * 6144 + 5120 + col);
#pragma unroll
          for (int mi = 0; mi < 4; ++mi) {
            const size_t row = (size_t)row0 + mi * 16 + lr;
            const float4 xv = *(const float4*)(X1 + row * 1024 + col);
            float4 o4;
            o4.x = ALPHA * xv.x + (1.f + g2.x) * acc[mi][ni][0];
            o4.y = ALPHA * xv.y + (1.f + g2.y) * acc[mi][ni][1];
            o4.z = ALPHA * xv.z + (1.f + g2.z) * acc[mi][ni][2];
            o4.w = ALPHA * xv.w + (1.f + g2.w) * acc[mi][ni][3];
            *(float4*)(outp + row * 1024 + col) = o4;
          }
        }
      };
      auto post = [&](int tm) {
        if (l == 0) ln_block(outp, tm * 128, p.ln2_g, p.ln2_b, mod + (size_t)8 * 6144, 0, 1024, H);
        else ln_block(outp, tm * 128, p.ln2_g + 1024, p.ln2_b + 1024, nullptr, 0, 0, nullptr);
      };
      gemm_rowblock_phase(HH, 2816, (const u16*)(ws + OFF_WT2 + l * SZ_WT2), 2816, 512, 8, 2816, bid, nb, smem, epi, post);
    }
    if (l == 0) gsync(grid);
  }
}

extern "C" void kernel_launch(void* const* d_in, const int* in_sizes, int n_in, void* d_out, int out_size, void* d_ws,
                              size_t ws_size, hipStream_t stream) {
  static int grid_blocks = 0;
  if (!grid_blocks) {
    int dev = 0, cus = 0, per_cu = 0;
    (void)hipGetDevice(&dev);
    (void)hipDeviceGetAttribute(&cus, hipDeviceAttributeMultiprocessorCount, dev);
    (void)hipOccupancyMaxActiveBlocksPerMultiprocessor(&per_cu, mega, 256, 0);
    if (per_cu > 2) per_cu = 2;
    if (per_cu < 1) per_cu = 1;
    grid_blocks = cus * per_cu;
  }
  Params p{};
  const float* const* in = (const float* const*)d_in;
  p.x = in[0]; p.c = in[1]; p.w_ada = in[2]; p.b_ada = in[3]; p.w_in = in[4]; p.cmp_pos = in[5]; p.cmp_w1 = in[6];
  p.cmp_w2 = in[7]; p.vn_g = in[8]; p.vn_b = in[9]; p.w_s = in[10]; p.b_s = in[11]; p.out_g = in[12]; p.w_o = in[13];
  p.ln1_g = in[14]; p.ln1_b = in[15]; p.w1 = in[16]; p.w3 = in[17]; p.w2 = in[18]; p.ln2_g = in[19]; p.ln2_b = in[20];
  p.out = (float*)d_out;
  p.ws = (char*)d_ws;
  void* args[] = {&p};
  hipError_t e = hipLaunchCooperativeKernel((void*)mega, dim3(grid_blocks), dim3(256), args, 0, stream);
  if (e != hipSuccess) fprintf(stderr, "cooperative launch failed: %s (grid %d)\n", hipGetErrorString(e), grid_blocks);
}
```

```cpp
#define STOP_AFTER 0
#include <hip/hip_runtime.h>
#include <hip/hip_cooperative_groups.h>
#include <cstdio>
namespace cg = cooperative_groups;

typedef unsigned short u16;
using bf16x8 = __attribute__((ext_vector_type(8))) short;
using f32x4 = __attribute__((ext_vector_type(4))) float;
using u32x4 = __attribute__((ext_vector_type(4))) unsigned;
#define DI __device__ __forceinline__
#define MFMA16(a, b, c) __builtin_amdgcn_mfma_f32_16x16x32_bf16((a), (b), (c), 0, 0, 0)

constexpr int S = 8192, TOK = 65536;
constexpr int INW = 2328, INP = 2432;
constexpr float ALPHA = 1.41421356237f;
constexpr float LOG2E = 1.4426950408889634f;
constexpr float QSCALE = 0.125f * LOG2E;
constexpr float NEGB = -1e30f, MINIT = -30000.f;
constexpr float EPS = 1e-5f;

constexpr size_t SZ_WTIN = (size_t)INP * 1024 * 2;
constexpr size_t SZ_WTO = (size_t)1024 * 1024 * 2;
constexpr size_t SZ_WT13 = (size_t)5632 * 1024 * 2;
constexpr size_t SZ_WT2 = (size_t)1024 * 2816 * 2;
constexpr size_t SZ_WTC1 = (size_t)256 * 2048 * 2;
constexpr size_t SZ_WTC2 = (size_t)128 * 256 * 2;
constexpr size_t OFF_WTIN = 0;
constexpr size_t OFF_WTO = OFF_WTIN + 2 * SZ_WTIN;
constexpr size_t OFF_WT13 = OFF_WTO + 2 * SZ_WTO;
constexpr size_t OFF_WT2 = OFF_WT13 + 2 * SZ_WT13;
constexpr size_t OFF_WTC1 = OFF_WT2 + 2 * SZ_WT2;
constexpr size_t OFF_WTC2 = OFF_WTC1 + 4 * SZ_WTC1;
constexpr size_t OFF_MODP = OFF_WTC2 + 4 * SZ_WTC2;
constexpr size_t SZ_MOD = (size_t)2 * 8 * 6144 * 4;
constexpr size_t OFF_MOD = OFF_MODP + 16 * SZ_MOD;
constexpr size_t SZ_CMP = (size_t)8 * 2 * 512 * 64 * 2;
constexpr size_t OFF_CB1P = OFF_MOD + SZ_MOD;
constexpr size_t OFF_CB1 = OFF_CB1P + 16 * 4 * 256 * 4;
constexpr size_t OFF_KCMP = OFF_CB1 + 4 * 256 * 4;
constexpr size_t OFF_VCMPT = OFF_KCMP + SZ_CMP;
constexpr size_t OFF_X1 = OFF_VCMPT + SZ_CMP;
constexpr size_t OFF_H = OFF_X1 + (size_t)TOK * 1024 * 4;
constexpr size_t OFF_A = OFF_H + (size_t)TOK * 1024 * 2;
constexpr size_t SZ_KV = (size_t)TOK * 128 * 2;
constexpr size_t A_Q = 0;
constexpr size_t A_KC = A_Q + (size_t)TOK * 512 * 2;
constexpr size_t A_VC = A_KC + SZ_KV;
constexpr size_t A_KS = A_VC + SZ_KV;
constexpr size_t A_VST = A_KS + SZ_KV;
constexpr size_t A_KW = A_VST + SZ_KV;
constexpr size_t A_VWT = A_KW + SZ_KV;
constexpr size_t A_G = A_VWT + SZ_KV;
constexpr size_t A_U = A_G + (size_t)TOK * 24 * 4;
constexpr size_t A_VGT = A_U + (size_t)TOK * 512 * 2;
constexpr size_t A_AC = A_VGT + (size_t)TOK * 512 * 2;
constexpr size_t A_HC = A_AC + (size_t)2 * 8192 * 2048 * 2;
constexpr size_t A_END = A_HC + (size_t)2 * 8192 * 256 * 2;

struct Params {
  const float *x, *c, *w_ada, *b_ada, *w_in, *cmp_pos, *cmp_w1, *cmp_w2, *vn_g, *vn_b, *w_s, *b_s, *out_g, *w_o,
      *ln1_g, *ln1_b, *w1, *w3, *w2, *ln2_g, *ln2_b;
  float* out;
  char* ws;
};

DI u16 f2bf(float x) { unsigned u = __float_as_uint(x); u += 0x7fffu + ((u >> 16) & 1u); return (u16)(u >> 16); }
DI float bf2f(u16 h) { return __uint_as_float(((unsigned)h) << 16); }
DI unsigned pack2(float a, float b) { return (unsigned)f2bf(a) | ((unsigned)f2bf(b) << 16); }
DI float gelu_t(float x) { float u = 1.5957691216f * (x + 0.044715f * x * x * x); return x / (1.f + __expf(-u)); }
DI float sigm(float x) { return 1.f / (1.f + __expf(-x)); }
DI float ex2(float x) { return __builtin_amdgcn_exp2f(x); }
DI int otid() { int t = threadIdx.x; asm volatile("" : "+v"(t)); return t; }

template <int MODE> DI int map_row(int n) {
  if (MODE == 1) return n < 1280 ? n : (n < 1304 ? n + 1024 : n - 24);
  if (MODE == 2) return (n >> 5) * 64 + (n & 31);
  if (MODE == 3) return (n >> 5) * 64 + 32 + (n & 31);
  return n;
}

template <int MODE>
DI void conv_tile(const float* __restrict__ W, int K, int N, u16* __restrict__ Wt, int ldk, int tile, float* tl) {
  const int tiles_n = (N + 63) / 64;
  const int tk = tile / tiles_n, tn = tile % tiles_n;
  const int k0 = tk * 64, n0 = tn * 64;
  const int tid = otid();
#pragma unroll
  for (int i = 0; i < 16; ++i) {
    int idx = tid + 256 * i;
    int r = idx >> 6, c = idx & 63;
    int n = n0 + c;
    tl[r * 65 + c] = (n < N) ? W[(long)(k0 + r) * N + n] : 0.f;
  }
  __syncthreads();
  const int nl = tid >> 2, kc = tid & 3;
  const int n = n0 + nl;
  if (n < N) {
    const int row = map_row<MODE>(n);
    unsigned pk[8];
#pragma unroll
    for (int i = 0; i < 8; ++i) pk[i] = pack2(tl[(kc * 16 + 2 * i) * 65 + nl], tl[(kc * 16 + 2 * i + 1) * 65 + nl]);
    uint4* dst = (uint4*)(Wt + (long)row * ldk + k0 + kc * 16);
    dst[0] = make_uint4(pk[0], pk[1], pk[2], pk[3]);
    dst[1] = make_uint4(pk[4], pk[5], pk[6], pk[7]);
  }
  __syncthreads();
}

DI void phase0a(const Params& p, char* smem) {
  char* ws = p.ws;
  const int tid = threadIdx.x;
  constexpr int PER_LAYER = 592 + 256 + 704 * 3 + 128 * 2 + 4 * 2;
  constexpr int NCONV = 2 * PER_LAYER;
  constexpr int NTOT = NCONV + 768 + 2 + 64;
  for (int it = blockIdx.x; it < NTOT; it += gridDim.x) {
    if (it < NCONV) {
      const int l = it / PER_LAYER;
      const int li = it % PER_LAYER;
      int base = 0;
#define SEG(MODE, SRC, DST, K_, N_, LDK)                                                   \
  {                                                                                        \
    const int nt_ = ((K_) / 64) * (((N_) + 63) / 64);                                      \
    if (li >= base && li < base + nt_) conv_tile<MODE>(SRC, K_, N_, DST, LDK, li - base, (float*)smem); \
    base += nt_;                                                                           \
  }
      SEG(1, p.w_in + (size_t)l * 1024 * INW, (u16*)(ws + OFF_WTIN + l * SZ_WTIN), 1024, INW, 1024)
      SEG(0, p.w_o + (size_t)l * 1024 * 1024, (u16*)(ws + OFF_WTO + l * SZ_WTO), 1024, 1024, 1024)
      SEG(2, p.w1 + (size_t)l * 1024 * 2816, (u16*)(ws + OFF_WT13 + l * SZ_WT13), 1024, 2816, 1024)
      SEG(3, p.w3 + (size_t)l * 1024 * 2816, (u16*)(ws + OFF_WT13 + l * SZ_WT13), 1024, 2816, 1024)
      SEG(0, p.w2 + (size_t)l * 2816 * 1024, (u16*)(ws + OFF_WT2 + l * SZ_WT2), 2816, 1024, 2816)
      SEG(0, p.cmp_w1 + (size_t)(l * 2 + 0) * 2048 * 256, (u16*)(ws + OFF_WTC1 + (l * 2 + 0) * SZ_WTC1), 2048, 256, 2048)
      SEG(0, p.cmp_w1 + (size_t)(l * 2 + 1) * 2048 * 256, (u16*)(ws + OFF_WTC1 + (l * 2 + 1) * SZ_WTC1), 2048, 256, 2048)
      SEG(0, p.cmp_w2 + (size_t)(l * 2 + 0) * 256 * 64, (u16*)(ws + OFF_WTC2 + (l * 2 + 0) * SZ_WTC2), 256, 64, 256)
      SEG(0, p.cmp_w2 + (size_t)(l * 2 + 1) * 256 * 64, (u16*)(ws + OFF_WTC2 + (l * 2 + 1) * SZ_WTC2), 256, 64, 256)
#undef SEG
    } else if (it < NCONV + 768) {
      const int idx = it - NCONV;
      const int l = idx / 384, r = idx % 384, nb = r / 16, kc = r % 16;
      float* cs = (float*)smem;
      for (int i = tid; i < 512; i += 256) {
        int b = i >> 6, k = i & 63;
        float cv = p.c[b * 1024 + kc * 64 + k];
        cs[i] = cv * sigm(cv);
      }
      __syncthreads();
      const int n = nb * 256 + tid;
      float acc[8];
#pragma unroll
      for (int b = 0; b < 8; ++b) acc[b] = 0.f;
      const float* wp = p.w_ada + ((size_t)l * 1024 + kc * 64) * 6144 + n;
#pragma unroll 8
      for (int k = 0; k < 64; ++k) {
        float wv = wp[(size_t)k * 6144];
#pragma unroll
        for (int b = 0; b < 8; ++b) acc[b] += cs[b * 64 + k] * wv;
      }
      float* modp = (float*)(ws + OFF_MODP);
#pragma unroll
      for (int b = 0; b < 8; ++b) modp[(size_t)((kc * 2 + l) * 8 + b) * 6144 + n] = acc[b];
      __syncthreads();
    } else if (it < NCONV + 768 + 2) {
      const int l = it - NCONV - 768;
      uint4* dst = (uint4*)(ws + OFF_WTIN + l * SZ_WTIN + (size_t)INW * 1024 * 2);
      const int n16 = (INP - INW) * 1024 * 2 / 16;
      for (int i = tid; i < n16; i += 256) dst[i] = make_uint4(0, 0, 0, 0);
    } else {
      const int idx = it - NCONV - 768 - 2;
      const int lw = idx >> 4, kc = idx & 15;
      const float* pos = p.cmp_pos + (size_t)lw * 2048 + kc * 128;
      const float* w1p = p.cmp_w1 + ((size_t)lw * 2048 + kc * 128) * 256 + tid;
      float a = 0.f;
#pragma unroll 8
      for (int k = 0; k < 128; ++k) a += pos[k] * w1p[(size_t)k * 256];
      ((float*)(ws + OFF_CB1P))[(kc * 4 + lw) * 256 + tid] = a;
    }
  }
}

DI void phase0b(const Params& p) {
  const float* modp = (const float*)(p.ws + OFF_MODP);
  float* mod = (float*)(p.ws + OFF_MOD);
  const int n = 2 * 8 * 6144;
  for (int i = blockIdx.x * 256 + threadIdx.x; i < n; i += gridDim.x * 256) {
    int l = i / (8 * 6144), c = i % 6144;
    float a = p.b_ada[l * 6144 + c];
#pragma unroll
    for (int kc = 0; kc < 16; ++kc) a += modp[(size_t)kc * n + i];
    mod[i] = a;
  }
  const float* cbp = (const float*)(p.ws + OFF_CB1P);
  float* cb = (float*)(p.ws + OFF_CB1);
  for (int i = blockIdx.x * 256 + threadIdx.x; i < 1024; i += gridDim.x * 256) {
    float a = 0.f;
#pragma unroll
    for (int kc = 0; kc < 16; ++kc) a += cbp[kc * 1024 + i];
    cb[i] = a;
  }
}

DI void phase_mod_x(const Params& p) {
  const float* mod = (const float*)(p.ws + OFF_MOD);
  u16* H = (u16*)(p.ws + OFF_H);
  const long nchunk = (long)TOK * 1024 / 8;
  for (long i = (long)blockIdx.x * 256 + otid(); i < nchunk; i += (long)gridDim.x * 256) {
    long e = i * 8;
    int col = (int)(e & 1023);
    int b = (int)(e >> 23);
    const float4* xp = (const float4*)(p.x + e);
    const float4* sh = (const float4*)(mod + (size_t)b * 6144 + 0 + col);
    const float4* sc = (const float4*)(mod + (size_t)b * 6144 + 1024 + col);
    float4 x0 = xp[0], x1 = xp[1], s0 = sc[0], s1 = sc[1], h0 = sh[0], h1 = sh[1];
    uint4 o;
    o.x = pack2(x0.x * (1.f + s0.x) + h0.x, x0.y * (1.f + s0.y) + h0.y);
    o.y = pack2(x0.z * (1.f + s0.z) + h0.z, x0.w * (1.f + s0.w) + h0.w);
    o.z = pack2(x1.x * (1.f + s1.x) + h1.x, x1.y * (1.f + s1.y) + h1.y);
    o.w = pack2(x1.z * (1.f + s1.z) + h1.z, x1.w * (1.f + s1.w) + h1.w);
    *(uint4*)(H + e) = o;
  }
}

constexpr int LDS_BYTES = 73728;
DI int swz_key(int r) { return (0x78 >> (2 * ((r >> 2) & 3))) & 3; }
template <int MT>
DI void g_issue(const u16* __restrict__ Ap, int lda, const u16* __restrict__ Bp, int ldb, int st, int ksa, int tid, char* buf) {
  constexpr int AOFF = 2048 * MT;
  const int koffA = (st >> 1) * ksa + (st & 1) * 32;
  const int koffB = st * 32;
  const int wbase = (tid & ~63) * 16;
#pragma unroll
  for (int i = 0; i < MT / 2; ++i) {
    const int c = tid + 256 * i;
    const int row = c >> 2, ph = c & 3;
    const int lc = ph ^ swz_key(row);
    __builtin_amdgcn_global_load_lds((const unsigned*)(Ap + (size_t)row * lda + koffA + lc * 8),
                                     (unsigned*)(buf + i * 4096 + wbase), 16, 0, 0);
  }
#pragma unroll
  for (int i = 0; i < 2; ++i) {
    const int c = tid + 256 * i;
    const int row = c >> 2, ph = c & 3;
    const int lc = ph ^ swz_key(row);
    __builtin_amdgcn_global_load_lds((const unsigned*)(Bp + (size_t)row * ldb + koffB + lc * 8),
                                     (unsigned*)(buf + AOFF + i * 4096 + wbase), 16, 0, 0);
  }
}
template <bool SWAP, int MT>
DI void g_compute(const char* sA, f32x4 (&acc)[MT][4], int wm, int wn, int lr, int lg) {
  const char* sB = sA + 2048 * MT;
  bf16x8 af[MT], bfr[4];
  const int ra = wm * (16 * MT) + lr, rb = wn * 64 + lr;
  const int ka = (lg ^ swz_key(ra)) << 4, kb = (lg ^ swz_key(rb)) << 4;
  af[0] = *(const bf16x8*)(sA + ra * 64 + ka);
#pragma unroll
  for (int ni = 0; ni < 4; ++ni) bfr[ni] = *(const bf16x8*)(sB + (rb + ni * 16) * 64 + kb);
#pragma unroll
  for (int mi = 1; mi < MT; ++mi) af[mi] = *(const bf16x8*)(sA + (ra + mi * 16) * 64 + ka);
  __builtin_amdgcn_sched_barrier(0);
#pragma unroll
  for (int mi = 0; mi < MT; ++mi)
#pragma unroll
    for (int ni = 0; ni < 4; ++ni)
      acc[mi][ni] = SWAP ? MFMA16(bfr[ni], af[mi], acc[mi][ni]) : MFMA16(af[mi], bfr[ni], acc[mi][ni]);
  __builtin_amdgcn_sched_barrier(0);
}
#define RAW_BARRIER() do { asm volatile("s_waitcnt lgkmcnt(0)" ::: "memory"); __builtin_amdgcn_s_barrier(); } while (0)

template <bool SWAP, int MT, class Epi>
DI void gemm_tile(const u16* __restrict__ Ap, int lda, const u16* __restrict__ Bp, int ldb, int nk, int tm, int tn, int tid,
                  char* smem, Epi epi, int ksa = 64) {
  constexpr int NBUF = (MT == 8) ? 3 : 4;
  constexpr int BUFSZ = 2048 * MT + 8192;
  constexpr int LA = NBUF - 1;
  const int lane = tid & 63, w = tid >> 6, wm = w >> 1, wn = w & 1;
  const int lr = lane & 15, lg = lane >> 4;
  const int nks = nk * 2;
  f32x4 acc[MT][4];
#pragma unroll
  for (int i = 0; i < MT; ++i)
#pragma unroll
    for (int j = 0; j < 4; ++j) acc[i][j] = f32x4{0.f, 0.f, 0.f, 0.f};
#pragma unroll
  for (int s = 0; s < LA; ++s) g_issue<MT>(Ap, lda, Bp, ldb, s, ksa, tid, smem + s * BUFSZ);
  int bi = 0, bn = LA;
  for (int st = 0; st < nks; ++st) {
    if (MT == 8) {
      if (st + 1 < nks) asm volatile("s_waitcnt vmcnt(6)" ::: "memory");
      else asm volatile("s_waitcnt vmcnt(0)" ::: "memory");
    } else {
      if (st + 2 < nks) asm volatile("s_waitcnt vmcnt(8)" ::: "memory");
      else if (st + 1 < nks) asm volatile("s_waitcnt vmcnt(4)" ::: "memory");
      else asm volatile("s_waitcnt vmcnt(0)" ::: "memory");
    }
    RAW_BARRIER();
    if (st + LA < nks) g_issue<MT>(Ap, lda, Bp, ldb, st + LA, ksa, tid, smem + bn * BUFSZ);
    g_compute<SWAP, MT>(smem + bi * BUFSZ, acc, wm, wn, lr, lg);
    bi = (bi + 1 == NBUF) ? 0 : bi + 1;
    bn = (bn + 1 == NBUF) ? 0 : bn + 1;
  }
  RAW_BARRIER();
  epi(SWAP, tm, tn, wm, wn, lr, lg, acc);
}

template <int MT, class AB, class Sel, class Epi>
DI void gemm_phase_g(AB abase, int lda, int ksa, const u16* __restrict__ Bt, int ldb, int ntm, int ntn, int K, int vb, int nvb,
                     char* smem, Sel swapsel, Epi epi) {
  if (vb < 0 || vb >= nvb) return;
  const int ntiles = ntm * ntn;
  const int nk = K / 64;
  int GM = nvb / ntn;
  if (GM < 1) GM = 1;
  if (GM > ntm) GM = ntm;
  const int gtiles = GM * ntn;
  const int q0 = ((nvb & 7) == 0) ? ((vb & 7) * (nvb >> 3) + (vb >> 3)) : vb;
  for (int q = q0; q < ntiles; q += nvb) {
    const int g = q / gtiles;
    const int i = q - g * gtiles;
    const int gsz = (ntm - g * GM < GM) ? (ntm - g * GM) : GM;
    const int tn = i / gsz;
    const int tm = g * GM + (i - tn * gsz);
    const u16* Ap = abase(tm);
    const u16* Bp = Bt + (size_t)tn * 128 * ldb;
    const int tid = otid();
    if (swapsel(tn)) gemm_tile<true, MT>(Ap, lda, Bp, ldb, nk, tm, tn, tid, smem, epi, ksa);
    else gemm_tile<false, MT>(Ap, lda, Bp, ldb, nk, tm, tn, tid, smem, epi, ksa);
  }
}
template <int MT, class Sel, class Epi>
DI void gemm_phase(const u16* __restrict__ A, int lda, const u16* __restrict__ Bt, int ldb, int ntm, int ntn, int K,
                   int vb, int nvb, char* smem, Sel swapsel, Epi epi) {
  auto ab = [=](int tm) { return A + (size_t)tm * (32 * MT) * lda; };
  gemm_phase_g<MT>(ab, lda, 64, Bt, ldb, ntm, ntn, K, vb, nvb, smem, swapsel, epi);
}
template <class Epi, class Post>
DI void gemm_rowblock_phase(const u16* __restrict__ A, int lda, const u16* __restrict__ Bt, int ldb, int ntm, int ntn, int K,
                            int vb, int nvb, char* smem, Epi epi, Post post) {
  const int nk = K / 64;
  for (int tm = vb; tm < ntm; tm += nvb) {
    const u16* Ap = A + (size_t)tm * 128 * lda;
    for (int tn = 0; tn < ntn; ++tn) {
      const int tid = otid();
      gemm_tile<true, 4>(Ap, lda, Bt + (size_t)tn * 128 * ldb, ldb, nk, tm, tn, tid, smem, epi, 64);
    }
    asm volatile("s_waitcnt vmcnt(0)" ::: "memory");
    __syncthreads();
    post(tm);
  }
}

DI void ln_rows(float* buf, const float* __restrict__ g, const float* __restrict__ bt, const float* __restrict__ modl,
                        int sh_off, int sc_off, u16* H) {
  const int tid_ = otid();
  const int lane = tid_ & 63, w = tid_ >> 6;
  for (int row = blockIdx.x * 4 + w; row < TOK; row += gridDim.x * 4) {
    float4* rp = (float4*)(buf + (size_t)row * 1024);
    float4 v[4];
    float s = 0.f;
#pragma unroll
    for (int i = 0; i < 4; ++i) { v[i] = rp[lane + 64 * i]; s += v[i].x + v[i].y + v[i].z + v[i].w; }
#pragma unroll
    for (int o = 32; o >= 1; o >>= 1) s += __shfl_xor(s, o);
    const float mu = s * (1.f / 1024.f);
    float q = 0.f;
#pragma unroll
    for (int i = 0; i < 4; ++i) {
      float a = v[i].x - mu, b = v[i].y - mu, c = v[i].z - mu, d = v[i].w - mu;
      q += a * a + b * b + c * c + d * d;
    }
#pragma unroll
    for (int o = 32; o >= 1; o >>= 1) q += __shfl_xor(q, o);
    const float rs = rsqrtf(q * (1.f / 1024.f) + EPS);
    const int b = row >> 13;
#pragma unroll
    for (int i = 0; i < 4; ++i) {
      const int col = (lane + 64 * i) * 4;
      float4 gg = *(const float4*)(g + col), bb = *(const float4*)(bt + col);
      float4 y;
      y.x = (v[i].x - mu) * rs * gg.x + bb.x;
      y.y = (v[i].y - mu) * rs * gg.y + bb.y;
      y.z = (v[i].z - mu) * rs * gg.z + bb.z;
      y.w = (v[i].w - mu) * rs * gg.w + bb.w;
      rp[lane + 64 * i] = y;
      if (H) {
        float4 sh = *(const float4*)(modl + (size_t)b * 6144 + sh_off + col);
        float4 sc = *(const float4*)(modl + (size_t)b * 6144 + sc_off + col);
        uint2 o2;
        o2.x = pack2(y.x * (1.f + sc.x) + sh.x, y.y * (1.f + sc.y) + sh.y);
        o2.y = pack2(y.z * (1.f + sc.z) + sh.z, y.w * (1.f + sc.w) + sh.w);
        *(uint2*)(H + (size_t)row * 1024 + col) = o2;
      }
    }
  }
}

DI void ln_block(float* buf, int row0, const float* __restrict__ g, const float* __restrict__ bt,
                 const float* __restrict__ modl, int sh_off, int sc_off, u16* H) {
  const int tid_ = otid();
  const int lane = tid_ & 63, w = tid_ >> 6;
  for (int rr = 0; rr < 32; ++rr) {
    const int row = row0 + w * 32 + rr;
    f32x4* rp = (f32x4*)(buf + (size_t)row * 1024);
    f32x4 v[4];
    float s = 0.f;
#pragma unroll
    for (int i = 0; i < 4; ++i) { v[i] = __builtin_nontemporal_load(rp + lane + 64 * i); s += v[i][0] + v[i][1] + v[i][2] + v[i][3]; }
#pragma unroll
    for (int o = 32; o >= 1; o >>= 1) s += __shfl_xor(s, o);
    const float mu = s * (1.f / 1024.f);
    float q = 0.f;
#pragma unroll
    for (int i = 0; i < 4; ++i)
#pragma unroll
      for (int k = 0; k < 4; ++k) { float a = v[i][k] - mu; q += a * a; }
#pragma unroll
    for (int o = 32; o >= 1; o >>= 1) q += __shfl_xor(q, o);
    const float rs = rsqrtf(q * (1.f / 1024.f) + EPS);
    const int b = row >> 13;
#pragma unroll
    for (int i = 0; i < 4; ++i) {
      const int col = (lane + 64 * i) * 4;
      const float4 gg = *(const float4*)(g + col), bb = *(const float4*)(bt + col);
      f32x4 y;
      y[0] = (v[i][0] - mu) * rs * gg.x + bb.x;
      y[1] = (v[i][1] - mu) * rs * gg.y + bb.y;
      y[2] = (v[i][2] - mu) * rs * gg.z + bb.z;
      y[3] = (v[i][3] - mu) * rs * gg.w + bb.w;
      rp[lane + 64 * i] = y;
      if (H) {
        const float4 sh = *(const float4*)(modl + (size_t)b * 6144 + sh_off + col);
        const float4 sc = *(const float4*)(modl + (size_t)b * 6144 + sc_off + col);
        uint2 o2;
        o2.x = pack2(y[0] * (1.f + sc.x) + sh.x, y[1] * (1.f + sc.y) + sh.y);
        o2.y = pack2(y[2] * (1.f + sc.z) + sh.z, y[3] * (1.f + sc.w) + sh.w);
        *(uint2*)(H + (size_t)row * 1024 + col) = o2;
      }
    }
  }
}

DI void gmlp_item(const Params& p, int l, int item) {
  const int b = item >> 9, c = (item >> 3) & 63, grp = item & 7;
  const int tid_ = otid();
  const int lane = tid_ & 63, w = tid_ >> 6, lr = lane & 15, lg = lane >> 4;
  const float* wsp = p.w_s + (size_t)(l * 8 + grp) * 128 * 128;
  const u16* vgt = (const u16*)(p.ws + OFF_A + A_VGT) + (size_t)(b * 8 + grp) * 64 * S + c * 128;
  const u16* U = (const u16*)(p.ws + OFF_A + A_U);
  u16* OM = (u16*)(p.ws + OFF_H);
  f32x4 acc[4][2];
#pragma unroll
  for (int i = 0; i < 4; ++i)
#pragma unroll
    for (int j = 0; j < 2; ++j) acc[i][j] = f32x4{0.f, 0.f, 0.f, 0.f};
#pragma unroll
  for (int ks = 0; ks < 4; ++ks) {
    const int s0 = ks * 32 + lg * 8;
    bf16x8 af[4];
#pragma unroll
    for (int dt = 0; dt < 4; ++dt) af[dt] = *(const bf16x8*)(vgt + (size_t)(dt * 16 + lr) * S + s0);
#pragma unroll
    for (int nt = 0; nt < 2; ++nt) {
      const int t = w * 32 + nt * 16 + lr;
      const float4* wp = (const float4*)(wsp + t * 128 + s0);
      float4 a0 = wp[0], a1 = wp[1];
      unsigned pw[4];
      pw[0] = pack2((s0 + 0 <= t) ? a0.x : 0.f, (s0 + 1 <= t) ? a0.y : 0.f);
      pw[1] = pack2((s0 + 2 <= t) ? a0.z : 0.f, (s0 + 3 <= t) ? a0.w : 0.f);
      pw[2] = pack2((s0 + 4 <= t) ? a1.x : 0.f, (s0 + 5 <= t) ? a1.y : 0.f);
      pw[3] = pack2((s0 + 6 <= t) ? a1.z : 0.f, (s0 + 7 <= t) ? a1.w : 0.f);
      bf16x8 bw = __builtin_bit_cast(bf16x8, make_uint4(pw[0], pw[1], pw[2], pw[3]));
#pragma unroll
      for (int dt = 0; dt < 4; ++dt) acc[dt][nt] = MFMA16(af[dt], bw, acc[dt][nt]);
    }
  }
#pragma unroll
  for (int nt = 0; nt < 2; ++nt) {
    const int t = w * 32 + nt * 16 + lr;
    const size_t tok = (size_t)b * S + c * 128 + t;
    const float bias = p.b_s[(l * 8 + grp) * 128 + t];
    float val[4][4];
    float ss = 0.f;
#pragma unroll
    for (int dt = 0; dt < 4; ++dt) {
      const int d = dt * 16 + lg * 4;
      const uint2 uu = *(const uint2*)(U + tok * 512 + grp * 64 + d);
      const float u0 = bf2f(uu.x & 0xffff), u1 = bf2f(uu.x >> 16), u2 = bf2f(uu.y & 0xffff), u3 = bf2f(uu.y >> 16);
      val[dt][0] = u0 * (acc[dt][nt][0] + bias);
      val[dt][1] = u1 * (acc[dt][nt][1] + bias);
      val[dt][2] = u2 * (acc[dt][nt][2] + bias);
      val[dt][3] = u3 * (acc[dt][nt][3] + bias);
#pragma unroll
      for (int j = 0; j < 4; ++j) ss += val[dt][j] * val[dt][j];
    }
    ss += __shfl_xor(ss, 16);
    ss += __shfl_xor(ss, 32);
    const float r = rsqrtf(ss * (1.f / 64.f) + EPS);
#pragma unroll
    for (int dt = 0; dt < 4; ++dt) {
      const int d = dt * 16 + lg * 4;
      const float4 gg = *(const float4*)(p.out_g + l * 1024 + 512 + grp * 64 + d);
      uint2 st;
      st.x = pack2(val[dt][0] * r * gg.x, val[dt][1] * r * gg.y);
      st.y = pack2(val[dt][2] * r * gg.z, val[dt][3] * r * gg.w);
      *(uint2*)(OM + tok * 1024 + 512 + grp * 64 + d) = st;
    }
  }
}

constexpr int SM_K = 0, SM_V = 8192, SM_IMP = 8192 + 8704, SM_SEL = SM_IMP + 64 * 132 * 4, SM_UNI = SM_SEL + 1024;

struct KVr { u32x4 k0, k1, v0, v1; };
DI void kv_load_k(KVr& t, const u16* __restrict__ src, int stride, int tid) {
  const int r = tid >> 3, ch = tid & 7;
  t.k0 = *(const u32x4*)(src + (size_t)r * stride + ch * 8);
  t.k1 = *(const u32x4*)(src + (size_t)(r + 32) * stride + ch * 8);
}
DI void kv_load_v(KVr& t, const u16* __restrict__ src, int stride, int tid) {
  const int d = tid >> 3, ch = tid & 7;
  t.v0 = *(const u32x4*)(src + (size_t)d * stride + ch * 8);
  t.v1 = *(const u32x4*)(src + (size_t)(d + 32) * stride + ch * 8);
}
DI void kv_store_k(const KVr& t, char* sK, int tid) {
  const int r = tid >> 3, ch = tid & 7;
  char* pk = sK + r * 128 + ((ch ^ (r & 7)) << 4);
  *(u32x4*)(pk) = t.k0;
  *(u32x4*)(pk + 4096) = t.k1;
}
DI void kv_store_v(const KVr& t, char* sV, int tid) {
  const int d = tid >> 3, ch = tid & 7;
  uint2* d0 = (uint2*)(sV + d * 136 + ch * 16);
  d0[0] = make_uint2(t.v0[0], t.v0[1]);
  d0[1] = make_uint2(t.v0[2], t.v0[3]);
  uint2* d1 = (uint2*)(sV + (d + 32) * 136 + ch * 16);
  d1[0] = make_uint2(t.v1[0], t.v1[1]);
  d1[1] = make_uint2(t.v1[2], t.v1[3]);
}
DI int next_set_bit(const unsigned* uni, int from) {
  int res = 1000;
#pragma unroll
  for (int wd = 3; wd >= 0; --wd) {
    unsigned mw = uni[wd];
    const int lo = from - wd * 32;
    if (lo >= 32) mw = 0u;
    else if (lo > 0) mw &= (~0u) << lo;
    if (mw) res = wd * 32 + __ffs(mw) - 1;
  }
  return __builtin_amdgcn_readfirstlane(res);
}

template <int MODE>
DI void half_step(const char* sK, const char* sV, int half, int lr, int lg, const bf16x8 (&qf)[2][2], const float (&slope)[2],
                  float (&m)[2], float (&lsum)[2], f32x4 (&o)[2][4], const float (&posf)[2][4], const bool (&valid)[2][4],
                  float (&psum)[2][4]) {
  bf16x8 kf[2][2];
#pragma unroll
  for (int kt2 = 0; kt2 < 2; ++kt2) {
    const int r = half * 32 + kt2 * 16 + lr;
    kf[kt2][0] = *(const bf16x8*)(sK + r * 128 + (((lg) ^ (r & 7)) << 4));
    kf[kt2][1] = *(const bf16x8*)(sK + r * 128 + (((4 + lg) ^ (r & 7)) << 4));
  }
  if (MODE == 1) {
#pragma unroll
    for (int a = 0; a < 2; ++a)
#pragma unroll
      for (int j = 0; j < 4; ++j) psum[a][j] = 0.f;
  }
  bf16x8 pf[2];
#pragma unroll
  for (int h = 0; h < 2; ++h) {
    f32x4 s[2];
#pragma unroll
    for (int kt2 = 0; kt2 < 2; ++kt2) {
      f32x4 z = f32x4{0.f, 0.f, 0.f, 0.f};
      z = MFMA16(kf[kt2][0], qf[h][0], z);
      z = MFMA16(kf[kt2][1], qf[h][1], z);
      s[kt2] = z;
    }
    float mx = NEGB;
#pragma unroll
    for (int kt2 = 0; kt2 < 2; ++kt2)
#pragma unroll
      for (int j = 0; j < 4; ++j) {
        float v = valid[kt2][j] ? (s[kt2][j] + slope[h] * posf[kt2][j]) : NEGB;
        s[kt2][j] = v;
        mx = fmaxf(mx, v);
      }
    if (MODE != 1) {
      mx = fmaxf(mx, __shfl_xor(mx, 16));
      mx = fmaxf(mx, __shfl_xor(mx, 32));
      const float mn = fmaxf(m[h], mx);
      const float alpha = ex2(m[h] - mn);
      m[h] = mn;
      float ps = 0.f;
#pragma unroll
      for (int kt2 = 0; kt2 < 2; ++kt2)
#pragma unroll
        for (int j = 0; j < 4; ++j) {
          float pv = ex2(s[kt2][j] - mn);
          s[kt2][j] = pv;
          ps += pv;
        }
      lsum[h] = lsum[h] * alpha + ps;
      if (MODE == 2) {
#pragma unroll
        for (int dt = 0; dt < 4; ++dt) o[h][dt] *= alpha;
      }
    } else {
#pragma unroll
      for (int kt2 = 0; kt2 < 2; ++kt2)
#pragma unroll
        for (int j = 0; j < 4; ++j) {
          float pv = ex2(s[kt2][j] - m[h]) * lsum[h];
          s[kt2][j] = pv;
          psum[kt2][j] += pv;
        }
    }
    if (MODE != 0) {
      uint4 pk = make_uint4(pack2(s[0][0], s[0][1]), pack2(s[0][2], s[0][3]), pack2(s[1][0], s[1][1]), pack2(s[1][2], s[1][3]));
      pf[h] = __builtin_bit_cast(bf16x8, pk);
    }
  }
  if (MODE != 0) {
#pragma unroll
    for (int dt = 0; dt < 4; ++dt) {
      const char* base = sV + (dt * 16 + lr) * 136 + half * 64 + lg * 8;
      uint2 a = *(const uint2*)(base);
      uint2 c = *(const uint2*)(base + 32);
      bf16x8 vf = __builtin_bit_cast(bf16x8, make_uint4(a.x, a.y, c.x, c.y));
#pragma unroll
      for (int h = 0; h < 2; ++h) o[h][dt] = MFMA16(vf, pf[h], o[h][dt]);
    }
  }
}

DI void attn_item(const Params& p, int l, int b, int kvh, int qh, char* smem) {
  char* sK = smem + SM_K;
  char* sV = smem + SM_V;
  float* sImp = (float*)(smem + SM_IMP);
  unsigned* sSel = (unsigned*)(smem + SM_SEL);
  unsigned* sUni = (unsigned*)(smem + SM_UNI);
  const char* wsA = p.ws + OFF_A;
  const u16* Q = (const u16*)(wsA + A_Q);
  const u16* KS = (const u16*)(wsA + A_KS);
  const u16* VST = (const u16*)(wsA + A_VST);
  const u16* KW = (const u16*)(wsA + A_KW);
  const u16* VWT = (const u16*)(wsA + A_VWT);
  const float* G = (const float*)(wsA + A_G);
  const u16* KCMP = (const u16*)(p.ws + OFF_KCMP);
  const u16* VCMPT = (const u16*)(p.ws + OFF_VCMPT);
  u16* OM = (u16*)(p.ws + OFF_H);

  const int tid = otid(), lane = tid & 63, w = tid >> 6, lr = lane & 15, lg = lane >> 4;
  const int hp = w >> 1;
  const int t0 = qh * 32;
  const int cur = qh >> 1;
  const int tql = 16 * (w & 1) + lr;
  const size_t tokq = (size_t)b * S + t0 + tql;
  const int bk = b * 2 + kvh;
  const int hg0 = kvh * 4 + hp * 2;

  bf16x8 qf[2][2];
  float slope[2];
#pragma unroll
  for (int h = 0; h < 2; ++h) {
    const u16* qp = Q + tokq * 512 + (hg0 + h) * 64 + lg * 8;
    qf[h][0] = *(const bf16x8*)qp;
    qf[h][1] = *(const bf16x8*)(qp + 32);
    slope[h] = ex2(-(float)(hg0 + h + 1)) * LOG2E;
  }
  float m[2], ls[2];
  f32x4 o[2][4], otot[2][4];
  float psum[2][4];
#pragma unroll
  for (int h = 0; h < 2; ++h) {
    m[h] = MINIT;
    ls[h] = 0.f;
#pragma unroll
    for (int dt = 0; dt < 4; ++dt) o[h][dt] = f32x4{0.f, 0.f, 0.f, 0.f};
  }

  const int amax = qh >> 5;
  const u16* kc_base = KCMP + (size_t)bk * 512 * 64;
  const u16* vc_base = VCMPT + (size_t)bk * 64 * 512;
  KVr tl;
  kv_load_k(tl, kc_base, 64, tid);
  for (int a = 0; a <= amax; ++a) {
    __syncthreads();
    kv_store_k(tl, sK, tid);
    __syncthreads();
    if (a < amax) kv_load_k(tl, kc_base + (size_t)(a + 1) * 64 * 64, 64, tid);
    else { kv_load_k(tl, kc_base, 64, tid); kv_load_v(tl, vc_base, 512, tid); }
#pragma unroll
    for (int half = 0; half < 2; ++half) {
      float posf[2][4];
      bool valid[2][4];
#pragma unroll
      for (int kt2 = 0; kt2 < 2; ++kt2)
#pragma unroll
        for (int j = 0; j < 4; ++j) {
          int n = a * 64 + half * 32 + kt2 * 16 + lg * 4 + j;
          int rel = 16 * n + 31 - t0;
          posf[kt2][j] = (float)rel;
          valid[kt2][j] = rel <= tql;
        }
      half_step<0>(sK, sV, half, lr, lg, qf, slope, m, ls, o, posf, valid, psum);
    }
  }
#pragma unroll
  for (int h = 0; h < 2; ++h) {
    float x = ls[h];
    x += __shfl_xor(x, 16);
    x += __shfl_xor(x, 32);
    ls[h] = x > 0.f ? 1.f / x : 0.f;
  }
  float carry = 0.f;
  float* myImp = sImp + hp * (32 * 132);
  for (int a = 0; a <= amax; ++a) {
    __syncthreads();
    kv_store_k(tl, sK, tid);
    kv_store_v(tl, sV, tid);
    __syncthreads();
    if (a < amax) {
      kv_load_k(tl, kc_base + (size_t)(a + 1) * 64 * 64, 64, tid);
      kv_load_v(tl, vc_base + (a + 1) * 64, 512, tid);
    }
#pragma unroll
    for (int half = 0; half < 2; ++half) {
      float posf[2][4];
      bool valid[2][4];
#pragma unroll
      for (int kt2 = 0; kt2 < 2; ++kt2)
#pragma unroll
        for (int j = 0; j < 4; ++j) {
          int n = a * 64 + half * 32 + kt2 * 16 + lg * 4 + j;
          int rel = 16 * n + 31 - t0;
          posf[kt2][j] = (float)rel;
          valid[kt2][j] = rel <= tql;
        }
      half_step<1>(sK, sV, half, lr, lg, qf, slope, m, ls, o, posf, valid, psum);
      float prev = carry;
#pragma unroll
      for (int kt2 = 0; kt2 < 2; ++kt2) {
        float sum4 = psum[kt2][0] + psum[kt2][1] + psum[kt2][2] + psum[kt2][3];
        float p3 = psum[kt2][3];
        float up = __shfl(p3, (lane + 48) & 63);
        float wrap = __shfl(prev, (lane + 48) & 63);
        float spill = lg > 0 ? up : wrap;
        int j = a * 16 + half * 8 + kt2 * 4 + lg;
        myImp[tql * 132 + j] = sum4 + spill;
        prev = p3;
      }
      carry = prev;
    }
  }
#pragma unroll
  for (int h = 0; h < 2; ++h) {
    const float g0 = G[tokq * 24 + (hg0 + h) * 3 + 0];
#pragma unroll
    for (int dt = 0; dt < 4; ++dt) {
      otot[h][dt] = o[h][dt] * g0;
      o[h][dt] = f32x4{0.f, 0.f, 0.f, 0.f};
    }
    m[h] = MINIT;
    ls[h] = 0.f;
  }
  if (tid < 4) sUni[tid] = 0u;
  __syncthreads();
  if (tid < 128) {
    const int q = tid >> 2, sub = tid & 3;
    unsigned mk[4] = {0u, 0u, 0u, 0u};
    if (cur < 16) {
      mk[0] = (1u << (cur + 1)) - 1u;
    } else {
      float v[32];
#pragma unroll
      for (int i = 0; i < 32; ++i) {
        int j = sub + 4 * i;
        v[i] = (j >= 1 && j <= cur - 2) ? (sImp[q * 132 + j] + sImp[32 * 132 + q * 132 + j]) : -1.f;
      }
      for (int round = 0; round < 13; ++round) {
        float bv = v[0];
        int bi = 0;
#pragma unroll
        for (int i = 1; i < 32; ++i)
          if (v[i] > bv) { bv = v[i]; bi = i; }
        int bj = sub + 4 * bi;
#pragma unroll
        for (int off = 1; off <= 2; off <<= 1) {
          float ov = __shfl_xor(bv, off);
          int oj = __shfl_xor(bj, off);
          if (ov > bv || (ov == bv && oj < bj)) { bv = ov; bj = oj; }
        }
#pragma unroll
        for (int i = 0; i < 32; ++i)
          if (sub + 4 * i == bj) v[i] = -2.f;
#pragma unroll
        for (int wd = 0; wd < 4; ++wd) mk[wd] |= ((bj >> 5) == wd) ? (1u << (bj & 31)) : 0u;
      }
      const int f1 = cur, f2 = cur - 1;
      mk[0] |= 1u;
#pragma unroll
      for (int wd = 0; wd < 4; ++wd) {
        mk[wd] |= ((f1 >> 5) == wd) ? (1u << (f1 & 31)) : 0u;
        mk[wd] |= ((f2 >> 5) == wd) ? (1u << (f2 & 31)) : 0u;
      }
    }
    if (sub == 0) {
#pragma unroll
      for (int wd = 0; wd < 4; ++wd) {
        sSel[q * 4 + wd] = mk[wd];
        atomicOr(&sUni[wd], mk[wd]);
      }
    }
  }
  __syncthreads();
  const int jw0 = (cur >= 8 ? cur - 8 : 0);
  {
    int j = next_set_bit(sUni, 0);
    kv_load_k(tl, KS + ((size_t)b * S + j * 64) * 128 + kvh * 64, 128, tid);
    kv_load_v(tl, VST + (size_t)bk * 64 * S + j * 64, S, tid);
    while (j <= cur) {
      __syncthreads();
      kv_store_k(tl, sK, tid);
      kv_store_v(tl, sV, tid);
      __syncthreads();
      const int jn = next_set_bit(sUni, j + 1);
      if (jn <= cur) {
        kv_load_k(tl, KS + ((size_t)b * S + jn * 64) * 128 + kvh * 64, 128, tid);
        kv_load_v(tl, VST + (size_t)bk * 64 * S + jn * 64, S, tid);
      } else {
        kv_load_k(tl, KW + ((size_t)b * S + jw0 * 64) * 128 + kvh * 64, 128, tid);
        kv_load_v(tl, VWT + (size_t)bk * 64 * S + jw0 * 64, S, tid);
      }
      const bool selbit = (sSel[tql * 4 + (j >> 5)] >> (j & 31)) & 1u;
#pragma unroll
      for (int half = 0; half < 2; ++half) {
        float posf[2][4];
        bool valid[2][4];
#pragma unroll
        for (int kt2 = 0; kt2 < 2; ++kt2)
#pragma unroll
          for (int jj = 0; jj < 4; ++jj) {
            int rel = j * 64 - t0 + half * 32 + kt2 * 16 + lg * 4 + jj;
            posf[kt2][jj] = (float)rel;
            valid[kt2][jj] = selbit && (rel <= tql);
          }
        half_step<2>(sK, sV, half, lr, lg, qf, slope, m, ls, o, posf, valid, psum);
      }
      j = jn;
    }
  }
#pragma unroll
  for (int h = 0; h < 2; ++h) {
    float x = ls[h];
    x += __shfl_xor(x, 16);
    x += __shfl_xor(x, 32);
    const float f = (x > 0.f ? 1.f / x : 0.f) * G[tokq * 24 + (hg0 + h) * 3 + 1];
#pragma unroll
    for (int dt = 0; dt < 4; ++dt) {
      otot[h][dt] += o[h][dt] * f;
      o[h][dt] = f32x4{0.f, 0.f, 0.f, 0.f};
    }
    m[h] = MINIT;
    ls[h] = 0.f;
  }
  for (int j = jw0; j <= cur; ++j) {
    __syncthreads();
    kv_store_k(tl, sK, tid);
    kv_store_v(tl, sV, tid);
    __syncthreads();
    if (j < cur) {
      kv_load_k(tl, KW + ((size_t)b * S + (j + 1) * 64) * 128 + kvh * 64, 128, tid);
      kv_load_v(tl, VWT + (size_t)bk * 64 * S + (j + 1) * 64, S, tid);
    }
#pragma unroll
    for (int half = 0; half < 2; ++half) {
      float posf[2][4];
      bool valid[2][4];
#pragma unroll
      for (int kt2 = 0; kt2 < 2; ++kt2)
#pragma unroll
        for (int jj = 0; jj < 4; ++jj) {
          int rel = j * 64 - t0 + half * 32 + kt2 * 16 + lg * 4 + jj;
          posf[kt2][jj] = (float)rel;
          valid[kt2][jj] = (rel <= tql) && (tql - rel < 512);
        }
      half_step<2>(sK, sV, half, lr, lg, qf, slope, m, ls, o, posf, valid, psum);
    }
  }
#pragma unroll
  for (int h = 0; h < 2; ++h) {
    float x = ls[h];
    x += __shfl_xor(x, 16);
    x += __shfl_xor(x, 32);
    const float f = (x > 0.f ? 1.f / x : 0.f) * G[tokq * 24 + (hg0 + h) * 3 + 2];
    float ss = 0.f;
#pragma unroll
    for (int dt = 0; dt < 4; ++dt) {
      otot[h][dt] += o[h][dt] * f;
#pragma unroll
      for (int jj = 0; jj < 4; ++jj) ss += otot[h][dt][jj] * otot[h][dt][jj];
    }
    ss += __shfl_xor(ss, 16);
    ss += __shfl_xor(ss, 32);
    const float r = rsqrtf(ss * (1.f / 64.f) + EPS);
#pragma unroll
    for (int dt = 0; dt < 4; ++dt) {
      const int d = dt * 16 + lg * 4;
      const float4 gg = *(const float4*)(p.out_g + l * 1024 + (hg0 + h) * 64 + d);
      uint2 st;
      st.x = pack2(otot[h][dt][0] * r * gg.x, otot[h][dt][1] * r * gg.y);
      st.y = pack2(otot[h][dt][2] * r * gg.z, otot[h][dt][3] * r * gg.w);
      *(uint2*)(OM + tokq * 1024 + (hg0 + h) * 64 + d) = st;
    }
  }
}

DI void gsync(cg::grid_group& g) {
  asm volatile("s_waitcnt vmcnt(0)" ::: "memory");
  g.sync();
  __builtin_amdgcn_fence(__ATOMIC_ACQUIRE, "agent");
  asm volatile("s_waitcnt vmcnt(0)" ::: "memory");
}


#ifndef STOP_AFTER
#define STOP_AFTER 0
#endif
#define DUMP_BF16_AND_STOP(ptr)                                                                   \
  {                                                                                               \
    const u16* s_ = (const u16*)(ptr);                                                            \
    for (size_t i = (size_t)bid * 256 + threadIdx.x; i < (size_t)TOK * 1024; i += (size_t)nb * 256) \
      p.out[i] = bf2f(s_[i]);                                                                     \
    return;                                                                                       \
  }
#define DUMP_F32_AND_STOP(ptr)                                                                    \
  {                                                                                               \
    const float* s_ = (const float*)(ptr);                                                        \
    for (size_t i = (size_t)bid * 256 + threadIdx.x; i < (size_t)TOK * 1024; i += (size_t)nb * 256) \
      p.out[i] = s_[i];                                                                           \
    return;                                                                                       \
  }
__global__ void __launch_bounds__(256, 2) mega(Params p) {
  extern __shared__ __attribute__((aligned(16))) char smem[];
  cg::grid_group grid = cg::this_grid();
  char* ws = p.ws;
  const int nb = gridDim.x, bid = blockIdx.x;
  float* X1 = (float*)(ws + OFF_X1);
  u16* H = (u16*)(ws + OFF_H);
  char* wsA = ws + OFF_A;
  const float* mod = (const float*)(ws + OFF_MOD);

#ifdef ZERO_WS
  {
    uint4* z = (uint4*)ws;
    const size_t n16 = (OFF_A + A_END) / 16;
    for (size_t i = (size_t)bid * 256 + threadIdx.x; i < n16; i += (size_t)nb * 256) z[i] = make_uint4(0, 0, 0, 0);
    uint4* zo = (uint4*)p.out;
    const size_t m16 = (size_t)TOK * 1024 * 4 / 16;
    for (size_t i = (size_t)bid * 256 + threadIdx.x; i < m16; i += (size_t)nb * 256) zo[i] = make_uint4(0, 0, 0, 0);
  }
  gsync(grid);
#endif
  phase0a(p, smem);
  gsync(grid);
  phase0b(p);
  gsync(grid);
  phase_mod_x(p);
  gsync(grid);

  for (int l = 0; l < 2; ++l) {
    const float* modl = mod + (size_t)l * 8 * 6144;
    const float* xin = (l == 0) ? p.x : p.out;
    {
      u16* Qo = (u16*)(wsA + A_Q);
      u16* KCo = (u16*)(wsA + A_KC);
      u16* VCo = (u16*)(wsA + A_VC);
      u16* KSo = (u16*)(wsA + A_KS);
      u16* VSTo = (u16*)(wsA + A_VST);
      u16* KWo = (u16*)(wsA + A_KW);
      u16* VWTo = (u16*)(wsA + A_VWT);
      float* Go = (float*)(wsA + A_G);
      u16* Uo = (u16*)(wsA + A_U);
      u16* VGTo = (u16*)(wsA + A_VGT);
      const float* vng = p.vn_g + l * 512;
      const float* vnb = p.vn_b + l * 512;
      auto sel1 = [](int tn) { return !(tn == 7 || tn == 9 || (tn >= 14 && tn < 18)); };
      auto epi = [&](bool swp, int tm, int tn, int wm, int wn, int lr, int lg, auto& acc) {
        constexpr int MT = sizeof(acc) / sizeof(acc[0]);
        const int row0 = tm * (32 * MT) + wm * (16 * MT);
        const int b = row0 >> 13;
        const int s0 = row0 & (S - 1);
        if (swp) {
          if (tn == 18) {
            if (wn == 0) {
#pragma unroll
              for (int mi = 0; mi < MT; ++mi)
#pragma unroll
                for (int ni = 0; ni < 2; ++ni) {
                  const int c = ni * 16 + lg * 4;
                  const size_t row = (size_t)row0 + mi * 16 + lr;
                  if (c < 24)
                    *(float4*)(Go + row * 24 + c) =
                        make_float4(sigm(acc[mi][ni][0]), sigm(acc[mi][ni][1]), sigm(acc[mi][ni][2]), sigm(acc[mi][ni][3]));
                }
            }
          } else {
            u16* dst;
            int ld, cb;
            float sc = 1.f;
            bool g = false;
            if (tn < 4) { dst = Qo; ld = 512; cb = tn * 128; sc = QSCALE; }
            else if (tn == 4) { dst = KCo; ld = 128; cb = 0; }
            else if (tn == 5) { dst = VCo; ld = 128; cb = 0; }
            else if (tn == 6) { dst = KSo; ld = 128; cb = 0; }
            else if (tn == 8) { dst = KWo; ld = 128; cb = 0; }
            else { dst = Uo; ld = 512; cb = (tn - 10) * 128; g = true; }
#pragma unroll
            for (int mi = 0; mi < MT; ++mi)
#pragma unroll
              for (int ni = 0; ni < 4; ++ni) {
                const size_t row = (size_t)row0 + mi * 16 + lr;
                float v[4];
#pragma unroll
                for (int j = 0; j < 4; ++j) v[j] = g ? gelu_t(acc[mi][ni][j]) : acc[mi][ni][j] * sc;
                uint2 st;
                st.x = pack2(v[0], v[1]);
                st.y = pack2(v[2], v[3]);
                *(uint2*)(dst + row * ld + cb + wn * 64 + ni * 16 + lg * 4) = st;
              }
          }
        } else if (tn == 7 || tn == 9) {
          u16* dst = (tn == 7) ? VSTo : VWTo;
#pragma unroll
          for (int mi = 0; mi < MT; ++mi)
#pragma unroll
            for (int ni = 0; ni < 4; ++ni) {
              const int d = ni * 16 + lr;
              uint2 st;
              st.x = pack2(acc[mi][ni][0], acc[mi][ni][1]);
              st.y = pack2(acc[mi][ni][2], acc[mi][ni][3]);
              *(uint2*)(dst + ((size_t)(b * 2 + wn) * 64 + d) * S + s0 + mi * 16 + lg * 4) = st;
            }
        } else {
          const int grp = (tn - 14) * 2 + wn;
          float vg[4], vb[4];
#pragma unroll
          for (int ni = 0; ni < 4; ++ni) { vg[ni] = vng[grp * 64 + ni * 16 + lr]; vb[ni] = vnb[grp * 64 + ni * 16 + lr]; }
#pragma unroll
          for (int mi = 0; mi < MT; ++mi) {
            float vv[4][4];
#pragma unroll
            for (int ni = 0; ni < 4; ++ni)
#pragma unroll
              for (int j = 0; j < 4; ++j) vv[ni][j] = gelu_t(acc[mi][ni][j]);
#pragma unroll
            for (int j = 0; j < 4; ++j) {
              float s1 = vv[0][j] + vv[1][j] + vv[2][j] + vv[3][j];
              s1 += __shfl_xor(s1, 1); s1 += __shfl_xor(s1, 2); s1 += __shfl_xor(s1, 4); s1 += __shfl_xor(s1, 8);
              const float mu = s1 * (1.f / 64.f);
              float s2 = 0.f;
#pragma unroll
              for (int ni = 0; ni < 4; ++ni) { float dd = vv[ni][j] - mu; s2 += dd * dd; }
              s2 += __shfl_xor(s2, 1); s2 += __shfl_xor(s2, 2); s2 += __shfl_xor(s2, 4); s2 += __shfl_xor(s2, 8);
              const float rs = rsqrtf(s2 * (1.f / 64.f) + EPS);
#pragma unroll
              for (int ni = 0; ni < 4; ++ni) vv[ni][j] = (vv[ni][j] - mu) * rs * vg[ni] + vb[ni];
            }
#pragma unroll
            for (int ni = 0; ni < 4; ++ni) {
              const int d = ni * 16 + lr;
              uint2 st;
              st.x = pack2(vv[ni][0], vv[ni][1]);
              st.y = pack2(vv[ni][2], vv[ni][3]);
              *(uint2*)(VGTo + ((size_t)(b * 8 + grp) * 64 + d) * S + s0 + mi * 16 + lg * 4) = st;
            }
          }
        }
      };
      gemm_phase<8>(H, 1024, (const u16*)(ws + OFF_WTIN + l * SZ_WTIN), 1024, 256, 19, 1024, bid, nb, smem, sel1, epi);
    }
    gsync(grid);
    if (STOP_AFTER == 1 && l == 0) DUMP_BF16_AND_STOP(wsA)
    if (STOP_AFTER == 11 && l == 0) DUMP_BF16_AND_STOP(wsA + A_KW)
    if (STOP_AFTER == 12 && l == 0) DUMP_BF16_AND_STOP(wsA + A_U)
    {
      const int ng = (nb >= 256) ? 256 : nb;
      const int half = ng / 2;
      for (int which = 0; which < 2; ++which) {
        u16* HC = (u16*)(wsA + A_HC) + (size_t)which * 8192 * 256;
        const float* cb1 = (const float*)(ws + OFF_CB1) + (l * 2 + which) * 256;
        const u16* src_tok = (const u16*)(wsA + (which ? A_VC : A_KC));
        auto selT = [](int) { return true; };
        auto ab = [=](int tm) {
          const int bk = tm >> 2, n0 = (tm & 3) * 128;
          return src_tok + ((size_t)(bk >> 1) * S + 16 * n0) * 128 + (bk & 1) * 64;
        };
        auto epi = [&](bool swp, int tm, int tn, int wm, int wn, int lr, int lg, auto& acc) {
        constexpr int MT = sizeof(acc) / sizeof(acc[0]);
          const int row0 = tm * (32 * MT) + wm * (16 * MT), col0 = tn * 128 + wn * 64;
#pragma unroll
          for (int ni = 0; ni < 4; ++ni) {
            const float4 cb = *(const float4*)(cb1 + col0 + ni * 16 + lg * 4);
#pragma unroll
            for (int mi = 0; mi < MT; ++mi) {
              uint2 st;
              st.x = pack2(gelu_t(acc[mi][ni][0] + cb.x), gelu_t(acc[mi][ni][1] + cb.y));
              st.y = pack2(gelu_t(acc[mi][ni][2] + cb.z), gelu_t(acc[mi][ni][3] + cb.w));
              *(uint2*)(HC + (size_t)(row0 + mi * 16 + lr) * 256 + col0 + ni * 16 + lg * 4) = st;
            }
          }
        };
        const int vb = (bid < ng) ? (which == 0 ? (bid < half ? bid : -1) : (bid >= half ? bid - half : -1)) : -1;
        gemm_phase_g<4>(ab, 2048, 128, (const u16*)(ws + OFF_WTC1 + (l * 2 + which) * SZ_WTC1), 2048, 64, 2, 2048, vb, half, smem,
                     selT, epi);
      }
    }
    gsync(grid);
    {
      for (int which = 0; which < 2; ++which) {
        u16* KCMP = (u16*)(ws + OFF_KCMP);
        u16* VCMPT = (u16*)(ws + OFF_VCMPT);
        auto selW = [which](int) { return which == 0; };
        auto epi = [&](bool swp, int tm, int tn, int wm, int wn, int lr, int lg, auto& acc) {
        constexpr int MT = sizeof(acc) / sizeof(acc[0]);
          if (wn != 0) return;
          const int row0 = tm * (32 * MT) + wm * (16 * MT);
#pragma unroll
          for (int mi = 0; mi < MT; ++mi)
#pragma unroll
            for (int ni = 0; ni < 4; ++ni) {
              uint2 st;
              st.x = pack2(acc[mi][ni][0], acc[mi][ni][1]);
              st.y = pack2(acc[mi][ni][2], acc[mi][ni][3]);
              if (swp) {
                *(uint2*)(KCMP + (size_t)(row0 + mi * 16 + lr) * 64 + ni * 16 + lg * 4) = st;
              } else {
                const int d = ni * 16 + lr;
                const int rb = row0 + mi * 16 + lg * 4;
                *(uint2*)(VCMPT + ((size_t)(rb >> 9) * 64 + d) * 512 + (rb & 511)) = st;
              }
            }
        };
        const int vb = (which == 0) ? bid : (bid + nb - 64) % nb;
        gemm_phase<4>((const u16*)(wsA + A_HC) + (size_t)which * 8192 * 256, 256,
                   (const u16*)(ws + OFF_WTC2 + (l * 2 + which) * SZ_WTC2), 256, 64, 1, 256, vb, nb, smem, selW, epi);
      }
    }
    gsync(grid);
    if (STOP_AFTER == 4 && l == 0) DUMP_BF16_AND_STOP(ws + OFF_KCMP)
    for (int r = 0; r * nb < 4096; ++r) {
      const int pos = (r & 1) ? (nb - 1 - bid) : bid;
      const int idx = r * nb + pos;
      if (idx < 4096) {
        const int qh = 255 - (idx >> 4);
        const int rem = idx & 15;
        attn_item(p, l, rem >> 1, rem & 1, qh, smem);
      }
    }
    for (int it = nb - 1 - bid; it < 4096; it += nb) gmlp_item(p, l, it);
    gsync(grid);
    if (STOP_AFTER == 5 && l == 0) DUMP_BF16_AND_STOP(H)
    if ((STOP_AFTER == 51 || STOP_AFTER == 52) && l == 0) {
      for (size_t i = (size_t)bid * 256 + threadIdx.x; i < (size_t)TOK * 1024; i += (size_t)nb * 256) {
        const int col = (int)(i & 1023);
        const bool keep = (STOP_AFTER == 51) ? (col < 512) : (col >= 512);
        p.out[i] = keep ? bf2f(H[i]) : 0.f;
      }
      return;
    }
    {
      auto selT = [](int) { return true; };
      auto epi = [&](bool swp, int tm, int tn, int wm, int wn, int lr, int lg, auto& acc) {
        constexpr int MT = sizeof(acc) / sizeof(acc[0]);
        const int row0 = tm * (32 * MT) + wm * (16 * MT), col0 = tn * 128 + wn * 64;
        const int b = row0 >> 13;
#pragma unroll
        for (int ni = 0; ni < 4; ++ni) {
          const int col = col0 + ni * 16 + lg * 4;
          const float4 g1 = *(const float4*)(modl + (size_t)b * 6144 + 2048 + col);
#pragma unroll
          for (int mi = 0; mi < MT; ++mi) {
            const size_t row = (size_t)row0 + mi * 16 + lr;
            const float4 xv = *(const float4*)(xin + row * 1024 + col);
            float4 o4;
            o4.x = ALPHA * xv.x + (1.f + g1.x) * acc[mi][ni][0];
            o4.y = ALPHA * xv.y + (1.f + g1.y) * acc[mi][ni][1];
            o4.z = ALPHA * xv.z + (1.f + g1.z) * acc[mi][ni][2];
            o4.w = ALPHA * xv.w + (1.f + g1.w) * acc[mi][ni][3];
            *(float4*)(X1 + row * 1024 + col) = o4;
          }
        }
      };
      auto post = [&](int tm) { ln_block(X1, tm * 128, p.ln1_g + l * 1024, p.ln1_b + l * 1024, modl, 3072, 4096, H); };
      gemm_rowblock_phase(H, 1024, (const u16*)(ws + OFF_WTO + l * SZ_WTO), 1024, 512, 8, 1024, bid, nb, smem, epi, post);
    }
    gsync(grid);
    if (STOP_AFTER == 7 && l == 0) DUMP_F32_AND_STOP(X1)
    {
      u16* HH = (u16*)(wsA);
      auto selT = [](int) { return true; };
      auto epi = [&](bool swp, int tm, int tn, int wm, int wn, int lr, int lg, auto& acc) {
        constexpr int MT = sizeof(acc) / sizeof(acc[0]);
        const int row0 = tm * (32 * MT) + wm * (16 * MT);
        const int cb = tn * 64 + wn * 32;
#pragma unroll
        for (int mi = 0; mi < MT; ++mi)
#pragma unroll
          for (int ni = 0; ni < 2; ++ni) {
            const size_t row = (size_t)row0 + mi * 16 + lr;
            float v[4];
#pragma unroll
            for (int j = 0; j < 4; ++j) {
              const float a = acc[mi][ni][j], bb = acc[mi][ni + 2][j];
              v[j] = a * sigm(a) * bb;
            }
            uint2 st;
            st.x = pack2(v[0], v[1]);
            st.y = pack2(v[2], v[3]);
            *(uint2*)(HH + row * 2816 + cb + ni * 16 + lg * 4) = st;
          }
      };
      gemm_phase<8>(H, 1024, (const u16*)(ws + OFF_WT13 + l * SZ_WT13), 1024, 256, 44, 1024, bid, nb, smem, selT, epi);
    }
    gsync(grid);
    if (STOP_AFTER == 8 && l == 0) DUMP_BF16_AND_STOP(wsA)
    {
      const u16* HH = (const u16*)(wsA);
      float* outp = p.out;
      auto selT = [](int) { return true; };
      auto epi = [&](bool swp, int tm, int tn, int wm, int wn, int lr, int lg, auto& acc) {
        constexpr int MT = sizeof(acc) / sizeof(acc[0]);
        const int row0 = tm * (32 * MT) + wm * (16 * MT), col0 = tn * 128 + wn * 64;
        const int b = row0 >> 13;
#pragma unroll
        for (int ni = 0; ni < 4; ++ni) {
          const int col = col0 + ni * 16 + lg * 4;
          const float4 g2 = *(const float4*)(modl + (size_t)b * 6144 + 5120 + col);
#pragma unroll
          for (int mi = 0; mi < MT; ++mi) {
            const size_t row = (size_t)row0 + mi * 16 + lr;
            const float4 xv = *(const float4*)(X1 + row * 1024 + col);
            float4 o4;
            o4.x = ALPHA * xv.x + (1.f + g2.x) * acc[mi][ni][0];
            o4.y = ALPHA * xv.y + (1.f + g2.y) * acc[mi][ni][1];
            o4.z = ALPHA * xv.z + (1.f + g2.z) * acc[mi][ni][2];
            o4.w = ALPHA * xv.w + (1.f + g2.w) * acc[mi][ni][3];
            *(float4*)(outp + row * 1024 + col) = o4;
          }
        }
      };
      auto post = [&](int tm) {
        if (l == 0) ln_block(outp, tm * 128, p.ln2_g, p.ln2_b, mod + (size_t)8 * 6144, 0, 1024, H);
        else ln_block(outp, tm * 128, p.ln2_g + 1024, p.ln2_b + 1024, nullptr, 0, 0, nullptr);
      };
      gemm_rowblock_phase(HH, 2816, (const u16*)(ws + OFF_WT2 + l * SZ_WT2), 2816, 512, 8, 2816, bid, nb, smem, epi, post);
    }
    if (l == 0) gsync(grid);
  }
}

extern "C" void kernel_launch(void* const* d_in, const int* in_sizes, int n_in, void* d_out, int out_size, void* d_ws,
                              size_t ws_size, hipStream_t stream) {
  static int grid_blocks = 0;
  if (!grid_blocks) {
    int dev = 0, cus = 0, per_cu = 0;
    (void)hipGetDevice(&dev);
    (void)hipDeviceGetAttribute(&cus, hipDeviceAttributeMultiprocessorCount, dev);
    (void)hipFuncSetAttribute((const void*)mega, hipFuncAttributeMaxDynamicSharedMemorySize, LDS_BYTES);
    (void)hipOccupancyMaxActiveBlocksPerMultiprocessor(&per_cu, mega, 256, LDS_BYTES);
    if (per_cu > 2) per_cu = 2;
    if (per_cu < 1) per_cu = 1;
    grid_blocks = cus * per_cu;
  }
  Params p{};
  const float* const* in = (const float* const*)d_in;
  p.x = in[0]; p.c = in[1]; p.w_ada = in[2]; p.b_ada = in[3]; p.w_in = in[4]; p.cmp_pos = in[5]; p.cmp_w1 = in[6];
  p.cmp_w2 = in[7]; p.vn_g = in[8]; p.vn_b = in[9]; p.w_s = in[10]; p.b_s = in[11]; p.out_g = in[12]; p.w_o = in[13];
  p.ln1_g = in[14]; p.ln1_b = in[15]; p.w1 = in[16]; p.w3 = in[17]; p.w2 = in[18]; p.ln2_g = in[19]; p.ln2_b = in[20];
  p.out = (float*)d_out;
  p.ws = (char*)d_ws;
  void* args[] = {&p};
  hipError_t e = hipLaunchCooperativeKernel((void*)mega, dim3(grid_blocks), dim3(256), args, LDS_BYTES, stream);
  if (e != hipSuccess) fprintf(stderr, "cooperative launch failed: %s (grid %d)\n", hipGetErrorString(e), grid_blocks);
}
```

```cpp
#define STOP_AFTER 0
#include <hip/hip_runtime.h>
#include <hip/hip_cooperative_groups.h>
#include <cstdio>
namespace cg = cooperative_groups;

typedef unsigned short u16;
using bf16x8 = __attribute__((ext_vector_type(8))) short;
using f32x4 = __attribute__((ext_vector_type(4))) float;
using u32x4 = __attribute__((ext_vector_type(4))) unsigned;
#define DI __device__ __forceinline__
#define MFMA16(a, b, c) __builtin_amdgcn_mfma_f32_16x16x32_bf16((a), (b), (c), 0, 0, 0)

constexpr int S = 8192, TOK = 65536;
constexpr int INW = 2328, INP = 2432;
constexpr float ALPHA = 1.41421356237f;
constexpr float LOG2E = 1.4426950408889634f;
constexpr float QSCALE = 0.125f * LOG2E;
constexpr float NEGB = -1e30f, MINIT = -30000.f;
constexpr float EPS = 1e-5f;

constexpr size_t SZ_WTIN = (size_t)INP * 1024 * 2;
constexpr size_t SZ_WTO = (size_t)1024 * 1024 * 2;
constexpr size_t SZ_WT13 = (size_t)5632 * 1024 * 2;
constexpr size_t SZ_WT2 = (size_t)1024 * 2816 * 2;
constexpr size_t SZ_WTC1 = (size_t)256 * 2048 * 2;
constexpr size_t SZ_WTC2 = (size_t)128 * 256 * 2;
constexpr size_t OFF_WTIN = 0;
constexpr size_t OFF_WTO = OFF_WTIN + 2 * SZ_WTIN;
constexpr size_t OFF_WT13 = OFF_WTO + 2 * SZ_WTO;
constexpr size_t OFF_WT2 = OFF_WT13 + 2 * SZ_WT13;
constexpr size_t OFF_WTC1 = OFF_WT2 + 2 * SZ_WT2;
constexpr size_t OFF_WTC2 = OFF_WTC1 + 4 * SZ_WTC1;
constexpr size_t OFF_MODP = OFF_WTC2 + 4 * SZ_WTC2;
constexpr size_t SZ_MOD = (size_t)2 * 8 * 6144 * 4;
constexpr size_t OFF_MOD = OFF_MODP + 16 * SZ_MOD;
constexpr size_t SZ_CMP = (size_t)8 * 2 * 512 * 64 * 2;
constexpr size_t OFF_CB1P = OFF_MOD + SZ_MOD;
constexpr size_t OFF_CB1 = OFF_CB1P + 16 * 4 * 256 * 4;
constexpr size_t OFF_KCMP = OFF_CB1 + 4 * 256 * 4;
constexpr size_t OFF_VCMPT = OFF_KCMP + SZ_CMP;
constexpr size_t OFF_X1 = OFF_VCMPT + SZ_CMP;
constexpr size_t OFF_H = OFF_X1 + (size_t)TOK * 1024 * 4;
constexpr size_t OFF_A = OFF_H + (size_t)TOK * 1024 * 2;
constexpr size_t SZ_KV = (size_t)TOK * 128 * 2;
constexpr size_t A_Q = 0;
constexpr size_t A_KC = A_Q + (size_t)TOK * 512 * 2;
constexpr size_t A_VC = A_KC + SZ_KV;
constexpr size_t A_KS = A_VC + SZ_KV;
constexpr size_t A_VST = A_KS + SZ_KV;
constexpr size_t A_KW = A_VST + SZ_KV;
constexpr size_t A_VWT = A_KW + SZ_KV;
constexpr size_t A_G = A_VWT + SZ_KV;
constexpr size_t A_U = A_G + (size_t)TOK * 24 * 4;
constexpr size_t A_VGT = A_U + (size_t)TOK * 512 * 2;
constexpr size_t A_AC = A_VGT + (size_t)TOK * 512 * 2;
constexpr size_t A_HC = A_AC + (size_t)2 * 8192 * 2048 * 2;
constexpr size_t A_END = A_HC + (size_t)2 * 8192 * 256 * 2;

struct Params {
  const float *x, *c, *w_ada, *b_ada, *w_in, *cmp_pos, *cmp_w1, *cmp_w2, *vn_g, *vn_b, *w_s, *b_s, *out_g, *w_o,
      *ln1_g, *ln1_b, *w1, *w3, *w2, *ln2_g, *ln2_b;
  float* out;
  char* ws;
};

DI u16 f2bf(float x) { unsigned u = __float_as_uint(x); u += 0x7fffu + ((u >> 16) & 1u); return (u16)(u >> 16); }
DI float bf2f(u16 h) { return __uint_as_float(((unsigned)h) << 16); }
DI unsigned pack2(float a, float b) { return (unsigned)f2bf(a) | ((unsigned)f2bf(b) << 16); }
DI float gelu_t(float x) { float u = 1.5957691216f * (x + 0.044715f * x * x * x); return x / (1.f + __expf(-u)); }
DI float sigm(float x) { return 1.f / (1.f + __expf(-x)); }
DI float ex2(float x) { return __builtin_amdgcn_exp2f(x); }
DI int otid() { int t = threadIdx.x; asm volatile("" : "+v"(t)); return t; }

template <int MODE> DI int map_row(int n) {
  if (MODE == 1) return n < 1280 ? n : (n < 1304 ? n + 1024 : n - 24);
  if (MODE == 2) return (n >> 5) * 64 + (n & 31);
  if (MODE == 3) return (n >> 5) * 64 + 32 + (n & 31);
  return n;
}

template <int MODE>
DI void conv_tile(const float* __restrict__ W, int K, int N, u16* __restrict__ Wt, int ldk, int tile, float* tl) {
  const int tiles_n = (N + 63) / 64;
  const int tk = tile / tiles_n, tn = tile % tiles_n;
  const int k0 = tk * 64, n0 = tn * 64;
  const int tid = otid();
#pragma unroll
  for (int i = 0; i < 16; ++i) {
    int idx = tid + 256 * i;
    int r = idx >> 6, c = idx & 63;
    int n = n0 + c;
    tl[r * 65 + c] = (n < N) ? W[(long)(k0 + r) * N + n] : 0.f;
  }
  __syncthreads();
  const int nl = tid >> 2, kc = tid & 3;
  const int n = n0 + nl;
  if (n < N) {
    const int row = map_row<MODE>(n);
    unsigned pk[8];
#pragma unroll
    for (int i = 0; i < 8; ++i) pk[i] = pack2(tl[(kc * 16 + 2 * i) * 65 + nl], tl[(kc * 16 + 2 * i + 1) * 65 + nl]);
    uint4* dst = (uint4*)(Wt + (long)row * ldk + k0 + kc * 16);
    dst[0] = make_uint4(pk[0], pk[1], pk[2], pk[3]);
    dst[1] = make_uint4(pk[4], pk[5], pk[6], pk[7]);
  }
  __syncthreads();
}

DI void phase0a(const Params& p, char* smem) {
  char* ws = p.ws;
  const int tid = threadIdx.x;
  constexpr int PER_LAYER = 592 + 256 + 704 * 3 + 128 * 2 + 4 * 2;
  constexpr int NCONV = 2 * PER_LAYER;
  constexpr int NTOT = NCONV + 768 + 2 + 64;
  for (int it = blockIdx.x; it < NTOT; it += gridDim.x) {
    if (it < NCONV) {
      const int l = it / PER_LAYER;
      const int li = it % PER_LAYER;
      int base = 0;
#define SEG(MODE, SRC, DST, K_, N_, LDK)                                                   \
  {                                                                                        \
    const int nt_ = ((K_) / 64) * (((N_) + 63) / 64);                                      \
    if (li >= base && li < base + nt_) conv_tile<MODE>(SRC, K_, N_, DST, LDK, li - base, (float*)smem); \
    base += nt_;                                                                           \
  }
      SEG(1, p.w_in + (size_t)l * 1024 * INW, (u16*)(ws + OFF_WTIN + l * SZ_WTIN), 1024, INW, 1024)
      SEG(0, p.w_o + (size_t)l * 1024 * 1024, (u16*)(ws + OFF_WTO + l * SZ_WTO), 1024, 1024, 1024)
      SEG(2, p.w1 + (size_t)l * 1024 * 2816, (u16*)(ws + OFF_WT13 + l * SZ_WT13), 1024, 2816, 1024)
      SEG(3, p.w3 + (size_t)l * 1024 * 2816, (u16*)(ws + OFF_WT13 + l * SZ_WT13), 1024, 2816, 1024)
      SEG(0, p.w2 + (size_t)l * 2816 * 1024, (u16*)(ws + OFF_WT2 + l * SZ_WT2), 2816, 1024, 2816)
      SEG(0, p.cmp_w1 + (size_t)(l * 2 + 0) * 2048 * 256, (u16*)(ws + OFF_WTC1 + (l * 2 + 0) * SZ_WTC1), 2048, 256, 2048)
      SEG(0, p.cmp_w1 + (size_t)(l * 2 + 1) * 2048 * 256, (u16*)(ws + OFF_WTC1 + (l * 2 + 1) * SZ_WTC1), 2048, 256, 2048)
      SEG(0, p.cmp_w2 + (size_t)(l * 2 + 0) * 256 * 64, (u16*)(ws + OFF_WTC2 + (l * 2 + 0) * SZ_WTC2), 256, 64, 256)
      SEG(0, p.cmp_w2 + (size_t)(l * 2 + 1) * 256 * 64, (u16*)(ws + OFF_WTC2 + (l * 2 + 1) * SZ_WTC2), 256, 64, 256)
#undef SEG
    } else if (it < NCONV + 768) {
      const int idx = it - NCONV;
      const int l = idx / 384, r = idx % 384, nb = r / 16, kc = r % 16;
      float* cs = (float*)smem;
      for (int i = tid; i < 512; i += 256) {
        int b = i >> 6, k = i & 63;
        float cv = p.c[b * 1024 + kc * 64 + k];
        cs[i] = cv * sigm(cv);
      }
      __syncthreads();
      const int n = nb * 256 + tid;
      float acc[8];
#pragma unroll
      for (int b = 0; b < 8; ++b) acc[b] = 0.f;
      const float* wp = p.w_ada + ((size_t)l * 1024 + kc * 64) * 6144 + n;
#pragma unroll 8
      for (int k = 0; k < 64; ++k) {
        float wv = wp[(size_t)k * 6144];
#pragma unroll
        for (int b = 0; b < 8; ++b) acc[b] += cs[b * 64 + k] * wv;
      }
      float* modp = (float*)(ws + OFF_MODP);
#pragma unroll
      for (int b = 0; b < 8; ++b) modp[(size_t)((kc * 2 + l) * 8 + b) * 6144 + n] = acc[b];
      __syncthreads();
    } else if (it < NCONV + 768 + 2) {
      const int l = it - NCONV - 768;
      uint4* dst = (uint4*)(ws + OFF_WTIN + l * SZ_WTIN + (size_t)INW * 1024 * 2);
      const int n16 = (INP - INW) * 1024 * 2 / 16;
      for (int i = tid; i < n16; i += 256) dst[i] = make_uint4(0, 0, 0, 0);
    } else {
      const int idx = it - NCONV - 768 - 2;
      const int lw = idx >> 4, kc = idx & 15;
      const float* pos = p.cmp_pos + (size_t)lw * 2048 + kc * 128;
      const float* w1p = p.cmp_w1 + ((size_t)lw * 2048 + kc * 128) * 256 + tid;
      float a = 0.f;
#pragma unroll 8
      for (int k = 0; k < 128; ++k) a += pos[k] * w1p[(size_t)k * 256];
      ((float*)(ws + OFF_CB1P))[(kc * 4 + lw) * 256 + tid] = a;
    }
  }
}

DI void phase0b(const Params& p) {
  const float* modp = (const float*)(p.ws + OFF_MODP);
  float* mod = (float*)(p.ws + OFF_MOD);
  const int n = 2 * 8 * 6144;
  for (int i = blockIdx.x * 256 + threadIdx.x; i < n; i += gridDim.x * 256) {
    int l = i / (8 * 6144), c = i % 6144;
    float a = p.b_ada[l * 6144 + c];
#pragma unroll
    for (int kc = 0; kc < 16; ++kc) a += modp[(size_t)kc * n + i];
    mod[i] = a;
  }
  const float* cbp = (const float*)(p.ws + OFF_CB1P);
  float* cb = (float*)(p.ws + OFF_CB1);
  for (int i = blockIdx.x * 256 + threadIdx.x; i < 1024; i += gridDim.x * 256) {
    float a = 0.f;
#pragma unroll
    for (int kc = 0; kc < 16; ++kc) a += cbp[kc * 1024 + i];
    cb[i] = a;
  }
}

DI void phase_mod_x(const Params& p) {
  const float* mod = (const float*)(p.ws + OFF_MOD);
  u16* H = (u16*)(p.ws + OFF_H);
  const long nchunk = (long)TOK * 1024 / 8;
  for (long i = (long)blockIdx.x * 256 + otid(); i < nchunk; i += (long)gridDim.x * 256) {
    long e = i * 8;
    int col = (int)(e & 1023);
    int b = (int)(e >> 23);
    const float4* xp = (const float4*)(p.x + e);
    const float4* sh = (const float4*)(mod + (size_t)b * 6144 + 0 + col);
    const float4* sc = (const float4*)(mod + (size_t)b * 6144 + 1024 + col);
    float4 x0 = xp[0], x1 = xp[1], s0 = sc[0], s1 = sc[1], h0 = sh[0], h1 = sh[1];
    uint4 o;
    o.x = pack2(x0.x * (1.f + s0.x) + h0.x, x0.y * (1.f + s0.y) + h0.y);
    o.y = pack2(x0.z * (1.f + s0.z) + h0.z, x0.w * (1.f + s0.w) + h0.w);
    o.z = pack2(x1.x * (1.f + s1.x) + h1.x, x1.y * (1.f + s1.y) + h1.y);
    o.w = pack2(x1.z * (1.f + s1.z) + h1.z, x1.w * (1.f + s1.w) + h1.w);
    *(uint4*)(H + e) = o;
  }
}

constexpr int LDS_BYTES = 73728;
DI int swz_key(int r) { return (0x78 >> (2 * ((r >> 2) & 3))) & 3; }
template <int MT>
DI void g_issue(const u16* __restrict__ Ap, int lda, const u16* __restrict__ Bp, int ldb, int st, int ksa, int tid, char* buf) {
  constexpr int AOFF = 2048 * MT;
  const int koffA = (st >> 1) * ksa + (st & 1) * 32;
  const int koffB = st * 32;
  const int wbase = (tid & ~63) * 16;
#pragma unroll
  for (int i = 0; i < MT / 2; ++i) {
    const int c = tid + 256 * i;
    const int row = c >> 2, ph = c & 3;
    const int lc = ph ^ swz_key(row);
    __builtin_amdgcn_global_load_lds((const unsigned*)(Ap + (size_t)row * lda + koffA + lc * 8),
                                     (unsigned*)(buf + i * 4096 + wbase), 16, 0, 0);
  }
#pragma unroll
  for (int i = 0; i < 2; ++i) {
    const int c = tid + 256 * i;
    const int row = c >> 2, ph = c & 3;
    const int lc = ph ^ swz_key(row);
    __builtin_amdgcn_global_load_lds((const unsigned*)(Bp + (size_t)row * ldb + koffB + lc * 8),
                                     (unsigned*)(buf + AOFF + i * 4096 + wbase), 16, 0, 0);
  }
}
template <bool SWAP, int MT>
DI void g_compute(const char* sA, f32x4 (&acc)[MT][4], int wm, int wn, int lr, int lg) {
  const char* sB = sA + 2048 * MT;
  bf16x8 af[MT], bfr[4];
  const int ra = wm * (16 * MT) + lr, rb = wn * 64 + lr;
  const int ka = (lg ^ swz_key(ra)) << 4, kb = (lg ^ swz_key(rb)) << 4;
  af[0] = *(const bf16x8*)(sA + ra * 64 + ka);
#pragma unroll
  for (int ni = 0; ni < 4; ++ni) bfr[ni] = *(const bf16x8*)(sB + (rb + ni * 16) * 64 + kb);
#pragma unroll
  for (int mi = 1; mi < MT; ++mi) af[mi] = *(const bf16x8*)(sA + (ra + mi * 16) * 64 + ka);
  __builtin_amdgcn_sched_barrier(0);
#pragma unroll
  for (int mi = 0; mi < MT; ++mi)
#pragma unroll
    for (int ni = 0; ni < 4; ++ni)
      acc[mi][ni] = SWAP ? MFMA16(bfr[ni], af[mi], acc[mi][ni]) : MFMA16(af[mi], bfr[ni], acc[mi][ni]);
  __builtin_amdgcn_sched_barrier(0);
}
#define RAW_BARRIER() do { asm volatile("s_waitcnt lgkmcnt(0)" ::: "memory"); __builtin_amdgcn_s_barrier(); } while (0)

template <bool SWAP, int MT, class Epi>
DI void gemm_tile(const u16* __restrict__ Ap, int lda, const u16* __restrict__ Bp, int ldb, int nk, int tm, int tn, int tid,
                  char* smem, Epi epi, int ksa = 64) {
  constexpr int NBUF = (MT == 8) ? 3 : 4;
  constexpr int BUFSZ = 2048 * MT + 8192;
  constexpr int LA = NBUF - 1;
  const int lane = tid & 63, w = tid >> 6, wm = w >> 1, wn = w & 1;
  const int lr = lane & 15, lg = lane >> 4;
  const int nks = nk * 2;
  f32x4 acc[MT][4];
#pragma unroll
  for (int i = 0; i < MT; ++i)
#pragma unroll
    for (int j = 0; j < 4; ++j) acc[i][j] = f32x4{0.f, 0.f, 0.f, 0.f};
#pragma unroll
  for (int s = 0; s < LA; ++s) g_issue<MT>(Ap, lda, Bp, ldb, s, ksa, tid, smem + s * BUFSZ);
  int bi = 0, bn = LA;
  for (int st = 0; st < nks; ++st) {
    if (MT == 8) {
      if (st + 1 < nks) asm volatile("s_waitcnt vmcnt(6)" ::: "memory");
      else asm volatile("s_waitcnt vmcnt(0)" ::: "memory");
    } else {
      if (st + 2 < nks) asm volatile("s_waitcnt vmcnt(8)" ::: "memory");
      else if (st + 1 < nks) asm volatile("s_waitcnt vmcnt(4)" ::: "memory");
      else asm volatile("s_waitcnt vmcnt(0)" ::: "memory");
    }
    RAW_BARRIER();
    if (st + LA < nks) g_issue<MT>(Ap, lda, Bp, ldb, st + LA, ksa, tid, smem + bn * BUFSZ);
    g_compute<SWAP, MT>(smem + bi * BUFSZ, acc, wm, wn, lr, lg);
    bi = (bi + 1 == NBUF) ? 0 : bi + 1;
    bn = (bn + 1 == NBUF) ? 0 : bn + 1;
  }
  RAW_BARRIER();
  epi(SWAP, tm, tn, wm, wn, lr, lg, acc);
}

template <int MT, class AB, class Sel, class Epi>
DI void gemm_phase_g(AB abase, int lda, int ksa, const u16* __restrict__ Bt, int ldb, int ntm, int ntn, int K, int vb, int nvb,
                     char* smem, Sel swapsel, Epi epi) {
  if (vb < 0 || vb >= nvb) return;
  const int ntiles = ntm * ntn;
  const int nk = K / 64;
  int GM = nvb / ntn;
  if (GM < 1) GM = 1;
  if (GM > ntm) GM = ntm;
  const int gtiles = GM * ntn;
  const int q0 = ((nvb & 7) == 0) ? ((vb & 7) * (nvb >> 3) + (vb >> 3)) : vb;
  for (int q = q0; q < ntiles; q += nvb) {
    const int g = q / gtiles;
    const int i = q - g * gtiles;
    const int gsz = (ntm - g * GM < GM) ? (ntm - g * GM) : GM;
    const int tn = i / gsz;
    const int tm = g * GM + (i - tn * gsz);
    const u16* Ap = abase(tm);
    const u16* Bp = Bt + (size_t)tn * 128 * ldb;
    const int tid = otid();
    if (swapsel(tn)) gemm_tile<true, MT>(Ap, lda, Bp, ldb, nk, tm, tn, tid, smem, epi, ksa);
    else gemm_tile<false, MT>(Ap, lda, Bp, ldb, nk, tm, tn, tid, smem, epi, ksa);
  }
}
template <int MT, class Sel, class Epi>
DI void gemm_phase(const u16* __restrict__ A, int lda, const u16* __restrict__ Bt, int ldb, int ntm, int ntn, int K,
                   int vb, int nvb, char* smem, Sel swapsel, Epi epi) {
  auto ab = [=](int tm) { return A + (size_t)tm * (32 * MT) * lda; };
  gemm_phase_g<MT>(ab, lda, 64, Bt, ldb, ntm, ntn, K, vb, nvb, smem, swapsel, epi);
}
template <class Epi, class Post>
DI void gemm_rowblock_phase(const u16* __restrict__ A, int lda, const u16* __restrict__ Bt, int ldb, int ntm, int ntn, int K,
                            int vb, int nvb, char* smem, Epi epi, Post post) {
  const int nk = K / 64;
  for (int tm = vb; tm < ntm; tm += nvb) {
    const u16* Ap = A + (size_t)tm * 128 * lda;
    for (int tn = 0; tn < ntn; ++tn) {
      const int tid = otid();
      gemm_tile<true, 4>(Ap, lda, Bt + (size_t)tn * 128 * ldb, ldb, nk, tm, tn, tid, smem, epi, 64);
    }
    asm volatile("s_waitcnt vmcnt(0)" ::: "memory");
    __syncthreads();
    post(tm);
  }
}

DI void ln_rows(float* buf, const float* __restrict__ g, const float* __restrict__ bt, const float* __restrict__ modl,
                        int sh_off, int sc_off, u16* H) {
  const int tid_ = otid();
  const int lane = tid_ & 63, w = tid_ >> 6;
  for (int row = blockIdx.x * 4 + w; row < TOK; row += gridDim.x * 4) {
    float4* rp = (float4*)(buf + (size_t)row * 1024);
    float4 v[4];
    float s = 0.f;
#pragma unroll
    for (int i = 0; i < 4; ++i) { v[i] = rp[lane + 64 * i]; s += v[i].x + v[i].y + v[i].z + v[i].w; }
#pragma unroll
    for (int o = 32; o >= 1; o >>= 1) s += __shfl_xor(s, o);
    const float mu = s * (1.f / 1024.f);
    float q = 0.f;
#pragma unroll
    for (int i = 0; i < 4; ++i) {
      float a = v[i].x - mu, b = v[i].y - mu, c = v[i].z - mu, d = v[i].w - mu;
      q += a * a + b * b + c * c + d * d;
    }
#pragma unroll
    for (int o = 32; o >= 1; o >>= 1) q += __shfl_xor(q, o);
    const float rs = rsqrtf(q * (1.f / 1024.f) + EPS);
    const int b = row >> 13;
#pragma unroll
    for (int i = 0; i < 4; ++i) {
      const int col = (lane + 64 * i) * 4;
      float4 gg = *(const float4*)(g + col), bb = *(const float4*)(bt + col);
      float4 y;
      y.x = (v[i].x - mu) * rs * gg.x + bb.x;
      y.y = (v[i].y - mu) * rs * gg.y + bb.y;
      y.z = (v[i].z - mu) * rs * gg.z + bb.z;
      y.w = (v[i].w - mu) * rs * gg.w + bb.w;
      rp[lane + 64 * i] = y;
      if (H) {
        float4 sh = *(const float4*)(modl + (size_t)b * 6144 + sh_off + col);
        float4 sc = *(const float4*)(modl + (size_t)b * 6144 + sc_off + col);
        uint2 o2;
        o2.x = pack2(y.x * (1.f + sc.x) + sh.x, y.y * (1.f + sc.y) + sh.y);
        o2.y = pack2(y.z * (1.f + sc.z) + sh.z, y.w * (1.f + sc.w) + sh.w);
        *(uint2*)(H + (size_t)row * 1024 + col) = o2;
      }
    }
  }
}

DI void ln_block(float* buf, int row0, const float* __restrict__ g, const float* __restrict__ bt,
                 const float* __restrict__ modl, int sh_off, int sc_off, u16* H) {
  const int tid_ = otid();
  const int lane = tid_ & 63, w = tid_ >> 6;
  for (int rr = 0; rr < 32; ++rr) {
    const int row = row0 + w * 32 + rr;
    f32x4* rp = (f32x4*)(buf + (size_t)row * 1024);
    f32x4 v[4];
    float s = 0.f;
#pragma unroll
    for (int i = 0; i < 4; ++i) { v[i] = __builtin_nontemporal_load(rp + lane + 64 * i); s += v[i][0] + v[i][1] + v[i][2] + v[i][3]; }
#pragma unroll
    for (int o = 32; o >= 1; o >>= 1) s += __shfl_xor(s, o);
    const float mu = s * (1.f / 1024.f);
    float q = 0.f;
#pragma unroll
    for (int i = 0; i < 4; ++i)
#pragma unroll
      for (int k = 0; k < 4; ++k) { float a = v[i][k] - mu; q += a * a; }
#pragma unroll
    for (int o = 32; o >= 1; o >>= 1) q += __shfl_xor(q, o);
    const float rs = rsqrtf(q * (1.f / 1024.f) + EPS);
    const int b = row >> 13;
#pragma unroll
    for (int i = 0; i < 4; ++i) {
      const int col = (lane + 64 * i) * 4;
      const float4 gg = *(const float4*)(g + col), bb = *(const float4*)(bt + col);
      f32x4 y;
      y[0] = (v[i][0] - mu) * rs * gg.x + bb.x;
      y[1] = (v[i][1] - mu) * rs * gg.y + bb.y;
      y[2] = (v[i][2] - mu) * rs * gg.z + bb.z;
      y[3] = (v[i][3] - mu) * rs * gg.w + bb.w;
      rp[lane + 64 * i] = y;
      if (H) {
        const float4 sh = *(const float4*)(modl + (size_t)b * 6144 + sh_off + col);
        const float4 sc = *(const float4*)(modl + (size_t)b * 6144 + sc_off + col);
        uint2 o2;
        o2.x = pack2(y[0] * (1.f + sc.x) + sh.x, y[1] * (1.f + sc.y) + sh.y);
        o2.y = pack2(y[2] * (1.f + sc.z) + sh.z, y[3] * (1.f + sc.w) + sh.w);
        *(uint2*)(H + (size_t)row * 1024 + col) = o2;
      }
    }
  }
}

DI void gmlp_item(const Params& p, int l, int item) {
  const int b = item >> 9, c = (item >> 3) & 63, grp = item & 7;
  const int tid_ = otid();
  const int lane = tid_ & 63, w = tid_ >> 6, lr = lane & 15, lg = lane >> 4;
  const float* wsp = p.w_s + (size_t)(l * 8 + grp) * 128 * 128;
  const u16* vgt = (const u16*)(p.ws + OFF_A + A_VGT) + (size_t)(b * 8 + grp) * 64 * S + c * 128;
  const u16* U = (const u16*)(p.ws + OFF_A + A_U);
  u16* OM = (u16*)(p.ws + OFF_H);
  f32x4 acc[4][2];
#pragma unroll
  for (int i = 0; i < 4; ++i)
#pragma unroll
    for (int j = 0; j < 2; ++j) acc[i][j] = f32x4{0.f, 0.f, 0.f, 0.f};
#pragma unroll
  for (int ks = 0; ks < 4; ++ks) {
    const int s0 = ks * 32 + lg * 8;
    bf16x8 af[4];
#pragma unroll
    for (int dt = 0; dt < 4; ++dt) af[dt] = *(const bf16x8*)(vgt + (size_t)(dt * 16 + lr) * S + s0);
#pragma unroll
    for (int nt = 0; nt < 2; ++nt) {
      const int t = w * 32 + nt * 16 + lr;
      const float4* wp = (const float4*)(wsp + t * 128 + s0);
      float4 a0 = wp[0], a1 = wp[1];
      unsigned pw[4];
      pw[0] = pack2((s0 + 0 <= t) ? a0.x : 0.f, (s0 + 1 <= t) ? a0.y : 0.f);
      pw[1] = pack2((s0 + 2 <= t) ? a0.z : 0.f, (s0 + 3 <= t) ? a0.w : 0.f);
      pw[2] = pack2((s0 + 4 <= t) ? a1.x : 0.f, (s0 + 5 <= t) ? a1.y : 0.f);
      pw[3] = pack2((s0 + 6 <= t) ? a1.z : 0.f, (s0 + 7 <= t) ? a1.w : 0.f);
      bf16x8 bw = __builtin_bit_cast(bf16x8, make_uint4(pw[0], pw[1], pw[2], pw[3]));
#pragma unroll
      for (int dt = 0; dt < 4; ++dt) acc[dt][nt] = MFMA16(af[dt], bw, acc[dt][nt]);
    }
  }
#pragma unroll
  for (int nt = 0; nt < 2; ++nt) {
    const int t = w * 32 + nt * 16 + lr;
    const size_t tok = (size_t)b * S + c * 128 + t;
    const float bias = p.b_s[(l * 8 + grp) * 128 + t];
    float val[4][4];
    float ss = 0.f;
#pragma unroll
    for (int dt = 0; dt < 4; ++dt) {
      const int d = dt * 16 + lg * 4;
      const uint2 uu = *(const uint2*)(U + tok * 512 + grp * 64 + d);
      const float u0 = bf2f(uu.x & 0xffff), u1 = bf2f(uu.x >> 16), u2 = bf2f(uu.y & 0xffff), u3 = bf2f(uu.y >> 16);
      val[dt][0] = u0 * (acc[dt][nt][0] + bias);
      val[dt][1] = u1 * (acc[dt][nt][1] + bias);
      val[dt][2] = u2 * (acc[dt][nt][2] + bias);
      val[dt][3] = u3 * (acc[dt][nt][3] + bias);
#pragma unroll
      for (int j = 0; j < 4; ++j) ss += val[dt][j] * val[dt][j];
    }
    ss += __shfl_xor(ss, 16);
    ss += __shfl_xor(ss, 32);
    const float r = rsqrtf(ss * (1.f / 64.f) + EPS);
#pragma unroll
    for (int dt = 0; dt < 4; ++dt) {
      const int d = dt * 16 + lg * 4;
      const float4 gg = *(const float4*)(p.out_g + l * 1024 + 512 + grp * 64 + d);
      uint2 st;
      st.x = pack2(val[dt][0] * r * gg.x, val[dt][1] * r * gg.y);
      st.y = pack2(val[dt][2] * r * gg.z, val[dt][3] * r * gg.w);
      *(uint2*)(OM + tok * 1024 + 512 + grp * 64 + d) = st;
    }
  }
}

constexpr int SM_K = 0, SM_V = 8192, SM_IMP = 8192 + 8704, SM_SEL = SM_IMP + 64 * 132 * 4, SM_UNI = SM_SEL + 1024;

struct KVr { u32x4 k0, k1, v0, v1; };
DI void kv_load_k(KVr& t, const u16* __restrict__ src, int stride, int tid) {
  const int r = tid >> 3, ch = tid & 7;
  t.k0 = *(const u32x4*)(src + (size_t)r * stride + ch * 8);
  t.k1 = *(const u32x4*)(src + (size_t)(r + 32) * stride + ch * 8);
}
DI void kv_load_v(KVr& t, const u16* __restrict__ src, int stride, int tid) {
  const int d = tid >> 3, ch = tid & 7;
  t.v0 = *(const u32x4*)(src + (size_t)d * stride + ch * 8);
  t.v1 = *(const u32x4*)(src + (size_t)(d + 32) * stride + ch * 8);
}
DI void kv_store_k(const KVr& t, char* sK, int tid) {
  const int r = tid >> 3, ch = tid & 7;
  char* pk = sK + r * 128 + ((ch ^ (r & 7)) << 4);
  *(u32x4*)(pk) = t.k0;
  *(u32x4*)(pk + 4096) = t.k1;
}
DI void kv_store_v(const KVr& t, char* sV, int tid) {
  const int d = tid >> 3, ch = tid & 7;
  uint2* d0 = (uint2*)(sV + d * 136 + ch * 16);
  d0[0] = make_uint2(t.v0[0], t.v0[1]);
  d0[1] = make_uint2(t.v0[2], t.v0[3]);
  uint2* d1 = (uint2*)(sV + (d + 32) * 136 + ch * 16);
  d1[0] = make_uint2(t.v1[0], t.v1[1]);
  d1[1] = make_uint2(t.v1[2], t.v1[3]);
}
DI int next_set_bit(const unsigned* uni, int from) {
  int res = 1000;
#pragma unroll
  for (int wd = 3; wd >= 0; --wd) {
    unsigned mw = uni[wd];
    const int lo = from - wd * 32;
    if (lo >= 32) mw = 0u;
    else if (lo > 0) mw &= (~0u) << lo;
    if (mw) res = wd * 32 + __ffs(mw) - 1;
  }
  return __builtin_amdgcn_readfirstlane(res);
}

template <int MODE>
DI void half_step(const char* sK, const char* sV, int half, int lr, int lg, const bf16x8 (&qf)[2][2], const float (&slope)[2],
                  float (&m)[2], float (&lsum)[2], f32x4 (&o)[2][4], const float (&posf)[2][4], const bool (&valid)[2][4],
                  float (&psum)[2][4]) {
  bf16x8 kf[2][2];
#pragma unroll
  for (int kt2 = 0; kt2 < 2; ++kt2) {
    const int r = half * 32 + kt2 * 16 + lr;
    kf[kt2][0] = *(const bf16x8*)(sK + r * 128 + (((lg) ^ (r & 7)) << 4));
    kf[kt2][1] = *(const bf16x8*)(sK + r * 128 + (((4 + lg) ^ (r & 7)) << 4));
  }
  if (MODE == 1) {
#pragma unroll
    for (int a = 0; a < 2; ++a)
#pragma unroll
      for (int j = 0; j < 4; ++j) psum[a][j] = 0.f;
  }
  bf16x8 pf[2];
#pragma unroll
  for (int h = 0; h < 2; ++h) {
    f32x4 s[2];
#pragma unroll
    for (int kt2 = 0; kt2 < 2; ++kt2) {
      f32x4 z = f32x4{0.f, 0.f, 0.f, 0.f};
      z = MFMA16(kf[kt2][0], qf[h][0], z);
      z = MFMA16(kf[kt2][1], qf[h][1], z);
      s[kt2] = z;
    }
    float mx = NEGB;
#pragma unroll
    for (int kt2 = 0; kt2 < 2; ++kt2)
#pragma unroll
      for (int j = 0; j < 4; ++j) {
        float v = valid[kt2][j] ? (s[kt2][j] + slope[h] * posf[kt2][j]) : NEGB;
        s[kt2][j] = v;
        mx = fmaxf(mx, v);
      }
    if (MODE != 1) {
      mx = fmaxf(mx, __shfl_xor(mx, 16));
      mx = fmaxf(mx, __shfl_xor(mx, 32));
      const float mn = fmaxf(m[h], mx);
      const float alpha = ex2(m[h] - mn);
      m[h] = mn;
      float ps = 0.f;
#pragma unroll
      for (int kt2 = 0; kt2 < 2; ++kt2)
#pragma unroll
        for (int j = 0; j < 4; ++j) {
          float pv = ex2(s[kt2][j] - mn);
          s[kt2][j] = pv;
          ps += pv;
        }
      lsum[h] = lsum[h] * alpha + ps;
      if (MODE == 2) {
#pragma unroll
        for (int dt = 0; dt < 4; ++dt) o[h][dt] *= alpha;
      }
    } else {
#pragma unroll
      for (int kt2 = 0; kt2 < 2; ++kt2)
#pragma unroll
        for (int j = 0; j < 4; ++j) {
          float pv = ex2(s[kt2][j] - m[h]) * lsum[h];
          s[kt2][j] = pv;
          psum[kt2][j] += pv;
        }
    }
    if (MODE != 0) {
      uint4 pk = make_uint4(pack2(s[0][0], s[0][1]), pack2(s[0][2], s[0][3]), pack2(s[1][0], s[1][1]), pack2(s[1][2], s[1][3]));
      pf[h] = __builtin_bit_cast(bf16x8, pk);
    }
  }
  if (MODE != 0) {
#pragma unroll
    for (int dt = 0; dt < 4; ++dt) {
      const char* base = sV + (dt * 16 + lr) * 136 + half * 64 + lg * 8;
      uint2 a = *(const uint2*)(base);
      uint2 c = *(const uint2*)(base + 32);
      bf16x8 vf = __builtin_bit_cast(bf16x8, make_uint4(a.x, a.y, c.x, c.y));
#pragma unroll
      for (int h = 0; h < 2; ++h) o[h][dt] = MFMA16(vf, pf[h], o[h][dt]);
    }
  }
}

DI void attn_item(const Params& p, int l, int b, int kvh, int qh, char* smem) {
  char* sK = smem + SM_K;
  char* sV = smem + SM_V;
  float* sImp = (float*)(smem + SM_IMP);
  unsigned* sSel = (unsigned*)(smem + SM_SEL);
  unsigned* sUni = (unsigned*)(smem + SM_UNI);
  const char* wsA = p.ws + OFF_A;
  const u16* Q = (const u16*)(wsA + A_Q);
  const u16* KS = (const u16*)(wsA + A_KS);
  const u16* VST = (const u16*)(wsA + A_VST);
  const u16* KW = (const u16*)(wsA + A_KW);
  const u16* VWT = (const u16*)(wsA + A_VWT);
  const float* G = (const float*)(wsA + A_G);
  const u16* KCMP = (const u16*)(p.ws + OFF_KCMP);
  const u16* VCMPT = (const u16*)(p.ws + OFF_VCMPT);
  u16* OM = (u16*)(p.ws + OFF_H);

  const int tid = otid(), lane = tid & 63, w = tid >> 6, lr = lane & 15, lg = lane >> 4;
  const int hp = w >> 1;
  const int t0 = qh * 32;
  const int cur = qh >> 1;
  const int tql = 16 * (w & 1) + lr;
  const size_t tokq = (size_t)b * S + t0 + tql;
  const int bk = b * 2 + kvh;
  const int hg0 = kvh * 4 + hp * 2;

  bf16x8 qf[2][2];
  float slope[2];
#pragma unroll
  for (int h = 0; h < 2; ++h) {
    const u16* qp = Q + tokq * 512 + (hg0 + h) * 64 + lg * 8;
    qf[h][0] = *(const bf16x8*)qp;
    qf[h][1] = *(const bf16x8*)(qp + 32);
    slope[h] = ex2(-(float)(hg0 + h + 1)) * LOG2E;
  }
  float m[2], ls[2];
  f32x4 o[2][4], otot[2][4];
  float psum[2][4];
#pragma unroll
  for (int h = 0; h < 2; ++h) {
    m[h] = MINIT;
    ls[h] = 0.f;
#pragma unroll
    for (int dt = 0; dt < 4; ++dt) o[h][dt] = f32x4{0.f, 0.f, 0.f, 0.f};
  }

  const int amax = qh >> 5;
  const u16* kc_base = KCMP + (size_t)bk * 512 * 64;
  const u16* vc_base = VCMPT + (size_t)bk * 64 * 512;
  KVr tl;
  kv_load_k(tl, kc_base, 64, tid);
  for (int a = 0; a <= amax; ++a) {
    __syncthreads();
    kv_store_k(tl, sK, tid);
    __syncthreads();
    if (a < amax) kv_load_k(tl, kc_base + (size_t)(a + 1) * 64 * 64, 64, tid);
    else { kv_load_k(tl, kc_base, 64, tid); kv_load_v(tl, vc_base, 512, tid); }
#pragma unroll
    for (int half = 0; half < 2; ++half) {
      float posf[2][4];
      bool valid[2][4];
#pragma unroll
      for (int kt2 = 0; kt2 < 2; ++kt2)
#pragma unroll
        for (int j = 0; j < 4; ++j) {
          int n = a * 64 + half * 32 + kt2 * 16 + lg * 4 + j;
          int rel = 16 * n + 31 - t0;
          posf[kt2][j] = (float)rel;
          valid[kt2][j] = rel <= tql;
        }
      half_step<0>(sK, sV, half, lr, lg, qf, slope, m, ls, o, posf, valid, psum);
    }
  }
#pragma unroll
  for (int h = 0; h < 2; ++h) {
    float x = ls[h];
    x += __shfl_xor(x, 16);
    x += __shfl_xor(x, 32);
    ls[h] = x > 0.f ? 1.f / x : 0.f;
  }
  float carry = 0.f;
  float* myImp = sImp + hp * (32 * 132);
  for (int a = 0; a <= amax; ++a) {
    __syncthreads();
    kv_store_k(tl, sK, tid);
    kv_store_v(tl, sV, tid);
    __syncthreads();
    if (a < amax) {
      kv_load_k(tl, kc_base + (size_t)(a + 1) * 64 * 64, 64, tid);
      kv_load_v(tl, vc_base + (a + 1) * 64, 512, tid);
    }
#pragma unroll
    for (int half = 0; half < 2; ++half) {
      float posf[2][4];
      bool valid[2][4];
#pragma unroll
      for (int kt2 = 0; kt2 < 2; ++kt2)
#pragma unroll
        for (int j = 0; j < 4; ++j) {
          int n = a * 64 + half * 32 + kt2 * 16 + lg * 4 + j;
          int rel = 16 * n + 31 - t0;
          posf[kt2][j] = (float)rel;
          valid[kt2][j] = rel <= tql;
        }
      half_step<1>(sK, sV, half, lr, lg, qf, slope, m, ls, o, posf, valid, psum);
      float prev = carry;
#pragma unroll
      for (int kt2 = 0; kt2 < 2; ++kt2) {
        float sum4 = psum[kt2][0] + psum[kt2][1] + psum[kt2][2] + psum[kt2][3];
        float p3 = psum[kt2][3];
        float up = __shfl(p3, (lane + 48) & 63);
        float wrap = __shfl(prev, (lane + 48) & 63);
        float spill = lg > 0 ? up : wrap;
        int j = a * 16 + half * 8 + kt2 * 4 + lg;
        myImp[tql * 132 + j] = sum4 + spill;
        prev = p3;
      }
      carry = prev;
    }
  }
#pragma unroll
  for (int h = 0; h < 2; ++h) {
    const float g0 = G[tokq * 24 + (hg0 + h) * 3 + 0];
#pragma unroll
    for (int dt = 0; dt < 4; ++dt) {
      otot[h][dt] = o[h][dt] * g0;
      o[h][dt] = f32x4{0.f, 0.f, 0.f, 0.f};
    }
    m[h] = MINIT;
    ls[h] = 0.f;
  }
  if (tid < 4) sUni[tid] = 0u;
  __syncthreads();
  if (tid < 128) {
    const int q = tid >> 2, sub = tid & 3;
    unsigned mk[4] = {0u, 0u, 0u, 0u};
    if (cur < 16) {
      mk[0] = (1u << (cur + 1)) - 1u;
    } else {
      float v[32];
#pragma unroll
      for (int i = 0; i < 32; ++i) {
        int j = sub + 4 * i;
        v[i] = (j >= 1 && j <= cur - 2) ? (sImp[q * 132 + j] + sImp[32 * 132 + q * 132 + j]) : -1.f;
      }
      for (int round = 0; round < 13; ++round) {
        float bv = v[0];
        int bi = 0;
#pragma unroll
        for (int i = 1; i < 32; ++i)
          if (v[i] > bv) { bv = v[i]; bi = i; }
        int bj = sub + 4 * bi;
#pragma unroll
        for (int off = 1; off <= 2; off <<= 1) {
          float ov = __shfl_xor(bv, off);
          int oj = __shfl_xor(bj, off);
          if (ov > bv || (ov == bv && oj < bj)) { bv = ov; bj = oj; }
        }
#pragma unroll
        for (int i = 0; i < 32; ++i)
          if (sub + 4 * i == bj) v[i] = -2.f;
#pragma unroll
        for (int wd = 0; wd < 4; ++wd) mk[wd] |= ((bj >> 5) == wd) ? (1u << (bj & 31)) : 0u;
      }
      const int f1 = cur, f2 = cur - 1;
      mk[0] |= 1u;
#pragma unroll
      for (int wd = 0; wd < 4; ++wd) {
        mk[wd] |= ((f1 >> 5) == wd) ? (1u << (f1 & 31)) : 0u;
        mk[wd] |= ((f2 >> 5) == wd) ? (1u << (f2 & 31)) : 0u;
      }
    }
    if (sub == 0) {
#pragma unroll
      for (int wd = 0; wd < 4; ++wd) {
        sSel[q * 4 + wd] = mk[wd];
        atomicOr(&sUni[wd], mk[wd]);
      }
    }
  }
  __syncthreads();
  const int jw0 = (cur >= 8 ? cur - 8 : 0);
  {
    int j = next_set_bit(sUni, 0);
    kv_load_k(tl, KS + ((size_t)b * S + j * 64) * 128 + kvh * 64, 128, tid);
    kv_load_v(tl, VST + (size_t)bk * 64 * S + j * 64, S, tid);
    while (j <= cur) {
      __syncthreads();
      kv_store_k(tl, sK, tid);
      kv_store_v(tl, sV, tid);
      __syncthreads();
      const int jn = next_set_bit(sUni, j + 1);
      if (jn <= cur) {
        kv_load_k(tl, KS + ((size_t)b * S + jn * 64) * 128 + kvh * 64, 128, tid);
        kv_load_v(tl, VST + (size_t)bk * 64 * S + jn * 64, S, tid);
      } else {
        kv_load_k(tl, KW + ((size_t)b * S + jw0 * 64) * 128 + kvh * 64, 128, tid);
        kv_load_v(tl, VWT + (size_t)bk * 64 * S + jw0 * 64, S, tid);
      }
      const bool selbit = (sSel[tql * 4 + (j >> 5)] >> (j & 31)) & 1u;
#pragma unroll
      for (int half = 0; half < 2; ++half) {
        float posf[2][4];
        bool valid[2][4];
#pragma unroll
        for (int kt2 = 0; kt2 < 2; ++kt2)
#pragma unroll
          for (int jj = 0; jj < 4; ++jj) {
            int rel = j * 64 - t0 + half * 32 + kt2 * 16 + lg * 4 + jj;
            posf[kt2][jj] = (float)rel;
            valid[kt2][jj] = selbit && (rel <= tql);
          }
        half_step<2>(sK, sV, half, lr, lg, qf, slope, m, ls, o, posf, valid, psum);
      }
      j = jn;
    }
  }
#pragma unroll
  for (int h = 0; h < 2; ++h) {
    float x = ls[h];
    x += __shfl_xor(x, 16);
    x += __shfl_xor(x, 32);
    const float f = (x > 0.f ? 1.f / x : 0.f) * G[tokq * 24 + (hg0 + h) * 3 + 1];
#pragma unroll
    for (int dt = 0; dt < 4; ++dt) {
      otot[h][dt] += o[h][dt] * f;
      o[h][dt] = f32x4{0.f, 0.f, 0.f, 0.f};
    }
    m[h] = MINIT;
    ls[h] = 0.f;
  }
  for (int j = jw0; j <= cur; ++j) {
    __syncthreads();
    kv_store_k(tl, sK, tid);
    kv_store_v(tl, sV, tid);
    __syncthreads();
    if (j < cur) {
      kv_load_k(tl, KW + ((size_t)b * S + (j + 1) * 64) * 128 + kvh * 64, 128, tid);
      kv_load_v(tl, VWT + (size_t)bk * 64 * S + (j + 1) * 64, S, tid);
    }
#pragma unroll
    for (int half = 0; half < 2; ++half) {
      float posf[2][4];
      bool valid[2][4];
#pragma unroll
      for (int kt2 = 0; kt2 < 2; ++kt2)
#pragma unroll
        for (int jj = 0; jj < 4; ++jj) {
          int rel = j * 64 - t0 + half * 32 + kt2 * 16 + lg * 4 + jj;
          posf[kt2][jj] = (float)rel;
          valid[kt2][jj] = (rel <= tql) && (tql - rel < 512);
        }
      half_step<2>(sK, sV, half, lr, lg, qf, slope, m, ls, o, posf, valid, psum);
    }
  }
#pragma unroll
  for (int h = 0; h < 2; ++h) {
    float x = ls[h];
    x += __shfl_xor(x, 16);
    x += __shfl_xor(x, 32);
    const float f = (x > 0.f ? 1.f / x : 0.f) * G[tokq * 24 + (hg0 + h) * 3 + 2];
    float ss = 0.f;
#pragma unroll
    for (int dt = 0; dt < 4; ++dt) {
      otot[h][dt] += o[h][dt] * f;
#pragma unroll
      for (int jj = 0; jj < 4; ++jj) ss += otot[h][dt][jj] * otot[h][dt][jj];
    }
    ss += __shfl_xor(ss, 16);
    ss += __shfl_xor(ss, 32);
    const float r = rsqrtf(ss * (1.f / 64.f) + EPS);
#pragma unroll
    for (int dt = 0; dt < 4; ++dt) {
      const int d = dt * 16 + lg * 4;
      const float4 gg = *(const float4*)(p.out_g + l * 1024 + (hg0 + h) * 64 + d);
      uint2 st;
      st.x = pack2(otot[h][dt][0] * r * gg.x, otot[h][dt][1] * r * gg.y);
      st.y = pack2(otot[h][dt][2] * r * gg.z, otot[h][dt][3] * r * gg.w);
      *(uint2*)(OM + tokq * 1024 + (hg0 + h) * 64 + d) = st;
    }
  }
}

DI void gsync(cg::grid_group& g) {
  asm volatile("s_waitcnt vmcnt(0)" ::: "memory");
  g.sync();
  __builtin_amdgcn_fence(__ATOMIC_ACQUIRE, "agent");
  asm volatile("s_waitcnt vmcnt(0)" ::: "memory");
}


#ifndef STOP_AFTER
#define STOP_AFTER 0
#endif
#define DUMP_BF16_AND_STOP(ptr)                                                                   \
  {                                                                                               \
    const u16* s_ = (const u16*)(ptr);                                                            \
    for (size_t i = (size_t)bid * 256 + threadIdx.x; i < (size_t)TOK * 1024; i += (size_t)nb * 256) \
      p.out[i] = bf2f(s_[i]);                                                                     \
    return;                                                                                       \
  }
#define DUMP_F32_AND_STOP(ptr)                                                                    \
  {                                                                                               \
    const float* s_ = (const float*)(ptr);                                                        \
    for (size_t i = (size_t)bid * 256 + threadIdx.x; i < (size_t)TOK * 1024; i += (size_t)nb * 256) \
      p.out[i] = s_[i];                                                                           \
    return;                                                                                       \
  }
__global__ void __launch_bounds__(256, 2) mega(Params p) {
  extern __shared__ __attribute__((aligned(16))) char smem[];
  cg::grid_group grid = cg::this_grid();
  char* ws = p.ws;
  const int nb = gridDim.x, bid = blockIdx.x;
  float* X1 = (float*)(ws + OFF_X1);
  u16* H = (u16*)(ws + OFF_H);
  char* wsA = ws + OFF_A;
  const float* mod = (const float*)(ws + OFF_MOD);

#ifdef ZERO_WS
  {
    uint4* z = (uint4*)ws;
    const size_t n16 = (OFF_A + A_END) / 16;
    for (size_t i = (size_t)bid * 256 + threadIdx.x; i < n16; i += (size_t)nb * 256) z[i] = make_uint4(0, 0, 0, 0);
    uint4* zo = (uint4*)p.out;
    const size_t m16 = (size_t)TOK * 1024 * 4 / 16;
    for (size_t i = (size_t)bid * 256 + threadIdx.x; i < m16; i += (size_t)nb * 256) zo[i] = make_uint4(0, 0, 0, 0);
  }
  gsync(grid);
#endif
  phase0a(p, smem);
  gsync(grid);
  phase0b(p);
  gsync(grid);
  phase_mod_x(p);
  gsync(grid);

  for (int l = 0; l < 2; ++l) {
    const float* modl = mod + (size_t)l * 8 * 6144;
    const float* xin = (l == 0) ? p.x : p.out;
    {
      u16* Qo = (u16*)(wsA + A_Q);
      u16* KCo = (u16*)(wsA + A_KC);
      u16* VCo = (u16*)(wsA + A_VC);
      u16* KSo = (u16*)(wsA + A_KS);
      u16* VSTo = (u16*)(wsA + A_VST);
      u16* KWo = (u16*)(wsA + A_KW);
      u16* VWTo = (u16*)(wsA + A_VWT);
      float* Go = (float*)(wsA + A_G);
      u16* Uo = (u16*)(wsA + A_U);
      u16* VGTo = (u16*)(wsA + A_VGT);
      const float* vng = p.vn_g + l * 512;
      const float* vnb = p.vn_b + l * 512;
      auto sel1 = [](int tn) { return !(tn == 7 || tn == 9 || (tn >= 14 && tn < 18)); };
      auto epi = [&](bool swp, int tm, int tn, int wm, int wn, int lr, int lg, auto& acc) {
        constexpr int MT = sizeof(acc) / sizeof(acc[0]);
        const int row0 = tm * (32 * MT) + wm * (16 * MT);
        const int b = row0 >> 13;
        const int s0 = row0 & (S - 1);
        if (swp) {
          if (tn == 18) {
            if (wn == 0) {
#pragma unroll
              for (int mi = 0; mi < MT; ++mi)
#pragma unroll
                for (int ni = 0; ni < 2; ++ni) {
                  const int c = ni * 16 + lg * 4;
                  const size_t row = (size_t)row0 + mi * 16 + lr;
                  if (c < 24)
                    *(float4*)(Go + row * 24 + c) =
                        make_float4(sigm(acc[mi][ni][0]), sigm(acc[mi][ni][1]), sigm(acc[mi][ni][2]), sigm(acc[mi][ni][3]));
                }
            }
          } else {
            u16* dst;
            int ld, cb;
            float sc = 1.f;
            bool g = false;
            if (tn < 4) { dst = Qo; ld = 512; cb = tn * 128; sc = QSCALE; }
            else if (tn == 4) { dst = KCo; ld = 128; cb = 0; }
            else if (tn == 5) { dst = VCo; ld = 128; cb = 0; }
            else if (tn == 6) { dst = KSo; ld = 128; cb = 0; }
            else if (tn == 8) { dst = KWo; ld = 128; cb = 0; }
            else { dst = Uo; ld = 512; cb = (tn - 10) * 128; g = true; }
#pragma unroll
            for (int mi = 0; mi < MT; ++mi)
#pragma unroll
              for (int ni = 0; ni < 4; ++ni) {
                const size_t row = (size_t)row0 + mi * 16 + lr;
                float v[4];
#pragma unroll
                for (int j = 0; j < 4; ++j) v[j] = g ? gelu_t(acc[mi][ni][j]) : acc[mi][ni][j] * sc;
                uint2 st;
                st.x = pack2(v[0], v[1]);
                st.y = pack2(v[2], v[3]);
                *(uint2*)(dst + row * ld + cb + wn * 64 + ni * 16 + lg * 4) = st;
              }
          }
        } else if (tn == 7 || tn == 9) {
          u16* dst = (tn == 7) ? VSTo : VWTo;
#pragma unroll
          for (int mi = 0; mi < MT; ++mi)
#pragma unroll
            for (int ni = 0; ni < 4; ++ni) {
              const int d = ni * 16 + lr;
              uint2 st;
              st.x = pack2(acc[mi][ni][0], acc[mi][ni][1]);
              st.y = pack2(acc[mi][ni][2], acc[mi][ni][3]);
              *(uint2*)(dst + ((size_t)(b * 2 + wn) * 64 + d) * S + s0 + mi * 16 + lg * 4) = st;
            }
        } else {
          const int grp = (tn - 14) * 2 + wn;
          float vg[4], vb[4];
#pragma unroll
          for (int ni = 0; ni < 4; ++ni) { vg[ni] = vng[grp * 64 + ni * 16 + lr]; vb[ni] = vnb[grp * 64 + ni * 16 + lr]; }
#pragma unroll
          for (int mi = 0; mi < MT; ++mi) {
            float vv[4][4];
#pragma unroll
            for (int ni = 0; ni < 4; ++ni)
#pragma unroll
              for (int j = 0; j < 4; ++j) vv[ni][j] = gelu_t(acc[mi][ni][j]);
#pragma unroll
            for (int j = 0; j < 4; ++j) {
              float s1 = vv[0][j] + vv[1][j] + vv[2][j] + vv[3][j];
              s1 += __shfl_xor(s1, 1); s1 += __shfl_xor(s1, 2); s1 += __shfl_xor(s1, 4); s1 += __shfl_xor(s1, 8);
              const float mu = s1 * (1.f / 64.f);
              float s2 = 0.f;
#pragma unroll
              for (int ni = 0; ni < 4; ++ni) { float dd = vv[ni][j] - mu; s2 += dd * dd; }
              s2 += __shfl_xor(s2, 1); s2 += __shfl_xor(s2, 2); s2 += __shfl_xor(s2, 4); s2 += __shfl_xor(s2, 8);
              const float rs = rsqrtf(s2 * (1.f / 64.f) + EPS);
#pragma unroll
              for (int ni = 0; ni < 4; ++ni) vv[ni][j] = (vv[ni][j] - mu) * rs * vg[ni] + vb[ni];
            }
#pragma unroll
            for (int ni = 0; ni < 4; ++ni) {
              const int d = ni * 16 + lr;
              uint2 st;
              st.x = pack2(vv[ni][0], vv[ni][1]);
              st.y = pack2(vv[ni][2], vv[ni][3]);
              *(uint2*)(VGTo + ((size_t)(b * 8 + grp) * 64 + d) * S + s0 + mi * 16 + lg * 4) = st;
            }
          }
        }
      };
      gemm_phase<8>(H, 1024, (const u16*)(ws + OFF_WTIN + l * SZ_WTIN), 1024, 256, 19, 1024, bid, nb, smem, sel1, epi);
    }
    gsync(grid);
    if (STOP_AFTER == 1 && l == 0) DUMP_BF16_AND_STOP(wsA)
    if (STOP_AFTER == 11 && l == 0) DUMP_BF16_AND_STOP(wsA + A_KW)
    if (STOP_AFTER == 12 && l == 0) DUMP_BF16_AND_STOP(wsA + A_U)
    {
      const int ng = (nb >= 256) ? 256 : nb;
      const int half = ng / 2;
      for (int which = 0; which < 2; ++which) {
        u16* HC = (u16*)(wsA + A_HC) + (size_t)which * 8192 * 256;
        const float* cb1 = (const float*)(ws + OFF_CB1) + (l * 2 + which) * 256;
        const u16* src_tok = (const u16*)(wsA + (which ? A_VC : A_KC));
        auto selT = [](int) { return true; };
        auto ab = [=](int tm) {
          const int bk = tm >> 2, n0 = (tm & 3) * 128;
          return src_tok + ((size_t)(bk >> 1) * S + 16 * n0) * 128 + (bk & 1) * 64;
        };
        auto epi = [&](bool swp, int tm, int tn, int wm, int wn, int lr, int lg, auto& acc) {
        constexpr int MT = sizeof(acc) / sizeof(acc[0]);
          const int row0 = tm * (32 * MT) + wm * (16 * MT), col0 = tn * 128 + wn * 64;
#pragma unroll
          for (int ni = 0; ni < 4; ++ni) {
            const float4 cb = *(const float4*)(cb1 + col0 + ni * 16 + lg * 4);
#pragma unroll
            for (int mi = 0; mi < MT; ++mi) {
              uint2 st;
              st.x = pack2(gelu_t(acc[mi][ni][0] + cb.x), gelu_t(acc[mi][ni][1] + cb.y));
              st.y = pack2(gelu_t(acc[mi][ni][2] + cb.z), gelu_t(acc[mi][ni][3] + cb.w));
              *(uint2*)(HC + (size_t)(row0 + mi * 16 + lr) * 256 + col0 + ni * 16 + lg * 4) = st;
            }
          }
        };
        const int vb = (bid < ng) ? (which == 0 ? (bid < half ? bid : -1) : (bid >= half ? bid - half : -1)) : -1;
        gemm_phase_g<4>(ab, 2048, 128, (const u16*)(ws + OFF_WTC1 + (l * 2 + which) * SZ_WTC1), 2048, 64, 2, 2048, vb, half, smem,
                     selT, epi);
      }
    }
    gsync(grid);
    {
      for (int which = 0; which < 2; ++which) {
        u16* KCMP = (u16*)(ws + OFF_KCMP);
        u16* VCMPT = (u16*)(ws + OFF_VCMPT);
        auto selW = [which](int) { return which == 0; };
        auto epi = [&](bool swp, int tm, int tn, int wm, int wn, int lr, int lg, auto& acc) {
        constexpr int MT = sizeof(acc) / sizeof(acc[0]);
          if (wn != 0) return;
          const int row0 = tm * (32 * MT) + wm * (16 * MT);
#pragma unroll
          for (int mi = 0; mi < MT; ++mi)
#pragma unroll
            for (int ni = 0; ni < 4; ++ni) {
              uint2 st;
              st.x = pack2(acc[mi][ni][0], acc[mi][ni][1]);
              st.y = pack2(acc[mi][ni][2], acc[mi][ni][3]);
              if (swp) {
                *(uint2*)(KCMP + (size_t)(row0 + mi * 16 + lr) * 64 + ni * 16 + lg * 4) = st;
              } else {
                const int d = ni * 16 + lr;
                const int rb = row0 + mi * 16 + lg * 4;
                *(uint2*)(VCMPT + ((size_t)(rb >> 9) * 64 + d) * 512 + (rb & 511)) = st;
              }
            }
        };
        const int vb = (which == 0) ? bid : (bid + nb - 64) % nb;
        gemm_phase<4>((const u16*)(wsA + A_HC) + (size_t)which * 8192 * 256, 256,
                   (const u16*)(ws + OFF_WTC2 + (l * 2 + which) * SZ_WTC2), 256, 64, 1, 256, vb, nb, smem, selW, epi);
      }
    }
    gsync(grid);
    if (STOP_AFTER == 4 && l == 0) DUMP_BF16_AND_STOP(ws + OFF_KCMP)
    for (int r = 0; r * nb < 4096; ++r) {
      const int pos = (r & 1) ? (nb - 1 - bid) : bid;
      const int idx = r * nb + pos;
      if (idx < 4096) {
        const int qh = 255 - (idx >> 4);
        const int rem = idx & 15;
        attn_item(p, l, rem >> 1, rem & 1, qh, smem);
      }
    }
    for (int it = nb - 1 - bid; it < 4096; it += nb) gmlp_item(p, l, it);
    gsync(grid);
    if (STOP_AFTER == 5 && l == 0) DUMP_BF16_AND_STOP(H)
    if ((STOP_AFTER == 51 || STOP_AFTER == 52) && l == 0) {
      for (size_t i = (size_t)bid * 256 + threadIdx.x; i < (size_t)TOK * 1024; i += (size_t)nb * 256) {
        const int col = (int)(i & 1023);
        const bool keep = (STOP_AFTER == 51) ? (col < 512) : (col >= 512);
        p.out[i] = keep ? bf2f(H[i]) : 0.f;
      }
      return;
    }
    {
      auto selT = [](int) { return true; };
      auto epi = [&](bool swp, int tm, int tn, int wm, int wn, int lr, int lg, auto& acc) {
        constexpr int MT = sizeof(acc) / sizeof(acc[0]);
        const int row0 = tm * (32 * MT) + wm * (16 * MT), col0 = tn * 128 + wn * 64;
        const int b = row0 >> 13;
#pragma unroll
        for (int ni = 0; ni < 4; ++ni) {
          const int col = col0 + ni * 16 + lg * 4;
          const float4 g1 = *(const float4*)(modl + (size_t)b * 6144 + 2048 + col);
#pragma unroll
          for (int mi = 0; mi < MT; ++mi) {
            const size_t row = (size_t)row0 + mi * 16 + lr;
            const float4 xv = *(const float4*)(xin + row * 1024 + col);
            float4 o4;
            o4.x = ALPHA * xv.x + (1.f + g1.x) * acc[mi][ni][0];
            o4.y = ALPHA * xv.y + (1.f + g1.y) * acc[mi][ni][1];
            o4.z = ALPHA * xv.z + (1.f + g1.z) * acc[mi][ni][2];
            o4.w = ALPHA * xv.w + (1.f + g1.w) * acc[mi][ni][3];
            *(float4*)(X1 + row * 1024 + col) = o4;
          }
        }
      };
      auto post = [&](int tm) { ln_block(X1, tm * 128, p.ln1_g + l * 1024, p.ln1_b + l * 1024, modl, 3072, 4096, H); };
      gemm_rowblock_phase(H, 1024, (const u16*)(ws + OFF_WTO + l * SZ_WTO), 1024, 512, 8, 1024, bid, nb, smem, epi, post);
    }
    gsync(grid);
    if (STOP_AFTER == 7 && l == 0) DUMP_F32_AND_STOP(X1)
    {
      u16* HH = (u16*)(wsA);
      auto selT = [](int) { return true; };
      auto epi = [&](bool swp, int tm, int tn, int wm, int wn, int lr, int lg, auto& acc) {
        constexpr int MT = sizeof(acc) / sizeof(acc[0]);
        const int row0 = tm * (32 * MT) + wm * (16 * MT);
        const int cb = tn * 64 + wn * 32;
#pragma unroll
        for (int mi = 0; mi < MT; ++mi)
#pragma unroll
          for (int ni = 0; ni < 2; ++ni) {
            const size_t row = (size_t)row0 + mi * 16 + lr;
            float v[4];
#pragma unroll
            for (int j = 0; j < 4; ++j) {
              const float a = acc[mi][ni][j], bb = acc[mi][ni + 2][j];
              v[j] = a * sigm(a) * bb;
            }
            uint2 st;
            st.x = pack2(v[0], v[1]);
            st.y = pack2(v[2], v[3]);
            *(uint2*)(HH + row * 2816 + cb + ni * 16 + lg * 4) = st;
          }
      };
      gemm_phase<8>(H, 1024, (const u16*)(ws + OFF_WT13 + l * SZ_WT13), 1024, 256, 44, 1024, bid, nb, smem, selT, epi);
    }
    gsync(grid);
    if (STOP_AFTER == 8 && l == 0) DUMP_BF16_AND_STOP(wsA)
    {
      const u16* HH = (const u16*)(wsA);
      float* outp = p.out;
      auto selT = [](int) { return true; };
      auto epi = [&](bool swp, int tm, int tn, int wm, int wn, int lr, int lg, auto& acc) {
        constexpr int MT = sizeof(acc) / sizeof(acc[0]);
        const int row0 = tm * (32 * MT) + wm * (16 * MT), col0 = tn * 128 + wn * 64;
        const int b = row0 >> 13;
#pragma unroll
        for (int ni = 0; ni < 4; ++ni) {
          const int col = col0 + ni * 16 + lg * 4;
          const float4 g2 = *(const float4*)(modl + (size_t)b * 6144 + 5120 + col);
#pragma unroll
          for (int mi = 0; mi < MT; ++mi) {
            const size_t row = (size_t)row0 + mi * 16 + lr;
            const float4 xv = *(const float4*)(X1 + row * 1024 + col);
            float4 o4;
            o4.x = ALPHA * xv.x + (1.f + g2.x) * acc[mi][ni][0];
            o4.y = ALPHA * xv.y + (1.f + g2.y) * acc[mi][ni][1];
            o4.z = ALPHA * xv.z + (1.f + g2.z) * acc[mi][ni][2];
            o4.w = ALPHA * xv.w + (1.f + g2.w) * acc[mi][ni][3];
            *(float4*)(outp + row * 1024 + col) = o4;
          }
        }
      };
      gemm_phase<8>(HH, 2816, (const u16*)(ws + OFF_WT2 + l * SZ_WT2), 2816, 256, 8, 2816, bid, nb, smem, selT, epi);
    }
    gsync(grid);
    if (l == 0) {
      ln_rows(p.out, p.ln2_g, p.ln2_b, mod + (size_t)8 * 6144, 0, 1024, H);
      gsync(grid);
    } else {
      ln_rows(p.out, p.ln2_g + 1024, p.ln2_b + 1024, nullptr, 0, 0, nullptr);
    }
  }
}

extern "C" void kernel_launch(void* const* d_in, const int* in_sizes, int n_in, void* d_out, int out_size, void* d_ws,
                              size_t ws_size, hipStream_t stream) {
  static int grid_blocks = 0;
  if (!grid_blocks) {
    int dev = 0, cus = 0, per_cu = 0;
    (void)hipGetDevice(&dev);
    (void)hipDeviceGetAttribute(&cus, hipDeviceAttributeMultiprocessorCount, dev);
    (void)hipFuncSetAttribute((const void*)mega, hipFuncAttributeMaxDynamicSharedMemorySize, LDS_BYTES);
    (void)hipOccupancyMaxActiveBlocksPerMultiprocessor(&per_cu, mega, 256, LDS_BYTES);
    if (per_cu > 2) per_cu = 2;
    if (per_cu < 1) per_cu = 1;
    grid_blocks = cus * per_cu;
  }
  Params p{};
  const float* const* in = (const float* const*)d_in;
  p.x = in[0]; p.c = in[1]; p.w_ada = in[2]; p.b_ada = in[3]; p.w_in = in[4]; p.cmp_pos = in[5]; p.cmp_w1 = in[6];
  p.cmp_w2 = in[7]; p.vn_g = in[8]; p.vn_b = in[9]; p.w_s = in[10]; p.b_s = in[11]; p.out_g = in[12]; p.w_o = in[13];
  p.ln1_g = in[14]; p.ln1_b = in[15]; p.w1 = in[16]; p.w3 = in[17]; p.w2 = in[18]; p.ln2_g = in[19]; p.ln2_b = in[20];
  p.out = (float*)d_out;
  p.ws = (char*)d_ws;
  void* args[] = {&p};
  hipError_t e = hipLaunchCooperativeKernel((void*)mega, dim3(grid_blocks), dim3(256), args, LDS_BYTES, stream);
  if (e != hipSuccess) fprintf(stderr, "cooperative launch failed: %s (grid %d)\n", hipGetErrorString(e), grid_blocks);
}
```

```cpp
#define STOP_AFTER 0
#include <hip/hip_runtime.h>
#include <hip/hip_cooperative_groups.h>
#include <cstdio>
namespace cg = cooperative_groups;

typedef unsigned short u16;
using bf16x8 = __attribute__((ext_vector_type(8))) short;
using f32x4 = __attribute__((ext_vector_type(4))) float;
using u32x4 = __attribute__((ext_vector_type(4))) unsigned;
#define DI __device__ __forceinline__
#define MFMA16(a, b, c) __builtin_amdgcn_mfma_f32_16x16x32_bf16((a), (b), (c), 0, 0, 0)

constexpr int S = 8192, TOK = 65536;
constexpr int INW = 2328, INP = 2432;
constexpr float ALPHA = 1.41421356237f;
constexpr float LOG2E = 1.4426950408889634f;
constexpr float QSCALE = 0.125f * LOG2E;
constexpr float NEGB = -1e30f, MINIT = -30000.f;
constexpr float EPS = 1e-5f;
constexpr int GMLP_EARLY = 2048;

constexpr size_t SZ_WTIN = (size_t)INP * 1024 * 2;
constexpr size_t SZ_WTO = (size_t)1024 * 1024 * 2;
constexpr size_t SZ_WT13 = (size_t)5632 * 1024 * 2;
constexpr size_t SZ_WT2 = (size_t)1024 * 2816 * 2;
constexpr size_t SZ_WTC1 = (size_t)256 * 2048 * 2;
constexpr size_t SZ_WTC2 = (size_t)128 * 256 * 2;
constexpr size_t OFF_WTIN = 0;
constexpr size_t OFF_WTO = OFF_WTIN + 2 * SZ_WTIN;
constexpr size_t OFF_WT13 = OFF_WTO + 2 * SZ_WTO;
constexpr size_t OFF_WT2 = OFF_WT13 + 2 * SZ_WT13;
constexpr size_t OFF_WTC1 = OFF_WT2 + 2 * SZ_WT2;
constexpr size_t OFF_WTC2 = OFF_WTC1 + 4 * SZ_WTC1;
constexpr size_t OFF_MODP = OFF_WTC2 + 4 * SZ_WTC2;
constexpr size_t SZ_MOD = (size_t)2 * 8 * 6144 * 4;
constexpr size_t OFF_MOD = OFF_MODP + 16 * SZ_MOD;
constexpr size_t SZ_CMP = (size_t)8 * 2 * 512 * 64 * 2;
constexpr size_t OFF_CB1P = OFF_MOD + SZ_MOD;
constexpr size_t OFF_CB1 = OFF_CB1P + 16 * 4 * 256 * 4;
constexpr size_t OFF_KCMP = OFF_CB1 + 4 * 256 * 4;
constexpr size_t OFF_VCMPT = OFF_KCMP + SZ_CMP;
constexpr size_t OFF_X1 = OFF_VCMPT + SZ_CMP;
constexpr size_t OFF_H = OFF_X1 + (size_t)TOK * 1024 * 4;
constexpr size_t OFF_A = OFF_H + (size_t)TOK * 1024 * 2;
constexpr size_t SZ_KV = (size_t)TOK * 128 * 2;
constexpr size_t A_Q = 0;
constexpr size_t A_KC = A_Q + (size_t)TOK * 512 * 2;
constexpr size_t A_VC = A_KC + SZ_KV;
constexpr size_t A_KS = A_VC + SZ_KV;
constexpr size_t A_VST = A_KS + SZ_KV;
constexpr size_t A_KW = A_VST + SZ_KV;
constexpr size_t A_VWT = A_KW + SZ_KV;
constexpr size_t A_G = A_VWT + SZ_KV;
constexpr size_t A_U = A_G + (size_t)TOK * 24 * 4;
constexpr size_t A_VGT = A_U + (size_t)TOK * 512 * 2;
constexpr size_t A_AC = A_VGT + (size_t)TOK * 512 * 2;
constexpr size_t A_HC = A_AC + (size_t)2 * 8192 * 2048 * 2;
constexpr size_t A_END = A_HC + (size_t)2 * 8192 * 256 * 2;
constexpr size_t OFF_ST1 = OFF_A + A_END;
constexpr size_t OFF_ST2 = OFF_ST1 + (size_t)TOK * 8;
constexpr size_t OFF_BAR = OFF_ST2 + (size_t)TOK * 8;

struct Params {
  const float *x, *c, *w_ada, *b_ada, *w_in, *cmp_pos, *cmp_w1, *cmp_w2, *vn_g, *vn_b, *w_s, *b_s, *out_g, *w_o,
      *ln1_g, *ln1_b, *w1, *w3, *w2, *ln2_g, *ln2_b;
  float* out;
  char* ws;
};

DI u16 f2bf(float x) { unsigned u = __float_as_uint(x); u += 0x7fffu + ((u >> 16) & 1u); return (u16)(u >> 16); }
DI float bf2f(u16 h) { return __uint_as_float(((unsigned)h) << 16); }
typedef __bf16 bf16x2_t __attribute__((ext_vector_type(2)));
typedef float f32x2_t __attribute__((ext_vector_type(2)));
DI unsigned pack2(float a, float b) {
  f32x2_t v = {a, b};
  bf16x2_t r = __builtin_convertvector(v, bf16x2_t);
  return __builtin_bit_cast(unsigned, r);
}
DI float gelu_t(float x) { float u = 1.5957691216f * (x + 0.044715f * x * x * x); return x / (1.f + __expf(-u)); }
DI float sigm(float x) { return 1.f / (1.f + __expf(-x)); }
DI float ex2(float x) { return __builtin_amdgcn_exp2f(x); }
typedef unsigned u32x2v __attribute__((ext_vector_type(2)));
DI float rows_max(float x) {
  u32x2v a = __builtin_amdgcn_permlane16_swap(__float_as_uint(x), __float_as_uint(x), false, false);
  const float m1 = fmaxf(__uint_as_float(a[0]), __uint_as_float(a[1]));
  u32x2v b = __builtin_amdgcn_permlane32_swap(__float_as_uint(m1), __float_as_uint(m1), false, false);
  return fmaxf(__uint_as_float(b[0]), __uint_as_float(b[1]));
}
DI float rows_sum(float x) {
  u32x2v a = __builtin_amdgcn_permlane16_swap(__float_as_uint(x), __float_as_uint(x), false, false);
  const float s1 = __uint_as_float(a[0]) + __uint_as_float(a[1]);
  u32x2v b = __builtin_amdgcn_permlane32_swap(__float_as_uint(s1), __float_as_uint(s1), false, false);
  return __uint_as_float(b[0]) + __uint_as_float(b[1]);
}
DI int otid() { int t = threadIdx.x; asm volatile("" : "+v"(t)); return t; }

template <int MODE> DI int map_row(int n) {
  if (MODE == 1) return n < 1280 ? n : (n < 1304 ? n + 1024 : n - 24);
  if (MODE == 2) return (n >> 5) * 64 + (n & 31);
  if (MODE == 3) return (n >> 5) * 64 + 32 + (n & 31);
  return n;
}

template <int MODE>
DI void conv_tile(const float* __restrict__ W, int K, int N, u16* __restrict__ Wt, int ldk, int tile, float* tl) {
  const int tiles_n = (N + 63) / 64;
  const int tk = tile / tiles_n, tn = tile % tiles_n;
  const int k0 = tk * 64, n0 = tn * 64;
  const int tid = otid();
#pragma unroll
  for (int i = 0; i < 16; ++i) {
    int idx = tid + 256 * i;
    int r = idx >> 6, c = idx & 63;
    int n = n0 + c;
    tl[r * 65 + c] = (n < N) ? W[(long)(k0 + r) * N + n] : 0.f;
  }
  __syncthreads();
  const int nl = tid >> 2, kc = tid & 3;
  const int n = n0 + nl;
  if (n < N) {
    const int row = map_row<MODE>(n);
    unsigned pk[8];
#pragma unroll
    for (int i = 0; i < 8; ++i) pk[i] = pack2(tl[(kc * 16 + 2 * i) * 65 + nl], tl[(kc * 16 + 2 * i + 1) * 65 + nl]);
    uint4* dst = (uint4*)(Wt + (long)row * ldk + k0 + kc * 16);
    dst[0] = make_uint4(pk[0], pk[1], pk[2], pk[3]);
    dst[1] = make_uint4(pk[4], pk[5], pk[6], pk[7]);
  }
  __syncthreads();
}

DI void phase0a(const Params& p, char* smem) {
  char* ws = p.ws;
  const int tid = threadIdx.x;
  constexpr int PER_LAYER = 592 + 256 + 704 * 3 + 128 * 2 + 4 * 2;
  constexpr int NCONV = 2 * PER_LAYER;
  constexpr int NTOT = NCONV + 768 + 2 + 64;
  for (int it = blockIdx.x; it < NTOT; it += gridDim.x) {
    if (it < NCONV) {
      const int l = it / PER_LAYER;
      const int li = it % PER_LAYER;
      int base = 0;
#define SEG(MODE, SRC, DST, K_, N_, LDK)                                                   \
  {                                                                                        \
    const int nt_ = ((K_) / 64) * (((N_) + 63) / 64);                                      \
    if (li >= base && li < base + nt_) conv_tile<MODE>(SRC, K_, N_, DST, LDK, li - base, (float*)smem); \
    base += nt_;                                                                           \
  }
      SEG(1, p.w_in + (size_t)l * 1024 * INW, (u16*)(ws + OFF_WTIN + l * SZ_WTIN), 1024, INW, 1024)
      SEG(0, p.w_o + (size_t)l * 1024 * 1024, (u16*)(ws + OFF_WTO + l * SZ_WTO), 1024, 1024, 1024)
      SEG(2, p.w1 + (size_t)l * 1024 * 2816, (u16*)(ws + OFF_WT13 + l * SZ_WT13), 1024, 2816, 1024)
      SEG(3, p.w3 + (size_t)l * 1024 * 2816, (u16*)(ws + OFF_WT13 + l * SZ_WT13), 1024, 2816, 1024)
      SEG(0, p.w2 + (size_t)l * 2816 * 1024, (u16*)(ws + OFF_WT2 + l * SZ_WT2), 2816, 1024, 2816)
      SEG(0, p.cmp_w1 + (size_t)(l * 2 + 0) * 2048 * 256, (u16*)(ws + OFF_WTC1 + (l * 2 + 0) * SZ_WTC1), 2048, 256, 2048)
      SEG(0, p.cmp_w1 + (size_t)(l * 2 + 1) * 2048 * 256, (u16*)(ws + OFF_WTC1 + (l * 2 + 1) * SZ_WTC1), 2048, 256, 2048)
      SEG(0, p.cmp_w2 + (size_t)(l * 2 + 0) * 256 * 64, (u16*)(ws + OFF_WTC2 + (l * 2 + 0) * SZ_WTC2), 256, 64, 256)
      SEG(0, p.cmp_w2 + (size_t)(l * 2 + 1) * 256 * 64, (u16*)(ws + OFF_WTC2 + (l * 2 + 1) * SZ_WTC2), 256, 64, 256)
#undef SEG
    } else if (it < NCONV + 768) {
      const int idx = it - NCONV;
      const int l = idx / 384, r = idx % 384, nb = r / 16, kc = r % 16;
      float* cs = (float*)smem;
      for (int i = tid; i < 512; i += 256) {
        int b = i >> 6, k = i & 63;
        float cv = p.c[b * 1024 + kc * 64 + k];
        cs[i] = cv * sigm(cv);
      }
      __syncthreads();
      const int n = nb * 256 + tid;
      float acc[8];
#pragma unroll
      for (int b = 0; b < 8; ++b) acc[b] = 0.f;
      const float* wp = p.w_ada + ((size_t)l * 1024 + kc * 64) * 6144 + n;
#pragma unroll 8
      for (int k = 0; k < 64; ++k) {
        float wv = wp[(size_t)k * 6144];
#pragma unroll
        for (int b = 0; b < 8; ++b) acc[b] += cs[b * 64 + k] * wv;
      }
      float* modp = (float*)(ws + OFF_MODP);
#pragma unroll
      for (int b = 0; b < 8; ++b) modp[(size_t)((kc * 2 + l) * 8 + b) * 6144 + n] = acc[b];
      __syncthreads();
    } else if (it < NCONV + 768 + 2) {
      const int l = it - NCONV - 768;
      uint4* dst = (uint4*)(ws + OFF_WTIN + l * SZ_WTIN + (size_t)INW * 1024 * 2);
      const int n16 = (INP - INW) * 1024 * 2 / 16;
      for (int i = tid; i < n16; i += 256) dst[i] = make_uint4(0, 0, 0, 0);
    } else {
      const int idx = it - NCONV - 768 - 2;
      const int lw = idx >> 4, kc = idx & 15;
      const float* pos = p.cmp_pos + (size_t)lw * 2048 + kc * 128;
      const float* w1p = p.cmp_w1 + ((size_t)lw * 2048 + kc * 128) * 256 + tid;
      float a = 0.f;
#pragma unroll 8
      for (int k = 0; k < 128; ++k) a += pos[k] * w1p[(size_t)k * 256];
      ((float*)(ws + OFF_CB1P))[(kc * 4 + lw) * 256 + tid] = a;
    }
  }
}

DI void phase0b(const Params& p) {
  const float* modp = (const float*)(p.ws + OFF_MODP);
  float* mod = (float*)(p.ws + OFF_MOD);
  const int n = 2 * 8 * 6144;
  for (int i = blockIdx.x * 256 + threadIdx.x; i < n; i += gridDim.x * 256) {
    int l = i / (8 * 6144), c = i % 6144;
    float a = p.b_ada[l * 6144 + c];
#pragma unroll
    for (int kc = 0; kc < 16; ++kc) a += modp[(size_t)kc * n + i];
    mod[i] = a;
  }
  const float* cbp = (const float*)(p.ws + OFF_CB1P);
  float* cb = (float*)(p.ws + OFF_CB1);
  for (int i = blockIdx.x * 256 + threadIdx.x; i < 1024; i += gridDim.x * 256) {
    float a = 0.f;
#pragma unroll
    for (int kc = 0; kc < 16; ++kc) a += cbp[kc * 1024 + i];
    cb[i] = a;
  }
}

DI void phase_mod_x(const Params& p) {
  const float* mod = (const float*)(p.ws + OFF_MOD);
  u16* H = (u16*)(p.ws + OFF_H);
  const long nchunk = (long)TOK * 1024 / 8;
  const long stride = (long)gridDim.x * 256;
  for (long i = (long)blockIdx.x * 256 + otid(); i < nchunk / 2; i += stride) {
    float4 xa[2][2], sa[2][2], ha[2][2];
    long ee[2];
#pragma unroll
    for (int u = 0; u < 2; ++u) {
      const long e = (i + u * (nchunk / 2)) * 8;
      ee[u] = e;
      const int col = (int)(e & 1023);
      const int b = (int)(e >> 23);
      const float4* xp = (const float4*)(p.x + e);
      const float4* sh = (const float4*)(mod + (size_t)b * 6144 + 0 + col);
      const float4* sc = (const float4*)(mod + (size_t)b * 6144 + 1024 + col);
      xa[u][0] = xp[0]; xa[u][1] = xp[1];
      sa[u][0] = sc[0]; sa[u][1] = sc[1];
      ha[u][0] = sh[0]; ha[u][1] = sh[1];
    }
#pragma unroll
    for (int u = 0; u < 2; ++u) {
      const float4 x0 = xa[u][0], x1 = xa[u][1], s0 = sa[u][0], s1 = sa[u][1], h0 = ha[u][0], h1 = ha[u][1];
      uint4 o;
      o.x = pack2(x0.x * (1.f + s0.x) + h0.x, x0.y * (1.f + s0.y) + h0.y);
      o.y = pack2(x0.z * (1.f + s0.z) + h0.z, x0.w * (1.f + s0.w) + h0.w);
      o.z = pack2(x1.x * (1.f + s1.x) + h1.x, x1.y * (1.f + s1.y) + h1.y);
      o.w = pack2(x1.z * (1.f + s1.z) + h1.z, x1.w * (1.f + s1.w) + h1.w);
      *(uint4*)(H + ee[u]) = o;
    }
  }
}

constexpr int LDS_BYTES = 73728 + 16;
DI int swz_key(int r) { return (0x78 >> (2 * ((r >> 2) & 3))) & 3; }
template <int MT>
DI void g_issue(const u16* __restrict__ Ap, int lda, const u16* __restrict__ Bp, int ldb, int st, int ksa, int tid, char* buf) {
  constexpr int AOFF = 2048 * MT;
  const int koffA = (st >> 1) * ksa + (st & 1) * 32;
  const int koffB = st * 32;
  const int wbase = (tid & ~63) * 16;
#pragma unroll
  for (int i = 0; i < MT / 2; ++i) {
    const int c = tid + 256 * i;
    const int row = c >> 2, ph = c & 3;
    const int lc = ph ^ swz_key(row);
    __builtin_amdgcn_global_load_lds((const unsigned*)(Ap + (size_t)row * lda + koffA + lc * 8),
                                     (unsigned*)(buf + i * 4096 + wbase), 16, 0, 0);
  }
#pragma unroll
  for (int i = 0; i < 2; ++i) {
    const int c = tid + 256 * i;
    const int row = c >> 2, ph = c & 3;
    const int lc = ph ^ swz_key(row);
    __builtin_amdgcn_global_load_lds((const unsigned*)(Bp + (size_t)row * ldb + koffB + lc * 8),
                                     (unsigned*)(buf + AOFF + i * 4096 + wbase), 16, 0, 0);
  }
}
#define DSR(dst, addr, off) "ds_read_b128 %" #dst ", %" #addr " offset:" #off "\n\t"
template <bool SWAP, int MT>
DI void g_compute(const char* sA, f32x4 (&acc)[MT][4], int wm, int wn, int lr, int lg) {
  const int ra = wm * (16 * MT) + lr, rb = wn * 64 + lr;
  const unsigned aA = (unsigned)(size_t)sA + ra * 64 + ((lg ^ swz_key(ra)) << 4);
  const unsigned aB = (unsigned)(size_t)sA + 2048 * MT + rb * 64 + ((lg ^ swz_key(rb)) << 4);
  bf16x8 af[MT], bfr[4];
  if constexpr (MT == 8) {
    asm volatile(DSR(0, 8, 0) DSR(1, 8, 1024) DSR(2, 8, 2048) DSR(3, 8, 3072) DSR(4, 9, 0) DSR(5, 9, 1024) DSR(6, 9, 2048) DSR(7, 9, 3072)
                 : "=&v"(bfr[0]), "=&v"(bfr[1]), "=&v"(bfr[2]), "=&v"(bfr[3]), "=&v"(af[0]), "=&v"(af[1]), "=&v"(af[2]), "=&v"(af[3])
                 : "v"(aB), "v"(aA)
                 : "memory");
    asm volatile(DSR(0, 4, 4096) DSR(1, 4, 5120) DSR(2, 4, 6144) DSR(3, 4, 7168)
                 : "=&v"(af[4]), "=&v"(af[5]), "=&v"(af[6]), "=&v"(af[7])
                 : "v"(aA)
                 : "memory");
    asm volatile("s_waitcnt lgkmcnt(4)"
                 : "+v"(bfr[0]), "+v"(bfr[1]), "+v"(bfr[2]), "+v"(bfr[3]), "+v"(af[0]), "+v"(af[1]), "+v"(af[2]), "+v"(af[3]));
  } else {
    asm volatile(DSR(0, 6, 0) DSR(1, 6, 1024) DSR(2, 6, 2048) DSR(3, 6, 3072) DSR(4, 7, 0) DSR(5, 7, 1024)
                 : "=&v"(bfr[0]), "=&v"(bfr[1]), "=&v"(bfr[2]), "=&v"(bfr[3]), "=&v"(af[0]), "=&v"(af[1])
                 : "v"(aB), "v"(aA)
                 : "memory");
    asm volatile(DSR(0, 2, 2048) DSR(1, 2, 3072) : "=&v"(af[2]), "=&v"(af[3]) : "v"(aA) : "memory");
    asm volatile("s_waitcnt lgkmcnt(2)"
                 : "+v"(bfr[0]), "+v"(bfr[1]), "+v"(bfr[2]), "+v"(bfr[3]), "+v"(af[0]), "+v"(af[1]));
  }
  __builtin_amdgcn_sched_barrier(0);
#pragma unroll
  for (int mi = 0; mi < MT / 2; ++mi)
#pragma unroll
    for (int ni = 0; ni < 4; ++ni)
      acc[mi][ni] = SWAP ? MFMA16(bfr[ni], af[mi], acc[mi][ni]) : MFMA16(af[mi], bfr[ni], acc[mi][ni]);
  __builtin_amdgcn_sched_barrier(0);
  if constexpr (MT == 8) asm volatile("s_waitcnt lgkmcnt(0)" : "+v"(af[4]), "+v"(af[5]), "+v"(af[6]), "+v"(af[7]), "+v"(acc[3][3]));
  else asm volatile("s_waitcnt lgkmcnt(0)" : "+v"(af[2]), "+v"(af[3]), "+v"(acc[1][3]));
  __builtin_amdgcn_sched_barrier(0);
#pragma unroll
  for (int mi = MT / 2; mi < MT; ++mi)
#pragma unroll
    for (int ni = 0; ni < 4; ++ni)
      acc[mi][ni] = SWAP ? MFMA16(bfr[ni], af[mi], acc[mi][ni]) : MFMA16(af[mi], bfr[ni], acc[mi][ni]);
  __builtin_amdgcn_sched_barrier(0);
}
#define RAW_BARRIER() do { asm volatile("s_waitcnt lgkmcnt(0)" ::: "memory"); __builtin_amdgcn_s_barrier(); } while (0)

template <bool SWAP, int MT, class Epi>
DI void gemm_tile(const u16* __restrict__ Ap, int lda, const u16* __restrict__ Bp, int ldb, int nk, int tm, int tn, int tid,
                  char* smem, Epi epi, int ksa = 64) {
  constexpr int NBUF = (MT == 8) ? 3 : 4;
  constexpr int BUFSZ = 2048 * MT + 8192;
  constexpr int LA = NBUF - 1;
  const int lane = tid & 63, w = tid >> 6, wm = w >> 1, wn = w & 1;
  const int lr = lane & 15, lg = lane >> 4;
  const int nks = nk * 2;
  f32x4 acc[MT][4];
#pragma unroll
  for (int i = 0; i < MT; ++i)
#pragma unroll
    for (int j = 0; j < 4; ++j) acc[i][j] = f32x4{0.f, 0.f, 0.f, 0.f};
#pragma unroll
  for (int s = 0; s < LA; ++s) g_issue<MT>(Ap, lda, Bp, ldb, s, ksa, tid, smem + s * BUFSZ);
  int bi = 0, bn = LA;
  for (int st = 0; st < nks; ++st) {
    if (MT == 8) {
      if (st + 1 < nks) asm volatile("s_waitcnt vmcnt(6)" ::: "memory");
      else asm volatile("s_waitcnt vmcnt(0)" ::: "memory");
    } else {
      if (st + 2 < nks) asm volatile("s_waitcnt vmcnt(8)" ::: "memory");
      else if (st + 1 < nks) asm volatile("s_waitcnt vmcnt(4)" ::: "memory");
      else asm volatile("s_waitcnt vmcnt(0)" ::: "memory");
    }
    RAW_BARRIER();
    if (st + LA < nks) g_issue<MT>(Ap, lda, Bp, ldb, st + LA, ksa, tid, smem + bn * BUFSZ);
    g_compute<SWAP, MT>(smem + bi * BUFSZ, acc, wm, wn, lr, lg);
    bi = (bi + 1 == NBUF) ? 0 : bi + 1;
    bn = (bn + 1 == NBUF) ? 0 : bn + 1;
  }
  RAW_BARRIER();
  epi(SWAP, tm, tn, wm, wn, lr, lg, acc);
}

template <int MT, class AB, class Sel, class Epi>
DI void gemm_phase_g(AB abase, int lda, int ksa, const u16* __restrict__ Bt, int ldb, int ntm, int ntn, int K, int vb, int nvb,
                     char* smem, Sel swapsel, Epi epi) {
  if (vb < 0 || vb >= nvb) return;
  const int ntiles = ntm * ntn;
  const int nk = K / 64;
  const int nbx = nvb >> 3;
  const int x = vb & 7, lb = vb >> 3;
  const int rgt = 4 * ntn;
  const int per_xcd = (ntm >> 5) * rgt;
  for (int ql = lb; ql < per_xcd; ql += nbx) {
    const int rgi = ql / rgt;
    const int i = ql - rgi * rgt;
    const int tn = i >> 2;
    const int tm = (x + 8 * rgi) * 4 + (i & 3);
    const u16* Ap = abase(tm);
    const u16* Bp = Bt + (size_t)tn * 128 * ldb;
    const int tid = otid();
    if (swapsel(tn)) gemm_tile<true, MT>(Ap, lda, Bp, ldb, nk, tm, tn, tid, smem, epi, ksa);
    else gemm_tile<false, MT>(Ap, lda, Bp, ldb, nk, tm, tn, tid, smem, epi, ksa);
  }
}
template <int MT, class Sel, class Epi>
DI void gemm_phase(const u16* __restrict__ A, int lda, const u16* __restrict__ Bt, int ldb, int ntm, int ntn, int K,
                   int vb, int nvb, char* smem, Sel swapsel, Epi epi) {
  auto ab = [=](int tm) { return A + (size_t)tm * (32 * MT) * lda; };
  gemm_phase_g<MT>(ab, lda, 64, Bt, ldb, ntm, ntn, K, vb, nvb, smem, swapsel, epi);
}
template <class Epi, class Post>
DI void gemm_rowblock_phase(const u16* __restrict__ A, int lda, const u16* __restrict__ Bt, int ldb, int ntm, int ntn, int K,
                            int vb, int nvb, char* smem, Epi epi, Post post) {
  const int nk = K / 64;
  for (int tm = vb; tm < ntm; tm += nvb) {
    const u16* Ap = A + (size_t)tm * 128 * lda;
    for (int tn = 0; tn < ntn; ++tn) {
      const int tid = otid();
      gemm_tile<true, 4>(Ap, lda, Bt + (size_t)tn * 128 * ldb, ldb, nk, tm, tn, tid, smem, epi, 64);
    }
    asm volatile("s_waitcnt vmcnt(0)" ::: "memory");
    __syncthreads();
    post(tm);
  }
}

DI void ln_rows(float* buf, const float* __restrict__ g, const float* __restrict__ bt, const float* __restrict__ modl,
                int sh_off, int sc_off, u16* H, float* stats, bool write_x) {
  const int tid_ = otid();
  const int lane = tid_ & 63, w = tid_ >> 6;
  constexpr int NR = 4;
  for (int r0 = (blockIdx.x * 4 + w) * NR; r0 < TOK; r0 += gridDim.x * 4 * NR) {
    f32x4 v[NR][4];
#pragma unroll
    for (int rr = 0; rr < NR; ++rr) {
      const f32x4* rp = (const f32x4*)(buf + (size_t)(r0 + rr) * 1024);
#pragma unroll
      for (int i = 0; i < 4; ++i) v[rr][i] = rp[lane + 64 * i];
    }
    float s[NR], q[NR];
#pragma unroll
    for (int rr = 0; rr < NR; ++rr) {
      s[rr] = 0.f;
#pragma unroll
      for (int i = 0; i < 4; ++i) s[rr] += v[rr][i][0] + v[rr][i][1] + v[rr][i][2] + v[rr][i][3];
    }
#pragma unroll
    for (int o = 32; o >= 1; o >>= 1) {
#pragma unroll
      for (int rr = 0; rr < NR; ++rr) s[rr] += __shfl_xor(s[rr], o);
    }
#pragma unroll
    for (int rr = 0; rr < NR; ++rr) {
      const float mu = s[rr] * (1.f / 1024.f);
      q[rr] = 0.f;
#pragma unroll
      for (int i = 0; i < 4; ++i)
#pragma unroll
        for (int k = 0; k < 4; ++k) { const float a = v[rr][i][k] - mu; q[rr] += a * a; }
    }
#pragma unroll
    for (int o = 32; o >= 1; o >>= 1) {
#pragma unroll
      for (int rr = 0; rr < NR; ++rr) q[rr] += __shfl_xor(q[rr], o);
    }
    const int b = r0 >> 13;
#pragma unroll
    for (int rr = 0; rr < NR; ++rr) {
      const int row = r0 + rr;
      const float mu = s[rr] * (1.f / 1024.f);
      const float rs = rsqrtf(q[rr] * (1.f / 1024.f) + EPS);
      if (stats && lane == 0) *(float2*)(stats + (size_t)row * 2) = make_float2(mu, rs);
      f32x4* rp = (f32x4*)(buf + (size_t)row * 1024);
#pragma unroll
      for (int i = 0; i < 4; ++i) {
        const int col = (lane + 64 * i) * 4;
        const float4 gg = *(const float4*)(g + col), bb = *(const float4*)(bt + col);
        f32x4 y;
        y[0] = (v[rr][i][0] - mu) * rs * gg.x + bb.x;
        y[1] = (v[rr][i][1] - mu) * rs * gg.y + bb.y;
        y[2] = (v[rr][i][2] - mu) * rs * gg.z + bb.z;
        y[3] = (v[rr][i][3] - mu) * rs * gg.w + bb.w;
        if (write_x) rp[lane + 64 * i] = y;
        if (H) {
          const float4 sh = *(const float4*)(modl + (size_t)b * 6144 + sh_off + col);
          const float4 sc = *(const float4*)(modl + (size_t)b * 6144 + sc_off + col);
          uint2 o2;
          o2.x = pack2(y[0] * (1.f + sc.x) + sh.x, y[1] * (1.f + sc.y) + sh.y);
          o2.y = pack2(y[2] * (1.f + sc.z) + sh.z, y[3] * (1.f + sc.w) + sh.w);
          *(uint2*)(H + (size_t)row * 1024 + col) = o2;
        }
      }
    }
  }
}

DI void ln_block(float* buf, int row0, const float* __restrict__ g, const float* __restrict__ bt,
                 const float* __restrict__ modl, int sh_off, int sc_off, u16* H) {
  const int tid_ = otid();
  const int lane = tid_ & 63, w = tid_ >> 6;
  for (int rr = 0; rr < 32; ++rr) {
    const int row = row0 + w * 32 + rr;
    f32x4* rp = (f32x4*)(buf + (size_t)row * 1024);
    f32x4 v[4];
    float s = 0.f;
#pragma unroll
    for (int i = 0; i < 4; ++i) { v[i] = __builtin_nontemporal_load(rp + lane + 64 * i); s += v[i][0] + v[i][1] + v[i][2] + v[i][3]; }
#pragma unroll
    for (int o = 32; o >= 1; o >>= 1) s += __shfl_xor(s, o);
    const float mu = s * (1.f / 1024.f);
    float q = 0.f;
#pragma unroll
    for (int i = 0; i < 4; ++i)
#pragma unroll
      for (int k = 0; k < 4; ++k) { float a = v[i][k] - mu; q += a * a; }
#pragma unroll
    for (int o = 32; o >= 1; o >>= 1) q += __shfl_xor(q, o);
    const float rs = rsqrtf(q * (1.f / 1024.f) + EPS);
    const int b = row >> 13;
#pragma unroll
    for (int i = 0; i < 4; ++i) {
      const int col = (lane + 64 * i) * 4;
      const float4 gg = *(const float4*)(g + col), bb = *(const float4*)(bt + col);
      f32x4 y;
      y[0] = (v[i][0] - mu) * rs * gg.x + bb.x;
      y[1] = (v[i][1] - mu) * rs * gg.y + bb.y;
      y[2] = (v[i][2] - mu) * rs * gg.z + bb.z;
      y[3] = (v[i][3] - mu) * rs * gg.w + bb.w;
      rp[lane + 64 * i] = y;
      if (H) {
        const float4 sh = *(const float4*)(modl + (size_t)b * 6144 + sh_off + col);
        const float4 sc = *(const float4*)(modl + (size_t)b * 6144 + sc_off + col);
        uint2 o2;
        o2.x = pack2(y[0] * (1.f + sc.x) + sh.x, y[1] * (1.f + sc.y) + sh.y);
        o2.y = pack2(y[2] * (1.f + sc.z) + sh.z, y[3] * (1.f + sc.w) + sh.w);
        *(uint2*)(H + (size_t)row * 1024 + col) = o2;
      }
    }
  }
}

DI void gmlp_item(const Params& p, int l, int item) {
  const int b = item >> 9, c = (item >> 3) & 63, grp = item & 7;
  const int tid_ = otid();
  const int lane = tid_ & 63, w = tid_ >> 6, lr = lane & 15, lg = lane >> 4;
  const float* wsp = p.w_s + (size_t)(l * 8 + grp) * 128 * 128;
  const u16* vgt = (const u16*)(p.ws + OFF_A + A_VGT) + (size_t)(b * 8 + grp) * 64 * S + c * 128;
  const u16* U = (const u16*)(p.ws + OFF_A + A_U);
  u16* OM = (u16*)(p.ws + OFF_H);
  f32x4 acc[4][2];
#pragma unroll
  for (int i = 0; i < 4; ++i)
#pragma unroll
    for (int j = 0; j < 2; ++j) acc[i][j] = f32x4{0.f, 0.f, 0.f, 0.f};
#pragma unroll
  for (int ks = 0; ks < 4; ++ks) {
    const int s0 = ks * 32 + lg * 8;
    bf16x8 af[4];
#pragma unroll
    for (int dt = 0; dt < 4; ++dt) af[dt] = *(const bf16x8*)(vgt + (size_t)(dt * 16 + lr) * S + s0);
#pragma unroll
    for (int nt = 0; nt < 2; ++nt) {
      const int t = w * 32 + nt * 16 + lr;
      const float4* wp = (const float4*)(wsp + t * 128 + s0);
      float4 a0 = wp[0], a1 = wp[1];
      unsigned pw[4];
      pw[0] = pack2((s0 + 0 <= t) ? a0.x : 0.f, (s0 + 1 <= t) ? a0.y : 0.f);
      pw[1] = pack2((s0 + 2 <= t) ? a0.z : 0.f, (s0 + 3 <= t) ? a0.w : 0.f);
      pw[2] = pack2((s0 + 4 <= t) ? a1.x : 0.f, (s0 + 5 <= t) ? a1.y : 0.f);
      pw[3] = pack2((s0 + 6 <= t) ? a1.z : 0.f, (s0 + 7 <= t) ? a1.w : 0.f);
      bf16x8 bw = __builtin_bit_cast(bf16x8, make_uint4(pw[0], pw[1], pw[2], pw[3]));
#pragma unroll
      for (int dt = 0; dt < 4; ++dt) acc[dt][nt] = MFMA16(af[dt], bw, acc[dt][nt]);
    }
  }
#pragma unroll
  for (int nt = 0; nt < 2; ++nt) {
    const int t = w * 32 + nt * 16 + lr;
    const size_t tok = (size_t)b * S + c * 128 + t;
    const float bias = p.b_s[(l * 8 + grp) * 128 + t];
    float val[4][4];
    float ss = 0.f;
#pragma unroll
    for (int dt = 0; dt < 4; ++dt) {
      const int d = dt * 16 + lg * 4;
      const uint2 uu = *(const uint2*)(U + tok * 512 + grp * 64 + d);
      const float u0 = bf2f(uu.x & 0xffff), u1 = bf2f(uu.x >> 16), u2 = bf2f(uu.y & 0xffff), u3 = bf2f(uu.y >> 16);
      val[dt][0] = u0 * (acc[dt][nt][0] + bias);
      val[dt][1] = u1 * (acc[dt][nt][1] + bias);
      val[dt][2] = u2 * (acc[dt][nt][2] + bias);
      val[dt][3] = u3 * (acc[dt][nt][3] + bias);
#pragma unroll
      for (int j = 0; j < 4; ++j) ss += val[dt][j] * val[dt][j];
    }
    ss = rows_sum(ss);
    const float r = rsqrtf(ss * (1.f / 64.f) + EPS);
#pragma unroll
    for (int dt = 0; dt < 4; ++dt) {
      const int d = dt * 16 + lg * 4;
      const float4 gg = *(const float4*)(p.out_g + l * 1024 + 512 + grp * 64 + d);
      uint2 st;
      st.x = pack2(val[dt][0] * r * gg.x, val[dt][1] * r * gg.y);
      st.y = pack2(val[dt][2] * r * gg.z, val[dt][3] * r * gg.w);
      *(uint2*)(OM + tok * 1024 + 512 + grp * 64 + d) = st;
    }
  }
}

constexpr int SM_K = 0, SM_V = 8192, SM_IMP = 8192 + 8704, SM_SEL = SM_IMP + 64 * 132 * 4, SM_UNI = SM_SEL + 1024;

struct KVr { u32x4 k0, k1, v0, v1; };
DI void kv_load_k(KVr& t, const u16* __restrict__ src, int stride, int tid) {
  const int r = tid >> 3, ch = tid & 7;
  t.k0 = *(const u32x4*)(src + (size_t)r * stride + ch * 8);
  t.k1 = *(const u32x4*)(src + (size_t)(r + 32) * stride + ch * 8);
}
DI void kv_load_v(KVr& t, const u16* __restrict__ src, int stride, int tid) {
  const int d = tid >> 3, ch = tid & 7;
  t.v0 = *(const u32x4*)(src + (size_t)d * stride + ch * 8);
  t.v1 = *(const u32x4*)(src + (size_t)(d + 32) * stride + ch * 8);
}
DI void kv_store_k(const KVr& t, char* sK, int tid) {
  const int r = tid >> 3, ch = tid & 7;
  char* pk = sK + r * 128 + ((ch ^ (r & 7)) << 4);
  *(u32x4*)(pk) = t.k0;
  *(u32x4*)(pk + 4096) = t.k1;
}
DI void kv_store_v(const KVr& t, char* sV, int tid) {
  const int d = tid >> 3, ch = tid & 7;
  uint2* d0 = (uint2*)(sV + d * 136 + ch * 16);
  d0[0] = make_uint2(t.v0[0], t.v0[1]);
  d0[1] = make_uint2(t.v0[2], t.v0[3]);
  uint2* d1 = (uint2*)(sV + (d + 32) * 136 + ch * 16);
  d1[0] = make_uint2(t.v1[0], t.v1[1]);
  d1[1] = make_uint2(t.v1[2], t.v1[3]);
}
DI int prev_set_bit(const unsigned* uni, int from) {
  int res = -1;
#pragma unroll
  for (int wd = 0; wd < 4; ++wd) {
    unsigned mw = uni[wd];
    const int hi = from - wd * 32;
    if (hi < 0) mw = 0u;
    else if (hi < 31) mw &= (2u << hi) - 1u;
    if (mw) res = wd * 32 + 31 - __clz(mw);
  }
  return __builtin_amdgcn_readfirstlane(res);
}
DI int next_set_bit(const unsigned* uni, int from) {
  int res = 1000;
#pragma unroll
  for (int wd = 3; wd >= 0; --wd) {
    unsigned mw = uni[wd];
    const int lo = from - wd * 32;
    if (lo >= 32) mw = 0u;
    else if (lo > 0) mw &= (~0u) << lo;
    if (mw) res = wd * 32 + __ffs(mw) - 1;
  }
  return __builtin_amdgcn_readfirstlane(res);
}

template <int MODE, bool MASKED, int WS>
DI void half_step(const char* sK, const char* sV, int half, int lr, int lg, const bf16x8 (&qf)[2][2], const unsigned (&sw)[2],
                  const float (&tb)[2], float (&m)[2], float (&lsum)[2], f32x4 (&o)[2][4], const bool (&valid)[2][4],
                  float (&psum)[2][4]) {
  bf16x8 kf[2][2], kw[2];
#pragma unroll
  for (int kt2 = 0; kt2 < 2; ++kt2) {
    const int r = half * 32 + kt2 * 16 + lr;
    kf[kt2][0] = *(const bf16x8*)(sK + r * 128 + (((lg) ^ (r & 7)) << 4));
    kf[kt2][1] = *(const bf16x8*)(sK + r * 128 + (((4 + lg) ^ (r & 7)) << 4));
    const float wv = (float)(WS * r);
    const unsigned pw = (lg == 0) ? pack2(wv, wv) : 0u;
    kw[kt2] = __builtin_bit_cast(bf16x8, make_uint4(pw, 0u, 0u, 0u));
  }
  if (MODE == 1) {
#pragma unroll
    for (int a = 0; a < 2; ++a)
#pragma unroll
      for (int j = 0; j < 4; ++j) psum[a][j] = 0.f;
  }
  bf16x8 vf[4];
  if (MODE != 0) {
#pragma unroll
    for (int dt = 0; dt < 2; ++dt) {
      const char* base = sV + (dt * 16 + lr) * 136 + half * 64 + lg * 8;
      const uint2 a = *(const uint2*)(base);
      const uint2 c = *(const uint2*)(base + 32);
      vf[dt] = __builtin_bit_cast(bf16x8, make_uint4(a.x, a.y, c.x, c.y));
    }
  }
  bf16x8 pf[2];
  f32x4 sall[2][2];
#pragma unroll
  for (int h = 0; h < 2; ++h)
#pragma unroll
    for (int kt2 = 0; kt2 < 2; ++kt2) {
      f32x4 z = f32x4{0.f, 0.f, 0.f, 0.f};
      z = MFMA16(kw[kt2], __builtin_bit_cast(bf16x8, make_uint4(sw[h], 0u, 0u, 0u)), z);
      z = MFMA16(kf[kt2][0], qf[h][0], z);
      z = MFMA16(kf[kt2][1], qf[h][1], z);
      sall[h][kt2] = z;
    }
#pragma unroll
  for (int h = 0; h < 2; ++h) {
    f32x4 s[2] = {sall[h][0], sall[h][1]};
    float mx = NEGB;
#pragma unroll
    for (int kt2 = 0; kt2 < 2; ++kt2)
#pragma unroll
      for (int j = 0; j < 4; ++j) {
        float v = s[kt2][j];
        if (MASKED) v = valid[kt2][j] ? v : NEGB;
        s[kt2][j] = v;
        mx = fmaxf(mx, v);
      }
    if (MODE != 1) {
      mx = rows_max(mx);
      const float mn = fmaxf(m[h], mx + tb[h]);
      const float mm = mn - tb[h];
      float ps = 0.f;
#pragma unroll
      for (int kt2 = 0; kt2 < 2; ++kt2)
#pragma unroll
        for (int j = 0; j < 4; ++j) {
          float pv = ex2(s[kt2][j] - mm);
          s[kt2][j] = pv;
          ps += pv;
        }
      if (__ballot(mn != m[h]) != 0ull) {
        const float alpha = ex2(m[h] - mn);
        m[h] = mn;
        lsum[h] = lsum[h] * alpha + ps;
        if (MODE == 2) {
#pragma unroll
          for (int dt = 0; dt < 4; ++dt) o[h][dt] *= alpha;
        }
      } else {
        lsum[h] += ps;
      }
    } else {
#pragma unroll
      for (int kt2 = 0; kt2 < 2; ++kt2)
#pragma unroll
        for (int j = 0; j < 4; ++j) {
          float pv = ex2(s[kt2][j] - (m[h] - tb[h])) * lsum[h];
          s[kt2][j] = pv;
          psum[kt2][j] += pv;
        }
    }
    if (MODE != 0) {
      uint4 pk = make_uint4(pack2(s[0][0], s[0][1]), pack2(s[0][2], s[0][3]), pack2(s[1][0], s[1][1]), pack2(s[1][2], s[1][3]));
      pf[h] = __builtin_bit_cast(bf16x8, pk);
    }
  }
  if (MODE != 0) {
#pragma unroll
    for (int dt = 2; dt < 4; ++dt) {
      const char* base = sV + (dt * 16 + lr) * 136 + half * 64 + lg * 8;
      const uint2 a = *(const uint2*)(base);
      const uint2 c = *(const uint2*)(base + 32);
      vf[dt] = __builtin_bit_cast(bf16x8, make_uint4(a.x, a.y, c.x, c.y));
    }
#pragma unroll
    for (int dt = 0; dt < 4; ++dt) {
#pragma unroll
      for (int h = 0; h < 2; ++h) o[h][dt] = MFMA16(vf[dt], pf[h], o[h][dt]);
    }
  }
}

DI void attn_item(const Params& p, int l, int b, int kvh, int qh, char* smem) {
  char* sK = smem + SM_K;
  char* sV = smem + SM_V;
  float* sImp = (float*)(smem + SM_IMP);
  unsigned* sSel = (unsigned*)(smem + SM_SEL);
  unsigned* sUni = (unsigned*)(smem + SM_UNI);
  const char* wsA = p.ws + OFF_A;
  const u16* Q = (const u16*)(wsA + A_Q);
  const u16* KS = (const u16*)(wsA + A_KS);
  const u16* VST = (const u16*)(wsA + A_VST);
  const u16* KW = (const u16*)(wsA + A_KW);
  const u16* VWT = (const u16*)(wsA + A_VWT);
  const float* G = (const float*)(wsA + A_G);
  const u16* KCMP = (const u16*)(p.ws + OFF_KCMP);
  const u16* VCMPT = (const u16*)(p.ws + OFF_VCMPT);
  u16* OM = (u16*)(p.ws + OFF_H);

  const int tid = otid(), lane = tid & 63, w = tid >> 6, lr = lane & 15, lg = lane >> 4;
  const int hp = w >> 1;
  const int t0 = qh * 32;
  const int cur = qh >> 1;
  const int tql = 16 * (w & 1) + lr;
  const size_t tokq = (size_t)b * S + t0 + tql;
  const int bk = b * 2 + kvh;
  const int hg0 = kvh * 4 + hp * 2;

  bf16x8 qf[2][2];
  float slope[2];
  unsigned qs[2];
#pragma unroll
  for (int h = 0; h < 2; ++h) {
    const u16* qp = Q + tokq * 512 + (hg0 + h) * 64 + lg * 8;
    qf[h][0] = *(const bf16x8*)qp;
    qf[h][1] = *(const bf16x8*)(qp + 32);
    slope[h] = ex2(-(float)(hg0 + h + 1)) * LOG2E;
    const float shi = bf2f(f2bf(slope[h]));
    qs[h] = (lg == 0) ? pack2(shi, slope[h] - shi) : 0u;
  }
  float m[2], ls[2];
  f32x4 o[2][4], otot[2][4];
  float psum[2][4];
#pragma unroll
  for (int h = 0; h < 2; ++h) {
    m[h] = MINIT;
    ls[h] = 0.f;
#pragma unroll
    for (int dt = 0; dt < 4; ++dt) o[h][dt] = f32x4{0.f, 0.f, 0.f, 0.f};
  }

  const int amax = qh >> 5;
  const u16* kc_base = KCMP + (size_t)bk * 512 * 64;
  const u16* vc_base = VCMPT + (size_t)bk * 64 * 512;
  KVr tl;
  kv_load_k(tl, kc_base, 64, tid);
  for (int a = 0; a <= amax; ++a) {
    __syncthreads();
    kv_store_k(tl, sK, tid);
    __syncthreads();
    if (a < amax) kv_load_k(tl, kc_base + (size_t)(a + 1) * 64 * 64, 64, tid);
    else { kv_load_k(tl, kc_base, 64, tid); kv_load_v(tl, vc_base, 512, tid); }
#pragma unroll
    for (int half = 0; half < 2; ++half) {
      float posf[2][4];
      bool valid[2][4];
#pragma unroll
      for (int kt2 = 0; kt2 < 2; ++kt2)
#pragma unroll
        for (int j = 0; j < 4; ++j) {
          int n = a * 64 + half * 32 + kt2 * 16 + lg * 4 + j;
          int rel = 16 * n + 31 - t0;
          posf[kt2][j] = (float)rel;
          valid[kt2][j] = rel <= tql;
        }
      const float tb[2] = {slope[0] * (float)(1024 * a + 31 - t0), slope[1] * (float)(1024 * a + 31 - t0)};
      half_step<0, true, 16>(sK, sV, half, lr, lg, qf, qs, tb, m, ls, o, valid, psum);
    }
  }
#pragma unroll
  for (int h = 0; h < 2; ++h) {
    float x = ls[h];
    x = rows_sum(x);
    ls[h] = x > 0.f ? 1.f / x : 0.f;
  }
  float carry = 0.f;
  float* myImp = sImp + hp * (32 * 132);
  for (int a = 0; a <= amax; ++a) {
    __syncthreads();
    kv_store_k(tl, sK, tid);
    kv_store_v(tl, sV, tid);
    __syncthreads();
    if (a < amax) {
      kv_load_k(tl, kc_base + (size_t)(a + 1) * 64 * 64, 64, tid);
      kv_load_v(tl, vc_base + (a + 1) * 64, 512, tid);
    }
#pragma unroll
    for (int half = 0; half < 2; ++half) {
      float posf[2][4];
      bool valid[2][4];
#pragma unroll
      for (int kt2 = 0; kt2 < 2; ++kt2)
#pragma unroll
        for (int j = 0; j < 4; ++j) {
          int n = a * 64 + half * 32 + kt2 * 16 + lg * 4 + j;
          int rel = 16 * n + 31 - t0;
          posf[kt2][j] = (float)rel;
          valid[kt2][j] = rel <= tql;
        }
      const float tb[2] = {slope[0] * (float)(1024 * a + 31 - t0), slope[1] * (float)(1024 * a + 31 - t0)};
      half_step<1, true, 16>(sK, sV, half, lr, lg, qf, qs, tb, m, ls, o, valid, psum);
      float prev = carry;
#pragma unroll
      for (int kt2 = 0; kt2 < 2; ++kt2) {
        float sum4 = psum[kt2][0] + psum[kt2][1] + psum[kt2][2] + psum[kt2][3];
        float p3 = psum[kt2][3];
        float up = __shfl(p3, (lane + 48) & 63);
        float wrap = __shfl(prev, (lane + 48) & 63);
        float spill = lg > 0 ? up : wrap;
        int j = a * 16 + half * 8 + kt2 * 4 + lg;
        myImp[tql * 132 + j] = sum4 + spill;
        prev = p3;
      }
      carry = prev;
    }
  }
  const size_t tokq_a = (size_t)b * S + t0 + 16 * ((otid() >> 6) & 1) + (otid() & 15);
#pragma unroll
  for (int h = 0; h < 2; ++h) {
    const float g0 = G[tokq_a * 24 + (hg0 + h) * 3 + 0];
#pragma unroll
    for (int dt = 0; dt < 4; ++dt) {
      otot[h][dt] = o[h][dt] * g0;
      o[h][dt] = f32x4{0.f, 0.f, 0.f, 0.f};
    }
    m[h] = MINIT;
    ls[h] = 0.f;
  }
  if (tid < 4) sUni[tid] = 0u;
  __syncthreads();
  if (tid < 128) {
    const int q = tid >> 2, sub = tid & 3;
    unsigned mk[4] = {0u, 0u, 0u, 0u};
    if (cur < 16) {
      mk[0] = (1u << (cur + 1)) - 1u;
    } else {
      float v[32];
#pragma unroll
      for (int i = 0; i < 32; ++i) {
        int j = sub + 4 * i;
        v[i] = (j >= 1 && j <= cur - 2) ? (sImp[q * 132 + j] + sImp[32 * 132 + q * 132 + j]) : -1.f;
      }
      for (int round = 0; round < 13; ++round) {
        float bv = v[0];
        int bi = 0;
#pragma unroll
        for (int i = 1; i < 32; ++i)
          if (v[i] > bv) { bv = v[i]; bi = i; }
        int bj = sub + 4 * bi;
#pragma unroll
        for (int off = 1; off <= 2; off <<= 1) {
          float ov = __shfl_xor(bv, off);
          int oj = __shfl_xor(bj, off);
          if (ov > bv || (ov == bv && oj < bj)) { bv = ov; bj = oj; }
        }
#pragma unroll
        for (int i = 0; i < 32; ++i)
          if (sub + 4 * i == bj) v[i] = -2.f;
#pragma unroll
        for (int wd = 0; wd < 4; ++wd) mk[wd] |= ((bj >> 5) == wd) ? (1u << (bj & 31)) : 0u;
      }
      const int f1 = cur, f2 = cur - 1;
      mk[0] |= 1u;
#pragma unroll
      for (int wd = 0; wd < 4; ++wd) {
        mk[wd] |= ((f1 >> 5) == wd) ? (1u << (f1 & 31)) : 0u;
        mk[wd] |= ((f2 >> 5) == wd) ? (1u << (f2 & 31)) : 0u;
      }
    }
    if (sub == 0) {
#pragma unroll
      for (int wd = 0; wd < 4; ++wd) {
        sSel[q * 4 + wd] = mk[wd];
        atomicOr(&sUni[wd], mk[wd]);
      }
    }
  }
  __syncthreads();
  const int jw0 = (cur >= 8 ? cur - 8 : 0);
  {
    int j = cur;
    kv_load_k(tl, KS + ((size_t)b * S + j * 64) * 128 + kvh * 64, 128, tid);
    kv_load_v(tl, VST + (size_t)bk * 64 * S + j * 64, S, tid);
    while (j >= 0) {
      __syncthreads();
      kv_store_k(tl, sK, tid);
      kv_store_v(tl, sV, tid);
      __syncthreads();
      const int jn = prev_set_bit(sUni, j - 1);
      if (jn >= 0) {
        kv_load_k(tl, KS + ((size_t)b * S + jn * 64) * 128 + kvh * 64, 128, tid);
        kv_load_v(tl, VST + (size_t)bk * 64 * S + jn * 64, S, tid);
      } else {
        kv_load_k(tl, KW + ((size_t)b * S + cur * 64) * 128 + kvh * 64, 128, tid);
        kv_load_v(tl, VWT + (size_t)bk * 64 * S + cur * 64, S, tid);
      }
      const bool selbit = (sSel[tql * 4 + (j >> 5)] >> (j & 31)) & 1u;
      const unsigned long long bal = __ballot(selbit);
      if (bal != 0ull) {
        const bool full = (j < cur) && (bal == ~0ull);
#pragma unroll
        for (int half = 0; half < 2; ++half) {
          float posf[2][4];
          bool valid[2][4];
#pragma unroll
          for (int kt2 = 0; kt2 < 2; ++kt2)
#pragma unroll
            for (int jj = 0; jj < 4; ++jj) {
              int rel = j * 64 - t0 + half * 32 + kt2 * 16 + lg * 4 + jj;
              posf[kt2][jj] = (float)rel;
              valid[kt2][jj] = selbit && (rel <= tql);
            }
          const float tb[2] = {slope[0] * (float)(j * 64 - t0), slope[1] * (float)(j * 64 - t0)};
          half_step<2, true, 1>(sK, sV, half, lr, lg, qf, qs, tb, m, ls, o, valid, psum);
        }
      }
      j = jn;
    }
  }
  const size_t tokq_b = (size_t)b * S + t0 + 16 * ((otid() >> 6) & 1) + (otid() & 15);
#pragma unroll
  for (int h = 0; h < 2; ++h) {
    float x = ls[h];
    x = rows_sum(x);
    const float f = (x > 0.f ? 1.f / x : 0.f) * G[tokq_b * 24 + (hg0 + h) * 3 + 1];
#pragma unroll
    for (int dt = 0; dt < 4; ++dt) {
      otot[h][dt] += o[h][dt] * f;
      o[h][dt] = f32x4{0.f, 0.f, 0.f, 0.f};
    }
    m[h] = MINIT;
    ls[h] = 0.f;
  }
  for (int j = cur; j >= jw0; --j) {
    __syncthreads();
    kv_store_k(tl, sK, tid);
    kv_store_v(tl, sV, tid);
    __syncthreads();
    if (j > jw0) {
      kv_load_k(tl, KW + ((size_t)b * S + (j - 1) * 64) * 128 + kvh * 64, 128, tid);
      kv_load_v(tl, VWT + (size_t)bk * 64 * S + (j - 1) * 64, S, tid);
    }
    const bool full = (j * 64 + 63 <= t0) && (t0 + 31 - j * 64 <= 511);
#pragma unroll
    for (int half = 0; half < 2; ++half) {
      float posf[2][4];
      bool valid[2][4];
#pragma unroll
      for (int kt2 = 0; kt2 < 2; ++kt2)
#pragma unroll
        for (int jj = 0; jj < 4; ++jj) {
          int rel = j * 64 - t0 + half * 32 + kt2 * 16 + lg * 4 + jj;
          posf[kt2][jj] = (float)rel;
          valid[kt2][jj] = (rel <= tql) && (tql - rel < 512);
        }
      const float tb[2] = {slope[0] * (float)(j * 64 - t0), slope[1] * (float)(j * 64 - t0)};
      half_step<2, true, 1>(sK, sV, half, lr, lg, qf, qs, tb, m, ls, o, valid, psum);
    }
  }
  const int tid_c = otid();
  const size_t tokq_c = (size_t)b * S + t0 + 16 * ((tid_c >> 6) & 1) + (tid_c & 15);
  const int hg_c = kvh * 4 + (tid_c >> 7) * 2;
  const int lg_c = (tid_c >> 4) & 3;
#pragma unroll
  for (int h = 0; h < 2; ++h) {
    float x = ls[h];
    x = rows_sum(x);
    const float f = (x > 0.f ? 1.f / x : 0.f) * G[tokq_c * 24 + (hg_c + h) * 3 + 2];
    float ss = 0.f;
#pragma unroll
    for (int dt = 0; dt < 4; ++dt) {
      otot[h][dt] += o[h][dt] * f;
#pragma unroll
      for (int jj = 0; jj < 4; ++jj) ss += otot[h][dt][jj] * otot[h][dt][jj];
    }
    ss = rows_sum(ss);
    const float r = rsqrtf(ss * (1.f / 64.f) + EPS);
#pragma unroll
    for (int dt = 0; dt < 4; ++dt) {
      const int d = dt * 16 + lg_c * 4;
      const float4 gg = *(const float4*)(p.out_g + l * 1024 + (hg_c + h) * 64 + d);
      uint2 st;
      st.x = pack2(otot[h][dt][0] * r * gg.x, otot[h][dt][1] * r * gg.y);
      st.y = pack2(otot[h][dt][2] * r * gg.z, otot[h][dt][3] * r * gg.w);
      *(uint2*)(OM + tokq_c * 1024 + (hg_c + h) * 64 + d) = st;
    }
  }
}

#define XB_TMO      128
#define XB_XCNT(j)  (256  + 64 * (j))
#define XB_XSUB(j)  (1280 + 64 * (j))
#define XB_XGEN(j)  (2304 + 64 * (j))
#define XB_TOP      3328
#define XB_TOPGEN   3392
#define XCD_BAR_WORDS 3456
#define XB_SPIN_CAP (1u << 20)
DI unsigned xb_ld(unsigned* p) { return __hip_atomic_load(p, __ATOMIC_RELAXED, __HIP_MEMORY_SCOPE_AGENT); }
DI unsigned xb_add(unsigned* p, unsigned v) { return __hip_atomic_fetch_add(p, v, __ATOMIC_RELAXED, __HIP_MEMORY_SCOPE_AGENT); }
DI unsigned xb_xcc_id() { return (unsigned)__builtin_amdgcn_s_getreg((3 << 11) | 20) & 0xFu; }
#define XB_SPIN(cond, bar) do { unsigned _sp = 0; while (cond) { __builtin_amdgcn_s_sleep(1); \
    if ((++_sp & 255u) == 0u) { if (xb_ld(&(bar)[XB_TMO])) break; if (_sp > XB_SPIN_CAP) { atomicAdd(&(bar)[XB_TMO], 1u); break; } } } } while (0)

struct XcdBarrier { unsigned* bar; unsigned x; volatile unsigned* st; };

DI void xcd_barrier_complete(unsigned* bar, unsigned x, unsigned& nloc, unsigned& nx) {
  const unsigned G = gridDim.x;
  unsigned sum, cnt, mine, sp = 0u;
  for (;;) {
    sum = 0u; cnt = 0u; mine = 0u;
#pragma unroll
    for (unsigned j = 0; j < 16; ++j) { const unsigned c = xb_ld(&bar[XB_XCNT(j)]); sum += c; cnt += (c > 0u) ? 1u : 0u; mine = (j == x) ? c : mine; }
    if (sum == G) break;
    __builtin_amdgcn_s_sleep(1);
    if ((++sp & 255u) == 0u) { if (xb_ld(&bar[XB_TMO])) break; if (sp > XB_SPIN_CAP) { atomicAdd(&bar[XB_TMO], 1u); break; } }
  }
  nloc = mine > 0u ? mine : 1u; nx = cnt > 0u ? cnt : 1u;
}

DI void gsync(const XcdBarrier& b0) {
  asm volatile("s_waitcnt vmcnt(0)" ::: "memory");
  __syncthreads();
  if (threadIdx.x == 0) {
    XcdBarrier b;
    b.bar = b0.bar;
    b.st = b0.st;
    b.x = xb_xcc_id();
    unsigned* bar = b.bar;
    __builtin_amdgcn_s_waitcnt(0);
    unsigned nloc = b.st[0], nx = b.st[1];
    if (nloc == 0u) { xcd_barrier_complete(bar, b.x, nloc, nx); b.st[0] = nloc; b.st[1] = nx; }
    const unsigned old = xb_add(&bar[XB_XSUB(b.x)], 1u);
    const unsigned gen = old / nloc;
    if (old + 1u == (gen + 1u) * nloc) {
      __builtin_amdgcn_fence(__ATOMIC_RELEASE, "agent");
      asm volatile("s_waitcnt vmcnt(0)" ::: "memory");
      const unsigned og = xb_add(&bar[XB_TOP], 1u);
      const unsigned tg = og / nx;
      if (og + 1u == (tg + 1u) * nx) xb_add(&bar[XB_TOPGEN], 1u);
      else XB_SPIN(xb_ld(&bar[XB_TOPGEN]) == tg, bar);
      __builtin_amdgcn_fence(__ATOMIC_ACQUIRE, "agent");
      xb_add(&bar[XB_XGEN(b.x)], 1u);
      asm volatile("s_waitcnt vmcnt(0)" ::: "memory");
    } else {
      XB_SPIN(xb_ld(&bar[XB_XGEN(b.x)]) == gen, bar);
      __builtin_amdgcn_fence(__ATOMIC_ACQUIRE, "agent");
      asm volatile("s_waitcnt vmcnt(0)" ::: "memory");
    }
  }
  __syncthreads();
}

#ifndef STOP_AFTER
#define STOP_AFTER 0
#endif
#define DUMP_BF16_AND_STOP(ptr)                                                                   \
  {                                                                                               \
    const u16* s_ = (const u16*)(ptr);                                                            \
    for (size_t i = (size_t)bid * 256 + threadIdx.x; i < (size_t)TOK * 1024; i += (size_t)nb * 256) \
      p.out[i] = bf2f(s_[i]);                                                                     \
    return;                                                                                       \
  }
#define DUMP_F32_AND_STOP(ptr)                                                                    \
  {                                                                                               \
    const float* s_ = (const float*)(ptr);                                                        \
    for (size_t i = (size_t)bid * 256 + threadIdx.x; i < (size_t)TOK * 1024; i += (size_t)nb * 256) \
      p.out[i] = s_[i];                                                                           \
    return;                                                                                       \
  }
__global__ void __launch_bounds__(256, 2) mega(Params p) {
  extern __shared__ __attribute__((aligned(16))) char smem[];
  char* ws = p.ws;
  const int nb = gridDim.x, bid = blockIdx.x;
  if (ws == nullptr) cg::this_grid().sync();
  volatile unsigned* xst = (volatile unsigned*)(smem + 73728);
  if (threadIdx.x == 0) { xst[0] = 0u; xst[1] = 0u; }
  __syncthreads();
  if (threadIdx.x == 0) (void)xb_add(&((unsigned*)(ws + OFF_BAR))[XB_XCNT(xb_xcc_id())], 1u);
#define grid (XcdBarrier{(unsigned*)(p.ws + OFF_BAR), 0u, (volatile unsigned*)(smem + 73728)})
  float* X1 = (float*)(ws + OFF_X1);
  u16* H = (u16*)(ws + OFF_H);
  char* wsA = ws + OFF_A;
  const float* mod = (const float*)(ws + OFF_MOD);

#ifdef ZERO_WS
  {
    uint4* z = (uint4*)ws;
    const size_t n16 = (OFF_A + A_END) / 16;
    for (size_t i = (size_t)bid * 256 + threadIdx.x; i < n16; i += (size_t)nb * 256) z[i] = make_uint4(0, 0, 0, 0);
    uint4* zo = (uint4*)p.out;
    const size_t m16 = (size_t)TOK * 1024 * 4 / 16;
    for (size_t i = (size_t)bid * 256 + threadIdx.x; i < m16; i += (size_t)nb * 256) zo[i] = make_uint4(0, 0, 0, 0);
  }
  gsync(grid);
#endif
  phase0a(p, smem);
  gsync(grid);
  phase0b(p);
  gsync(grid);
  phase_mod_x(p);
  gsync(grid);

  for (int l = 0; l < 2; ++l) {
    const float* modl = mod + (size_t)l * 8 * 6144;
    const float* xin = (l == 0) ? p.x : p.out;
    {
      u16* Qo = (u16*)(wsA + A_Q);
      u16* KCo = (u16*)(wsA + A_KC);
      u16* VCo = (u16*)(wsA + A_VC);
      u16* KSo = (u16*)(wsA + A_KS);
      u16* VSTo = (u16*)(wsA + A_VST);
      u16* KWo = (u16*)(wsA + A_KW);
      u16* VWTo = (u16*)(wsA + A_VWT);
      float* Go = (float*)(wsA + A_G);
      u16* Uo = (u16*)(wsA + A_U);
      u16* VGTo = (u16*)(wsA + A_VGT);
      const float* vng = p.vn_g + l * 512;
      const float* vnb = p.vn_b + l * 512;
      auto sel1 = [](int tn) { return !(tn == 7 || tn == 9 || (tn >= 14 && tn < 18)); };
      auto epi = [&](bool swp, int tm, int tn, int wm, int wn, int lr, int lg, auto& acc) {
        constexpr int MT = sizeof(acc) / sizeof(acc[0]);
        const int row0 = tm * (32 * MT) + wm * (16 * MT);
        const int b = row0 >> 13;
        const int s0 = row0 & (S - 1);
        if (swp) {
          if (tn == 18) {
            if (wn == 0) {
#pragma unroll
              for (int mi = 0; mi < MT; ++mi)
#pragma unroll
                for (int ni = 0; ni < 2; ++ni) {
                  const int c = ni * 16 + lg * 4;
                  const size_t row = (size_t)row0 + mi * 16 + lr;
                  if (c < 24)
                    *(float4*)(Go + row * 24 + c) =
                        make_float4(sigm(acc[mi][ni][0]), sigm(acc[mi][ni][1]), sigm(acc[mi][ni][2]), sigm(acc[mi][ni][3]));
                }
            }
          } else {
            u16* dst;
            int ld, cb;
            float sc = 1.f;
            bool g = false;
            if (tn < 4) { dst = Qo; ld = 512; cb = tn * 128; sc = QSCALE; }
            else if (tn == 4) { dst = KCo; ld = 128; cb = 0; }
            else if (tn == 5) { dst = VCo; ld = 128; cb = 0; }
            else if (tn == 6) { dst = KSo; ld = 128; cb = 0; }
            else if (tn == 8) { dst = KWo; ld = 128; cb = 0; }
            else { dst = Uo; ld = 512; cb = (tn - 10) * 128; g = true; }
#pragma unroll
            for (int mi = 0; mi < MT; ++mi)
#pragma unroll
              for (int ni = 0; ni < 4; ++ni) {
                const size_t row = (size_t)row0 + mi * 16 + lr;
                float v[4];
#pragma unroll
                for (int j = 0; j < 4; ++j) v[j] = g ? gelu_t(acc[mi][ni][j]) : acc[mi][ni][j] * sc;
                uint2 st;
                st.x = pack2(v[0], v[1]);
                st.y = pack2(v[2], v[3]);
                *(uint2*)(dst + row * ld + cb + wn * 64 + ni * 16 + lg * 4) = st;
              }
          }
        } else if (tn == 7 || tn == 9) {
          u16* dst = (tn == 7) ? VSTo : VWTo;
#pragma unroll
          for (int mi = 0; mi < MT; ++mi)
#pragma unroll
            for (int ni = 0; ni < 4; ++ni) {
              const int d = ni * 16 + lr;
              uint2 st;
              st.x = pack2(acc[mi][ni][0], acc[mi][ni][1]);
              st.y = pack2(acc[mi][ni][2], acc[mi][ni][3]);
              *(uint2*)(dst + ((size_t)(b * 2 + wn) * 64 + d) * S + s0 + mi * 16 + lg * 4) = st;
            }
        } else {
          const int grp = (tn - 14) * 2 + wn;
          float vg[4], vb[4];
#pragma unroll
          for (int ni = 0; ni < 4; ++ni) { vg[ni] = vng[grp * 64 + ni * 16 + lr]; vb[ni] = vnb[grp * 64 + ni * 16 + lr]; }
#pragma unroll
          for (int mi = 0; mi < MT; ++mi) {
            float vv[4][4];
#pragma unroll
            for (int ni = 0; ni < 4; ++ni)
#pragma unroll
              for (int j = 0; j < 4; ++j) vv[ni][j] = gelu_t(acc[mi][ni][j]);
#pragma unroll
            for (int j = 0; j < 4; ++j) {
              float s1 = vv[0][j] + vv[1][j] + vv[2][j] + vv[3][j];
              s1 += __shfl_xor(s1, 1); s1 += __shfl_xor(s1, 2); s1 += __shfl_xor(s1, 4); s1 += __shfl_xor(s1, 8);
              const float mu = s1 * (1.f / 64.f);
              float s2 = 0.f;
#pragma unroll
              for (int ni = 0; ni < 4; ++ni) { float dd = vv[ni][j] - mu; s2 += dd * dd; }
              s2 += __shfl_xor(s2, 1); s2 += __shfl_xor(s2, 2); s2 += __shfl_xor(s2, 4); s2 += __shfl_xor(s2, 8);
              const float rs = rsqrtf(s2 * (1.f / 64.f) + EPS);
#pragma unroll
              for (int ni = 0; ni < 4; ++ni) vv[ni][j] = (vv[ni][j] - mu) * rs * vg[ni] + vb[ni];
            }
#pragma unroll
            for (int ni = 0; ni < 4; ++ni) {
              const int d = ni * 16 + lr;
              uint2 st;
              st.x = pack2(vv[ni][0], vv[ni][1]);
              st.y = pack2(vv[ni][2], vv[ni][3]);
              *(uint2*)(VGTo + ((size_t)(b * 8 + grp) * 64 + d) * S + s0 + mi * 16 + lg * 4) = st;
            }
          }
        }
      };
      gemm_phase<8>(H, 1024, (const u16*)(ws + OFF_WTIN + l * SZ_WTIN), 1024, 256, 19, 1024, bid, nb, smem, sel1, epi);
    }
    gsync(grid);
    if (STOP_AFTER == 1 && l == 0) DUMP_BF16_AND_STOP(wsA)
    if (STOP_AFTER == 11 && l == 0) DUMP_BF16_AND_STOP(wsA + A_KW)
    if (STOP_AFTER == 12 && l == 0) DUMP_BF16_AND_STOP(wsA + A_U)
    {
      const int ng = (nb >= 256) ? 256 : nb;
      const int half = ng / 2;
      for (int which = 0; which < 2; ++which) {
        u16* HC = (u16*)(wsA + A_HC) + (size_t)which * 8192 * 256;
        const float* cb1 = (const float*)(ws + OFF_CB1) + (l * 2 + which) * 256;
        const u16* src_tok = (const u16*)(wsA + (which ? A_VC : A_KC));
        auto selT = [](int) { return true; };
        auto ab = [=](int tm) {
          const int bk = tm >> 2, n0 = (tm & 3) * 128;
          return src_tok + ((size_t)(bk >> 1) * S + 16 * n0) * 128 + (bk & 1) * 64;
        };
        auto epi = [&](bool swp, int tm, int tn, int wm, int wn, int lr, int lg, auto& acc) {
        constexpr int MT = sizeof(acc) / sizeof(acc[0]);
          const int row0 = tm * (32 * MT) + wm * (16 * MT), col0 = tn * 128 + wn * 64;
#pragma unroll
          for (int ni = 0; ni < 4; ++ni) {
            const float4 cb = *(const float4*)(cb1 + col0 + ni * 16 + lg * 4);
#pragma unroll
            for (int mi = 0; mi < MT; ++mi) {
              uint2 st;
              st.x = pack2(gelu_t(acc[mi][ni][0] + cb.x), gelu_t(acc[mi][ni][1] + cb.y));
              st.y = pack2(gelu_t(acc[mi][ni][2] + cb.z), gelu_t(acc[mi][ni][3] + cb.w));
              *(uint2*)(HC + (size_t)(row0 + mi * 16 + lr) * 256 + col0 + ni * 16 + lg * 4) = st;
            }
          }
        };
        const int vb = (bid < ng) ? (which == 0 ? (bid < half ? bid : -1) : (bid >= half ? bid - half : -1)) : -1;
        gemm_phase_g<4>(ab, 2048, 128, (const u16*)(ws + OFF_WTC1 + (l * 2 + which) * SZ_WTC1), 2048, 64, 2, 2048, vb, half, smem,
                     selT, epi);
      }
      if (bid >= ng) {
        unsigned* gctr = (unsigned*)(ws + OFF_BAR) + (l ? 96 : 32);
        volatile unsigned* slot = (volatile unsigned*)(smem + 73728) + 2;
        for (;;) {
          __syncthreads();
          if (threadIdx.x == 0) *slot = xb_add(gctr, 1u);
          __syncthreads();
          const unsigned idx = (unsigned)__builtin_amdgcn_readfirstlane((int)*slot);
          if (idx >= (unsigned)GMLP_EARLY) break;
          gmlp_item(p, l, (int)idx);
        }
      }
    }
    gsync(grid);
    {
      for (int which = 0; which < 2; ++which) {
        u16* KCMP = (u16*)(ws + OFF_KCMP);
        u16* VCMPT = (u16*)(ws + OFF_VCMPT);
        auto selW = [which](int) { return which == 0; };
        auto epi = [&](bool swp, int tm, int tn, int wm, int wn, int lr, int lg, auto& acc) {
        constexpr int MT = sizeof(acc) / sizeof(acc[0]);
          if (wn != 0) return;
          const int row0 = tm * (32 * MT) + wm * (16 * MT);
#pragma unroll
          for (int mi = 0; mi < MT; ++mi)
#pragma unroll
            for (int ni = 0; ni < 4; ++ni) {
              uint2 st;
              st.x = pack2(acc[mi][ni][0], acc[mi][ni][1]);
              st.y = pack2(acc[mi][ni][2], acc[mi][ni][3]);
              if (swp) {
                *(uint2*)(KCMP + (size_t)(row0 + mi * 16 + lr) * 64 + ni * 16 + lg * 4) = st;
              } else {
                const int d = ni * 16 + lr;
                const int rb = row0 + mi * 16 + lg * 4;
                *(uint2*)(VCMPT + ((size_t)(rb >> 9) * 64 + d) * 512 + (rb & 511)) = st;
              }
            }
        };
        const int vb = (which == 0) ? bid : (bid + nb - 64) % nb;
        gemm_phase<4>((const u16*)(wsA + A_HC) + (size_t)which * 8192 * 256, 256,
                   (const u16*)(ws + OFF_WTC2 + (l * 2 + which) * SZ_WTC2), 256, 64, 1, 256, vb, nb, smem, selW, epi);
      }
    }
    gsync(grid);
    if (STOP_AFTER == 4 && l == 0) DUMP_BF16_AND_STOP(ws + OFF_KCMP)
    {
      unsigned* qctr = (unsigned*)(ws + OFF_BAR) + (l ? 64 : 0);
      volatile unsigned* slot = (volatile unsigned*)(smem + 73728) + 2;
      for (;;) {
        __syncthreads();
        if (threadIdx.x == 0) *slot = xb_add(qctr, 1u);
        __syncthreads();
        const unsigned idx = (unsigned)__builtin_amdgcn_readfirstlane((int)*slot);
        if (idx >= 8192u - (unsigned)GMLP_EARLY) break;
        if (idx < 4096u) {
          const int qh = 255 - (int)(idx >> 4);
          const int rem = (int)(idx & 15u);
          attn_item(p, l, rem >> 1, rem & 1, qh, smem);
        } else {
          gmlp_item(p, l, (int)(idx - 4096u) + GMLP_EARLY);
        }
      }
    }
    gsync(grid);
    if (STOP_AFTER == 5 && l == 0) DUMP_BF16_AND_STOP(H)
    if ((STOP_AFTER == 51 || STOP_AFTER == 52) && l == 0) {
      for (size_t i = (size_t)bid * 256 + threadIdx.x; i < (size_t)TOK * 1024; i += (size_t)nb * 256) {
        const int col = (int)(i & 1023);
        const bool keep = (STOP_AFTER == 51) ? (col < 512) : (col >= 512);
        p.out[i] = keep ? bf2f(H[i]) : 0.f;
      }
      return;
    }
    {
      auto selT = [](int) { return true; };
      auto epi = [&](bool swp, int tm, int tn, int wm, int wn, int lr, int lg, auto& acc) {
        constexpr int MT = sizeof(acc) / sizeof(acc[0]);
        const int row0 = tm * (32 * MT) + wm * (16 * MT), col0 = tn * 128 + wn * 64;
        const int b = row0 >> 13;
#pragma unroll
        for (int ni = 0; ni < 4; ++ni) {
          const int col = col0 + ni * 16 + lg * 4;
          const float4 g1 = *(const float4*)(modl + (size_t)b * 6144 + 2048 + col);
#pragma unroll
          for (int mi = 0; mi < MT; ++mi) {
            const size_t row = (size_t)row0 + mi * 16 + lr;
            float4 xv = *(const float4*)(xin + row * 1024 + col);
            if (l == 1) {
              const float2 st = *(const float2*)((const float*)(ws + OFF_ST2) + row * 2);
              const float4 gg = *(const float4*)(p.ln2_g + col), bb = *(const float4*)(p.ln2_b + col);
              xv.x = (xv.x - st.x) * st.y * gg.x + bb.x;
              xv.y = (xv.y - st.x) * st.y * gg.y + bb.y;
              xv.z = (xv.z - st.x) * st.y * gg.z + bb.z;
              xv.w = (xv.w - st.x) * st.y * gg.w + bb.w;
            }
            float4 o4;
            o4.x = ALPHA * xv.x + (1.f + g1.x) * acc[mi][ni][0];
            o4.y = ALPHA * xv.y + (1.f + g1.y) * acc[mi][ni][1];
            o4.z = ALPHA * xv.z + (1.f + g1.z) * acc[mi][ni][2];
            o4.w = ALPHA * xv.w + (1.f + g1.w) * acc[mi][ni][3];
            *(float4*)(X1 + row * 1024 + col) = o4;
          }
        }
      };
      gemm_phase<8>(H, 1024, (const u16*)(ws + OFF_WTO + l * SZ_WTO), 1024, 256, 8, 1024, bid, nb, smem, selT, epi);
    }
    gsync(grid);
    ln_rows(X1, p.ln1_g + l * 1024, p.ln1_b + l * 1024, modl, 3072, 4096, H, (float*)(ws + OFF_ST1), false);
    gsync(grid);
    if (STOP_AFTER == 7 && l == 0) DUMP_F32_AND_STOP(X1)
    {
      u16* HH = (u16*)(wsA);
      auto selT = [](int) { return true; };
      auto epi = [&](bool swp, int tm, int tn, int wm, int wn, int lr, int lg, auto& acc) {
        constexpr int MT = sizeof(acc) / sizeof(acc[0]);
        const int row0 = tm * (32 * MT) + wm * (16 * MT);
        const int cb = tn * 64 + wn * 32;
#pragma unroll
        for (int mi = 0; mi < MT; ++mi)
#pragma unroll
          for (int ni = 0; ni < 2; ++ni) {
            const size_t row = (size_t)row0 + mi * 16 + lr;
            float v[4];
#pragma unroll
            for (int j = 0; j < 4; ++j) {
              const float a = acc[mi][ni][j], bb = acc[mi][ni + 2][j];
              v[j] = a * sigm(a) * bb;
            }
            uint2 st;
            st.x = pack2(v[0], v[1]);
            st.y = pack2(v[2], v[3]);
            *(uint2*)(HH + row * 2816 + cb + ni * 16 + lg * 4) = st;
          }
      };
      gemm_phase<8>(H, 1024, (const u16*)(ws + OFF_WT13 + l * SZ_WT13), 1024, 256, 44, 1024, bid, nb, smem, selT, epi);
    }
    gsync(grid);
    if (STOP_AFTER == 8 && l == 0) DUMP_BF16_AND_STOP(wsA)
    {
      const u16* HH = (const u16*)(wsA);
      float* outp = p.out;
      auto selT = [](int) { return true; };
      auto epi = [&](bool swp, int tm, int tn, int wm, int wn, int lr, int lg, auto& acc) {
        constexpr int MT = sizeof(acc) / sizeof(acc[0]);
        const int row0 = tm * (32 * MT) + wm * (16 * MT), col0 = tn * 128 + wn * 64;
        const int b = row0 >> 13;
#pragma unroll
        for (int ni = 0; ni < 4; ++ni) {
          const int col = col0 + ni * 16 + lg * 4;
          const float4 g2 = *(const float4*)(modl + (size_t)b * 6144 + 5120 + col);
#pragma unroll
          for (int mi = 0; mi < MT; ++mi) {
            const size_t row = (size_t)row0 + mi * 16 + lr;
            float4 xv = *(const float4*)(X1 + row * 1024 + col);
            {
              const float2 st = *(const float2*)((const float*)(ws + OFF_ST1) + row * 2);
              const float4 gg = *(const float4*)(p.ln1_g + l * 1024 + col), bb = *(const float4*)(p.ln1_b + l * 1024 + col);
              xv.x = (xv.x - st.x) * st.y * gg.x + bb.x;
              xv.y = (xv.y - st.x) * st.y * gg.y + bb.y;
              xv.z = (xv.z - st.x) * st.y * gg.z + bb.z;
              xv.w = (xv.w - st.x) * st.y * gg.w + bb.w;
            }
            float4 o4;
            o4.x = ALPHA * xv.x + (1.f + g2.x) * acc[mi][ni][0];
            o4.y = ALPHA * xv.y + (1.f + g2.y) * acc[mi][ni][1];
            o4.z = ALPHA * xv.z + (1.f + g2.z) * acc[mi][ni][2];
            o4.w = ALPHA * xv.w + (1.f + g2.w) * acc[mi][ni][3];
            *(float4*)(outp + row * 1024 + col) = o4;
          }
        }
      };
      gemm_phase<8>(HH, 2816, (const u16*)(ws + OFF_WT2 + l * SZ_WT2), 2816, 256, 8, 2816, bid, nb, smem, selT, epi);
    }
    gsync(grid);
    if (l == 0) {
      ln_rows(p.out, p.ln2_g, p.ln2_b, mod + (size_t)8 * 6144, 0, 1024, H, (float*)(ws + OFF_ST2), false);
      gsync(grid);
    } else {
      ln_rows(p.out, p.ln2_g + 1024, p.ln2_b + 1024, nullptr, 0, 0, nullptr, nullptr, true);
    }
  }
}

extern "C" void kernel_launch(void* const* d_in, const int* in_sizes, int n_in, void* d_out, int out_size, void* d_ws,
                              size_t ws_size, hipStream_t stream) {
  static int grid_blocks = 0;
  if (!grid_blocks) {
    int dev = 0, cus = 0, per_cu = 0;
    (void)hipGetDevice(&dev);
    (void)hipDeviceGetAttribute(&cus, hipDeviceAttributeMultiprocessorCount, dev);
    (void)hipFuncSetAttribute((const void*)mega, hipFuncAttributeMaxDynamicSharedMemorySize, LDS_BYTES);
    (void)hipOccupancyMaxActiveBlocksPerMultiprocessor(&per_cu, mega, 256, LDS_BYTES);
    if (per_cu > 2) per_cu = 2;
    if (per_cu < 1) per_cu = 1;
    grid_blocks = cus * per_cu;
  }
  Params p{};
  const float* const* in = (const float* const*)d_in;
  p.x = in[0]; p.c = in[1]; p.w_ada = in[2]; p.b_ada = in[3]; p.w_in = in[4]; p.cmp_pos = in[5]; p.cmp_w1 = in[6];
  p.cmp_w2 = in[7]; p.vn_g = in[8]; p.vn_b = in[9]; p.w_s = in[10]; p.b_s = in[11]; p.out_g = in[12]; p.w_o = in[13];
  p.ln1_g = in[14]; p.ln1_b = in[15]; p.w1 = in[16]; p.w3 = in[17]; p.w2 = in[18]; p.ln2_g = in[19]; p.ln2_b = in[20];
  p.out = (float*)d_out;
  p.ws = (char*)d_ws;
  (void)hipMemsetAsync((char*)d_ws + OFF_BAR, 0, XCD_BAR_WORDS * sizeof(unsigned), stream);
  void* args[] = {&p};
  hipError_t e = hipLaunchCooperativeKernel((void*)mega, dim3(grid_blocks), dim3(256), args, LDS_BYTES, stream);
  if (e != hipSuccess) fprintf(stderr, "cooperative launch failed: %s (grid %d)\n", hipGetErrorString(e), grid_blocks);
}
```

```cpp
#define STOP_AFTER 0
#include <hip/hip_runtime.h>
#include <hip/hip_cooperative_groups.h>
#include <cstdio>
namespace cg = cooperative_groups;

typedef unsigned short u16;
using bf16x8 = __attribute__((ext_vector_type(8))) short;
using f32x4 = __attribute__((ext_vector_type(4))) float;
using u32x4 = __attribute__((ext_vector_type(4))) unsigned;
#define DI __device__ __forceinline__
#define MFMA16(a, b, c) __builtin_amdgcn_mfma_f32_16x16x32_bf16((a), (b), (c), 0, 0, 0)

constexpr int S = 8192, TOK = 65536;
constexpr int INW = 2328, INP = 2432;
constexpr float ALPHA = 1.41421356237f;
constexpr float LOG2E = 1.4426950408889634f;
constexpr float QSCALE = 0.125f * LOG2E;
constexpr float NEGB = -1e30f, MINIT = -30000.f;
constexpr float EPS = 1e-5f;
constexpr int GMLP_EARLY = 2048;

constexpr size_t SZ_WTIN = (size_t)INP * 1024 * 2;
constexpr size_t SZ_WTO = (size_t)1024 * 1024 * 2;
constexpr size_t SZ_WT13 = (size_t)5632 * 1024 * 2;
constexpr size_t SZ_WT2 = (size_t)1024 * 2816 * 2;
constexpr size_t SZ_WTC1 = (size_t)256 * 2048 * 2;
constexpr size_t SZ_WTC2 = (size_t)128 * 256 * 2;
constexpr size_t OFF_WTIN = 0;
constexpr size_t OFF_WTO = OFF_WTIN + 2 * SZ_WTIN;
constexpr size_t OFF_WT13 = OFF_WTO + 2 * SZ_WTO;
constexpr size_t OFF_WT2 = OFF_WT13 + 2 * SZ_WT13;
constexpr size_t OFF_WTC1 = OFF_WT2 + 2 * SZ_WT2;
constexpr size_t OFF_WTC2 = OFF_WTC1 + 4 * SZ_WTC1;
constexpr size_t OFF_MODP = OFF_WTC2 + 4 * SZ_WTC2;
constexpr size_t SZ_MOD = (size_t)2 * 8 * 6144 * 4;
constexpr size_t OFF_MOD = OFF_MODP + 16 * SZ_MOD;
constexpr size_t SZ_CMP = (size_t)8 * 2 * 512 * 64 * 2;
constexpr size_t OFF_CB1P = OFF_MOD + SZ_MOD;
constexpr size_t OFF_CB1 = OFF_CB1P + 16 * 4 * 256 * 4;
constexpr size_t OFF_KCMP = OFF_CB1 + 4 * 256 * 4;
constexpr size_t OFF_VCMPT = OFF_KCMP + SZ_CMP;
constexpr size_t OFF_X1 = OFF_VCMPT + SZ_CMP;
constexpr size_t OFF_H = OFF_X1 + (size_t)TOK * 1024 * 4;
constexpr size_t OFF_A = OFF_H + (size_t)TOK * 1024 * 2;
constexpr size_t SZ_KV = (size_t)TOK * 128 * 2;
constexpr size_t A_Q = 0;
constexpr size_t A_KC = A_Q + (size_t)TOK * 512 * 2;
constexpr size_t A_VC = A_KC + SZ_KV;
constexpr size_t A_KS = A_VC + SZ_KV;
constexpr size_t A_VST = A_KS + SZ_KV;
constexpr size_t A_KW = A_VST + SZ_KV;
constexpr size_t A_VWT = A_KW + SZ_KV;
constexpr size_t A_G = A_VWT + SZ_KV;
constexpr size_t A_U = A_G + (size_t)TOK * 24 * 4;
constexpr size_t A_VGT = A_U + (size_t)TOK * 512 * 2;
constexpr size_t A_AC = A_VGT + (size_t)TOK * 512 * 2;
constexpr size_t A_HC = A_AC + (size_t)2 * 8192 * 2048 * 2;
constexpr size_t A_END = A_HC + (size_t)2 * 8192 * 256 * 2;
constexpr size_t OFF_ST1 = OFF_A + A_END;
constexpr size_t OFF_ST2 = OFF_ST1 + (size_t)TOK * 8;
constexpr size_t OFF_BAR = OFF_ST2 + (size_t)TOK * 8;

struct Params {
  const float *x, *c, *w_ada, *b_ada, *w_in, *cmp_pos, *cmp_w1, *cmp_w2, *vn_g, *vn_b, *w_s, *b_s, *out_g, *w_o,
      *ln1_g, *ln1_b, *w1, *w3, *w2, *ln2_g, *ln2_b;
  float* out;
  char* ws;
};

DI u16 f2bf(float x) { unsigned u = __float_as_uint(x); u += 0x7fffu + ((u >> 16) & 1u); return (u16)(u >> 16); }
DI float bf2f(u16 h) { return __uint_as_float(((unsigned)h) << 16); }
typedef __bf16 bf16x2_t __attribute__((ext_vector_type(2)));
typedef float f32x2_t __attribute__((ext_vector_type(2)));
DI unsigned pack2(float a, float b) {
  f32x2_t v = {a, b};
  bf16x2_t r = __builtin_convertvector(v, bf16x2_t);
  return __builtin_bit_cast(unsigned, r);
}
DI float gelu_t(float x) { float u = 1.5957691216f * (x + 0.044715f * x * x * x); return x / (1.f + __expf(-u)); }
DI float sigm(float x) { return 1.f / (1.f + __expf(-x)); }
DI float ex2(float x) { return __builtin_amdgcn_exp2f(x); }
typedef unsigned u32x2v __attribute__((ext_vector_type(2)));
DI float rows_max(float x) {
  u32x2v a = __builtin_amdgcn_permlane16_swap(__float_as_uint(x), __float_as_uint(x), false, false);
  const float m1 = fmaxf(__uint_as_float(a[0]), __uint_as_float(a[1]));
  u32x2v b = __builtin_amdgcn_permlane32_swap(__float_as_uint(m1), __float_as_uint(m1), false, false);
  return fmaxf(__uint_as_float(b[0]), __uint_as_float(b[1]));
}
DI float rows_sum(float x) {
  u32x2v a = __builtin_amdgcn_permlane16_swap(__float_as_uint(x), __float_as_uint(x), false, false);
  const float s1 = __uint_as_float(a[0]) + __uint_as_float(a[1]);
  u32x2v b = __builtin_amdgcn_permlane32_swap(__float_as_uint(s1), __float_as_uint(s1), false, false);
  return __uint_as_float(b[0]) + __uint_as_float(b[1]);
}
DI int otid() { int t = threadIdx.x; asm volatile("" : "+v"(t)); return t; }

template <int MODE> DI int map_row(int n) {
  if (MODE == 1) return n < 1280 ? n : (n < 1304 ? n + 1024 : n - 24);
  if (MODE == 2) return (n >> 5) * 64 + (n & 31);
  if (MODE == 3) return (n >> 5) * 64 + 32 + (n & 31);
  return n;
}

template <int MODE>
DI void conv_tile(const float* __restrict__ W, int K, int N, u16* __restrict__ Wt, int ldk, int tile, float* tl) {
  const int tiles_n = (N + 63) / 64;
  const int tk = tile / tiles_n, tn = tile % tiles_n;
  const int k0 = tk * 64, n0 = tn * 64;
  const int tid = otid();
#pragma unroll
  for (int i = 0; i < 16; ++i) {
    int idx = tid + 256 * i;
    int r = idx >> 6, c = idx & 63;
    int n = n0 + c;
    tl[r * 65 + c] = (n < N) ? W[(long)(k0 + r) * N + n] : 0.f;
  }
  __syncthreads();
  const int nl = tid >> 2, kc = tid & 3;
  const int n = n0 + nl;
  if (n < N) {
    const int row = map_row<MODE>(n);
    unsigned pk[8];
#pragma unroll
    for (int i = 0; i < 8; ++i) pk[i] = pack2(tl[(kc * 16 + 2 * i) * 65 + nl], tl[(kc * 16 + 2 * i + 1) * 65 + nl]);
    uint4* dst = (uint4*)(Wt + (long)row * ldk + k0 + kc * 16);
    dst[0] = make_uint4(pk[0], pk[1], pk[2], pk[3]);
    dst[1] = make_uint4(pk[4], pk[5], pk[6], pk[7]);
  }
  __syncthreads();
}

DI void phase0a(const Params& p, char* smem) {
  char* ws = p.ws;
  const int tid = threadIdx.x;
  constexpr int PER_LAYER = 592 + 256 + 704 * 3 + 128 * 2 + 4 * 2;
  constexpr int NCONV = 2 * PER_LAYER;
  constexpr int NTOT = NCONV + 768 + 2 + 64;
  for (int it = blockIdx.x; it < NTOT; it += gridDim.x) {
    if (it < NCONV) {
      const int l = it / PER_LAYER;
      const int li = it % PER_LAYER;
      int base = 0;
#define SEG(MODE, SRC, DST, K_, N_, LDK)                                                   \
  {                                                                                        \
    const int nt_ = ((K_) / 64) * (((N_) + 63) / 64);                                      \
    if (li >= base && li < base + nt_) conv_tile<MODE>(SRC, K_, N_, DST, LDK, li - base, (float*)smem); \
    base += nt_;                                                                           \
  }
      SEG(1, p.w_in + (size_t)l * 1024 * INW, (u16*)(ws + OFF_WTIN + l * SZ_WTIN), 1024, INW, 1024)
      SEG(0, p.w_o + (size_t)l * 1024 * 1024, (u16*)(ws + OFF_WTO + l * SZ_WTO), 1024, 1024, 1024)
      SEG(2, p.w1 + (size_t)l * 1024 * 2816, (u16*)(ws + OFF_WT13 + l * SZ_WT13), 1024, 2816, 1024)
      SEG(3, p.w3 + (size_t)l * 1024 * 2816, (u16*)(ws + OFF_WT13 + l * SZ_WT13), 1024, 2816, 1024)
      SEG(0, p.w2 + (size_t)l * 2816 * 1024, (u16*)(ws + OFF_WT2 + l * SZ_WT2), 2816, 1024, 2816)
      SEG(0, p.cmp_w1 + (size_t)(l * 2 + 0) * 2048 * 256, (u16*)(ws + OFF_WTC1 + (l * 2 + 0) * SZ_WTC1), 2048, 256, 2048)
      SEG(0, p.cmp_w1 + (size_t)(l * 2 + 1) * 2048 * 256, (u16*)(ws + OFF_WTC1 + (l * 2 + 1) * SZ_WTC1), 2048, 256, 2048)
      SEG(0, p.cmp_w2 + (size_t)(l * 2 + 0) * 256 * 64, (u16*)(ws + OFF_WTC2 + (l * 2 + 0) * SZ_WTC2), 256, 64, 256)
      SEG(0, p.cmp_w2 + (size_t)(l * 2 + 1) * 256 * 64, (u16*)(ws + OFF_WTC2 + (l * 2 + 1) * SZ_WTC2), 256, 64, 256)
#undef SEG
    } else if (it < NCONV + 768) {
      const int idx = it - NCONV;
      const int l = idx / 384, r = idx % 384, nb = r / 16, kc = r % 16;
      float* cs = (float*)smem;
      for (int i = tid; i < 512; i += 256) {
        int b = i >> 6, k = i & 63;
        float cv = p.c[b * 1024 + kc * 64 + k];
        cs[i] = cv * sigm(cv);
      }
      __syncthreads();
      const int n = nb * 256 + tid;
      float acc[8];
#pragma unroll
      for (int b = 0; b < 8; ++b) acc[b] = 0.f;
      const float* wp = p.w_ada + ((size_t)l * 1024 + kc * 64) * 6144 + n;
#pragma unroll 8
      for (int k = 0; k < 64; ++k) {
        float wv = wp[(size_t)k * 6144];
#pragma unroll
        for (int b = 0; b < 8; ++b) acc[b] += cs[b * 64 + k] * wv;
      }
      float* modp = (float*)(ws + OFF_MODP);
#pragma unroll
      for (int b = 0; b < 8; ++b) modp[(size_t)((kc * 2 + l) * 8 + b) * 6144 + n] = acc[b];
      __syncthreads();
    } else if (it < NCONV + 768 + 2) {
      const int l = it - NCONV - 768;
      uint4* dst = (uint4*)(ws + OFF_WTIN + l * SZ_WTIN + (size_t)INW * 1024 * 2);
      const int n16 = (INP - INW) * 1024 * 2 / 16;
      for (int i = tid; i < n16; i += 256) dst[i] = make_uint4(0, 0, 0, 0);
    } else {
      const int idx = it - NCONV - 768 - 2;
      const int lw = idx >> 4, kc = idx & 15;
      const float* pos = p.cmp_pos + (size_t)lw * 2048 + kc * 128;
      const float* w1p = p.cmp_w1 + ((size_t)lw * 2048 + kc * 128) * 256 + tid;
      float a = 0.f;
#pragma unroll 8
      for (int k = 0; k < 128; ++k) a += pos[k] * w1p[(size_t)k * 256];
      ((float*)(ws + OFF_CB1P))[(kc * 4 + lw) * 256 + tid] = a;
    }
  }
}

DI void phase0b(const Params& p) {
  const float* modp = (const float*)(p.ws + OFF_MODP);
  float* mod = (float*)(p.ws + OFF_MOD);
  const int n = 2 * 8 * 6144;
  for (int i = blockIdx.x * 256 + threadIdx.x; i < n; i += gridDim.x * 256) {
    int l = i / (8 * 6144), c = i % 6144;
    float a = p.b_ada[l * 6144 + c];
#pragma unroll
    for (int kc = 0; kc < 16; ++kc) a += modp[(size_t)kc * n + i];
    mod[i] = a;
  }
  const float* cbp = (const float*)(p.ws + OFF_CB1P);
  float* cb = (float*)(p.ws + OFF_CB1);
  for (int i = blockIdx.x * 256 + threadIdx.x; i < 1024; i += gridDim.x * 256) {
    float a = 0.f;
#pragma unroll
    for (int kc = 0; kc < 16; ++kc) a += cbp[kc * 1024 + i];
    cb[i] = a;
  }
}

DI void phase_mod_x(const Params& p) {
  const float* mod = (const float*)(p.ws + OFF_MOD);
  u16* H = (u16*)(p.ws + OFF_H);
  const long nchunk = (long)TOK * 1024 / 8;
  const long stride = (long)gridDim.x * 256;
  for (long i = (long)blockIdx.x * 256 + otid(); i < nchunk / 2; i += stride) {
    float4 xa[2][2], sa[2][2], ha[2][2];
    long ee[2];
#pragma unroll
    for (int u = 0; u < 2; ++u) {
      const long e = (i + u * (nchunk / 2)) * 8;
      ee[u] = e;
      const int col = (int)(e & 1023);
      const int b = (int)(e >> 23);
      const float4* xp = (const float4*)(p.x + e);
      const float4* sh = (const float4*)(mod + (size_t)b * 6144 + 0 + col);
      const float4* sc = (const float4*)(mod + (size_t)b * 6144 + 1024 + col);
      xa[u][0] = xp[0]; xa[u][1] = xp[1];
      sa[u][0] = sc[0]; sa[u][1] = sc[1];
      ha[u][0] = sh[0]; ha[u][1] = sh[1];
    }
#pragma unroll
    for (int u = 0; u < 2; ++u) {
      const float4 x0 = xa[u][0], x1 = xa[u][1], s0 = sa[u][0], s1 = sa[u][1], h0 = ha[u][0], h1 = ha[u][1];
      uint4 o;
      o.x = pack2(x0.x * (1.f + s0.x) + h0.x, x0.y * (1.f + s0.y) + h0.y);
      o.y = pack2(x0.z * (1.f + s0.z) + h0.z, x0.w * (1.f + s0.w) + h0.w);
      o.z = pack2(x1.x * (1.f + s1.x) + h1.x, x1.y * (1.f + s1.y) + h1.y);
      o.w = pack2(x1.z * (1.f + s1.z) + h1.z, x1.w * (1.f + s1.w) + h1.w);
      *(uint4*)(H + ee[u]) = o;
    }
  }
}

constexpr int LDS_BYTES = 73728 + 16;
DI int swz_key(int r) { return (0x78 >> (2 * ((r >> 2) & 3))) & 3; }
template <int MT>
DI void g_issue(const u16* __restrict__ Ap, int lda, const u16* __restrict__ Bp, int ldb, int st, int ksa, int tid, char* buf) {
  constexpr int AOFF = 2048 * MT;
  const int koffA = (st >> 1) * ksa + (st & 1) * 32;
  const int koffB = st * 32;
  const int wbase = (tid & ~63) * 16;
#pragma unroll
  for (int i = 0; i < MT / 2; ++i) {
    const int c = tid + 256 * i;
    const int row = c >> 2, ph = c & 3;
    const int lc = ph ^ swz_key(row);
    __builtin_amdgcn_global_load_lds((const unsigned*)(Ap + (size_t)row * lda + koffA + lc * 8),
                                     (unsigned*)(buf + i * 4096 + wbase), 16, 0, 0);
  }
#pragma unroll
  for (int i = 0; i < 2; ++i) {
    const int c = tid + 256 * i;
    const int row = c >> 2, ph = c & 3;
    const int lc = ph ^ swz_key(row);
    __builtin_amdgcn_global_load_lds((const unsigned*)(Bp + (size_t)row * ldb + koffB + lc * 8),
                                     (unsigned*)(buf + AOFF + i * 4096 + wbase), 16, 0, 0);
  }
}
#define DSR(dst, addr, off) "ds_read_b128 %" #dst ", %" #addr " offset:" #off "\n\t"
template <bool SWAP, int MT>
DI void g_compute(const char* sA, f32x4 (&acc)[MT][4], int wm, int wn, int lr, int lg) {
  const int ra = wm * (16 * MT) + lr, rb = wn * 64 + lr;
  const unsigned aA = (unsigned)(size_t)sA + ra * 64 + ((lg ^ swz_key(ra)) << 4);
  const unsigned aB = (unsigned)(size_t)sA + 2048 * MT + rb * 64 + ((lg ^ swz_key(rb)) << 4);
  bf16x8 af[MT], bfr[4];
  if constexpr (MT == 8) {
    asm volatile(DSR(0, 8, 0) DSR(1, 8, 1024) DSR(2, 8, 2048) DSR(3, 8, 3072) DSR(4, 9, 0) DSR(5, 9, 1024) DSR(6, 9, 2048) DSR(7, 9, 3072)
                 : "=&v"(bfr[0]), "=&v"(bfr[1]), "=&v"(bfr[2]), "=&v"(bfr[3]), "=&v"(af[0]), "=&v"(af[1]), "=&v"(af[2]), "=&v"(af[3])
                 : "v"(aB), "v"(aA)
                 : "memory");
    asm volatile(DSR(0, 4, 4096) DSR(1, 4, 5120) DSR(2, 4, 6144) DSR(3, 4, 7168)
                 : "=&v"(af[4]), "=&v"(af[5]), "=&v"(af[6]), "=&v"(af[7])
                 : "v"(aA)
                 : "memory");
    asm volatile("s_waitcnt lgkmcnt(4)"
                 : "+v"(bfr[0]), "+v"(bfr[1]), "+v"(bfr[2]), "+v"(bfr[3]), "+v"(af[0]), "+v"(af[1]), "+v"(af[2]), "+v"(af[3]));
  } else {
    asm volatile(DSR(0, 6, 0) DSR(1, 6, 1024) DSR(2, 6, 2048) DSR(3, 6, 3072) DSR(4, 7, 0) DSR(5, 7, 1024)
                 : "=&v"(bfr[0]), "=&v"(bfr[1]), "=&v"(bfr[2]), "=&v"(bfr[3]), "=&v"(af[0]), "=&v"(af[1])
                 : "v"(aB), "v"(aA)
                 : "memory");
    asm volatile(DSR(0, 2, 2048) DSR(1, 2, 3072) : "=&v"(af[2]), "=&v"(af[3]) : "v"(aA) : "memory");
    asm volatile("s_waitcnt lgkmcnt(2)"
                 : "+v"(bfr[0]), "+v"(bfr[1]), "+v"(bfr[2]), "+v"(bfr[3]), "+v"(af[0]), "+v"(af[1]));
  }
  __builtin_amdgcn_sched_barrier(0);
#pragma unroll
  for (int mi = 0; mi < MT / 2; ++mi)
#pragma unroll
    for (int ni = 0; ni < 4; ++ni)
      acc[mi][ni] = SWAP ? MFMA16(bfr[ni], af[mi], acc[mi][ni]) : MFMA16(af[mi], bfr[ni], acc[mi][ni]);
  __builtin_amdgcn_sched_barrier(0);
  if constexpr (MT == 8) asm volatile("s_waitcnt lgkmcnt(0)" : "+v"(af[4]), "+v"(af[5]), "+v"(af[6]), "+v"(af[7]), "+v"(acc[3][3]));
  else asm volatile("s_waitcnt lgkmcnt(0)" : "+v"(af[2]), "+v"(af[3]), "+v"(acc[1][3]));
  __builtin_amdgcn_sched_barrier(0);
#pragma unroll
  for (int mi = MT / 2; mi < MT; ++mi)
#pragma unroll
    for (int ni = 0; ni < 4; ++ni)
      acc[mi][ni] = SWAP ? MFMA16(bfr[ni], af[mi], acc[mi][ni]) : MFMA16(af[mi], bfr[ni], acc[mi][ni]);
  __builtin_amdgcn_sched_barrier(0);
}
#define RAW_BARRIER() do { asm volatile("s_waitcnt lgkmcnt(0)" ::: "memory"); __builtin_amdgcn_s_barrier(); } while (0)

template <bool SWAP, int MT, class Epi>
DI void gemm_tile(const u16* __restrict__ Ap, int lda, const u16* __restrict__ Bp, int ldb, int nk, int tm, int tn, int tid,
                  char* smem, Epi epi, int ksa = 64) {
  constexpr int NBUF = (MT == 8) ? 3 : 4;
  constexpr int BUFSZ = 2048 * MT + 8192;
  constexpr int LA = NBUF - 1;
  const int lane = tid & 63, w = tid >> 6, wm = w >> 1, wn = w & 1;
  const int lr = lane & 15, lg = lane >> 4;
  const int nks = nk * 2;
  f32x4 acc[MT][4];
#pragma unroll
  for (int i = 0; i < MT; ++i)
#pragma unroll
    for (int j = 0; j < 4; ++j) acc[i][j] = f32x4{0.f, 0.f, 0.f, 0.f};
#pragma unroll
  for (int s = 0; s < LA; ++s) g_issue<MT>(Ap, lda, Bp, ldb, s, ksa, tid, smem + s * BUFSZ);
  int bi = 0, bn = LA;
  for (int st = 0; st < nks; ++st) {
    if (MT == 8) {
      if (st + 1 < nks) asm volatile("s_waitcnt vmcnt(6)" ::: "memory");
      else asm volatile("s_waitcnt vmcnt(0)" ::: "memory");
    } else {
      if (st + 2 < nks) asm volatile("s_waitcnt vmcnt(8)" ::: "memory");
      else if (st + 1 < nks) asm volatile("s_waitcnt vmcnt(4)" ::: "memory");
      else asm volatile("s_waitcnt vmcnt(0)" ::: "memory");
    }
    RAW_BARRIER();
    if (st + LA < nks) g_issue<MT>(Ap, lda, Bp, ldb, st + LA, ksa, tid, smem + bn * BUFSZ);
    g_compute<SWAP, MT>(smem + bi * BUFSZ, acc, wm, wn, lr, lg);
    bi = (bi + 1 == NBUF) ? 0 : bi + 1;
    bn = (bn + 1 == NBUF) ? 0 : bn + 1;
  }
  RAW_BARRIER();
  epi(SWAP, tm, tn, wm, wn, lr, lg, acc);
}

template <int MT, class AB, class Sel, class Epi>
DI void gemm_phase_g(AB abase, int lda, int ksa, const u16* __restrict__ Bt, int ldb, int ntm, int ntn, int K, int vb, int nvb,
                     char* smem, Sel swapsel, Epi epi) {
  if (vb < 0 || vb >= nvb) return;
  const int ntiles = ntm * ntn;
  const int nk = K / 64;
  const int nbx = nvb >> 3;
  const int x = vb & 7, lb = vb >> 3;
  const int rgt = 4 * ntn;
  const int per_xcd = (ntm >> 5) * rgt;
  for (int ql = lb; ql < per_xcd; ql += nbx) {
    const int rgi = ql / rgt;
    const int i = ql - rgi * rgt;
    const int tn = i >> 2;
    const int tm = (x + 8 * rgi) * 4 + (i & 3);
    const u16* Ap = abase(tm);
    const u16* Bp = Bt + (size_t)tn * 128 * ldb;
    const int tid = otid();
    if (swapsel(tn)) gemm_tile<true, MT>(Ap, lda, Bp, ldb, nk, tm, tn, tid, smem, epi, ksa);
    else gemm_tile<false, MT>(Ap, lda, Bp, ldb, nk, tm, tn, tid, smem, epi, ksa);
  }
}
template <int MT, class Sel, class Epi>
DI void gemm_phase(const u16* __restrict__ A, int lda, const u16* __restrict__ Bt, int ldb, int ntm, int ntn, int K,
                   int vb, int nvb, char* smem, Sel swapsel, Epi epi) {
  auto ab = [=](int tm) { return A + (size_t)tm * (32 * MT) * lda; };
  gemm_phase_g<MT>(ab, lda, 64, Bt, ldb, ntm, ntn, K, vb, nvb, smem, swapsel, epi);
}
template <class Epi, class Post>
DI void gemm_rowblock_phase(const u16* __restrict__ A, int lda, const u16* __restrict__ Bt, int ldb, int ntm, int ntn, int K,
                            int vb, int nvb, char* smem, Epi epi, Post post) {
  const int nk = K / 64;
  for (int tm = vb; tm < ntm; tm += nvb) {
    const u16* Ap = A + (size_t)tm * 128 * lda;
    for (int tn = 0; tn < ntn; ++tn) {
      const int tid = otid();
      gemm_tile<true, 4>(Ap, lda, Bt + (size_t)tn * 128 * ldb, ldb, nk, tm, tn, tid, smem, epi, 64);
    }
    asm volatile("s_waitcnt vmcnt(0)" ::: "memory");
    __syncthreads();
    post(tm);
  }
}

DI void ln_rows(float* buf, const float* __restrict__ g, const float* __restrict__ bt, const float* __restrict__ modl,
                int sh_off, int sc_off, u16* H, float* stats, bool write_x) {
  const int tid_ = otid();
  const int lane = tid_ & 63, w = tid_ >> 6;
  constexpr int NR = 4;
  for (int rq = (blockIdx.x * 4 + w) * NR; rq < TOK; rq += gridDim.x * 4 * NR) {
    const int r0 = TOK - NR - rq;
    f32x4 v[NR][4];
#pragma unroll
    for (int rr = 0; rr < NR; ++rr) {
      const f32x4* rp = (const f32x4*)(buf + (size_t)(r0 + rr) * 1024);
#pragma unroll
      for (int i = 0; i < 4; ++i) v[rr][i] = rp[lane + 64 * i];
    }
    float s[NR], q[NR];
#pragma unroll
    for (int rr = 0; rr < NR; ++rr) {
      s[rr] = 0.f;
#pragma unroll
      for (int i = 0; i < 4; ++i) s[rr] += v[rr][i][0] + v[rr][i][1] + v[rr][i][2] + v[rr][i][3];
    }
#pragma unroll
    for (int o = 32; o >= 1; o >>= 1) {
#pragma unroll
      for (int rr = 0; rr < NR; ++rr) s[rr] += __shfl_xor(s[rr], o);
    }
#pragma unroll
    for (int rr = 0; rr < NR; ++rr) {
      const float mu = s[rr] * (1.f / 1024.f);
      q[rr] = 0.f;
#pragma unroll
      for (int i = 0; i < 4; ++i)
#pragma unroll
        for (int k = 0; k < 4; ++k) { const float a = v[rr][i][k] - mu; q[rr] += a * a; }
    }
#pragma unroll
    for (int o = 32; o >= 1; o >>= 1) {
#pragma unroll
      for (int rr = 0; rr < NR; ++rr) q[rr] += __shfl_xor(q[rr], o);
    }
    const int b = r0 >> 13;
#pragma unroll
    for (int rr = 0; rr < NR; ++rr) {
      const int row = r0 + rr;
      const float mu = s[rr] * (1.f / 1024.f);
      const float rs = rsqrtf(q[rr] * (1.f / 1024.f) + EPS);
      if (stats && lane == 0) *(float2*)(stats + (size_t)row * 2) = make_float2(mu, rs);
      f32x4* rp = (f32x4*)(buf + (size_t)row * 1024);
#pragma unroll
      for (int i = 0; i < 4; ++i) {
        const int col = (lane + 64 * i) * 4;
        const float4 gg = *(const float4*)(g + col), bb = *(const float4*)(bt + col);
        f32x4 y;
        y[0] = (v[rr][i][0] - mu) * rs * gg.x + bb.x;
        y[1] = (v[rr][i][1] - mu) * rs * gg.y + bb.y;
        y[2] = (v[rr][i][2] - mu) * rs * gg.z + bb.z;
        y[3] = (v[rr][i][3] - mu) * rs * gg.w + bb.w;
        if (write_x) rp[lane + 64 * i] = y;
        if (H) {
          const float4 sh = *(const float4*)(modl + (size_t)b * 6144 + sh_off + col);
          const float4 sc = *(const float4*)(modl + (size_t)b * 6144 + sc_off + col);
          uint2 o2;
          o2.x = pack2(y[0] * (1.f + sc.x) + sh.x, y[1] * (1.f + sc.y) + sh.y);
          o2.y = pack2(y[2] * (1.f + sc.z) + sh.z, y[3] * (1.f + sc.w) + sh.w);
          *(uint2*)(H + (size_t)row * 1024 + col) = o2;
        }
      }
    }
  }
}

DI void ln_block(float* buf, int row0, const float* __restrict__ g, const float* __restrict__ bt,
                 const float* __restrict__ modl, int sh_off, int sc_off, u16* H) {
  const int tid_ = otid();
  const int lane = tid_ & 63, w = tid_ >> 6;
  for (int rr = 0; rr < 32; ++rr) {
    const int row = row0 + w * 32 + rr;
    f32x4* rp = (f32x4*)(buf + (size_t)row * 1024);
    f32x4 v[4];
    float s = 0.f;
#pragma unroll
    for (int i = 0; i < 4; ++i) { v[i] = __builtin_nontemporal_load(rp + lane + 64 * i); s += v[i][0] + v[i][1] + v[i][2] + v[i][3]; }
#pragma unroll
    for (int o = 32; o >= 1; o >>= 1) s += __shfl_xor(s, o);
    const float mu = s * (1.f / 1024.f);
    float q = 0.f;
#pragma unroll
    for (int i = 0; i < 4; ++i)
#pragma unroll
      for (int k = 0; k < 4; ++k) { float a = v[i][k] - mu; q += a * a; }
#pragma unroll
    for (int o = 32; o >= 1; o >>= 1) q += __shfl_xor(q, o);
    const float rs = rsqrtf(q * (1.f / 1024.f) + EPS);
    const int b = row >> 13;
#pragma unroll
    for (int i = 0; i < 4; ++i) {
      const int col = (lane + 64 * i) * 4;
      const float4 gg = *(const float4*)(g + col), bb = *(const float4*)(bt + col);
      f32x4 y;
      y[0] = (v[i][0] - mu) * rs * gg.x + bb.x;
      y[1] = (v[i][1] - mu) * rs * gg.y + bb.y;
      y[2] = (v[i][2] - mu) * rs * gg.z + bb.z;
      y[3] = (v[i][3] - mu) * rs * gg.w + bb.w;
      rp[lane + 64 * i] = y;
      if (H) {
        const float4 sh = *(const float4*)(modl + (size_t)b * 6144 + sh_off + col);
        const float4 sc = *(const float4*)(modl + (size_t)b * 6144 + sc_off + col);
        uint2 o2;
        o2.x = pack2(y[0] * (1.f + sc.x) + sh.x, y[1] * (1.f + sc.y) + sh.y);
        o2.y = pack2(y[2] * (1.f + sc.z) + sh.z, y[3] * (1.f + sc.w) + sh.w);
        *(uint2*)(H + (size_t)row * 1024 + col) = o2;
      }
    }
  }
}

DI void gmlp_item(const Params& p, int l, int item) {
  const int b = item >> 9, c = (item >> 3) & 63, grp = item & 7;
  const int tid_ = otid();
  const int lane = tid_ & 63, w = tid_ >> 6, lr = lane & 15, lg = lane >> 4;
  const float* wsp = p.w_s + (size_t)(l * 8 + grp) * 128 * 128;
  const u16* vgt = (const u16*)(p.ws + OFF_A + A_VGT) + (size_t)(b * 8 + grp) * 64 * S + c * 128;
  const u16* U = (const u16*)(p.ws + OFF_A + A_U);
  u16* OM = (u16*)(p.ws + OFF_H);
  f32x4 acc[4][2];
#pragma unroll
  for (int i = 0; i < 4; ++i)
#pragma unroll
    for (int j = 0; j < 2; ++j) acc[i][j] = f32x4{0.f, 0.f, 0.f, 0.f};
#pragma unroll
  for (int ks = 0; ks < 4; ++ks) {
    const int s0 = ks * 32 + lg * 8;
    bf16x8 af[4];
#pragma unroll
    for (int dt = 0; dt < 4; ++dt) af[dt] = *(const bf16x8*)(vgt + (size_t)(dt * 16 + lr) * S + s0);
#pragma unroll
    for (int nt = 0; nt < 2; ++nt) {
      const int t = w * 32 + nt * 16 + lr;
      const float4* wp = (const float4*)(wsp + t * 128 + s0);
      float4 a0 = wp[0], a1 = wp[1];
      unsigned pw[4];
      pw[0] = pack2((s0 + 0 <= t) ? a0.x : 0.f, (s0 + 1 <= t) ? a0.y : 0.f);
      pw[1] = pack2((s0 + 2 <= t) ? a0.z : 0.f, (s0 + 3 <= t) ? a0.w : 0.f);
      pw[2] = pack2((s0 + 4 <= t) ? a1.x : 0.f, (s0 + 5 <= t) ? a1.y : 0.f);
      pw[3] = pack2((s0 + 6 <= t) ? a1.z : 0.f, (s0 + 7 <= t) ? a1.w : 0.f);
      bf16x8 bw = __builtin_bit_cast(bf16x8, make_uint4(pw[0], pw[1], pw[2], pw[3]));
#pragma unroll
      for (int dt = 0; dt < 4; ++dt) acc[dt][nt] = MFMA16(af[dt], bw, acc[dt][nt]);
    }
  }
#pragma unroll
  for (int nt = 0; nt < 2; ++nt) {
    const int t = w * 32 + nt * 16 + lr;
    const size_t tok = (size_t)b * S + c * 128 + t;
    const float bias = p.b_s[(l * 8 + grp) * 128 + t];
    float val[4][4];
    float ss = 0.f;
#pragma unroll
    for (int dt = 0; dt < 4; ++dt) {
      const int d = dt * 16 + lg * 4;
      const uint2 uu = *(const uint2*)(U + tok * 512 + grp * 64 + d);
      const float u0 = bf2f(uu.x & 0xffff), u1 = bf2f(uu.x >> 16), u2 = bf2f(uu.y & 0xffff), u3 = bf2f(uu.y >> 16);
      val[dt][0] = u0 * (acc[dt][nt][0] + bias);
      val[dt][1] = u1 * (acc[dt][nt][1] + bias);
      val[dt][2] = u2 * (acc[dt][nt][2] + bias);
      val[dt][3] = u3 * (acc[dt][nt][3] + bias);
#pragma unroll
      for (int j = 0; j < 4; ++j) ss += val[dt][j] * val[dt][j];
    }
    ss = rows_sum(ss);
    const float r = rsqrtf(ss * (1.f / 64.f) + EPS);
#pragma unroll
    for (int dt = 0; dt < 4; ++dt) {
      const int d = dt * 16 + lg * 4;
      const float4 gg = *(const float4*)(p.out_g + l * 1024 + 512 + grp * 64 + d);
      uint2 st;
      st.x = pack2(val[dt][0] * r * gg.x, val[dt][1] * r * gg.y);
      st.y = pack2(val[dt][2] * r * gg.z, val[dt][3] * r * gg.w);
      *(uint2*)(OM + tok * 1024 + 512 + grp * 64 + d) = st;
    }
  }
}

constexpr int SM_K = 0, SM_V = 8192, SM_IMP = 8192 + 8704, SM_SEL = SM_IMP + 64 * 132 * 4, SM_UNI = SM_SEL + 1024;

struct KVr { u32x4 k0, k1, v0, v1; };
DI void kv_load_k(KVr& t, const u16* __restrict__ src, int stride, int tid) {
  const int r = tid >> 3, ch = tid & 7;
  t.k0 = *(const u32x4*)(src + (size_t)r * stride + ch * 8);
  t.k1 = *(const u32x4*)(src + (size_t)(r + 32) * stride + ch * 8);
}
DI void kv_load_v(KVr& t, const u16* __restrict__ src, int stride, int tid) {
  const int d = tid >> 3, ch = tid & 7;
  t.v0 = *(const u32x4*)(src + (size_t)d * stride + ch * 8);
  t.v1 = *(const u32x4*)(src + (size_t)(d + 32) * stride + ch * 8);
}
DI void kv_store_k(const KVr& t, char* sK, int tid) {
  const int r = tid >> 3, ch = tid & 7;
  char* pk = sK + r * 128 + ((ch ^ (r & 7)) << 4);
  *(u32x4*)(pk) = t.k0;
  *(u32x4*)(pk + 4096) = t.k1;
}
DI void kv_store_v(const KVr& t, char* sV, int tid) {
  const int d = tid >> 3, ch = tid & 7;
  uint2* d0 = (uint2*)(sV + d * 136 + ch * 16);
  d0[0] = make_uint2(t.v0[0], t.v0[1]);
  d0[1] = make_uint2(t.v0[2], t.v0[3]);
  uint2* d1 = (uint2*)(sV + (d + 32) * 136 + ch * 16);
  d1[0] = make_uint2(t.v1[0], t.v1[1]);
  d1[1] = make_uint2(t.v1[2], t.v1[3]);
}
DI int prev_set_bit(const unsigned* uni, int from) {
  int res = -1;
#pragma unroll
  for (int wd = 0; wd < 4; ++wd) {
    unsigned mw = uni[wd];
    const int hi = from - wd * 32;
    if (hi < 0) mw = 0u;
    else if (hi < 31) mw &= (2u << hi) - 1u;
    if (mw) res = wd * 32 + 31 - __clz(mw);
  }
  return __builtin_amdgcn_readfirstlane(res);
}
DI int next_set_bit(const unsigned* uni, int from) {
  int res = 1000;
#pragma unroll
  for (int wd = 3; wd >= 0; --wd) {
    unsigned mw = uni[wd];
    const int lo = from - wd * 32;
    if (lo >= 32) mw = 0u;
    else if (lo > 0) mw &= (~0u) << lo;
    if (mw) res = wd * 32 + __ffs(mw) - 1;
  }
  return __builtin_amdgcn_readfirstlane(res);
}

template <int MODE, bool MASKED, int WS>
DI void half_step(const char* sK, const char* sV, int half, int lr, int lg, const bf16x8 (&qf)[2][2], const unsigned (&sw)[2],
                  const float (&tb)[2], float (&m)[2], float (&lsum)[2], f32x4 (&o)[2][4], const bool (&valid)[2][4],
                  float (&psum)[2][4]) {
  bf16x8 kf[2][2], kw[2];
#pragma unroll
  for (int kt2 = 0; kt2 < 2; ++kt2) {
    const int r = half * 32 + kt2 * 16 + lr;
    kf[kt2][0] = *(const bf16x8*)(sK + r * 128 + (((lg) ^ (r & 7)) << 4));
    kf[kt2][1] = *(const bf16x8*)(sK + r * 128 + (((4 + lg) ^ (r & 7)) << 4));
    const float wv = (float)(WS * r);
    const unsigned pw = (lg == 0) ? pack2(wv, wv) : 0u;
    kw[kt2] = __builtin_bit_cast(bf16x8, make_uint4(pw, 0u, 0u, 0u));
  }
  if (MODE == 1) {
#pragma unroll
    for (int a = 0; a < 2; ++a)
#pragma unroll
      for (int j = 0; j < 4; ++j) psum[a][j] = 0.f;
  }
  bf16x8 pf[2];
  f32x4 sall[2][2];
#pragma unroll
  for (int h = 0; h < 2; ++h)
#pragma unroll
    for (int kt2 = 0; kt2 < 2; ++kt2) {
      f32x4 z = f32x4{0.f, 0.f, 0.f, 0.f};
      z = MFMA16(kw[kt2], __builtin_bit_cast(bf16x8, make_uint4(sw[h], 0u, 0u, 0u)), z);
      z = MFMA16(kf[kt2][0], qf[h][0], z);
      z = MFMA16(kf[kt2][1], qf[h][1], z);
      sall[h][kt2] = z;
    }
#pragma unroll
  for (int h = 0; h < 2; ++h) {
    f32x4 s[2] = {sall[h][0], sall[h][1]};
    float mx = NEGB;
#pragma unroll
    for (int kt2 = 0; kt2 < 2; ++kt2)
#pragma unroll
      for (int j = 0; j < 4; ++j) {
        float v = s[kt2][j];
        if (MASKED) v = valid[kt2][j] ? v : NEGB;
        s[kt2][j] = v;
        mx = fmaxf(mx, v);
      }
    if (MODE != 1) {
      mx = rows_max(mx);
      const float mn = fmaxf(m[h], mx + tb[h]);
      const float mm = mn - tb[h];
      float ps = 0.f;
#pragma unroll
      for (int kt2 = 0; kt2 < 2; ++kt2)
#pragma unroll
        for (int j = 0; j < 4; ++j) {
          float pv = ex2(s[kt2][j] - mm);
          s[kt2][j] = pv;
          ps += pv;
        }
      if (__ballot(mn != m[h]) != 0ull) {
        const float alpha = ex2(m[h] - mn);
        m[h] = mn;
        lsum[h] = lsum[h] * alpha + ps;
        if (MODE == 2) {
#pragma unroll
          for (int dt = 0; dt < 4; ++dt) o[h][dt] *= alpha;
        }
      } else {
        lsum[h] += ps;
      }
    } else {
#pragma unroll
      for (int kt2 = 0; kt2 < 2; ++kt2)
#pragma unroll
        for (int j = 0; j < 4; ++j) {
          float pv = ex2(s[kt2][j] - (m[h] - tb[h])) * lsum[h];
          s[kt2][j] = pv;
          psum[kt2][j] += pv;
        }
    }
    if (MODE != 0) {
      uint4 pk = make_uint4(pack2(s[0][0], s[0][1]), pack2(s[0][2], s[0][3]), pack2(s[1][0], s[1][1]), pack2(s[1][2], s[1][3]));
      pf[h] = __builtin_bit_cast(bf16x8, pk);
    }
  }
  if (MODE != 0) {
#pragma unroll
    for (int dt = 0; dt < 4; ++dt) {
      const char* base = sV + (dt * 16 + lr) * 136 + half * 64 + lg * 8;
      uint2 a = *(const uint2*)(base);
      uint2 c = *(const uint2*)(base + 32);
      bf16x8 vf = __builtin_bit_cast(bf16x8, make_uint4(a.x, a.y, c.x, c.y));
#pragma unroll
      for (int h = 0; h < 2; ++h) o[h][dt] = MFMA16(vf, pf[h], o[h][dt]);
    }
  }
}

DI void attn_item(const Params& p, int l, int b, int kvh, int qh, char* smem) {
  char* sK = smem + SM_K;
  char* sV = smem + SM_V;
  float* sImp = (float*)(smem + SM_IMP);
  unsigned* sSel = (unsigned*)(smem + SM_SEL);
  unsigned* sUni = (unsigned*)(smem + SM_UNI);
  const char* wsA = p.ws + OFF_A;
  const u16* Q = (const u16*)(wsA + A_Q);
  const u16* KS = (const u16*)(wsA + A_KS);
  const u16* VST = (const u16*)(wsA + A_VST);
  const u16* KW = (const u16*)(wsA + A_KW);
  const u16* VWT = (const u16*)(wsA + A_VWT);
  const float* G = (const float*)(wsA + A_G);
  const u16* KCMP = (const u16*)(p.ws + OFF_KCMP);
  const u16* VCMPT = (const u16*)(p.ws + OFF_VCMPT);
  u16* OM = (u16*)(p.ws + OFF_H);

  const int tid = otid(), lane = tid & 63, w = tid >> 6, lr = lane & 15, lg = lane >> 4;
  const int hp = w >> 1;
  const int t0 = qh * 32;
  const int cur = qh >> 1;
  const int tql = 16 * (w & 1) + lr;
  const size_t tokq = (size_t)b * S + t0 + tql;
  const int bk = b * 2 + kvh;
  const int hg0 = kvh * 4 + hp * 2;

  bf16x8 qf[2][2];
  float slope[2];
  unsigned qs[2];
#pragma unroll
  for (int h = 0; h < 2; ++h) {
    const u16* qp = Q + tokq * 512 + (hg0 + h) * 64 + lg * 8;
    qf[h][0] = *(const bf16x8*)qp;
    qf[h][1] = *(const bf16x8*)(qp + 32);
    slope[h] = ex2(-(float)(hg0 + h + 1)) * LOG2E;
    const float shi = bf2f(f2bf(slope[h]));
    qs[h] = (lg == 0) ? pack2(shi, slope[h] - shi) : 0u;
  }
  float m[2], ls[2];
  f32x4 o[2][4], otot[2][4];
  float psum[2][4];
#pragma unroll
  for (int h = 0; h < 2; ++h) {
    m[h] = MINIT;
    ls[h] = 0.f;
#pragma unroll
    for (int dt = 0; dt < 4; ++dt) o[h][dt] = f32x4{0.f, 0.f, 0.f, 0.f};
  }

  const int amax = qh >> 5;
  const u16* kc_base = KCMP + (size_t)bk * 512 * 64;
  const u16* vc_base = VCMPT + (size_t)bk * 64 * 512;
  KVr tl;
  kv_load_k(tl, kc_base, 64, tid);
  for (int a = 0; a <= amax; ++a) {
    __syncthreads();
    kv_store_k(tl, sK, tid);
    __syncthreads();
    if (a < amax) kv_load_k(tl, kc_base + (size_t)(a + 1) * 64 * 64, 64, tid);
    else { kv_load_k(tl, kc_base, 64, tid); kv_load_v(tl, vc_base, 512, tid); }
#pragma unroll
    for (int half = 0; half < 2; ++half) {
      float posf[2][4];
      bool valid[2][4];
#pragma unroll
      for (int kt2 = 0; kt2 < 2; ++kt2)
#pragma unroll
        for (int j = 0; j < 4; ++j) {
          int n = a * 64 + half * 32 + kt2 * 16 + lg * 4 + j;
          int rel = 16 * n + 31 - t0;
          posf[kt2][j] = (float)rel;
          valid[kt2][j] = rel <= tql;
        }
      const float tb[2] = {slope[0] * (float)(1024 * a + 31 - t0), slope[1] * (float)(1024 * a + 31 - t0)};
      half_step<0, true, 16>(sK, sV, half, lr, lg, qf, qs, tb, m, ls, o, valid, psum);
    }
  }
#pragma unroll
  for (int h = 0; h < 2; ++h) {
    float x = ls[h];
    x = rows_sum(x);
    ls[h] = x > 0.f ? 1.f / x : 0.f;
  }
  float carry = 0.f;
  float* myImp = sImp + hp * (32 * 132);
  for (int a = 0; a <= amax; ++a) {
    __syncthreads();
    kv_store_k(tl, sK, tid);
    kv_store_v(tl, sV, tid);
    __syncthreads();
    if (a < amax) {
      kv_load_k(tl, kc_base + (size_t)(a + 1) * 64 * 64, 64, tid);
      kv_load_v(tl, vc_base + (a + 1) * 64, 512, tid);
    }
#pragma unroll
    for (int half = 0; half < 2; ++half) {
      float posf[2][4];
      bool valid[2][4];
#pragma unroll
      for (int kt2 = 0; kt2 < 2; ++kt2)
#pragma unroll
        for (int j = 0; j < 4; ++j) {
          int n = a * 64 + half * 32 + kt2 * 16 + lg * 4 + j;
          int rel = 16 * n + 31 - t0;
          posf[kt2][j] = (float)rel;
          valid[kt2][j] = rel <= tql;
        }
      const float tb[2] = {slope[0] * (float)(1024 * a + 31 - t0), slope[1] * (float)(1024 * a + 31 - t0)};
      half_step<1, true, 16>(sK, sV, half, lr, lg, qf, qs, tb, m, ls, o, valid, psum);
      float prev = carry;
#pragma unroll
      for (int kt2 = 0; kt2 < 2; ++kt2) {
        float sum4 = psum[kt2][0] + psum[kt2][1] + psum[kt2][2] + psum[kt2][3];
        float p3 = psum[kt2][3];
        float up = __shfl(p3, (lane + 48) & 63);
        float wrap = __shfl(prev, (lane + 48) & 63);
        float spill = lg > 0 ? up : wrap;
        int j = a * 16 + half * 8 + kt2 * 4 + lg;
        myImp[tql * 132 + j] = sum4 + spill;
        prev = p3;
      }
      carry = prev;
    }
  }
  const size_t tokq_a = (size_t)b * S + t0 + 16 * ((otid() >> 6) & 1) + (otid() & 15);
#pragma unroll
  for (int h = 0; h < 2; ++h) {
    const float g0 = G[tokq_a * 24 + (hg0 + h) * 3 + 0];
#pragma unroll
    for (int dt = 0; dt < 4; ++dt) {
      otot[h][dt] = o[h][dt] * g0;
      o[h][dt] = f32x4{0.f, 0.f, 0.f, 0.f};
    }
    m[h] = MINIT;
    ls[h] = 0.f;
  }
  if (tid < 4) sUni[tid] = 0u;
  __syncthreads();
  if (tid < 128) {
    const int q = tid >> 2, sub = tid & 3;
    unsigned mk[4] = {0u, 0u, 0u, 0u};
    if (cur < 16) {
      mk[0] = (1u << (cur + 1)) - 1u;
    } else {
      float v[32];
#pragma unroll
      for (int i = 0; i < 32; ++i) {
        int j = sub + 4 * i;
        v[i] = (j >= 1 && j <= cur - 2) ? (sImp[q * 132 + j] + sImp[32 * 132 + q * 132 + j]) : -1.f;
      }
      for (int round = 0; round < 13; ++round) {
        float bv = v[0];
        int bi = 0;
#pragma unroll
        for (int i = 1; i < 32; ++i)
          if (v[i] > bv) { bv = v[i]; bi = i; }
        int bj = sub + 4 * bi;
#pragma unroll
        for (int off = 1; off <= 2; off <<= 1) {
          float ov = __shfl_xor(bv, off);
          int oj = __shfl_xor(bj, off);
          if (ov > bv || (ov == bv && oj < bj)) { bv = ov; bj = oj; }
        }
#pragma unroll
        for (int i = 0; i < 32; ++i)
          if (sub + 4 * i == bj) v[i] = -2.f;
#pragma unroll
        for (int wd = 0; wd < 4; ++wd) mk[wd] |= ((bj >> 5) == wd) ? (1u << (bj & 31)) : 0u;
      }
      const int f1 = cur, f2 = cur - 1;
      mk[0] |= 1u;
#pragma unroll
      for (int wd = 0; wd < 4; ++wd) {
        mk[wd] |= ((f1 >> 5) == wd) ? (1u << (f1 & 31)) : 0u;
        mk[wd] |= ((f2 >> 5) == wd) ? (1u << (f2 & 31)) : 0u;
      }
    }
    if (sub == 0) {
#pragma unroll
      for (int wd = 0; wd < 4; ++wd) {
        sSel[q * 4 + wd] = mk[wd];
        atomicOr(&sUni[wd], mk[wd]);
      }
    }
  }
  __syncthreads();
  const int jw0 = (cur >= 8 ? cur - 8 : 0);
  {
    int j = cur;
    kv_load_k(tl, KS + ((size_t)b * S + j * 64) * 128 + kvh * 64, 128, tid);
    kv_load_v(tl, VST + (size_t)bk * 64 * S + j * 64, S, tid);
    while (j >= 0) {
      __syncthreads();
      kv_store_k(tl, sK, tid);
      kv_store_v(tl, sV, tid);
      __syncthreads();
      const int jn = prev_set_bit(sUni, j - 1);
      if (jn >= 0) {
        kv_load_k(tl, KS + ((size_t)b * S + jn * 64) * 128 + kvh * 64, 128, tid);
        kv_load_v(tl, VST + (size_t)bk * 64 * S + jn * 64, S, tid);
      } else {
        kv_load_k(tl, KW + ((size_t)b * S + cur * 64) * 128 + kvh * 64, 128, tid);
        kv_load_v(tl, VWT + (size_t)bk * 64 * S + cur * 64, S, tid);
      }
      const bool selbit = (sSel[tql * 4 + (j >> 5)] >> (j & 31)) & 1u;
      const unsigned long long bal = __ballot(selbit);
      if (bal != 0ull) {
        const bool full = (j < cur) && (bal == ~0ull);
#pragma unroll
        for (int half = 0; half < 2; ++half) {
          float posf[2][4];
          bool valid[2][4];
#pragma unroll
          for (int kt2 = 0; kt2 < 2; ++kt2)
#pragma unroll
            for (int jj = 0; jj < 4; ++jj) {
              int rel = j * 64 - t0 + half * 32 + kt2 * 16 + lg * 4 + jj;
              posf[kt2][jj] = (float)rel;
              valid[kt2][jj] = selbit && (rel <= tql);
            }
          const float tb[2] = {slope[0] * (float)(j * 64 - t0), slope[1] * (float)(j * 64 - t0)};
          half_step<2, true, 1>(sK, sV, half, lr, lg, qf, qs, tb, m, ls, o, valid, psum);
        }
      }
      j = jn;
    }
  }
  const size_t tokq_b = (size_t)b * S + t0 + 16 * ((otid() >> 6) & 1) + (otid() & 15);
#pragma unroll
  for (int h = 0; h < 2; ++h) {
    float x = ls[h];
    x = rows_sum(x);
    const float f = (x > 0.f ? 1.f / x : 0.f) * G[tokq_b * 24 + (hg0 + h) * 3 + 1];
#pragma unroll
    for (int dt = 0; dt < 4; ++dt) {
      otot[h][dt] += o[h][dt] * f;
      o[h][dt] = f32x4{0.f, 0.f, 0.f, 0.f};
    }
    m[h] = MINIT;
    ls[h] = 0.f;
  }
  for (int j = cur; j >= jw0; --j) {
    __syncthreads();
    kv_store_k(tl, sK, tid);
    kv_store_v(tl, sV, tid);
    __syncthreads();
    if (j > jw0) {
      kv_load_k(tl, KW + ((size_t)b * S + (j - 1) * 64) * 128 + kvh * 64, 128, tid);
      kv_load_v(tl, VWT + (size_t)bk * 64 * S + (j - 1) * 64, S, tid);
    }
    const bool full = (j * 64 + 63 <= t0) && (t0 + 31 - j * 64 <= 511);
#pragma unroll
    for (int half = 0; half < 2; ++half) {
      float posf[2][4];
      bool valid[2][4];
#pragma unroll
      for (int kt2 = 0; kt2 < 2; ++kt2)
#pragma unroll
        for (int jj = 0; jj < 4; ++jj) {
          int rel = j * 64 - t0 + half * 32 + kt2 * 16 + lg * 4 + jj;
          posf[kt2][jj] = (float)rel;
          valid[kt2][jj] = (rel <= tql) && (tql - rel < 512);
        }
      const float tb[2] = {slope[0] * (float)(j * 64 - t0), slope[1] * (float)(j * 64 - t0)};
      half_step<2, true, 1>(sK, sV, half, lr, lg, qf, qs, tb, m, ls, o, valid, psum);
    }
  }
  const int tid_c = otid();
  const size_t tokq_c = (size_t)b * S + t0 + 16 * ((tid_c >> 6) & 1) + (tid_c & 15);
  const int hg_c = kvh * 4 + (tid_c >> 7) * 2;
  const int lg_c = (tid_c >> 4) & 3;
#pragma unroll
  for (int h = 0; h < 2; ++h) {
    float x = ls[h];
    x = rows_sum(x);
    const float f = (x > 0.f ? 1.f / x : 0.f) * G[tokq_c * 24 + (hg_c + h) * 3 + 2];
    float ss = 0.f;
#pragma unroll
    for (int dt = 0; dt < 4; ++dt) {
      otot[h][dt] += o[h][dt] * f;
#pragma unroll
      for (int jj = 0; jj < 4; ++jj) ss += otot[h][dt][jj] * otot[h][dt][jj];
    }
    ss = rows_sum(ss);
    const float r = rsqrtf(ss * (1.f / 64.f) + EPS);
#pragma unroll
    for (int dt = 0; dt < 4; ++dt) {
      const int d = dt * 16 + lg_c * 4;
      const float4 gg = *(const float4*)(p.out_g + l * 1024 + (hg_c + h) * 64 + d);
      uint2 st;
      st.x = pack2(otot[h][dt][0] * r * gg.x, otot[h][dt][1] * r * gg.y);
      st.y = pack2(otot[h][dt][2] * r * gg.z, otot[h][dt][3] * r * gg.w);
      *(uint2*)(OM + tokq_c * 1024 + (hg_c + h) * 64 + d) = st;
    }
  }
}

#define XB_TMO      128
#define XB_XCNT(j)  (256  + 64 * (j))
#define XB_XSUB(j)  (1280 + 64 * (j))
#define XB_XGEN(j)  (2304 + 64 * (j))
#define XB_TOP      3328
#define XB_TOPGEN   3392
#define XCD_BAR_WORDS 3456
#define XB_SPIN_CAP (1u << 20)
DI unsigned xb_ld(unsigned* p) { return __hip_atomic_load(p, __ATOMIC_RELAXED, __HIP_MEMORY_SCOPE_AGENT); }
DI unsigned xb_add(unsigned* p, unsigned v) { return __hip_atomic_fetch_add(p, v, __ATOMIC_RELAXED, __HIP_MEMORY_SCOPE_AGENT); }
DI unsigned xb_xcc_id() { return (unsigned)__builtin_amdgcn_s_getreg((3 << 11) | 20) & 0xFu; }
#define XB_SPIN(cond, bar) do { unsigned _sp = 0; while (cond) { __builtin_amdgcn_s_sleep(1); \
    if ((++_sp & 255u) == 0u) { if (xb_ld(&(bar)[XB_TMO])) break; if (_sp > XB_SPIN_CAP) { atomicAdd(&(bar)[XB_TMO], 1u); break; } } } } while (0)

struct XcdBarrier { unsigned* bar; unsigned x; volatile unsigned* st; };

DI void xcd_barrier_complete(unsigned* bar, unsigned x, unsigned& nloc, unsigned& nx) {
  const unsigned G = gridDim.x;
  unsigned sum, cnt, mine, sp = 0u;
  for (;;) {
    sum = 0u; cnt = 0u; mine = 0u;
#pragma unroll
    for (unsigned j = 0; j < 16; ++j) { const unsigned c = xb_ld(&bar[XB_XCNT(j)]); sum += c; cnt += (c > 0u) ? 1u : 0u; mine = (j == x) ? c : mine; }
    if (sum == G) break;
    __builtin_amdgcn_s_sleep(1);
    if ((++sp & 255u) == 0u) { if (xb_ld(&bar[XB_TMO])) break; if (sp > XB_SPIN_CAP) { atomicAdd(&bar[XB_TMO], 1u); break; } }
  }
  nloc = mine > 0u ? mine : 1u; nx = cnt > 0u ? cnt : 1u;
}

DI void gsync(const XcdBarrier& b0) {
  asm volatile("s_waitcnt vmcnt(0)" ::: "memory");
  __syncthreads();
  if (threadIdx.x == 0) {
    XcdBarrier b;
    b.bar = b0.bar;
    b.st = b0.st;
    b.x = xb_xcc_id();
    unsigned* bar = b.bar;
    __builtin_amdgcn_s_waitcnt(0);
    unsigned nloc = b.st[0], nx = b.st[1];
    if (nloc == 0u) { xcd_barrier_complete(bar, b.x, nloc, nx); b.st[0] = nloc; b.st[1] = nx; }
    const unsigned old = xb_add(&bar[XB_XSUB(b.x)], 1u);
    const unsigned gen = old / nloc;
    if (old + 1u == (gen + 1u) * nloc) {
      __builtin_amdgcn_fence(__ATOMIC_RELEASE, "agent");
      asm volatile("s_waitcnt vmcnt(0)" ::: "memory");
      const unsigned og = xb_add(&bar[XB_TOP], 1u);
      const unsigned tg = og / nx;
      if (og + 1u == (tg + 1u) * nx) xb_add(&bar[XB_TOPGEN], 1u);
      else XB_SPIN(xb_ld(&bar[XB_TOPGEN]) == tg, bar);
      __builtin_amdgcn_fence(__ATOMIC_ACQUIRE, "agent");
      xb_add(&bar[XB_XGEN(b.x)], 1u);
      asm volatile("s_waitcnt vmcnt(0)" ::: "memory");
    } else {
      XB_SPIN(xb_ld(&bar[XB_XGEN(b.x)]) == gen, bar);
      __builtin_amdgcn_fence(__ATOMIC_ACQUIRE, "agent");
      asm volatile("s_waitcnt vmcnt(0)" ::: "memory");
    }
  }
  __syncthreads();
}

#ifndef STOP_AFTER
#define STOP_AFTER 0
#endif
#define DUMP_BF16_AND_STOP(ptr)                                                                   \
  {                                                                                               \
    const u16* s_ = (const u16*)(ptr);                                                            \
    for (size_t i = (size_t)bid * 256 + threadIdx.x; i < (size_t)TOK * 1024; i += (size_t)nb * 256) \
      p.out[i] = bf2f(s_[i]);                                                                     \
    return;                                                                                       \
  }
#define DUMP_F32_AND_STOP(ptr)                                                                    \
  {                                                                                               \
    const float* s_ = (const float*)(ptr);                                                        \
    for (size_t i = (size_t)bid * 256 + threadIdx.x; i < (size_t)TOK * 1024; i += (size_t)nb * 256) \
      p.out[i] = s_[i];                                                                           \
    return;                                                                                       \
  }
__global__ void __launch_bounds__(256, 2) mega(Params p) {
  extern __shared__ __attribute__((aligned(16))) char smem[];
  char* ws = p.ws;
  const int nb = gridDim.x, bid = blockIdx.x;
  if (ws == nullptr) cg::this_grid().sync();
  volatile unsigned* xst = (volatile unsigned*)(smem + 73728);
  if (threadIdx.x == 0) { xst[0] = 0u; xst[1] = 0u; }
  __syncthreads();
  if (threadIdx.x == 0) (void)xb_add(&((unsigned*)(ws + OFF_BAR))[XB_XCNT(xb_xcc_id())], 1u);
#define grid (XcdBarrier{(unsigned*)(p.ws + OFF_BAR), 0u, (volatile unsigned*)(smem + 73728)})
  float* X1 = (float*)(ws + OFF_X1);
  u16* H = (u16*)(ws + OFF_H);
  char* wsA = ws + OFF_A;
  const float* mod = (const float*)(ws + OFF_MOD);

#ifdef ZERO_WS
  {
    uint4* z = (uint4*)ws;
    const size_t n16 = (OFF_A + A_END) / 16;
    for (size_t i = (size_t)bid * 256 + threadIdx.x; i < n16; i += (size_t)nb * 256) z[i] = make_uint4(0, 0, 0, 0);
    uint4* zo = (uint4*)p.out;
    const size_t m16 = (size_t)TOK * 1024 * 4 / 16;
    for (size_t i = (size_t)bid * 256 + threadIdx.x; i < m16; i += (size_t)nb * 256) zo[i] = make_uint4(0, 0, 0, 0);
  }
  gsync(grid);
#endif
  phase0a(p, smem);
  gsync(grid);
  phase0b(p);
  gsync(grid);
  phase_mod_x(p);
  gsync(grid);

  for (int l = 0; l < 2; ++l) {
    const float* modl = mod + (size_t)l * 8 * 6144;
    const float* xin = (l == 0) ? p.x : p.out;
    {
      u16* Qo = (u16*)(wsA + A_Q);
      u16* KCo = (u16*)(wsA + A_KC);
      u16* VCo = (u16*)(wsA + A_VC);
      u16* KSo = (u16*)(wsA + A_KS);
      u16* VSTo = (u16*)(wsA + A_VST);
      u16* KWo = (u16*)(wsA + A_KW);
      u16* VWTo = (u16*)(wsA + A_VWT);
      float* Go = (float*)(wsA + A_G);
      u16* Uo = (u16*)(wsA + A_U);
      u16* VGTo = (u16*)(wsA + A_VGT);
      const float* vng = p.vn_g + l * 512;
      const float* vnb = p.vn_b + l * 512;
      auto sel1 = [](int tn) { return !(tn == 7 || tn == 9 || (tn >= 14 && tn < 18)); };
      auto epi = [&](bool swp, int tm, int tn, int wm, int wn, int lr, int lg, auto& acc) {
        constexpr int MT = sizeof(acc) / sizeof(acc[0]);
        const int row0 = tm * (32 * MT) + wm * (16 * MT);
        const int b = row0 >> 13;
        const int s0 = row0 & (S - 1);
        if (swp) {
          if (tn == 18) {
            if (wn == 0) {
#pragma unroll
              for (int mi = 0; mi < MT; ++mi)
#pragma unroll
                for (int ni = 0; ni < 2; ++ni) {
                  const int c = ni * 16 + lg * 4;
                  const size_t row = (size_t)row0 + mi * 16 + lr;
                  if (c < 24)
                    *(float4*)(Go + row * 24 + c) =
                        make_float4(sigm(acc[mi][ni][0]), sigm(acc[mi][ni][1]), sigm(acc[mi][ni][2]), sigm(acc[mi][ni][3]));
                }
            }
          } else {
            u16* dst;
            int ld, cb;
            float sc = 1.f;
            bool g = false;
            if (tn < 4) { dst = Qo; ld = 512; cb = tn * 128; sc = QSCALE; }
            else if (tn == 4) { dst = KCo; ld = 128; cb = 0; }
            else if (tn == 5) { dst = VCo; ld = 128; cb = 0; }
            else if (tn == 6) { dst = KSo; ld = 128; cb = 0; }
            else if (tn == 8) { dst = KWo; ld = 128; cb = 0; }
            else { dst = Uo; ld = 512; cb = (tn - 10) * 128; g = true; }
#pragma unroll
            for (int mi = 0; mi < MT; ++mi)
#pragma unroll
              for (int ni = 0; ni < 4; ++ni) {
                const size_t row = (size_t)row0 + mi * 16 + lr;
                float v[4];
#pragma unroll
                for (int j = 0; j < 4; ++j) v[j] = g ? gelu_t(acc[mi][ni][j]) : acc[mi][ni][j] * sc;
                uint2 st;
                st.x = pack2(v[0], v[1]);
                st.y = pack2(v[2], v[3]);
                *(uint2*)(dst + row * ld + cb + wn * 64 + ni * 16 + lg * 4) = st;
              }
          }
        } else if (tn == 7 || tn == 9) {
          u16* dst = (tn == 7) ? VSTo : VWTo;
#pragma unroll
          for (int mi = 0; mi < MT; ++mi)
#pragma unroll
            for (int ni = 0; ni < 4; ++ni) {
              const int d = ni * 16 + lr;
              uint2 st;
              st.x = pack2(acc[mi][ni][0], acc[mi][ni][1]);
              st.y = pack2(acc[mi][ni][2], acc[mi][ni][3]);
              *(uint2*)(dst + ((size_t)(b * 2 + wn) * 64 + d) * S + s0 + mi * 16 + lg * 4) = st;
            }
        } else {
          const int grp = (tn - 14) * 2 + wn;
          float vg[4], vb[4];
#pragma unroll
          for (int ni = 0; ni < 4; ++ni) { vg[ni] = vng[grp * 64 + ni * 16 + lr]; vb[ni] = vnb[grp * 64 + ni * 16 + lr]; }
#pragma unroll
          for (int mi = 0; mi < MT; ++mi) {
            float vv[4][4];
#pragma unroll
            for (int ni = 0; ni < 4; ++ni)
#pragma unroll
              for (int j = 0; j < 4; ++j) vv[ni][j] = gelu_t(acc[mi][ni][j]);
#pragma unroll
            for (int j = 0; j < 4; ++j) {
              float s1 = vv[0][j] + vv[1][j] + vv[2][j] + vv[3][j];
              s1 += __shfl_xor(s1, 1); s1 += __shfl_xor(s1, 2); s1 += __shfl_xor(s1, 4); s1 += __shfl_xor(s1, 8);
              const float mu = s1 * (1.f / 64.f);
              float s2 = 0.f;
#pragma unroll
              for (int ni = 0; ni < 4; ++ni) { float dd = vv[ni][j] - mu; s2 += dd * dd; }
              s2 += __shfl_xor(s2, 1); s2 += __shfl_xor(s2, 2); s2 += __shfl_xor(s2, 4); s2 += __shfl_xor(s2, 8);
              const float rs = rsqrtf(s2 * (1.f / 64.f) + EPS);
#pragma unroll
              for (int ni = 0; ni < 4; ++ni) vv[ni][j] = (vv[ni][j] - mu) * rs * vg[ni] + vb[ni];
            }
#pragma unroll
            for (int ni = 0; ni < 4; ++ni) {
              const int d = ni * 16 + lr;
              uint2 st;
              st.x = pack2(vv[ni][0], vv[ni][1]);
              st.y = pack2(vv[ni][2], vv[ni][3]);
              *(uint2*)(VGTo + ((size_t)(b * 8 + grp) * 64 + d) * S + s0 + mi * 16 + lg * 4) = st;
            }
          }
        }
      };
      gemm_phase<8>(H, 1024, (const u16*)(ws + OFF_WTIN + l * SZ_WTIN), 1024, 256, 19, 1024, bid, nb, smem, sel1, epi);
    }
    gsync(grid);
    if (STOP_AFTER == 1 && l == 0) DUMP_BF16_AND_STOP(wsA)
    if (STOP_AFTER == 11 && l == 0) DUMP_BF16_AND_STOP(wsA + A_KW)
    if (STOP_AFTER == 12 && l == 0) DUMP_BF16_AND_STOP(wsA + A_U)
    {
      const int ng = (nb >= 256) ? 256 : nb;
      const int half = ng / 2;
      for (int which = 0; which < 2; ++which) {
        u16* HC = (u16*)(wsA + A_HC) + (size_t)which * 8192 * 256;
        const float* cb1 = (const float*)(ws + OFF_CB1) + (l * 2 + which) * 256;
        const u16* src_tok = (const u16*)(wsA + (which ? A_VC : A_KC));
        auto selT = [](int) { return true; };
        auto ab = [=](int tm) {
          const int bk = tm >> 2, n0 = (tm & 3) * 128;
          return src_tok + ((size_t)(bk >> 1) * S + 16 * n0) * 128 + (bk & 1) * 64;
        };
        auto epi = [&](bool swp, int tm, int tn, int wm, int wn, int lr, int lg, auto& acc) {
        constexpr int MT = sizeof(acc) / sizeof(acc[0]);
          const int row0 = tm * (32 * MT) + wm * (16 * MT), col0 = tn * 128 + wn * 64;
#pragma unroll
          for (int ni = 0; ni < 4; ++ni) {
            const float4 cb = *(const float4*)(cb1 + col0 + ni * 16 + lg * 4);
#pragma unroll
            for (int mi = 0; mi < MT; ++mi) {
              uint2 st;
              st.x = pack2(gelu_t(acc[mi][ni][0] + cb.x), gelu_t(acc[mi][ni][1] + cb.y));
              st.y = pack2(gelu_t(acc[mi][ni][2] + cb.z), gelu_t(acc[mi][ni][3] + cb.w));
              *(uint2*)(HC + (size_t)(row0 + mi * 16 + lr) * 256 + col0 + ni * 16 + lg * 4) = st;
            }
          }
        };
        const int vb = (bid < ng) ? (which == 0 ? (bid < half ? bid : -1) : (bid >= half ? bid - half : -1)) : -1;
        gemm_phase_g<4>(ab, 2048, 128, (const u16*)(ws + OFF_WTC1 + (l * 2 + which) * SZ_WTC1), 2048, 64, 2, 2048, vb, half, smem,
                     selT, epi);
      }
      if (bid >= ng) {
        unsigned* gctr = (unsigned*)(ws + OFF_BAR) + (l ? 96 : 32);
        volatile unsigned* slot = (volatile unsigned*)(smem + 73728) + 2;
        for (;;) {
          __syncthreads();
          if (threadIdx.x == 0) *slot = xb_add(gctr, 1u);
          __syncthreads();
          const unsigned idx = (unsigned)__builtin_amdgcn_readfirstlane((int)*slot);
          if (idx >= (unsigned)GMLP_EARLY) break;
          gmlp_item(p, l, (int)idx);
        }
      }
    }
    gsync(grid);
    {
      for (int which = 0; which < 2; ++which) {
        u16* KCMP = (u16*)(ws + OFF_KCMP);
        u16* VCMPT = (u16*)(ws + OFF_VCMPT);
        auto selW = [which](int) { return which == 0; };
        auto epi = [&](bool swp, int tm, int tn, int wm, int wn, int lr, int lg, auto& acc) {
        constexpr int MT = sizeof(acc) / sizeof(acc[0]);
          if (wn != 0) return;
          const int row0 = tm * (32 * MT) + wm * (16 * MT);
#pragma unroll
          for (int mi = 0; mi < MT; ++mi)
#pragma unroll
            for (int ni = 0; ni < 4; ++ni) {
              uint2 st;
              st.x = pack2(acc[mi][ni][0], acc[mi][ni][1]);
              st.y = pack2(acc[mi][ni][2], acc[mi][ni][3]);
              if (swp) {
                *(uint2*)(KCMP + (size_t)(row0 + mi * 16 + lr) * 64 + ni * 16 + lg * 4) = st;
              } else {
                const int d = ni * 16 + lr;
                const int rb = row0 + mi * 16 + lg * 4;
                *(uint2*)(VCMPT + ((size_t)(rb >> 9) * 64 + d) * 512 + (rb & 511)) = st;
              }
            }
        };
        const int vb = (which == 0) ? bid : (bid + nb - 64) % nb;
        gemm_phase<4>((const u16*)(wsA + A_HC) + (size_t)which * 8192 * 256, 256,
                   (const u16*)(ws + OFF_WTC2 + (l * 2 + which) * SZ_WTC2), 256, 64, 1, 256, vb, nb, smem, selW, epi);
      }
    }
    gsync(grid);
    if (STOP_AFTER == 4 && l == 0) DUMP_BF16_AND_STOP(ws + OFF_KCMP)
    {
      unsigned* qctr = (unsigned*)(ws + OFF_BAR) + (l ? 64 : 0);
      volatile unsigned* slot = (volatile unsigned*)(smem + 73728) + 2;
      for (;;) {
        __syncthreads();
        if (threadIdx.x == 0) *slot = xb_add(qctr, 1u);
        __syncthreads();
        const unsigned idx = (unsigned)__builtin_amdgcn_readfirstlane((int)*slot);
        if (idx >= 8192u - (unsigned)GMLP_EARLY) break;
        if (idx < 4096u) {
          const int qh = 255 - (int)(idx >> 4);
          const int rem = (int)(idx & 15u);
          attn_item(p, l, rem >> 1, rem & 1, qh, smem);
        } else {
          gmlp_item(p, l, (int)(idx - 4096u) + GMLP_EARLY);
        }
      }
    }
    gsync(grid);
    if (STOP_AFTER == 5 && l == 0) DUMP_BF16_AND_STOP(H)
    if ((STOP_AFTER == 51 || STOP_AFTER == 52) && l == 0) {
      for (size_t i = (size_t)bid * 256 + threadIdx.x; i < (size_t)TOK * 1024; i += (size_t)nb * 256) {
        const int col = (int)(i & 1023);
        const bool keep = (STOP_AFTER == 51) ? (col < 512) : (col >= 512);
        p.out[i] = keep ? bf2f(H[i]) : 0.f;
      }
      return;
    }
    {
      auto selT = [](int) { return true; };
      auto epi = [&](bool swp, int tm, int tn, int wm, int wn, int lr, int lg, auto& acc) {
        constexpr int MT = sizeof(acc) / sizeof(acc[0]);
        const int row0 = tm * (32 * MT) + wm * (16 * MT), col0 = tn * 128 + wn * 64;
        const int b = row0 >> 13;
#pragma unroll
        for (int ni = 0; ni < 4; ++ni) {
          const int col = col0 + ni * 16 + lg * 4;
          const float4 g1 = *(const float4*)(modl + (size_t)b * 6144 + 2048 + col);
#pragma unroll
          for (int mi = 0; mi < MT; ++mi) {
            const size_t row = (size_t)row0 + mi * 16 + lr;
            float4 xv = *(const float4*)(xin + row * 1024 + col);
            if (l == 1) {
              const float2 st = *(const float2*)((const float*)(ws + OFF_ST2) + row * 2);
              const float4 gg = *(const float4*)(p.ln2_g + col), bb = *(const float4*)(p.ln2_b + col);
              xv.x = (xv.x - st.x) * st.y * gg.x + bb.x;
              xv.y = (xv.y - st.x) * st.y * gg.y + bb.y;
              xv.z = (xv.z - st.x) * st.y * gg.z + bb.z;
              xv.w = (xv.w - st.x) * st.y * gg.w + bb.w;
            }
            float4 o4;
            o4.x = ALPHA * xv.x + (1.f + g1.x) * acc[mi][ni][0];
            o4.y = ALPHA * xv.y + (1.f + g1.y) * acc[mi][ni][1];
            o4.z = ALPHA * xv.z + (1.f + g1.z) * acc[mi][ni][2];
            o4.w = ALPHA * xv.w + (1.f + g1.w) * acc[mi][ni][3];
            *(float4*)(X1 + row * 1024 + col) = o4;
          }
        }
      };
      gemm_phase<8>(H, 1024, (const u16*)(ws + OFF_WTO + l * SZ_WTO), 1024, 256, 8, 1024, bid, nb, smem, selT, epi);
    }
    gsync(grid);
    ln_rows(X1, p.ln1_g + l * 1024, p.ln1_b + l * 1024, modl, 3072, 4096, H, (float*)(ws + OFF_ST1), false);
    gsync(grid);
    if (STOP_AFTER == 7 && l == 0) DUMP_F32_AND_STOP(X1)
    {
      u16* HH = (u16*)(wsA);
      auto selT = [](int) { return true; };
      auto epi = [&](bool swp, int tm, int tn, int wm, int wn, int lr, int lg, auto& acc) {
        constexpr int MT = sizeof(acc) / sizeof(acc[0]);
        const int row0 = tm * (32 * MT) + wm * (16 * MT);
        const int cb = tn * 64 + wn * 32;
#pragma unroll
        for (int mi = 0; mi < MT; ++mi)
#pragma unroll
          for (int ni = 0; ni < 2; ++ni) {
            const size_t row = (size_t)row0 + mi * 16 + lr;
            float v[4];
#pragma unroll
            for (int j = 0; j < 4; ++j) {
              const float a = acc[mi][ni][j], bb = acc[mi][ni + 2][j];
              v[j] = a * sigm(a) * bb;
            }
            uint2 st;
            st.x = pack2(v[0], v[1]);
            st.y = pack2(v[2], v[3]);
            *(uint2*)(HH + row * 2816 + cb + ni * 16 + lg * 4) = st;
          }
      };
      gemm_phase<8>(H, 1024, (const u16*)(ws + OFF_WT13 + l * SZ_WT13), 1024, 256, 44, 1024, bid, nb, smem, selT, epi);
    }
    gsync(grid);
    if (STOP_AFTER == 8 && l == 0) DUMP_BF16_AND_STOP(wsA)
    {
      const u16* HH = (const u16*)(wsA);
      float* outp = p.out;
      auto selT = [](int) { return true; };
      auto epi = [&](bool swp, int tm, int tn, int wm, int wn, int lr, int lg, auto& acc) {
        constexpr int MT = sizeof(acc) / sizeof(acc[0]);
        const int row0 = tm * (32 * MT) + wm * (16 * MT), col0 = tn * 128 + wn * 64;
        const int b = row0 >> 13;
#pragma unroll
        for (int ni = 0; ni < 4; ++ni) {
          const int col = col0 + ni * 16 + lg * 4;
          const float4 g2 = *(const float4*)(modl + (size_t)b * 6144 + 5120 + col);
#pragma unroll
          for (int mi = 0; mi < MT; ++mi) {
            const size_t row = (size_t)row0 + mi * 16 + lr;
            float4 xv = *(const float4*)(X1 + row * 1024 + col);
            {
              const float2 st = *(const float2*)((const float*)(ws + OFF_ST1) + row * 2);
              const float4 gg = *(const float4*)(p.ln1_g + l * 1024 + col), bb = *(const float4*)(p.ln1_b + l * 1024 + col);
              xv.x = (xv.x - st.x) * st.y * gg.x + bb.x;
              xv.y = (xv.y - st.x) * st.y * gg.y + bb.y;
              xv.z = (xv.z - st.x) * st.y * gg.z + bb.z;
              xv.w = (xv.w - st.x) * st.y * gg.w + bb.w;
            }
            float4 o4;
            o4.x = ALPHA * xv.x + (1.f + g2.x) * acc[mi][ni][0];
            o4.y = ALPHA * xv.y + (1.f + g2.y) * acc[mi][ni][1];
            o4.z = ALPHA * xv.z + (1.f + g2.z) * acc[mi][ni][2];
            o4.w = ALPHA * xv.w + (1.f + g2.w) * acc[mi][ni][3];
            *(float4*)(outp + row * 1024 + col) = o4;
          }
        }
      };
      gemm_phase<8>(HH, 2816, (const u16*)(ws + OFF_WT2 + l * SZ_WT2), 2816, 256, 8, 2816, bid, nb, smem, selT, epi);
    }
    gsync(grid);
    if (l == 0) {
      ln_rows(p.out, p.ln2_g, p.ln2_b, mod + (size_t)8 * 6144, 0, 1024, H, (float*)(ws + OFF_ST2), false);
      gsync(grid);
    } else {
      ln_rows(p.out, p.ln2_g + 1024, p.ln2_b + 1024, nullptr, 0, 0, nullptr, nullptr, true);
    }
  }
}

extern "C" void kernel_launch(void* const* d_in, const int* in_sizes, int n_in, void* d_out, int out_size, void* d_ws,
                              size_t ws_size, hipStream_t stream) {
  static int grid_blocks = 0;
  if (!grid_blocks) {
    int dev = 0, cus = 0, per_cu = 0;
    (void)hipGetDevice(&dev);
    (void)hipDeviceGetAttribute(&cus, hipDeviceAttributeMultiprocessorCount, dev);
    (void)hipFuncSetAttribute((const void*)mega, hipFuncAttributeMaxDynamicSharedMemorySize, LDS_BYTES);
    (void)hipOccupancyMaxActiveBlocksPerMultiprocessor(&per_cu, mega, 256, LDS_BYTES);
    if (per_cu > 2) per_cu = 2;
    if (per_cu < 1) per_cu = 1;
    grid_blocks = cus * per_cu;
  }
  Params p{};
  const float* const* in = (const float* const*)d_in;
  p.x = in[0]; p.c = in[1]; p.w_ada = in[2]; p.b_ada = in[3]; p.w_in = in[4]; p.cmp_pos = in[5]; p.cmp_w1 = in[6];
  p.cmp_w2 = in[7]; p.vn_g = in[8]; p.vn_b = in[9]; p.w_s = in[10]; p.b_s = in[11]; p.out_g = in[12]; p.w_o = in[13];
  p.ln1_g = in[14]; p.ln1_b = in[15]; p.w1 = in[16]; p.w3 = in[17]; p.w2 = in[18]; p.ln2_g = in[19]; p.ln2_b = in[20];
  p.out = (float*)d_out;
  p.ws = (char*)d_ws;
  (void)hipMemsetAsync((char*)d_ws + OFF_BAR, 0, XCD_BAR_WORDS * sizeof(unsigned), stream);
  void* args[] = {&p};
  hipError_t e = hipLaunchCooperativeKernel((void*)mega, dim3(grid_blocks), dim3(256), args, LDS_BYTES, stream);
  if (e != hipSuccess) fprintf(stderr, "cooperative launch failed: %s (grid %d)\n", hipGetErrorString(e), grid_blocks);
}
```

```cpp
#define STOP_AFTER 0
#include <hip/hip_runtime.h>
#include <hip/hip_cooperative_groups.h>
#include <cstdio>
namespace cg = cooperative_groups;

typedef unsigned short u16;
using bf16x8 = __attribute__((ext_vector_type(8))) short;
using f32x4 = __attribute__((ext_vector_type(4))) float;
using u32x4 = __attribute__((ext_vector_type(4))) unsigned;
#define DI __device__ __forceinline__
#define MFMA16(a, b, c) __builtin_amdgcn_mfma_f32_16x16x32_bf16((a), (b), (c), 0, 0, 0)

constexpr int S = 8192, TOK = 65536;
constexpr int INW = 2328, INP = 2432;
constexpr float ALPHA = 1.41421356237f;
constexpr float LOG2E = 1.4426950408889634f;
constexpr float QSCALE = 0.125f * LOG2E;
constexpr float NEGB = -1e30f, MINIT = -30000.f;
constexpr float EPS = 1e-5f;
constexpr int GMLP_EARLY = 2048;

constexpr size_t SZ_WTIN = (size_t)INP * 1024 * 2;
constexpr size_t SZ_WTO = (size_t)1024 * 1024 * 2;
constexpr size_t SZ_WT13 = (size_t)5632 * 1024 * 2;
constexpr size_t SZ_WT2 = (size_t)1024 * 2816 * 2;
constexpr size_t SZ_WTC1 = (size_t)256 * 2048 * 2;
constexpr size_t SZ_WTC2 = (size_t)128 * 256 * 2;
constexpr size_t OFF_WTIN = 0;
constexpr size_t OFF_WTO = OFF_WTIN + 2 * SZ_WTIN;
constexpr size_t OFF_WT13 = OFF_WTO + 2 * SZ_WTO;
constexpr size_t OFF_WT2 = OFF_WT13 + 2 * SZ_WT13;
constexpr size_t OFF_WTC1 = OFF_WT2 + 2 * SZ_WT2;
constexpr size_t OFF_WTC2 = OFF_WTC1 + 4 * SZ_WTC1;
constexpr size_t OFF_MODP = OFF_WTC2 + 4 * SZ_WTC2;
constexpr size_t SZ_MOD = (size_t)2 * 8 * 6144 * 4;
constexpr size_t OFF_MOD = OFF_MODP + 16 * SZ_MOD;
constexpr size_t SZ_CMP = (size_t)8 * 2 * 512 * 64 * 2;
constexpr size_t OFF_CB1P = OFF_MOD + SZ_MOD;
constexpr size_t OFF_CB1 = OFF_CB1P + 16 * 4 * 256 * 4;
constexpr size_t OFF_KCMP = OFF_CB1 + 4 * 256 * 4;
constexpr size_t OFF_VCMPT = OFF_KCMP + SZ_CMP;
constexpr size_t OFF_X1 = OFF_VCMPT + SZ_CMP;
constexpr size_t OFF_H = OFF_X1 + (size_t)TOK * 1024 * 4;
constexpr size_t OFF_A = OFF_H + (size_t)TOK * 1024 * 2;
constexpr size_t SZ_KV = (size_t)TOK * 128 * 2;
constexpr size_t A_Q = 0;
constexpr size_t A_KC = A_Q + (size_t)TOK * 512 * 2;
constexpr size_t A_VC = A_KC + SZ_KV;
constexpr size_t A_KS = A_VC + SZ_KV;
constexpr size_t A_VST = A_KS + SZ_KV;
constexpr size_t A_KW = A_VST + SZ_KV;
constexpr size_t A_VWT = A_KW + SZ_KV;
constexpr size_t A_G = A_VWT + SZ_KV;
constexpr size_t A_U = A_G + (size_t)TOK * 24 * 4;
constexpr size_t A_VGT = A_U + (size_t)TOK * 512 * 2;
constexpr size_t A_AC = A_VGT + (size_t)TOK * 512 * 2;
constexpr size_t A_HC = A_AC + (size_t)2 * 8192 * 2048 * 2;
constexpr size_t A_END = A_HC + (size_t)2 * 8192 * 256 * 2;
constexpr size_t OFF_ST1 = OFF_A + A_END;
constexpr size_t OFF_ST2 = OFF_ST1 + (size_t)TOK * 8;
constexpr size_t OFF_BAR = OFF_ST2 + (size_t)TOK * 8;

struct Params {
  const float *x, *c, *w_ada, *b_ada, *w_in, *cmp_pos, *cmp_w1, *cmp_w2, *vn_g, *vn_b, *w_s, *b_s, *out_g, *w_o,
      *ln1_g, *ln1_b, *w1, *w3, *w2, *ln2_g, *ln2_b;
  float* out;
  char* ws;
};

DI u16 f2bf(float x) { unsigned u = __float_as_uint(x); u += 0x7fffu + ((u >> 16) & 1u); return (u16)(u >> 16); }
DI float bf2f(u16 h) { return __uint_as_float(((unsigned)h) << 16); }
typedef __bf16 bf16x2_t __attribute__((ext_vector_type(2)));
typedef float f32x2_t __attribute__((ext_vector_type(2)));
DI unsigned pack2(float a, float b) {
  f32x2_t v = {a, b};
  bf16x2_t r = __builtin_convertvector(v, bf16x2_t);
  return __builtin_bit_cast(unsigned, r);
}
DI float gelu_t(float x) { float u = 1.5957691216f * (x + 0.044715f * x * x * x); return x / (1.f + __expf(-u)); }
DI float sigm(float x) { return 1.f / (1.f + __expf(-x)); }
DI float ex2(float x) { return __builtin_amdgcn_exp2f(x); }
typedef unsigned u32x2v __attribute__((ext_vector_type(2)));
DI float rows_max(float x) {
  u32x2v a = __builtin_amdgcn_permlane16_swap(__float_as_uint(x), __float_as_uint(x), false, false);
  const float m1 = fmaxf(__uint_as_float(a[0]), __uint_as_float(a[1]));
  u32x2v b = __builtin_amdgcn_permlane32_swap(__float_as_uint(m1), __float_as_uint(m1), false, false);
  return fmaxf(__uint_as_float(b[0]), __uint_as_float(b[1]));
}
DI float rows_sum(float x) {
  u32x2v a = __builtin_amdgcn_permlane16_swap(__float_as_uint(x), __float_as_uint(x), false, false);
  const float s1 = __uint_as_float(a[0]) + __uint_as_float(a[1]);
  u32x2v b = __builtin_amdgcn_permlane32_swap(__float_as_uint(s1), __float_as_uint(s1), false, false);
  return __uint_as_float(b[0]) + __uint_as_float(b[1]);
}
DI int otid() { int t = threadIdx.x; asm volatile("" : "+v"(t)); return t; }

template <int MODE> DI int map_row(int n) {
  if (MODE == 1) return n < 1280 ? n : (n < 1304 ? n + 1024 : n - 24);
  if (MODE == 2) return (n >> 5) * 64 + (n & 31);
  if (MODE == 3) return (n >> 5) * 64 + 32 + (n & 31);
  return n;
}

template <int MODE>
DI void conv_tile(const float* __restrict__ W, int K, int N, u16* __restrict__ Wt, int ldk, int tile, float* tl) {
  const int tiles_n = (N + 63) / 64;
  const int tk = tile / tiles_n, tn = tile % tiles_n;
  const int k0 = tk * 64, n0 = tn * 64;
  const int tid = otid();
#pragma unroll
  for (int i = 0; i < 16; ++i) {
    int idx = tid + 256 * i;
    int r = idx >> 6, c = idx & 63;
    int n = n0 + c;
    tl[r * 65 + c] = (n < N) ? W[(long)(k0 + r) * N + n] : 0.f;
  }
  __syncthreads();
  const int nl = tid >> 2, kc = tid & 3;
  const int n = n0 + nl;
  if (n < N) {
    const int row = map_row<MODE>(n);
    unsigned pk[8];
#pragma unroll
    for (int i = 0; i < 8; ++i) pk[i] = pack2(tl[(kc * 16 + 2 * i) * 65 + nl], tl[(kc * 16 + 2 * i + 1) * 65 + nl]);
    uint4* dst = (uint4*)(Wt + (long)row * ldk + k0 + kc * 16);
    dst[0] = make_uint4(pk[0], pk[1], pk[2], pk[3]);
    dst[1] = make_uint4(pk[4], pk[5], pk[6], pk[7]);
  }
  __syncthreads();
}

DI void phase0a(const Params& p, char* smem) {
  char* ws = p.ws;
  const int tid = threadIdx.x;
  constexpr int PER_LAYER = 592 + 256 + 704 * 3 + 128 * 2 + 4 * 2;
  constexpr int NCONV = 2 * PER_LAYER;
  constexpr int NTOT = NCONV + 768 + 2 + 64;
  for (int it = blockIdx.x; it < NTOT; it += gridDim.x) {
    if (it < NCONV) {
      const int l = it / PER_LAYER;
      const int li = it % PER_LAYER;
      int base = 0;
#define SEG(MODE, SRC, DST, K_, N_, LDK)                                                   \
  {                                                                                        \
    const int nt_ = ((K_) / 64) * (((N_) + 63) / 64);                                      \
    if (li >= base && li < base + nt_) conv_tile<MODE>(SRC, K_, N_, DST, LDK, li - base, (float*)smem); \
    base += nt_;                                                                           \
  }
      SEG(1, p.w_in + (size_t)l * 1024 * INW, (u16*)(ws + OFF_WTIN + l * SZ_WTIN), 1024, INW, 1024)
      SEG(0, p.w_o + (size_t)l * 1024 * 1024, (u16*)(ws + OFF_WTO + l * SZ_WTO), 1024, 1024, 1024)
      SEG(2, p.w1 + (size_t)l * 1024 * 2816, (u16*)(ws + OFF_WT13 + l * SZ_WT13), 1024, 2816, 1024)
      SEG(3, p.w3 + (size_t)l * 1024 * 2816, (u16*)(ws + OFF_WT13 + l * SZ_WT13), 1024, 2816, 1024)
      SEG(0, p.w2 + (size_t)l * 2816 * 1024, (u16*)(ws + OFF_WT2 + l * SZ_WT2), 2816, 1024, 2816)
      SEG(0, p.cmp_w1 + (size_t)(l * 2 + 0) * 2048 * 256, (u16*)(ws + OFF_WTC1 + (l * 2 + 0) * SZ_WTC1), 2048, 256, 2048)
      SEG(0, p.cmp_w1 + (size_t)(l * 2 + 1) * 2048 * 256, (u16*)(ws + OFF_WTC1 + (l * 2 + 1) * SZ_WTC1), 2048, 256, 2048)
      SEG(0, p.cmp_w2 + (size_t)(l * 2 + 0) * 256 * 64, (u16*)(ws + OFF_WTC2 + (l * 2 + 0) * SZ_WTC2), 256, 64, 256)
      SEG(0, p.cmp_w2 + (size_t)(l * 2 + 1) * 256 * 64, (u16*)(ws + OFF_WTC2 + (l * 2 + 1) * SZ_WTC2), 256, 64, 256)
#undef SEG
    } else if (it < NCONV + 768) {
      const int idx = it - NCONV;
      const int l = idx / 384, r = idx % 384, nb = r / 16, kc = r % 16;
      float* cs = (float*)smem;
      for (int i = tid; i < 512; i += 256) {
        int b = i >> 6, k = i & 63;
        float cv = p.c[b * 1024 + kc * 64 + k];
        cs[i] = cv * sigm(cv);
      }
      __syncthreads();
      const int n = nb * 256 + tid;
      float acc[8];
#pragma unroll
      for (int b = 0; b < 8; ++b) acc[b] = 0.f;
      const float* wp = p.w_ada + ((size_t)l * 1024 + kc * 64) * 6144 + n;
#pragma unroll 8
      for (int k = 0; k < 64; ++k) {
        float wv = wp[(size_t)k * 6144];
#pragma unroll
        for (int b = 0; b < 8; ++b) acc[b] += cs[b * 64 + k] * wv;
      }
      float* modp = (float*)(ws + OFF_MODP);
#pragma unroll
      for (int b = 0; b < 8; ++b) modp[(size_t)((kc * 2 + l) * 8 + b) * 6144 + n] = acc[b];
      __syncthreads();
    } else if (it < NCONV + 768 + 2) {
      const int l = it - NCONV - 768;
      uint4* dst = (uint4*)(ws + OFF_WTIN + l * SZ_WTIN + (size_t)INW * 1024 * 2);
      const int n16 = (INP - INW) * 1024 * 2 / 16;
      for (int i = tid; i < n16; i += 256) dst[i] = make_uint4(0, 0, 0, 0);
    } else {
      const int idx = it - NCONV - 768 - 2;
      const int lw = idx >> 4, kc = idx & 15;
      const float* pos = p.cmp_pos + (size_t)lw * 2048 + kc * 128;
      const float* w1p = p.cmp_w1 + ((size_t)lw * 2048 + kc * 128) * 256 + tid;
      float a = 0.f;
#pragma unroll 8
      for (int k = 0; k < 128; ++k) a += pos[k] * w1p[(size_t)k * 256];
      ((float*)(ws + OFF_CB1P))[(kc * 4 + lw) * 256 + tid] = a;
    }
  }
}

DI void phase0b(const Params& p) {
  const float* modp = (const float*)(p.ws + OFF_MODP);
  float* mod = (float*)(p.ws + OFF_MOD);
  const int n = 2 * 8 * 6144;
  for (int i = blockIdx.x * 256 + threadIdx.x; i < n; i += gridDim.x * 256) {
    int l = i / (8 * 6144), c = i % 6144;
    float a = p.b_ada[l * 6144 + c];
#pragma unroll
    for (int kc = 0; kc < 16; ++kc) a += modp[(size_t)kc * n + i];
    mod[i] = a;
  }
  const float* cbp = (const float*)(p.ws + OFF_CB1P);
  float* cb = (float*)(p.ws + OFF_CB1);
  for (int i = blockIdx.x * 256 + threadIdx.x; i < 1024; i += gridDim.x * 256) {
    float a = 0.f;
#pragma unroll
    for (int kc = 0; kc < 16; ++kc) a += cbp[kc * 1024 + i];
    cb[i] = a;
  }
}

DI void phase_mod_x(const Params& p) {
  const float* mod = (const float*)(p.ws + OFF_MOD);
  u16* H = (u16*)(p.ws + OFF_H);
  const long nchunk = (long)TOK * 1024 / 8;
  const long stride = (long)gridDim.x * 256;
  for (long i = (long)blockIdx.x * 256 + otid(); i < nchunk / 2; i += stride) {
    float4 xa[2][2], sa[2][2], ha[2][2];
    long ee[2];
#pragma unroll
    for (int u = 0; u < 2; ++u) {
      const long e = (i + u * (nchunk / 2)) * 8;
      ee[u] = e;
      const int col = (int)(e & 1023);
      const int b = (int)(e >> 23);
      const float4* xp = (const float4*)(p.x + e);
      const float4* sh = (const float4*)(mod + (size_t)b * 6144 + 0 + col);
      const float4* sc = (const float4*)(mod + (size_t)b * 6144 + 1024 + col);
      xa[u][0] = xp[0]; xa[u][1] = xp[1];
      sa[u][0] = sc[0]; sa[u][1] = sc[1];
      ha[u][0] = sh[0]; ha[u][1] = sh[1];
    }
#pragma unroll
    for (int u = 0; u < 2; ++u) {
      const float4 x0 = xa[u][0], x1 = xa[u][1], s0 = sa[u][0], s1 = sa[u][1], h0 = ha[u][0], h1 = ha[u][1];
      uint4 o;
      o.x = pack2(x0.x * (1.f + s0.x) + h0.x, x0.y * (1.f + s0.y) + h0.y);
      o.y = pack2(x0.z * (1.f + s0.z) + h0.z, x0.w * (1.f + s0.w) + h0.w);
      o.z = pack2(x1.x * (1.f + s1.x) + h1.x, x1.y * (1.f + s1.y) + h1.y);
      o.w = pack2(x1.z * (1.f + s1.z) + h1.z, x1.w * (1.f + s1.w) + h1.w);
      *(uint4*)(H + ee[u]) = o;
    }
  }
}

constexpr int LDS_BYTES = 73728 + 16;
DI int swz_key(int r) { return (0x78 >> (2 * ((r >> 2) & 3))) & 3; }
template <int MT>
DI void g_issue(const u16* __restrict__ Ap, int lda, const u16* __restrict__ Bp, int ldb, int st, int ksa, int tid, char* buf) {
  constexpr int AOFF = 2048 * MT;
  const int koffA = (st >> 1) * ksa + (st & 1) * 32;
  const int koffB = st * 32;
  const int wbase = (tid & ~63) * 16;
#pragma unroll
  for (int i = 0; i < MT / 2; ++i) {
    const int c = tid + 256 * i;
    const int row = c >> 2, ph = c & 3;
    const int lc = ph ^ swz_key(row);
    __builtin_amdgcn_global_load_lds((const unsigned*)(Ap + (size_t)row * lda + koffA + lc * 8),
                                     (unsigned*)(buf + i * 4096 + wbase), 16, 0, 0);
  }
#pragma unroll
  for (int i = 0; i < 2; ++i) {
    const int c = tid + 256 * i;
    const int row = c >> 2, ph = c & 3;
    const int lc = ph ^ swz_key(row);
    __builtin_amdgcn_global_load_lds((const unsigned*)(Bp + (size_t)row * ldb + koffB + lc * 8),
                                     (unsigned*)(buf + AOFF + i * 4096 + wbase), 16, 0, 0);
  }
}
#define DSR(dst, addr, off) "ds_read_b128 %" #dst ", %" #addr " offset:" #off "\n\t"
template <bool SWAP, int MT>
DI void g_compute(const char* sA, f32x4 (&acc)[MT][4], int wm, int wn, int lr, int lg) {
  const int ra = wm * (16 * MT) + lr, rb = wn * 64 + lr;
  const unsigned aA = (unsigned)(size_t)sA + ra * 64 + ((lg ^ swz_key(ra)) << 4);
  const unsigned aB = (unsigned)(size_t)sA + 2048 * MT + rb * 64 + ((lg ^ swz_key(rb)) << 4);
  bf16x8 af[MT], bfr[4];
  if constexpr (MT == 8) {
    asm volatile(DSR(0, 8, 0) DSR(1, 8, 1024) DSR(2, 8, 2048) DSR(3, 8, 3072) DSR(4, 9, 0) DSR(5, 9, 1024) DSR(6, 9, 2048) DSR(7, 9, 3072)
                 : "=&v"(bfr[0]), "=&v"(bfr[1]), "=&v"(bfr[2]), "=&v"(bfr[3]), "=&v"(af[0]), "=&v"(af[1]), "=&v"(af[2]), "=&v"(af[3])
                 : "v"(aB), "v"(aA)
                 : "memory");
    asm volatile(DSR(0, 4, 4096) DSR(1, 4, 5120) DSR(2, 4, 6144) DSR(3, 4, 7168)
                 : "=&v"(af[4]), "=&v"(af[5]), "=&v"(af[6]), "=&v"(af[7])
                 : "v"(aA)
                 : "memory");
    asm volatile("s_waitcnt lgkmcnt(4)"
                 : "+v"(bfr[0]), "+v"(bfr[1]), "+v"(bfr[2]), "+v"(bfr[3]), "+v"(af[0]), "+v"(af[1]), "+v"(af[2]), "+v"(af[3]));
  } else {
    asm volatile(DSR(0, 6, 0) DSR(1, 6, 1024) DSR(2, 6, 2048) DSR(3, 6, 3072) DSR(4, 7, 0) DSR(5, 7, 1024)
                 : "=&v"(bfr[0]), "=&v"(bfr[1]), "=&v"(bfr[2]), "=&v"(bfr[3]), "=&v"(af[0]), "=&v"(af[1])
                 : "v"(aB), "v"(aA)
                 : "memory");
    asm volatile(DSR(0, 2, 2048) DSR(1, 2, 3072) : "=&v"(af[2]), "=&v"(af[3]) : "v"(aA) : "memory");
    asm volatile("s_waitcnt lgkmcnt(2)"
                 : "+v"(bfr[0]), "+v"(bfr[1]), "+v"(bfr[2]), "+v"(bfr[3]), "+v"(af[0]), "+v"(af[1]));
  }
  __builtin_amdgcn_sched_barrier(0);
#pragma unroll
  for (int mi = 0; mi < MT / 2; ++mi)
#pragma unroll
    for (int ni = 0; ni < 4; ++ni)
      acc[mi][ni] = SWAP ? MFMA16(bfr[ni], af[mi], acc[mi][ni]) : MFMA16(af[mi], bfr[ni], acc[mi][ni]);
  __builtin_amdgcn_sched_barrier(0);
  if constexpr (MT == 8) asm volatile("s_waitcnt lgkmcnt(0)" : "+v"(af[4]), "+v"(af[5]), "+v"(af[6]), "+v"(af[7]), "+v"(acc[3][3]));
  else asm volatile("s_waitcnt lgkmcnt(0)" : "+v"(af[2]), "+v"(af[3]), "+v"(acc[1][3]));
  __builtin_amdgcn_sched_barrier(0);
#pragma unroll
  for (int mi = MT / 2; mi < MT; ++mi)
#pragma unroll
    for (int ni = 0; ni < 4; ++ni)
      acc[mi][ni] = SWAP ? MFMA16(bfr[ni], af[mi], acc[mi][ni]) : MFMA16(af[mi], bfr[ni], acc[mi][ni]);
  __builtin_amdgcn_sched_barrier(0);
}
#define RAW_BARRIER() do { asm volatile("s_waitcnt lgkmcnt(0)" ::: "memory"); __builtin_amdgcn_s_barrier(); } while (0)

template <bool SWAP, int MT, class Epi>
DI void gemm_tile(const u16* __restrict__ Ap, int lda, const u16* __restrict__ Bp, int ldb, int nk, int tm, int tn, int tid,
                  char* smem, Epi epi, int ksa = 64) {
  constexpr int NBUF = (MT == 8) ? 3 : 4;
  constexpr int BUFSZ = 2048 * MT + 8192;
  constexpr int LA = NBUF - 1;
  const int lane = tid & 63, w = tid >> 6, wm = w >> 1, wn = w & 1;
  const int lr = lane & 15, lg = lane >> 4;
  const int nks = nk * 2;
  f32x4 acc[MT][4];
#pragma unroll
  for (int i = 0; i < MT; ++i)
#pragma unroll
    for (int j = 0; j < 4; ++j) acc[i][j] = f32x4{0.f, 0.f, 0.f, 0.f};
#pragma unroll
  for (int s = 0; s < LA; ++s) g_issue<MT>(Ap, lda, Bp, ldb, s, ksa, tid, smem + s * BUFSZ);
  int bi = 0, bn = LA;
  for (int st = 0; st < nks; ++st) {
    if (MT == 8) {
      if (st + 1 < nks) asm volatile("s_waitcnt vmcnt(6)" ::: "memory");
      else asm volatile("s_waitcnt vmcnt(0)" ::: "memory");
    } else {
      if (st + 2 < nks) asm volatile("s_waitcnt vmcnt(8)" ::: "memory");
      else if (st + 1 < nks) asm volatile("s_waitcnt vmcnt(4)" ::: "memory");
      else asm volatile("s_waitcnt vmcnt(0)" ::: "memory");
    }
    RAW_BARRIER();
    if (st + LA < nks) g_issue<MT>(Ap, lda, Bp, ldb, st + LA, ksa, tid, smem + bn * BUFSZ);
    g_compute<SWAP, MT>(smem + bi * BUFSZ, acc, wm, wn, lr, lg);
    bi = (bi + 1 == NBUF) ? 0 : bi + 1;
    bn = (bn + 1 == NBUF) ? 0 : bn + 1;
  }
  RAW_BARRIER();
  epi(SWAP, tm, tn, wm, wn, lr, lg, acc);
}

template <int MT, class AB, class Sel, class Epi>
DI void gemm_phase_g(AB abase, int lda, int ksa, const u16* __restrict__ Bt, int ldb, int ntm, int ntn, int K, int vb, int nvb,
                     char* smem, Sel swapsel, Epi epi, bool rev = false) {
  if (vb < 0 || vb >= nvb) return;
  const int ntiles = ntm * ntn;
  const int nk = K / 64;
  const int nbx = nvb >> 3;
  const int x = vb & 7, lb = vb >> 3;
  const int rgt = 4 * ntn;
  const int per_xcd = (ntm >> 5) * rgt;
  for (int ql = lb; ql < per_xcd; ql += nbx) {
    const int rg0 = ql / rgt;
    const int i = ql - rg0 * rgt;
    const int rgi = rev ? ((ntm >> 5) - 1 - rg0) : rg0;
    const int tn = i >> 2;
    const int tm = (x + 8 * rgi) * 4 + (i & 3);
    const u16* Ap = abase(tm);
    const u16* Bp = Bt + (size_t)tn * 128 * ldb;
    const int tid = otid();
    if (swapsel(tn)) gemm_tile<true, MT>(Ap, lda, Bp, ldb, nk, tm, tn, tid, smem, epi, ksa);
    else gemm_tile<false, MT>(Ap, lda, Bp, ldb, nk, tm, tn, tid, smem, epi, ksa);
  }
}
template <int MT, class Sel, class Epi>
DI void gemm_phase(const u16* __restrict__ A, int lda, const u16* __restrict__ Bt, int ldb, int ntm, int ntn, int K,
                   int vb, int nvb, char* smem, Sel swapsel, Epi epi, bool rev = false) {
  auto ab = [=](int tm) { return A + (size_t)tm * (32 * MT) * lda; };
  gemm_phase_g<MT>(ab, lda, 64, Bt, ldb, ntm, ntn, K, vb, nvb, smem, swapsel, epi, rev);
}
template <class Epi, class Post>
DI void gemm_rowblock_phase(const u16* __restrict__ A, int lda, const u16* __restrict__ Bt, int ldb, int ntm, int ntn, int K,
                            int vb, int nvb, char* smem, Epi epi, Post post) {
  const int nk = K / 64;
  for (int tm = vb; tm < ntm; tm += nvb) {
    const u16* Ap = A + (size_t)tm * 128 * lda;
    for (int tn = 0; tn < ntn; ++tn) {
      const int tid = otid();
      gemm_tile<true, 4>(Ap, lda, Bt + (size_t)tn * 128 * ldb, ldb, nk, tm, tn, tid, smem, epi, 64);
    }
    asm volatile("s_waitcnt vmcnt(0)" ::: "memory");
    __syncthreads();
    post(tm);
  }
}

DI void ln_rows(float* buf, const float* __restrict__ g, const float* __restrict__ bt, const float* __restrict__ modl,
                int sh_off, int sc_off, u16* H, float* stats, bool write_x, bool topdown) {
  const int tid_ = otid();
  const int lane = tid_ & 63, w = tid_ >> 6;
  constexpr int NR = 4;
  for (int rq = (blockIdx.x * 4 + w) * NR; rq < TOK; rq += gridDim.x * 4 * NR) {
    const int r0 = topdown ? (TOK - NR - rq) : rq;
    f32x4 v[NR][4];
#pragma unroll
    for (int rr = 0; rr < NR; ++rr) {
      const f32x4* rp = (const f32x4*)(buf + (size_t)(r0 + rr) * 1024);
#pragma unroll
      for (int i = 0; i < 4; ++i) v[rr][i] = rp[lane + 64 * i];
    }
    float s[NR], q[NR];
#pragma unroll
    for (int rr = 0; rr < NR; ++rr) {
      s[rr] = 0.f;
#pragma unroll
      for (int i = 0; i < 4; ++i) s[rr] += v[rr][i][0] + v[rr][i][1] + v[rr][i][2] + v[rr][i][3];
    }
#pragma unroll
    for (int o = 32; o >= 1; o >>= 1) {
#pragma unroll
      for (int rr = 0; rr < NR; ++rr) s[rr] += __shfl_xor(s[rr], o);
    }
#pragma unroll
    for (int rr = 0; rr < NR; ++rr) {
      const float mu = s[rr] * (1.f / 1024.f);
      q[rr] = 0.f;
#pragma unroll
      for (int i = 0; i < 4; ++i)
#pragma unroll
        for (int k = 0; k < 4; ++k) { const float a = v[rr][i][k] - mu; q[rr] += a * a; }
    }
#pragma unroll
    for (int o = 32; o >= 1; o >>= 1) {
#pragma unroll
      for (int rr = 0; rr < NR; ++rr) q[rr] += __shfl_xor(q[rr], o);
    }
    const int b = r0 >> 13;
#pragma unroll
    for (int rr = 0; rr < NR; ++rr) {
      const int row = r0 + rr;
      const float mu = s[rr] * (1.f / 1024.f);
      const float rs = rsqrtf(q[rr] * (1.f / 1024.f) + EPS);
      if (stats && lane == 0) *(float2*)(stats + (size_t)row * 2) = make_float2(mu, rs);
      f32x4* rp = (f32x4*)(buf + (size_t)row * 1024);
#pragma unroll
      for (int i = 0; i < 4; ++i) {
        const int col = (lane + 64 * i) * 4;
        const float4 gg = *(const float4*)(g + col), bb = *(const float4*)(bt + col);
        f32x4 y;
        y[0] = (v[rr][i][0] - mu) * rs * gg.x + bb.x;
        y[1] = (v[rr][i][1] - mu) * rs * gg.y + bb.y;
        y[2] = (v[rr][i][2] - mu) * rs * gg.z + bb.z;
        y[3] = (v[rr][i][3] - mu) * rs * gg.w + bb.w;
        if (write_x) rp[lane + 64 * i] = y;
        if (H) {
          const float4 sh = *(const float4*)(modl + (size_t)b * 6144 + sh_off + col);
          const float4 sc = *(const float4*)(modl + (size_t)b * 6144 + sc_off + col);
          uint2 o2;
          o2.x = pack2(y[0] * (1.f + sc.x) + sh.x, y[1] * (1.f + sc.y) + sh.y);
          o2.y = pack2(y[2] * (1.f + sc.z) + sh.z, y[3] * (1.f + sc.w) + sh.w);
          *(uint2*)(H + (size_t)row * 1024 + col) = o2;
        }
      }
    }
  }
}

DI void ln_block(float* buf, int row0, const float* __restrict__ g, const float* __restrict__ bt,
                 const float* __restrict__ modl, int sh_off, int sc_off, u16* H) {
  const int tid_ = otid();
  const int lane = tid_ & 63, w = tid_ >> 6;
  for (int rr = 0; rr < 32; ++rr) {
    const int row = row0 + w * 32 + rr;
    f32x4* rp = (f32x4*)(buf + (size_t)row * 1024);
    f32x4 v[4];
    float s = 0.f;
#pragma unroll
    for (int i = 0; i < 4; ++i) { v[i] = __builtin_nontemporal_load(rp + lane + 64 * i); s += v[i][0] + v[i][1] + v[i][2] + v[i][3]; }
#pragma unroll
    for (int o = 32; o >= 1; o >>= 1) s += __shfl_xor(s, o);
    const float mu = s * (1.f / 1024.f);
    float q = 0.f;
#pragma unroll
    for (int i = 0; i < 4; ++i)
#pragma unroll
      for (int k = 0; k < 4; ++k) { float a = v[i][k] - mu; q += a * a; }
#pragma unroll
    for (int o = 32; o >= 1; o >>= 1) q += __shfl_xor(q, o);
    const float rs = rsqrtf(q * (1.f / 1024.f) + EPS);
    const int b = row >> 13;
#pragma unroll
    for (int i = 0; i < 4; ++i) {
      const int col = (lane + 64 * i) * 4;
      const float4 gg = *(const float4*)(g + col), bb = *(const float4*)(bt + col);
      f32x4 y;
      y[0] = (v[i][0] - mu) * rs * gg.x + bb.x;
      y[1] = (v[i][1] - mu) * rs * gg.y + bb.y;
      y[2] = (v[i][2] - mu) * rs * gg.z + bb.z;
      y[3] = (v[i][3] - mu) * rs * gg.w + bb.w;
      rp[lane + 64 * i] = y;
      if (H) {
        const float4 sh = *(const float4*)(modl + (size_t)b * 6144 + sh_off + col);
        const float4 sc = *(const float4*)(modl + (size_t)b * 6144 + sc_off + col);
        uint2 o2;
        o2.x = pack2(y[0] * (1.f + sc.x) + sh.x, y[1] * (1.f + sc.y) + sh.y);
        o2.y = pack2(y[2] * (1.f + sc.z) + sh.z, y[3] * (1.f + sc.w) + sh.w);
        *(uint2*)(H + (size_t)row * 1024 + col) = o2;
      }
    }
  }
}

DI void gmlp_item(const Params& p, int l, int item) {
  const int b = item >> 9, c = (item >> 3) & 63, grp = item & 7;
  const int tid_ = otid();
  const int lane = tid_ & 63, w = tid_ >> 6, lr = lane & 15, lg = lane >> 4;
  const float* wsp = p.w_s + (size_t)(l * 8 + grp) * 128 * 128;
  const u16* vgt = (const u16*)(p.ws + OFF_A + A_VGT) + (size_t)(b * 8 + grp) * 64 * S + c * 128;
  const u16* U = (const u16*)(p.ws + OFF_A + A_U);
  u16* OM = (u16*)(p.ws + OFF_H);
  f32x4 acc[4][2];
#pragma unroll
  for (int i = 0; i < 4; ++i)
#pragma unroll
    for (int j = 0; j < 2; ++j) acc[i][j] = f32x4{0.f, 0.f, 0.f, 0.f};
#pragma unroll
  for (int ks = 0; ks < 4; ++ks) {
    const int s0 = ks * 32 + lg * 8;
    bf16x8 af[4];
#pragma unroll
    for (int dt = 0; dt < 4; ++dt) af[dt] = *(const bf16x8*)(vgt + (size_t)(dt * 16 + lr) * S + s0);
#pragma unroll
    for (int nt = 0; nt < 2; ++nt) {
      const int t = w * 32 + nt * 16 + lr;
      const float4* wp = (const float4*)(wsp + t * 128 + s0);
      float4 a0 = wp[0], a1 = wp[1];
      unsigned pw[4];
      pw[0] = pack2((s0 + 0 <= t) ? a0.x : 0.f, (s0 + 1 <= t) ? a0.y : 0.f);
      pw[1] = pack2((s0 + 2 <= t) ? a0.z : 0.f, (s0 + 3 <= t) ? a0.w : 0.f);
      pw[2] = pack2((s0 + 4 <= t) ? a1.x : 0.f, (s0 + 5 <= t) ? a1.y : 0.f);
      pw[3] = pack2((s0 + 6 <= t) ? a1.z : 0.f, (s0 + 7 <= t) ? a1.w : 0.f);
      bf16x8 bw = __builtin_bit_cast(bf16x8, make_uint4(pw[0], pw[1], pw[2], pw[3]));
#pragma unroll
      for (int dt = 0; dt < 4; ++dt) acc[dt][nt] = MFMA16(af[dt], bw, acc[dt][nt]);
    }
  }
#pragma unroll
  for (int nt = 0; nt < 2; ++nt) {
    const int t = w * 32 + nt * 16 + lr;
    const size_t tok = (size_t)b * S + c * 128 + t;
    const float bias = p.b_s[(l * 8 + grp) * 128 + t];
    float val[4][4];
    float ss = 0.f;
#pragma unroll
    for (int dt = 0; dt < 4; ++dt) {
      const int d = dt * 16 + lg * 4;
      const uint2 uu = *(const uint2*)(U + tok * 512 + grp * 64 + d);
      const float u0 = bf2f(uu.x & 0xffff), u1 = bf2f(uu.x >> 16), u2 = bf2f(uu.y & 0xffff), u3 = bf2f(uu.y >> 16);
      val[dt][0] = u0 * (acc[dt][nt][0] + bias);
      val[dt][1] = u1 * (acc[dt][nt][1] + bias);
      val[dt][2] = u2 * (acc[dt][nt][2] + bias);
      val[dt][3] = u3 * (acc[dt][nt][3] + bias);
#pragma unroll
      for (int j = 0; j < 4; ++j) ss += val[dt][j] * val[dt][j];
    }
    ss = rows_sum(ss);
    const float r = rsqrtf(ss * (1.f / 64.f) + EPS);
#pragma unroll
    for (int dt = 0; dt < 4; ++dt) {
      const int d = dt * 16 + lg * 4;
      const float4 gg = *(const float4*)(p.out_g + l * 1024 + 512 + grp * 64 + d);
      uint2 st;
      st.x = pack2(val[dt][0] * r * gg.x, val[dt][1] * r * gg.y);
      st.y = pack2(val[dt][2] * r * gg.z, val[dt][3] * r * gg.w);
      *(uint2*)(OM + tok * 1024 + 512 + grp * 64 + d) = st;
    }
  }
}

constexpr int SM_K = 0, SM_V = 8192, SM_IMP = 8192 + 8704, SM_SEL = SM_IMP + 64 * 132 * 4, SM_UNI = SM_SEL + 1024;

struct KVr { u32x4 k0, k1, v0, v1; };
DI void kv_load_k(KVr& t, const u16* __restrict__ src, int stride, int tid) {
  const int r = tid >> 3, ch = tid & 7;
  t.k0 = *(const u32x4*)(src + (size_t)r * stride + ch * 8);
  t.k1 = *(const u32x4*)(src + (size_t)(r + 32) * stride + ch * 8);
}
DI void kv_load_v(KVr& t, const u16* __restrict__ src, int stride, int tid) {
  const int d = tid >> 3, ch = tid & 7;
  t.v0 = *(const u32x4*)(src + (size_t)d * stride + ch * 8);
  t.v1 = *(const u32x4*)(src + (size_t)(d + 32) * stride + ch * 8);
}
DI void kv_store_k(const KVr& t, char* sK, int tid) {
  const int r = tid >> 3, ch = tid & 7;
  char* pk = sK + r * 128 + ((ch ^ (r & 7)) << 4);
  *(u32x4*)(pk) = t.k0;
  *(u32x4*)(pk + 4096) = t.k1;
}
DI void kv_store_v(const KVr& t, char* sV, int tid) {
  const int d = tid >> 3, ch = tid & 7;
  uint2* d0 = (uint2*)(sV + d * 136 + ch * 16);
  d0[0] = make_uint2(t.v0[0], t.v0[1]);
  d0[1] = make_uint2(t.v0[2], t.v0[3]);
  uint2* d1 = (uint2*)(sV + (d + 32) * 136 + ch * 16);
  d1[0] = make_uint2(t.v1[0], t.v1[1]);
  d1[1] = make_uint2(t.v1[2], t.v1[3]);
}
DI int prev_set_bit(const unsigned* uni, int from) {
  int res = -1;
#pragma unroll
  for (int wd = 0; wd < 4; ++wd) {
    unsigned mw = uni[wd];
    const int hi = from - wd * 32;
    if (hi < 0) mw = 0u;
    else if (hi < 31) mw &= (2u << hi) - 1u;
    if (mw) res = wd * 32 + 31 - __clz(mw);
  }
  return __builtin_amdgcn_readfirstlane(res);
}
DI int next_set_bit(const unsigned* uni, int from) {
  int res = 1000;
#pragma unroll
  for (int wd = 3; wd >= 0; --wd) {
    unsigned mw = uni[wd];
    const int lo = from - wd * 32;
    if (lo >= 32) mw = 0u;
    else if (lo > 0) mw &= (~0u) << lo;
    if (mw) res = wd * 32 + __ffs(mw) - 1;
  }
  return __builtin_amdgcn_readfirstlane(res);
}

template <int MODE, bool MASKED, int WS>
DI void half_step(const char* sK, const char* sV, int half, int lr, int lg, const bf16x8 (&qf)[2][2], const unsigned (&sw)[2],
                  const float (&tb)[2], float (&m)[2], float (&lsum)[2], f32x4 (&o)[2][4], const bool (&valid)[2][4],
                  float (&psum)[2][4]) {
  bf16x8 kf[2][2], kw[2];
#pragma unroll
  for (int kt2 = 0; kt2 < 2; ++kt2) {
    const int r = half * 32 + kt2 * 16 + lr;
    kf[kt2][0] = *(const bf16x8*)(sK + r * 128 + (((lg) ^ (r & 7)) << 4));
    kf[kt2][1] = *(const bf16x8*)(sK + r * 128 + (((4 + lg) ^ (r & 7)) << 4));
    const float wv = (float)(WS * r);
    const unsigned pw = (lg == 0) ? pack2(wv, wv) : 0u;
    kw[kt2] = __builtin_bit_cast(bf16x8, make_uint4(pw, 0u, 0u, 0u));
  }
  if (MODE == 1) {
#pragma unroll
    for (int a = 0; a < 2; ++a)
#pragma unroll
      for (int j = 0; j < 4; ++j) psum[a][j] = 0.f;
  }
  bf16x8 pf[2];
  f32x4 sall[2][2];
#pragma unroll
  for (int h = 0; h < 2; ++h)
#pragma unroll
    for (int kt2 = 0; kt2 < 2; ++kt2) {
      f32x4 z = f32x4{0.f, 0.f, 0.f, 0.f};
      z = MFMA16(kw[kt2], __builtin_bit_cast(bf16x8, make_uint4(sw[h], 0u, 0u, 0u)), z);
      z = MFMA16(kf[kt2][0], qf[h][0], z);
      z = MFMA16(kf[kt2][1], qf[h][1], z);
      sall[h][kt2] = z;
    }
#pragma unroll
  for (int h = 0; h < 2; ++h) {
    f32x4 s[2] = {sall[h][0], sall[h][1]};
    float mx = NEGB;
#pragma unroll
    for (int kt2 = 0; kt2 < 2; ++kt2)
#pragma unroll
      for (int j = 0; j < 4; ++j) {
        float v = s[kt2][j];
        if (MASKED) v = valid[kt2][j] ? v : NEGB;
        s[kt2][j] = v;
        mx = fmaxf(mx, v);
      }
    if (MODE != 1) {
      mx = rows_max(mx);
      const float mn = fmaxf(m[h], mx + tb[h]);
      const float mm = mn - tb[h];
      float ps = 0.f;
#pragma unroll
      for (int kt2 = 0; kt2 < 2; ++kt2)
#pragma unroll
        for (int j = 0; j < 4; ++j) {
          float pv = ex2(s[kt2][j] - mm);
          s[kt2][j] = pv;
          ps += pv;
        }
      if (__ballot(mn != m[h]) != 0ull) {
        const float alpha = ex2(m[h] - mn);
        m[h] = mn;
        lsum[h] = lsum[h] * alpha + ps;
        if (MODE == 2) {
#pragma unroll
          for (int dt = 0; dt < 4; ++dt) o[h][dt] *= alpha;
        }
      } else {
        lsum[h] += ps;
      }
    } else {
#pragma unroll
      for (int kt2 = 0; kt2 < 2; ++kt2)
#pragma unroll
        for (int j = 0; j < 4; ++j) {
          float pv = ex2(s[kt2][j] - (m[h] - tb[h])) * lsum[h];
          s[kt2][j] = pv;
          psum[kt2][j] += pv;
        }
    }
    if (MODE != 0) {
      uint4 pk = make_uint4(pack2(s[0][0], s[0][1]), pack2(s[0][2], s[0][3]), pack2(s[1][0], s[1][1]), pack2(s[1][2], s[1][3]));
      pf[h] = __builtin_bit_cast(bf16x8, pk);
    }
  }
  if (MODE != 0) {
#pragma unroll
    for (int dt = 0; dt < 4; ++dt) {
      const char* base = sV + (dt * 16 + lr) * 136 + half * 64 + lg * 8;
      uint2 a = *(const uint2*)(base);
      uint2 c = *(const uint2*)(base + 32);
      bf16x8 vf = __builtin_bit_cast(bf16x8, make_uint4(a.x, a.y, c.x, c.y));
#pragma unroll
      for (int h = 0; h < 2; ++h) o[h][dt] = MFMA16(vf, pf[h], o[h][dt]);
    }
  }
}

DI void attn_item(const Params& p, int l, int b, int kvh, int qh, char* smem) {
  char* sK = smem + SM_K;
  char* sV = smem + SM_V;
  float* sImp = (float*)(smem + SM_IMP);
  unsigned* sSel = (unsigned*)(smem + SM_SEL);
  unsigned* sUni = (unsigned*)(smem + SM_UNI);
  const char* wsA = p.ws + OFF_A;
  const u16* Q = (const u16*)(wsA + A_Q);
  const u16* KS = (const u16*)(wsA + A_KS);
  const u16* VST = (const u16*)(wsA + A_VST);
  const u16* KW = (const u16*)(wsA + A_KW);
  const u16* VWT = (const u16*)(wsA + A_VWT);
  const float* G = (const float*)(wsA + A_G);
  const u16* KCMP = (const u16*)(p.ws + OFF_KCMP);
  const u16* VCMPT = (const u16*)(p.ws + OFF_VCMPT);
  u16* OM = (u16*)(p.ws + OFF_H);

  const int tid = otid(), lane = tid & 63, w = tid >> 6, lr = lane & 15, lg = lane >> 4;
  const int hp = w >> 1;
  const int t0 = qh * 32;
  const int cur = qh >> 1;
  const int tql = 16 * (w & 1) + lr;
  const size_t tokq = (size_t)b * S + t0 + tql;
  const int bk = b * 2 + kvh;
  const int hg0 = kvh * 4 + hp * 2;

  bf16x8 qf[2][2];
  float slope[2];
  unsigned qs[2];
#pragma unroll
  for (int h = 0; h < 2; ++h) {
    const u16* qp = Q + tokq * 512 + (hg0 + h) * 64 + lg * 8;
    qf[h][0] = *(const bf16x8*)qp;
    qf[h][1] = *(const bf16x8*)(qp + 32);
    slope[h] = ex2(-(float)(hg0 + h + 1)) * LOG2E;
    const float shi = bf2f(f2bf(slope[h]));
    qs[h] = (lg == 0) ? pack2(shi, slope[h] - shi) : 0u;
  }
  float m[2], ls[2];
  f32x4 o[2][4], otot[2][4];
  float psum[2][4];
#pragma unroll
  for (int h = 0; h < 2; ++h) {
    m[h] = MINIT;
    ls[h] = 0.f;
#pragma unroll
    for (int dt = 0; dt < 4; ++dt) o[h][dt] = f32x4{0.f, 0.f, 0.f, 0.f};
  }

  const int amax = qh >> 5;
  const u16* kc_base = KCMP + (size_t)bk * 512 * 64;
  const u16* vc_base = VCMPT + (size_t)bk * 64 * 512;
  KVr tl;
  kv_load_k(tl, kc_base, 64, tid);
  for (int a = 0; a <= amax; ++a) {
    __syncthreads();
    kv_store_k(tl, sK, tid);
    __syncthreads();
    if (a < amax) kv_load_k(tl, kc_base + (size_t)(a + 1) * 64 * 64, 64, tid);
    else { kv_load_k(tl, kc_base, 64, tid); kv_load_v(tl, vc_base, 512, tid); }
#pragma unroll
    for (int half = 0; half < 2; ++half) {
      float posf[2][4];
      bool valid[2][4];
#pragma unroll
      for (int kt2 = 0; kt2 < 2; ++kt2)
#pragma unroll
        for (int j = 0; j < 4; ++j) {
          int n = a * 64 + half * 32 + kt2 * 16 + lg * 4 + j;
          int rel = 16 * n + 31 - t0;
          posf[kt2][j] = (float)rel;
          valid[kt2][j] = rel <= tql;
        }
      const float tb[2] = {slope[0] * (float)(1024 * a + 31 - t0), slope[1] * (float)(1024 * a + 31 - t0)};
      half_step<0, true, 16>(sK, sV, half, lr, lg, qf, qs, tb, m, ls, o, valid, psum);
    }
  }
#pragma unroll
  for (int h = 0; h < 2; ++h) {
    float x = ls[h];
    x = rows_sum(x);
    ls[h] = x > 0.f ? 1.f / x : 0.f;
  }
  float carry = 0.f;
  float* myImp = sImp + hp * (32 * 132);
  for (int a = 0; a <= amax; ++a) {
    __syncthreads();
    kv_store_k(tl, sK, tid);
    kv_store_v(tl, sV, tid);
    __syncthreads();
    if (a < amax) {
      kv_load_k(tl, kc_base + (size_t)(a + 1) * 64 * 64, 64, tid);
      kv_load_v(tl, vc_base + (a + 1) * 64, 512, tid);
    }
#pragma unroll
    for (int half = 0; half < 2; ++half) {
      float posf[2][4];
      bool valid[2][4];
#pragma unroll
      for (int kt2 = 0; kt2 < 2; ++kt2)
#pragma unroll
        for (int j = 0; j < 4; ++j) {
          int n = a * 64 + half * 32 + kt2 * 16 + lg * 4 + j;
          int rel = 16 * n + 31 - t0;
          posf[kt2][j] = (float)rel;
          valid[kt2][j] = rel <= tql;
        }
      const float tb[2] = {slope[0] * (float)(1024 * a + 31 - t0), slope[1] * (float)(1024 * a + 31 - t0)};
      half_step<1, true, 16>(sK, sV, half, lr, lg, qf, qs, tb, m, ls, o, valid, psum);
      float prev = carry;
#pragma unroll
      for (int kt2 = 0; kt2 < 2; ++kt2) {
        float sum4 = psum[kt2][0] + psum[kt2][1] + psum[kt2][2] + psum[kt2][3];
        float p3 = psum[kt2][3];
        float up = __shfl(p3, (lane + 48) & 63);
        float wrap = __shfl(prev, (lane + 48) & 63);
        float spill = lg > 0 ? up : wrap;
        int j = a * 16 + half * 8 + kt2 * 4 + lg;
        myImp[tql * 132 + j] = sum4 + spill;
        prev = p3;
      }
      carry = prev;
    }
  }
  const size_t tokq_a = (size_t)b * S + t0 + 16 * ((otid() >> 6) & 1) + (otid() & 15);
#pragma unroll
  for (int h = 0; h < 2; ++h) {
    const float g0 = G[tokq_a * 24 + (hg0 + h) * 3 + 0];
#pragma unroll
    for (int dt = 0; dt < 4; ++dt) {
      otot[h][dt] = o[h][dt] * g0;
      o[h][dt] = f32x4{0.f, 0.f, 0.f, 0.f};
    }
    m[h] = MINIT;
    ls[h] = 0.f;
  }
  if (tid < 4) sUni[tid] = 0u;
  __syncthreads();
  if (tid < 128) {
    const int q = tid >> 2, sub = tid & 3;
    unsigned mk[4] = {0u, 0u, 0u, 0u};
    if (cur < 16) {
      mk[0] = (1u << (cur + 1)) - 1u;
    } else {
      float v[32];
#pragma unroll
      for (int i = 0; i < 32; ++i) {
        int j = sub + 4 * i;
        v[i] = (j >= 1 && j <= cur - 2) ? (sImp[q * 132 + j] + sImp[32 * 132 + q * 132 + j]) : -1.f;
      }
      for (int round = 0; round < 13; ++round) {
        float bv = v[0];
        int bi = 0;
#pragma unroll
        for (int i = 1; i < 32; ++i)
          if (v[i] > bv) { bv = v[i]; bi = i; }
        int bj = sub + 4 * bi;
#pragma unroll
        for (int off = 1; off <= 2; off <<= 1) {
          float ov = __shfl_xor(bv, off);
          int oj = __shfl_xor(bj, off);
          if (ov > bv || (ov == bv && oj < bj)) { bv = ov; bj = oj; }
        }
#pragma unroll
        for (int i = 0; i < 32; ++i)
          if (sub + 4 * i == bj) v[i] = -2.f;
#pragma unroll
        for (int wd = 0; wd < 4; ++wd) mk[wd] |= ((bj >> 5) == wd) ? (1u << (bj & 31)) : 0u;
      }
      const int f1 = cur, f2 = cur - 1;
      mk[0] |= 1u;
#pragma unroll
      for (int wd = 0; wd < 4; ++wd) {
        mk[wd] |= ((f1 >> 5) == wd) ? (1u << (f1 & 31)) : 0u;
        mk[wd] |= ((f2 >> 5) == wd) ? (1u << (f2 & 31)) : 0u;
      }
    }
    if (sub == 0) {
#pragma unroll
      for (int wd = 0; wd < 4; ++wd) {
        sSel[q * 4 + wd] = mk[wd];
        atomicOr(&sUni[wd], mk[wd]);
      }
    }
  }
  __syncthreads();
  const int jw0 = (cur >= 8 ? cur - 8 : 0);
  {
    int j = cur;
    kv_load_k(tl, KS + ((size_t)b * S + j * 64) * 128 + kvh * 64, 128, tid);
    kv_load_v(tl, VST + (size_t)bk * 64 * S + j * 64, S, tid);
    while (j >= 0) {
      __syncthreads();
      kv_store_k(tl, sK, tid);
      kv_store_v(tl, sV, tid);
      __syncthreads();
      const int jn = prev_set_bit(sUni, j - 1);
      if (jn >= 0) {
        kv_load_k(tl, KS + ((size_t)b * S + jn * 64) * 128 + kvh * 64, 128, tid);
        kv_load_v(tl, VST + (size_t)bk * 64 * S + jn * 64, S, tid);
      } else {
        kv_load_k(tl, KW + ((size_t)b * S + cur * 64) * 128 + kvh * 64, 128, tid);
        kv_load_v(tl, VWT + (size_t)bk * 64 * S + cur * 64, S, tid);
      }
      const bool selbit = (sSel[tql * 4 + (j >> 5)] >> (j & 31)) & 1u;
      const unsigned long long bal = __ballot(selbit);
      if (bal != 0ull) {
        const bool full = (j < cur) && (bal == ~0ull);
#pragma unroll
        for (int half = 0; half < 2; ++half) {
          float posf[2][4];
          bool valid[2][4];
#pragma unroll
          for (int kt2 = 0; kt2 < 2; ++kt2)
#pragma unroll
            for (int jj = 0; jj < 4; ++jj) {
              int rel = j * 64 - t0 + half * 32 + kt2 * 16 + lg * 4 + jj;
              posf[kt2][jj] = (float)rel;
              valid[kt2][jj] = selbit && (rel <= tql);
            }
          const float tb[2] = {slope[0] * (float)(j * 64 - t0), slope[1] * (float)(j * 64 - t0)};
          half_step<2, true, 1>(sK, sV, half, lr, lg, qf, qs, tb, m, ls, o, valid, psum);
        }
      }
      j = jn;
    }
  }
  const size_t tokq_b = (size_t)b * S + t0 + 16 * ((otid() >> 6) & 1) + (otid() & 15);
#pragma unroll
  for (int h = 0; h < 2; ++h) {
    float x = ls[h];
    x = rows_sum(x);
    const float f = (x > 0.f ? 1.f / x : 0.f) * G[tokq_b * 24 + (hg0 + h) * 3 + 1];
#pragma unroll
    for (int dt = 0; dt < 4; ++dt) {
      otot[h][dt] += o[h][dt] * f;
      o[h][dt] = f32x4{0.f, 0.f, 0.f, 0.f};
    }
    m[h] = MINIT;
    ls[h] = 0.f;
  }
  for (int j = cur; j >= jw0; --j) {
    __syncthreads();
    kv_store_k(tl, sK, tid);
    kv_store_v(tl, sV, tid);
    __syncthreads();
    if (j > jw0) {
      kv_load_k(tl, KW + ((size_t)b * S + (j - 1) * 64) * 128 + kvh * 64, 128, tid);
      kv_load_v(tl, VWT + (size_t)bk * 64 * S + (j - 1) * 64, S, tid);
    }
    const bool full = (j * 64 + 63 <= t0) && (t0 + 31 - j * 64 <= 511);
#pragma unroll
    for (int half = 0; half < 2; ++half) {
      float posf[2][4];
      bool valid[2][4];
#pragma unroll
      for (int kt2 = 0; kt2 < 2; ++kt2)
#pragma unroll
        for (int jj = 0; jj < 4; ++jj) {
          int rel = j * 64 - t0 + half * 32 + kt2 * 16 + lg * 4 + jj;
          posf[kt2][jj] = (float)rel;
          valid[kt2][jj] = (rel <= tql) && (tql - rel < 512);
        }
      const float tb[2] = {slope[0] * (float)(j * 64 - t0), slope[1] * (float)(j * 64 - t0)};
      half_step<2, true, 1>(sK, sV, half, lr, lg, qf, qs, tb, m, ls, o, valid, psum);
    }
  }
  const int tid_c = otid();
  const size_t tokq_c = (size_t)b * S + t0 + 16 * ((tid_c >> 6) & 1) + (tid_c & 15);
  const int hg_c = kvh * 4 + (tid_c >> 7) * 2;
  const int lg_c = (tid_c >> 4) & 3;
#pragma unroll
  for (int h = 0; h < 2; ++h) {
    float x = ls[h];
    x = rows_sum(x);
    const float f = (x > 0.f ? 1.f / x : 0.f) * G[tokq_c * 24 + (hg_c + h) * 3 + 2];
    float ss = 0.f;
#pragma unroll
    for (int dt = 0; dt < 4; ++dt) {
      otot[h][dt] += o[h][dt] * f;
#pragma unroll
      for (int jj = 0; jj < 4; ++jj) ss += otot[h][dt][jj] * otot[h][dt][jj];
    }
    ss = rows_sum(ss);
    const float r = rsqrtf(ss * (1.f / 64.f) + EPS);
#pragma unroll
    for (int dt = 0; dt < 4; ++dt) {
      const int d = dt * 16 + lg_c * 4;
      const float4 gg = *(const float4*)(p.out_g + l * 1024 + (hg_c + h) * 64 + d);
      uint2 st;
      st.x = pack2(otot[h][dt][0] * r * gg.x, otot[h][dt][1] * r * gg.y);
      st.y = pack2(otot[h][dt][2] * r * gg.z, otot[h][dt][3] * r * gg.w);
      *(uint2*)(OM + tokq_c * 1024 + (hg_c + h) * 64 + d) = st;
    }
  }
}

#define XB_TMO      128
#define XB_XCNT(j)  (256  + 64 * (j))
#define XB_XSUB(j)  (1280 + 64 * (j))
#define XB_XGEN(j)  (2304 + 64 * (j))
#define XB_TOP      3328
#define XB_TOPGEN   3392
#define XCD_BAR_WORDS 3456
#define XB_SPIN_CAP (1u << 20)
DI unsigned xb_ld(unsigned* p) { return __hip_atomic_load(p, __ATOMIC_RELAXED, __HIP_MEMORY_SCOPE_AGENT); }
DI unsigned xb_add(unsigned* p, unsigned v) { return __hip_atomic_fetch_add(p, v, __ATOMIC_RELAXED, __HIP_MEMORY_SCOPE_AGENT); }
DI unsigned xb_xcc_id() { return (unsigned)__builtin_amdgcn_s_getreg((3 << 11) | 20) & 0xFu; }
#define XB_SPIN(cond, bar) do { unsigned _sp = 0; while (cond) { __builtin_amdgcn_s_sleep(1); \
    if ((++_sp & 255u) == 0u) { if (xb_ld(&(bar)[XB_TMO])) break; if (_sp > XB_SPIN_CAP) { atomicAdd(&(bar)[XB_TMO], 1u); break; } } } } while (0)

struct XcdBarrier { unsigned* bar; unsigned x; volatile unsigned* st; };

DI void xcd_barrier_complete(unsigned* bar, unsigned x, unsigned& nloc, unsigned& nx) {
  const unsigned G = gridDim.x;
  unsigned sum, cnt, mine, sp = 0u;
  for (;;) {
    sum = 0u; cnt = 0u; mine = 0u;
#pragma unroll
    for (unsigned j = 0; j < 16; ++j) { const unsigned c = xb_ld(&bar[XB_XCNT(j)]); sum += c; cnt += (c > 0u) ? 1u : 0u; mine = (j == x) ? c : mine; }
    if (sum == G) break;
    __builtin_amdgcn_s_sleep(1);
    if ((++sp & 255u) == 0u) { if (xb_ld(&bar[XB_TMO])) break; if (sp > XB_SPIN_CAP) { atomicAdd(&bar[XB_TMO], 1u); break; } }
  }
  nloc = mine > 0u ? mine : 1u; nx = cnt > 0u ? cnt : 1u;
}

DI void gsync(const XcdBarrier& b0) {
  asm volatile("s_waitcnt vmcnt(0)" ::: "memory");
  __syncthreads();
  if (threadIdx.x == 0) {
    XcdBarrier b;
    b.bar = b0.bar;
    b.st = b0.st;
    b.x = xb_xcc_id();
    unsigned* bar = b.bar;
    __builtin_amdgcn_s_waitcnt(0);
    unsigned nloc = b.st[0], nx = b.st[1];
    if (nloc == 0u) { xcd_barrier_complete(bar, b.x, nloc, nx); b.st[0] = nloc; b.st[1] = nx; }
    const unsigned old = xb_add(&bar[XB_XSUB(b.x)], 1u);
    const unsigned gen = old / nloc;
    if (old + 1u == (gen + 1u) * nloc) {
      __builtin_amdgcn_fence(__ATOMIC_RELEASE, "agent");
      asm volatile("s_waitcnt vmcnt(0)" ::: "memory");
      const unsigned og = xb_add(&bar[XB_TOP], 1u);
      const unsigned tg = og / nx;
      if (og + 1u == (tg + 1u) * nx) xb_add(&bar[XB_TOPGEN], 1u);
      else XB_SPIN(xb_ld(&bar[XB_TOPGEN]) == tg, bar);
      __builtin_amdgcn_fence(__ATOMIC_ACQUIRE, "agent");
      xb_add(&bar[XB_XGEN(b.x)], 1u);
      asm volatile("s_waitcnt vmcnt(0)" ::: "memory");
    } else {
      XB_SPIN(xb_ld(&bar[XB_XGEN(b.x)]) == gen, bar);
      __builtin_amdgcn_fence(__ATOMIC_ACQUIRE, "agent");
      asm volatile("s_waitcnt vmcnt(0)" ::: "memory");
    }
  }
  __syncthreads();
}

#ifndef STOP_AFTER
#define STOP_AFTER 0
#endif
#define DUMP_BF16_AND_STOP(ptr)                                                                   \
  {                                                                                               \
    const u16* s_ = (const u16*)(ptr);                                                            \
    for (size_t i = (size_t)bid * 256 + threadIdx.x; i < (size_t)TOK * 1024; i += (size_t)nb * 256) \
      p.out[i] = bf2f(s_[i]);                                                                     \
    return;                                                                                       \
  }
#define DUMP_F32_AND_STOP(ptr)                                                                    \
  {                                                                                               \
    const float* s_ = (const float*)(ptr);                                                        \
    for (size_t i = (size_t)bid * 256 + threadIdx.x; i < (size_t)TOK * 1024; i += (size_t)nb * 256) \
      p.out[i] = s_[i];                                                                           \
    return;                                                                                       \
  }
__global__ void __launch_bounds__(256, 2) mega(Params p) {
  extern __shared__ __attribute__((aligned(16))) char smem[];
  char* ws = p.ws;
  const int nb = gridDim.x, bid = blockIdx.x;
  if (ws == nullptr) cg::this_grid().sync();
  volatile unsigned* xst = (volatile unsigned*)(smem + 73728);
  if (threadIdx.x == 0) { xst[0] = 0u; xst[1] = 0u; }
  __syncthreads();
  if (threadIdx.x == 0) (void)xb_add(&((unsigned*)(ws + OFF_BAR))[XB_XCNT(xb_xcc_id())], 1u);
#define grid (XcdBarrier{(unsigned*)(p.ws + OFF_BAR), 0u, (volatile unsigned*)(smem + 73728)})
  float* X1 = (float*)(ws + OFF_X1);
  u16* H = (u16*)(ws + OFF_H);
  char* wsA = ws + OFF_A;
  const float* mod = (const float*)(ws + OFF_MOD);

#ifdef ZERO_WS
  {
    uint4* z = (uint4*)ws;
    const size_t n16 = (OFF_A + A_END) / 16;
    for (size_t i = (size_t)bid * 256 + threadIdx.x; i < n16; i += (size_t)nb * 256) z[i] = make_uint4(0, 0, 0, 0);
    uint4* zo = (uint4*)p.out;
    const size_t m16 = (size_t)TOK * 1024 * 4 / 16;
    for (size_t i = (size_t)bid * 256 + threadIdx.x; i < m16; i += (size_t)nb * 256) zo[i] = make_uint4(0, 0, 0, 0);
  }
  gsync(grid);
#endif
  phase0a(p, smem);
  gsync(grid);
  phase0b(p);
  gsync(grid);
  phase_mod_x(p);
  gsync(grid);

  for (int l = 0; l < 2; ++l) {
    const float* modl = mod + (size_t)l * 8 * 6144;
    const float* xin = (l == 0) ? p.x : p.out;
    {
      u16* Qo = (u16*)(wsA + A_Q);
      u16* KCo = (u16*)(wsA + A_KC);
      u16* VCo = (u16*)(wsA + A_VC);
      u16* KSo = (u16*)(wsA + A_KS);
      u16* VSTo = (u16*)(wsA + A_VST);
      u16* KWo = (u16*)(wsA + A_KW);
      u16* VWTo = (u16*)(wsA + A_VWT);
      float* Go = (float*)(wsA + A_G);
      u16* Uo = (u16*)(wsA + A_U);
      u16* VGTo = (u16*)(wsA + A_VGT);
      const float* vng = p.vn_g + l * 512;
      const float* vnb = p.vn_b + l * 512;
      auto sel1 = [](int tn) { return !(tn == 7 || tn == 9 || (tn >= 14 && tn < 18)); };
      auto epi = [&](bool swp, int tm, int tn, int wm, int wn, int lr, int lg, auto& acc) {
        constexpr int MT = sizeof(acc) / sizeof(acc[0]);
        const int row0 = tm * (32 * MT) + wm * (16 * MT);
        const int b = row0 >> 13;
        const int s0 = row0 & (S - 1);
        if (swp) {
          if (tn == 18) {
            if (wn == 0) {
#pragma unroll
              for (int mi = 0; mi < MT; ++mi)
#pragma unroll
                for (int ni = 0; ni < 2; ++ni) {
                  const int c = ni * 16 + lg * 4;
                  const size_t row = (size_t)row0 + mi * 16 + lr;
                  if (c < 24)
                    *(float4*)(Go + row * 24 + c) =
                        make_float4(sigm(acc[mi][ni][0]), sigm(acc[mi][ni][1]), sigm(acc[mi][ni][2]), sigm(acc[mi][ni][3]));
                }
            }
          } else {
            u16* dst;
            int ld, cb;
            float sc = 1.f;
            bool g = false;
            if (tn < 4) { dst = Qo; ld = 512; cb = tn * 128; sc = QSCALE; }
            else if (tn == 4) { dst = KCo; ld = 128; cb = 0; }
            else if (tn == 5) { dst = VCo; ld = 128; cb = 0; }
            else if (tn == 6) { dst = KSo; ld = 128; cb = 0; }
            else if (tn == 8) { dst = KWo; ld = 128; cb = 0; }
            else { dst = Uo; ld = 512; cb = (tn - 10) * 128; g = true; }
#pragma unroll
            for (int mi = 0; mi < MT; ++mi)
#pragma unroll
              for (int ni = 0; ni < 4; ++ni) {
                const size_t row = (size_t)row0 + mi * 16 + lr;
                float v[4];
#pragma unroll
                for (int j = 0; j < 4; ++j) v[j] = g ? gelu_t(acc[mi][ni][j]) : acc[mi][ni][j] * sc;
                uint2 st;
                st.x = pack2(v[0], v[1]);
                st.y = pack2(v[2], v[3]);
                *(uint2*)(dst + row * ld + cb + wn * 64 + ni * 16 + lg * 4) = st;
              }
          }
        } else if (tn == 7 || tn == 9) {
          u16* dst = (tn == 7) ? VSTo : VWTo;
#pragma unroll
          for (int mi = 0; mi < MT; ++mi)
#pragma unroll
            for (int ni = 0; ni < 4; ++ni) {
              const int d = ni * 16 + lr;
              uint2 st;
              st.x = pack2(acc[mi][ni][0], acc[mi][ni][1]);
              st.y = pack2(acc[mi][ni][2], acc[mi][ni][3]);
              *(uint2*)(dst + ((size_t)(b * 2 + wn) * 64 + d) * S + s0 + mi * 16 + lg * 4) = st;
            }
        } else {
          const int grp = (tn - 14) * 2 + wn;
          float vg[4], vb[4];
#pragma unroll
          for (int ni = 0; ni < 4; ++ni) { vg[ni] = vng[grp * 64 + ni * 16 + lr]; vb[ni] = vnb[grp * 64 + ni * 16 + lr]; }
#pragma unroll
          for (int mi = 0; mi < MT; ++mi) {
            float vv[4][4];
#pragma unroll
            for (int ni = 0; ni < 4; ++ni)
#pragma unroll
              for (int j = 0; j < 4; ++j) vv[ni][j] = gelu_t(acc[mi][ni][j]);
#pragma unroll
            for (int j = 0; j < 4; ++j) {
              float s1 = vv[0][j] + vv[1][j] + vv[2][j] + vv[3][j];
              s1 += __shfl_xor(s1, 1); s1 += __shfl_xor(s1, 2); s1 += __shfl_xor(s1, 4); s1 += __shfl_xor(s1, 8);
              const float mu = s1 * (1.f / 64.f);
              float s2 = 0.f;
#pragma unroll
              for (int ni = 0; ni < 4; ++ni) { float dd = vv[ni][j] - mu; s2 += dd * dd; }
              s2 += __shfl_xor(s2, 1); s2 += __shfl_xor(s2, 2); s2 += __shfl_xor(s2, 4); s2 += __shfl_xor(s2, 8);
              const float rs = rsqrtf(s2 * (1.f / 64.f) + EPS);
#pragma unroll
              for (int ni = 0; ni < 4; ++ni) vv[ni][j] = (vv[ni][j] - mu) * rs * vg[ni] + vb[ni];
            }
#pragma unroll
            for (int ni = 0; ni < 4; ++ni) {
              const int d = ni * 16 + lr;
              uint2 st;
              st.x = pack2(vv[ni][0], vv[ni][1]);
              st.y = pack2(vv[ni][2], vv[ni][3]);
              *(uint2*)(VGTo + ((size_t)(b * 8 + grp) * 64 + d) * S + s0 + mi * 16 + lg * 4) = st;
            }
          }
        }
      };
      gemm_phase<8>(H, 1024, (const u16*)(ws + OFF_WTIN + l * SZ_WTIN), 1024, 256, 19, 1024, bid, nb, smem, sel1, epi);
    }
    gsync(grid);
    if (STOP_AFTER == 1 && l == 0) DUMP_BF16_AND_STOP(wsA)
    if (STOP_AFTER == 11 && l == 0) DUMP_BF16_AND_STOP(wsA + A_KW)
    if (STOP_AFTER == 12 && l == 0) DUMP_BF16_AND_STOP(wsA + A_U)
    {
      const int ng = (nb >= 256) ? 256 : nb;
      const int half = ng / 2;
      for (int which = 0; which < 2; ++which) {
        u16* HC = (u16*)(wsA + A_HC) + (size_t)which * 8192 * 256;
        const float* cb1 = (const float*)(ws + OFF_CB1) + (l * 2 + which) * 256;
        const u16* src_tok = (const u16*)(wsA + (which ? A_VC : A_KC));
        auto selT = [](int) { return true; };
        auto ab = [=](int tm) {
          const int bk = tm >> 2, n0 = (tm & 3) * 128;
          return src_tok + ((size_t)(bk >> 1) * S + 16 * n0) * 128 + (bk & 1) * 64;
        };
        auto epi = [&](bool swp, int tm, int tn, int wm, int wn, int lr, int lg, auto& acc) {
        constexpr int MT = sizeof(acc) / sizeof(acc[0]);
          const int row0 = tm * (32 * MT) + wm * (16 * MT), col0 = tn * 128 + wn * 64;
#pragma unroll
          for (int ni = 0; ni < 4; ++ni) {
            const float4 cb = *(const float4*)(cb1 + col0 + ni * 16 + lg * 4);
#pragma unroll
            for (int mi = 0; mi < MT; ++mi) {
              uint2 st;
              st.x = pack2(gelu_t(acc[mi][ni][0] + cb.x), gelu_t(acc[mi][ni][1] + cb.y));
              st.y = pack2(gelu_t(acc[mi][ni][2] + cb.z), gelu_t(acc[mi][ni][3] + cb.w));
              *(uint2*)(HC + (size_t)(row0 + mi * 16 + lr) * 256 + col0 + ni * 16 + lg * 4) = st;
            }
          }
        };
        const int vb = (bid < ng) ? (which == 0 ? (bid < half ? bid : -1) : (bid >= half ? bid - half : -1)) : -1;
        gemm_phase_g<4>(ab, 2048, 128, (const u16*)(ws + OFF_WTC1 + (l * 2 + which) * SZ_WTC1), 2048, 64, 2, 2048, vb, half, smem,
                     selT, epi);
      }
      if (bid >= ng) {
        unsigned* gctr = (unsigned*)(ws + OFF_BAR) + (l ? 96 : 32);
        volatile unsigned* slot = (volatile unsigned*)(smem + 73728) + 2;
        for (;;) {
          __syncthreads();
          if (threadIdx.x == 0) *slot = xb_add(gctr, 1u);
          __syncthreads();
          const unsigned idx = (unsigned)__builtin_amdgcn_readfirstlane((int)*slot);
          if (idx >= (unsigned)GMLP_EARLY) break;
          gmlp_item(p, l, (int)idx);
        }
      }
    }
    gsync(grid);
    {
      for (int which = 0; which < 2; ++which) {
        u16* KCMP = (u16*)(ws + OFF_KCMP);
        u16* VCMPT = (u16*)(ws + OFF_VCMPT);
        auto selW = [which](int) { return which == 0; };
        auto epi = [&](bool swp, int tm, int tn, int wm, int wn, int lr, int lg, auto& acc) {
        constexpr int MT = sizeof(acc) / sizeof(acc[0]);
          if (wn != 0) return;
          const int row0 = tm * (32 * MT) + wm * (16 * MT);
#pragma unroll
          for (int mi = 0; mi < MT; ++mi)
#pragma unroll
            for (int ni = 0; ni < 4; ++ni) {
              uint2 st;
              st.x = pack2(acc[mi][ni][0], acc[mi][ni][1]);
              st.y = pack2(acc[mi][ni][2], acc[mi][ni][3]);
              if (swp) {
                *(uint2*)(KCMP + (size_t)(row0 + mi * 16 + lr) * 64 + ni * 16 + lg * 4) = st;
              } else {
                const int d = ni * 16 + lr;
                const int rb = row0 + mi * 16 + lg * 4;
                *(uint2*)(VCMPT + ((size_t)(rb >> 9) * 64 + d) * 512 + (rb & 511)) = st;
              }
            }
        };
        const int vb = (which == 0) ? bid : (bid + nb - 64) % nb;
        gemm_phase<4>((const u16*)(wsA + A_HC) + (size_t)which * 8192 * 256, 256,
                   (const u16*)(ws + OFF_WTC2 + (l * 2 + which) * SZ_WTC2), 256, 64, 1, 256, vb, nb, smem, selW, epi);
      }
    }
    gsync(grid);
    if (STOP_AFTER == 4 && l == 0) DUMP_BF16_AND_STOP(ws + OFF_KCMP)
    {
      unsigned* qctr = (unsigned*)(ws + OFF_BAR) + (l ? 64 : 0);
      volatile unsigned* slot = (volatile unsigned*)(smem + 73728) + 2;
      for (;;) {
        __syncthreads();
        if (threadIdx.x == 0) *slot = xb_add(qctr, 1u);
        __syncthreads();
        const unsigned idx = (unsigned)__builtin_amdgcn_readfirstlane((int)*slot);
        if (idx >= 8192u - (unsigned)GMLP_EARLY) break;
        if (idx < 4096u) {
          const int qh = 255 - (int)(idx >> 4);
          const int rem = (int)(idx & 15u);
          attn_item(p, l, rem >> 1, rem & 1, qh, smem);
        } else {
          gmlp_item(p, l, (int)(idx - 4096u) + GMLP_EARLY);
        }
      }
    }
    gsync(grid);
    if (STOP_AFTER == 5 && l == 0) DUMP_BF16_AND_STOP(H)
    if ((STOP_AFTER == 51 || STOP_AFTER == 52) && l == 0) {
      for (size_t i = (size_t)bid * 256 + threadIdx.x; i < (size_t)TOK * 1024; i += (size_t)nb * 256) {
        const int col = (int)(i & 1023);
        const bool keep = (STOP_AFTER == 51) ? (col < 512) : (col >= 512);
        p.out[i] = keep ? bf2f(H[i]) : 0.f;
      }
      return;
    }
    {
      auto selT = [](int) { return true; };
      auto epi = [&](bool swp, int tm, int tn, int wm, int wn, int lr, int lg, auto& acc) {
        constexpr int MT = sizeof(acc) / sizeof(acc[0]);
        const int row0 = tm * (32 * MT) + wm * (16 * MT), col0 = tn * 128 + wn * 64;
        const int b = row0 >> 13;
#pragma unroll
        for (int ni = 0; ni < 4; ++ni) {
          const int col = col0 + ni * 16 + lg * 4;
          const float4 g1 = *(const float4*)(modl + (size_t)b * 6144 + 2048 + col);
#pragma unroll
          for (int mi = 0; mi < MT; ++mi) {
            const size_t row = (size_t)row0 + mi * 16 + lr;
            float4 xv = *(const float4*)(xin + row * 1024 + col);
            if (l == 1) {
              const float2 st = *(const float2*)((const float*)(ws + OFF_ST2) + row * 2);
              const float4 gg = *(const float4*)(p.ln2_g + col), bb = *(const float4*)(p.ln2_b + col);
              xv.x = (xv.x - st.x) * st.y * gg.x + bb.x;
              xv.y = (xv.y - st.x) * st.y * gg.y + bb.y;
              xv.z = (xv.z - st.x) * st.y * gg.z + bb.z;
              xv.w = (xv.w - st.x) * st.y * gg.w + bb.w;
            }
            float4 o4;
            o4.x = ALPHA * xv.x + (1.f + g1.x) * acc[mi][ni][0];
            o4.y = ALPHA * xv.y + (1.f + g1.y) * acc[mi][ni][1];
            o4.z = ALPHA * xv.z + (1.f + g1.z) * acc[mi][ni][2];
            o4.w = ALPHA * xv.w + (1.f + g1.w) * acc[mi][ni][3];
            *(float4*)(X1 + row * 1024 + col) = o4;
          }
        }
      };
      gemm_phase<8>(H, 1024, (const u16*)(ws + OFF_WTO + l * SZ_WTO), 1024, 256, 8, 1024, bid, nb, smem, selT, epi);
    }
    gsync(grid);
    ln_rows(X1, p.ln1_g + l * 1024, p.ln1_b + l * 1024, modl, 3072, 4096, H, (float*)(ws + OFF_ST1), false, true);
    gsync(grid);
    if (STOP_AFTER == 7 && l == 0) DUMP_F32_AND_STOP(X1)
    {
      u16* HH = (u16*)(wsA);
      auto selT = [](int) { return true; };
      auto epi = [&](bool swp, int tm, int tn, int wm, int wn, int lr, int lg, auto& acc) {
        constexpr int MT = sizeof(acc) / sizeof(acc[0]);
        const int row0 = tm * (32 * MT) + wm * (16 * MT);
        const int cb = tn * 64 + wn * 32;
#pragma unroll
        for (int mi = 0; mi < MT; ++mi)
#pragma unroll
          for (int ni = 0; ni < 2; ++ni) {
            const size_t row = (size_t)row0 + mi * 16 + lr;
            float v[4];
#pragma unroll
            for (int j = 0; j < 4; ++j) {
              const float a = acc[mi][ni][j], bb = acc[mi][ni + 2][j];
              v[j] = a * sigm(a) * bb;
            }
            uint2 st;
            st.x = pack2(v[0], v[1]);
            st.y = pack2(v[2], v[3]);
            *(uint2*)(HH + row * 2816 + cb + ni * 16 + lg * 4) = st;
          }
      };
      gemm_phase<8>(H, 1024, (const u16*)(ws + OFF_WT13 + l * SZ_WT13), 1024, 256, 44, 1024, bid, nb, smem, selT, epi);
    }
    gsync(grid);
    if (STOP_AFTER == 8 && l == 0) DUMP_BF16_AND_STOP(wsA)
    {
      const u16* HH = (const u16*)(wsA);
      float* outp = p.out;
      auto selT = [](int) { return true; };
      auto epi = [&](bool swp, int tm, int tn, int wm, int wn, int lr, int lg, auto& acc) {
        constexpr int MT = sizeof(acc) / sizeof(acc[0]);
        const int row0 = tm * (32 * MT) + wm * (16 * MT), col0 = tn * 128 + wn * 64;
        const int b = row0 >> 13;
#pragma unroll
        for (int ni = 0; ni < 4; ++ni) {
          const int col = col0 + ni * 16 + lg * 4;
          const float4 g2 = *(const float4*)(modl + (size_t)b * 6144 + 5120 + col);
#pragma unroll
          for (int mi = 0; mi < MT; ++mi) {
            const size_t row = (size_t)row0 + mi * 16 + lr;
            float4 xv = *(const float4*)(X1 + row * 1024 + col);
            {
              const float2 st = *(const float2*)((const float*)(ws + OFF_ST1) + row * 2);
              const float4 gg = *(const float4*)(p.ln1_g + l * 1024 + col), bb = *(const float4*)(p.ln1_b + l * 1024 + col);
              xv.x = (xv.x - st.x) * st.y * gg.x + bb.x;
              xv.y = (xv.y - st.x) * st.y * gg.y + bb.y;
              xv.z = (xv.z - st.x) * st.y * gg.z + bb.z;
              xv.w = (xv.w - st.x) * st.y * gg.w + bb.w;
            }
            float4 o4;
            o4.x = ALPHA * xv.x + (1.f + g2.x) * acc[mi][ni][0];
            o4.y = ALPHA * xv.y + (1.f + g2.y) * acc[mi][ni][1];
            o4.z = ALPHA * xv.z + (1.f + g2.z) * acc[mi][ni][2];
            o4.w = ALPHA * xv.w + (1.f + g2.w) * acc[mi][ni][3];
            *(float4*)(outp + row * 1024 + col) = o4;
          }
        }
      };
      gemm_phase<8>(HH, 2816, (const u16*)(ws + OFF_WT2 + l * SZ_WT2), 2816, 256, 8, 2816, bid, nb, smem, selT, epi, true);
    }
    gsync(grid);
    if (l == 0) {
      ln_rows(p.out, p.ln2_g, p.ln2_b, mod + (size_t)8 * 6144, 0, 1024, H, (float*)(ws + OFF_ST2), false, false);
      gsync(grid);
    } else {
      ln_rows(p.out, p.ln2_g + 1024, p.ln2_b + 1024, nullptr, 0, 0, nullptr, nullptr, true, false);
    }
  }
}

extern "C" void kernel_launch(void* const* d_in, const int* in_sizes, int n_in, void* d_out, int out_size, void* d_ws,
                              size_t ws_size, hipStream_t stream) {
  static int grid_blocks = 0;
  if (!grid_blocks) {
    int dev = 0, cus = 0, per_cu = 0;
    (void)hipGetDevice(&dev);
    (void)hipDeviceGetAttribute(&cus, hipDeviceAttributeMultiprocessorCount, dev);
    (void)hipFuncSetAttribute((const void*)mega, hipFuncAttributeMaxDynamicSharedMemorySize, LDS_BYTES);
    (void)hipOccupancyMaxActiveBlocksPerMultiprocessor(&per_cu, mega, 256, LDS_BYTES);
    if (per_cu > 2) per_cu = 2;
    if (per_cu < 1) per_cu = 1;
    grid_blocks = cus * per_cu;
  }
  Params p{};
  const float* const* in = (const float* const*)d_in;
  p.x = in[0]; p.c = in[1]; p.w_ada = in[2]; p.b_ada = in[3]; p.w_in = in[4]; p.cmp_pos = in[5]; p.cmp_w1 = in[6];
  p.cmp_w2 = in[7]; p.vn_g = in[8]; p.vn_b = in[9]; p.w_s = in[10]; p.b_s = in[11]; p.out_g = in[12]; p.w_o = in[13];
  p.ln1_g = in[14]; p.ln1_b = in[15]; p.w1 = in[16]; p.w3 = in[17]; p.w2 = in[18]; p.ln2_g = in[19]; p.ln2_b = in[20];
  p.out = (float*)d_out;
  p.ws = (char*)d_ws;
  (void)hipMemsetAsync((char*)d_ws + OFF_BAR, 0, XCD_BAR_WORDS * sizeof(unsigned), stream);
  void* args[] = {&p};
  hipError_t e = hipLaunchCooperativeKernel((void*)mega, dim3(grid_blocks), dim3(256), args, LDS_BYTES, stream);
  if (e != hipSuccess) fprintf(stderr, "cooperative launch failed: %s (grid %d)\n", hipGetErrorString(e), grid_blocks);
}
```

```cpp
#define STOP_AFTER 0
#include <hip/hip_runtime.h>
#include <hip/hip_cooperative_groups.h>
#include <cstdio>
namespace cg = cooperative_groups;

typedef unsigned short u16;
using bf16x8 = __attribute__((ext_vector_type(8))) short;
using f32x4 = __attribute__((ext_vector_type(4))) float;
using u32x4 = __attribute__((ext_vector_type(4))) unsigned;
#define DI __device__ __forceinline__
#define MFMA16(a, b, c) __builtin_amdgcn_mfma_f32_16x16x32_bf16((a), (b), (c), 0, 0, 0)

constexpr int S = 8192, TOK = 65536;
constexpr int INW = 2328, INP = 2432;
constexpr float ALPHA = 1.41421356237f;
constexpr float LOG2E = 1.4426950408889634f;
constexpr float QSCALE = 0.125f * LOG2E;
constexpr float NEGB = -1e30f, MINIT = -30000.f;
constexpr float EPS = 1e-5f;
constexpr int GMLP_EARLY = 2048;

constexpr size_t SZ_WTIN = (size_t)INP * 1024 * 2;
constexpr size_t SZ_WTO = (size_t)1024 * 1024 * 2;
constexpr size_t SZ_WT13 = (size_t)5632 * 1024 * 2;
constexpr size_t SZ_WT2 = (size_t)1024 * 2816 * 2;
constexpr size_t SZ_WTC1 = (size_t)256 * 2048 * 2;
constexpr size_t SZ_WTC2 = (size_t)128 * 256 * 2;
constexpr size_t OFF_WTIN = 0;
constexpr size_t OFF_WTO = OFF_WTIN + 2 * SZ_WTIN;
constexpr size_t OFF_WT13 = OFF_WTO + 2 * SZ_WTO;
constexpr size_t OFF_WT2 = OFF_WT13 + 2 * SZ_WT13;
constexpr size_t OFF_WTC1 = OFF_WT2 + 2 * SZ_WT2;
constexpr size_t OFF_WTC2 = OFF_WTC1 + 4 * SZ_WTC1;
constexpr size_t OFF_MODP = OFF_WTC2 + 4 * SZ_WTC2;
constexpr size_t SZ_MOD = (size_t)2 * 8 * 6144 * 4;
constexpr size_t OFF_MOD = OFF_MODP + 16 * SZ_MOD;
constexpr size_t SZ_CMP = (size_t)8 * 2 * 512 * 64 * 2;
constexpr size_t OFF_CB1P = OFF_MOD + SZ_MOD;
constexpr size_t OFF_CB1 = OFF_CB1P + 16 * 4 * 256 * 4;
constexpr size_t OFF_KCMP = OFF_CB1 + 4 * 256 * 4;
constexpr size_t OFF_VCMPT = OFF_KCMP + SZ_CMP;
constexpr size_t OFF_X1 = OFF_VCMPT + SZ_CMP;
constexpr size_t OFF_H = OFF_X1 + (size_t)TOK * 1024 * 4;
constexpr size_t OFF_A = OFF_H + (size_t)TOK * 1024 * 2;
constexpr size_t SZ_KV = (size_t)TOK * 128 * 2;
constexpr size_t A_Q = 0;
constexpr size_t A_KC = A_Q + (size_t)TOK * 512 * 2;
constexpr size_t A_VC = A_KC + SZ_KV;
constexpr size_t A_KS = A_VC + SZ_KV;
constexpr size_t A_VST = A_KS + SZ_KV;
constexpr size_t A_KW = A_VST + SZ_KV;
constexpr size_t A_VWT = A_KW + SZ_KV;
constexpr size_t A_G = A_VWT + SZ_KV;
constexpr size_t A_U = A_G + (size_t)TOK * 24 * 4;
constexpr size_t A_VGT = A_U + (size_t)TOK * 512 * 2;
constexpr size_t A_AC = A_VGT + (size_t)TOK * 512 * 2;
constexpr size_t A_HC = A_AC + (size_t)2 * 8192 * 2048 * 2;
constexpr size_t A_END = A_HC + (size_t)2 * 8192 * 256 * 2;
constexpr size_t OFF_ST1 = OFF_A + A_END;
constexpr size_t OFF_ST2 = OFF_ST1 + (size_t)TOK * 8;
constexpr size_t OFF_BAR = OFF_ST2 + (size_t)TOK * 8;

struct Params {
  const float *x, *c, *w_ada, *b_ada, *w_in, *cmp_pos, *cmp_w1, *cmp_w2, *vn_g, *vn_b, *w_s, *b_s, *out_g, *w_o,
      *ln1_g, *ln1_b, *w1, *w3, *w2, *ln2_g, *ln2_b;
  float* out;
  char* ws;
};

DI u16 f2bf(float x) { unsigned u = __float_as_uint(x); u += 0x7fffu + ((u >> 16) & 1u); return (u16)(u >> 16); }
DI float bf2f(u16 h) { return __uint_as_float(((unsigned)h) << 16); }
typedef __bf16 bf16x2_t __attribute__((ext_vector_type(2)));
typedef float f32x2_t __attribute__((ext_vector_type(2)));
DI unsigned pack2(float a, float b) {
  f32x2_t v = {a, b};
  bf16x2_t r = __builtin_convertvector(v, bf16x2_t);
  return __builtin_bit_cast(unsigned, r);
}
DI float gelu_t(float x) { float u = 1.5957691216f * (x + 0.044715f * x * x * x); return x / (1.f + __expf(-u)); }
DI float sigm(float x) { return 1.f / (1.f + __expf(-x)); }
DI float ex2(float x) { return __builtin_amdgcn_exp2f(x); }
typedef unsigned u32x2v __attribute__((ext_vector_type(2)));
DI float rows_max(float x) {
  u32x2v a = __builtin_amdgcn_permlane16_swap(__float_as_uint(x), __float_as_uint(x), false, false);
  const float m1 = fmaxf(__uint_as_float(a[0]), __uint_as_float(a[1]));
  u32x2v b = __builtin_amdgcn_permlane32_swap(__float_as_uint(m1), __float_as_uint(m1), false, false);
  return fmaxf(__uint_as_float(b[0]), __uint_as_float(b[1]));
}
DI float rows_sum(float x) {
  u32x2v a = __builtin_amdgcn_permlane16_swap(__float_as_uint(x), __float_as_uint(x), false, false);
  const float s1 = __uint_as_float(a[0]) + __uint_as_float(a[1]);
  u32x2v b = __builtin_amdgcn_permlane32_swap(__float_as_uint(s1), __float_as_uint(s1), false, false);
  return __uint_as_float(b[0]) + __uint_as_float(b[1]);
}
DI int otid() { int t = threadIdx.x; asm volatile("" : "+v"(t)); return t; }

template <int MODE> DI int map_row(int n) {
  if (MODE == 1) return n < 1280 ? n : (n < 1304 ? n + 1024 : n - 24);
  if (MODE == 2) return (n >> 5) * 64 + (n & 31);
  if (MODE == 3) return (n >> 5) * 64 + 32 + (n & 31);
  return n;
}

template <int MODE>
DI void conv_tile(const float* __restrict__ W, int K, int N, u16* __restrict__ Wt, int ldk, int tile, float* tl) {
  const int tiles_n = (N + 63) / 64;
  const int tk = tile / tiles_n, tn = tile % tiles_n;
  const int k0 = tk * 64, n0 = tn * 64;
  const int tid = otid();
#pragma unroll
  for (int i = 0; i < 16; ++i) {
    int idx = tid + 256 * i;
    int r = idx >> 6, c = idx & 63;
    int n = n0 + c;
    tl[r * 65 + c] = (n < N) ? W[(long)(k0 + r) * N + n] : 0.f;
  }
  __syncthreads();
  const int nl = tid >> 2, kc = tid & 3;
  const int n = n0 + nl;
  if (n < N) {
    const int row = map_row<MODE>(n);
    unsigned pk[8];
#pragma unroll
    for (int i = 0; i < 8; ++i) pk[i] = pack2(tl[(kc * 16 + 2 * i) * 65 + nl], tl[(kc * 16 + 2 * i + 1) * 65 + nl]);
    uint4* dst = (uint4*)(Wt + (long)row * ldk + k0 + kc * 16);
    dst[0] = make_uint4(pk[0], pk[1], pk[2], pk[3]);
    dst[1] = make_uint4(pk[4], pk[5], pk[6], pk[7]);
  }
  __syncthreads();
}

DI void phase0a(const Params& p, char* smem) {
  char* ws = p.ws;
  const int tid = threadIdx.x;
  constexpr int PER_LAYER = 592 + 256 + 704 * 3 + 128 * 2 + 4 * 2;
  constexpr int NCONV = 2 * PER_LAYER;
  constexpr int NTOT = NCONV + 768 + 2 + 64;
  for (int it = blockIdx.x; it < NTOT; it += gridDim.x) {
    if (it < NCONV) {
      const int l = it / PER_LAYER;
      const int li = it % PER_LAYER;
      int base = 0;
#define SEG(MODE, SRC, DST, K_, N_, LDK)                                                   \
  {                                                                                        \
    const int nt_ = ((K_) / 64) * (((N_) + 63) / 64);                                      \
    if (li >= base && li < base + nt_) conv_tile<MODE>(SRC, K_, N_, DST, LDK, li - base, (float*)smem); \
    base += nt_;                                                                           \
  }
      SEG(1, p.w_in + (size_t)l * 1024 * INW, (u16*)(ws + OFF_WTIN + l * SZ_WTIN), 1024, INW, 1024)
      SEG(0, p.w_o + (size_t)l * 1024 * 1024, (u16*)(ws + OFF_WTO + l * SZ_WTO), 1024, 1024, 1024)
      SEG(2, p.w1 + (size_t)l * 1024 * 2816, (u16*)(ws + OFF_WT13 + l * SZ_WT13), 1024, 2816, 1024)
      SEG(3, p.w3 + (size_t)l * 1024 * 2816, (u16*)(ws + OFF_WT13 + l * SZ_WT13), 1024, 2816, 1024)
      SEG(0, p.w2 + (size_t)l * 2816 * 1024, (u16*)(ws + OFF_WT2 + l * SZ_WT2), 2816, 1024, 2816)
      SEG(0, p.cmp_w1 + (size_t)(l * 2 + 0) * 2048 * 256, (u16*)(ws + OFF_WTC1 + (l * 2 + 0) * SZ_WTC1), 2048, 256, 2048)
      SEG(0, p.cmp_w1 + (size_t)(l * 2 + 1) * 2048 * 256, (u16*)(ws + OFF_WTC1 + (l * 2 + 1) * SZ_WTC1), 2048, 256, 2048)
      SEG(0, p.cmp_w2 + (size_t)(l * 2 + 0) * 256 * 64, (u16*)(ws + OFF_WTC2 + (l * 2 + 0) * SZ_WTC2), 256, 64, 256)
      SEG(0, p.cmp_w2 + (size_t)(l * 2 + 1) * 256 * 64, (u16*)(ws + OFF_WTC2 + (l * 2 + 1) * SZ_WTC2), 256, 64, 256)
#undef SEG
    } else if (it < NCONV + 768) {
      const int idx = it - NCONV;
      const int l = idx / 384, r = idx % 384, nb = r / 16, kc = r % 16;
      float* cs = (float*)smem;
      for (int i = tid; i < 512; i += 256) {
        int b = i >> 6, k = i & 63;
        float cv = p.c[b * 1024 + kc * 64 + k];
        cs[i] = cv * sigm(cv);
      }
      __syncthreads();
      const int n = nb * 256 + tid;
      float acc[8];
#pragma unroll
      for (int b = 0; b < 8; ++b) acc[b] = 0.f;
      const float* wp = p.w_ada + ((size_t)l * 1024 + kc * 64) * 6144 + n;
#pragma unroll 8
      for (int k = 0; k < 64; ++k) {
        float wv = wp[(size_t)k * 6144];
#pragma unroll
        for (int b = 0; b < 8; ++b) acc[b] += cs[b * 64 + k] * wv;
      }
      float* modp = (float*)(ws + OFF_MODP);
#pragma unroll
      for (int b = 0; b < 8; ++b) modp[(size_t)((kc * 2 + l) * 8 + b) * 6144 + n] = acc[b];
      __syncthreads();
    } else if (it < NCONV + 768 + 2) {
      const int l = it - NCONV - 768;
      uint4* dst = (uint4*)(ws + OFF_WTIN + l * SZ_WTIN + (size_t)INW * 1024 * 2);
      const int n16 = (INP - INW) * 1024 * 2 / 16;
      for (int i = tid; i < n16; i += 256) dst[i] = make_uint4(0, 0, 0, 0);
    } else {
      const int idx = it - NCONV - 768 - 2;
      const int lw = idx >> 4, kc = idx & 15;
      const float* pos = p.cmp_pos + (size_t)lw * 2048 + kc * 128;
      const float* w1p = p.cmp_w1 + ((size_t)lw * 2048 + kc * 128) * 256 + tid;
      float a = 0.f;
#pragma unroll 8
      for (int k = 0; k < 128; ++k) a += pos[k] * w1p[(size_t)k * 256];
      ((float*)(ws + OFF_CB1P))[(kc * 4 + lw) * 256 + tid] = a;
    }
  }
}

DI void phase0b(const Params& p) {
  const float* modp = (const float*)(p.ws + OFF_MODP);
  float* mod = (float*)(p.ws + OFF_MOD);
  const int n = 2 * 8 * 6144;
  for (int i = blockIdx.x * 256 + threadIdx.x; i < n; i += gridDim.x * 256) {
    int l = i / (8 * 6144), c = i % 6144;
    float a = p.b_ada[l * 6144 + c];
#pragma unroll
    for (int kc = 0; kc < 16; ++kc) a += modp[(size_t)kc * n + i];
    mod[i] = a;
  }
  const float* cbp = (const float*)(p.ws + OFF_CB1P);
  float* cb = (float*)(p.ws + OFF_CB1);
  for (int i = blockIdx.x * 256 + threadIdx.x; i < 1024; i += gridDim.x * 256) {
    float a = 0.f;
#pragma unroll
    for (int kc = 0; kc < 16; ++kc) a += cbp[kc * 1024 + i];
    cb[i] = a;
  }
}

DI void phase_mod_x(const Params& p) {
  const float* mod = (const float*)(p.ws + OFF_MOD);
  u16* H = (u16*)(p.ws + OFF_H);
  const long nchunk = (long)TOK * 1024 / 8;
  const long stride = (long)gridDim.x * 256;
  for (long i = (long)blockIdx.x * 256 + otid(); i < nchunk / 2; i += stride) {
    float4 xa[2][2], sa[2][2], ha[2][2];
    long ee[2];
#pragma unroll
    for (int u = 0; u < 2; ++u) {
      const long e = (i + u * (nchunk / 2)) * 8;
      ee[u] = e;
      const int col = (int)(e & 1023);
      const int b = (int)(e >> 23);
      const float4* xp = (const float4*)(p.x + e);
      const float4* sh = (const float4*)(mod + (size_t)b * 6144 + 0 + col);
      const float4* sc = (const float4*)(mod + (size_t)b * 6144 + 1024 + col);
      const f32x4* xq = (const f32x4*)xp;
      const f32x4 q0 = __builtin_nontemporal_load(xq), q1 = __builtin_nontemporal_load(xq + 1);
      xa[u][0] = make_float4(q0[0], q0[1], q0[2], q0[3]); xa[u][1] = make_float4(q1[0], q1[1], q1[2], q1[3]);
      sa[u][0] = sc[0]; sa[u][1] = sc[1];
      ha[u][0] = sh[0]; ha[u][1] = sh[1];
    }
#pragma unroll
    for (int u = 0; u < 2; ++u) {
      const float4 x0 = xa[u][0], x1 = xa[u][1], s0 = sa[u][0], s1 = sa[u][1], h0 = ha[u][0], h1 = ha[u][1];
      uint4 o;
      o.x = pack2(x0.x * (1.f + s0.x) + h0.x, x0.y * (1.f + s0.y) + h0.y);
      o.y = pack2(x0.z * (1.f + s0.z) + h0.z, x0.w * (1.f + s0.w) + h0.w);
      o.z = pack2(x1.x * (1.f + s1.x) + h1.x, x1.y * (1.f + s1.y) + h1.y);
      o.w = pack2(x1.z * (1.f + s1.z) + h1.z, x1.w * (1.f + s1.w) + h1.w);
      *(uint4*)(H + ee[u]) = o;
    }
  }
}

constexpr int LDS_BYTES = 73728 + 16;
DI int swz_key(int r) { return (0x78 >> (2 * ((r >> 2) & 3))) & 3; }
template <int MT>
DI void g_issue(const u16* __restrict__ Ap, int lda, const u16* __restrict__ Bp, int ldb, int st, int ksa, int tid, char* buf) {
  constexpr int AOFF = 2048 * MT;
  const int koffA = (st >> 1) * ksa + (st & 1) * 32;
  const int koffB = st * 32;
  const int wbase = (tid & ~63) * 16;
#pragma unroll
  for (int i = 0; i < MT / 2; ++i) {
    const int c = tid + 256 * i;
    const int row = c >> 2, ph = c & 3;
    const int lc = ph ^ swz_key(row);
    __builtin_amdgcn_global_load_lds((const unsigned*)(Ap + (size_t)row * lda + koffA + lc * 8),
                                     (unsigned*)(buf + i * 4096 + wbase), 16, 0, 0);
  }
#pragma unroll
  for (int i = 0; i < 2; ++i) {
    const int c = tid + 256 * i;
    const int row = c >> 2, ph = c & 3;
    const int lc = ph ^ swz_key(row);
    __builtin_amdgcn_global_load_lds((const unsigned*)(Bp + (size_t)row * ldb + koffB + lc * 8),
                                     (unsigned*)(buf + AOFF + i * 4096 + wbase), 16, 0, 0);
  }
}
#define DSR(dst, addr, off) "ds_read_b128 %" #dst ", %" #addr " offset:" #off "\n\t"
template <bool SWAP, int MT>
DI void g_compute(const char* sA, f32x4 (&acc)[MT][4], int wm, int wn, int lr, int lg) {
  const int ra = wm * (16 * MT) + lr, rb = wn * 64 + lr;
  const unsigned aA = (unsigned)(size_t)sA + ra * 64 + ((lg ^ swz_key(ra)) << 4);
  const unsigned aB = (unsigned)(size_t)sA + 2048 * MT + rb * 64 + ((lg ^ swz_key(rb)) << 4);
  bf16x8 af[MT], bfr[4];
  if constexpr (MT == 8) {
    asm volatile(DSR(0, 8, 0) DSR(1, 8, 1024) DSR(2, 8, 2048) DSR(3, 8, 3072) DSR(4, 9, 0) DSR(5, 9, 1024) DSR(6, 9, 2048) DSR(7, 9, 3072)
                 : "=&v"(bfr[0]), "=&v"(bfr[1]), "=&v"(bfr[2]), "=&v"(bfr[3]), "=&v"(af[0]), "=&v"(af[1]), "=&v"(af[2]), "=&v"(af[3])
                 : "v"(aB), "v"(aA)
                 : "memory");
    asm volatile(DSR(0, 4, 4096) DSR(1, 4, 5120) DSR(2, 4, 6144) DSR(3, 4, 7168)
                 : "=&v"(af[4]), "=&v"(af[5]), "=&v"(af[6]), "=&v"(af[7])
                 : "v"(aA)
                 : "memory");
    asm volatile("s_waitcnt lgkmcnt(4)"
                 : "+v"(bfr[0]), "+v"(bfr[1]), "+v"(bfr[2]), "+v"(bfr[3]), "+v"(af[0]), "+v"(af[1]), "+v"(af[2]), "+v"(af[3]));
  } else {
    asm volatile(DSR(0, 6, 0) DSR(1, 6, 1024) DSR(2, 6, 2048) DSR(3, 6, 3072) DSR(4, 7, 0) DSR(5, 7, 1024)
                 : "=&v"(bfr[0]), "=&v"(bfr[1]), "=&v"(bfr[2]), "=&v"(bfr[3]), "=&v"(af[0]), "=&v"(af[1])
                 : "v"(aB), "v"(aA)
                 : "memory");
    asm volatile(DSR(0, 2, 2048) DSR(1, 2, 3072) : "=&v"(af[2]), "=&v"(af[3]) : "v"(aA) : "memory");
    asm volatile("s_waitcnt lgkmcnt(2)"
                 : "+v"(bfr[0]), "+v"(bfr[1]), "+v"(bfr[2]), "+v"(bfr[3]), "+v"(af[0]), "+v"(af[1]));
  }
  __builtin_amdgcn_sched_barrier(0);
#pragma unroll
  for (int mi = 0; mi < MT / 2; ++mi)
#pragma unroll
    for (int ni = 0; ni < 4; ++ni)
      acc[mi][ni] = SWAP ? MFMA16(bfr[ni], af[mi], acc[mi][ni]) : MFMA16(af[mi], bfr[ni], acc[mi][ni]);
  __builtin_amdgcn_sched_barrier(0);
  if constexpr (MT == 8) asm volatile("s_waitcnt lgkmcnt(0)" : "+v"(af[4]), "+v"(af[5]), "+v"(af[6]), "+v"(af[7]), "+v"(acc[3][3]));
  else asm volatile("s_waitcnt lgkmcnt(0)" : "+v"(af[2]), "+v"(af[3]), "+v"(acc[1][3]));
  __builtin_amdgcn_sched_barrier(0);
#pragma unroll
  for (int mi = MT / 2; mi < MT; ++mi)
#pragma unroll
    for (int ni = 0; ni < 4; ++ni)
      acc[mi][ni] = SWAP ? MFMA16(bfr[ni], af[mi], acc[mi][ni]) : MFMA16(af[mi], bfr[ni], acc[mi][ni]);
  __builtin_amdgcn_sched_barrier(0);
}
#define RAW_BARRIER() do { asm volatile("s_waitcnt lgkmcnt(0)" ::: "memory"); __builtin_amdgcn_s_barrier(); } while (0)

template <bool SWAP, int MT, class Epi>
DI void gemm_tile(const u16* __restrict__ Ap, int lda, const u16* __restrict__ Bp, int ldb, int nk, int tm, int tn, int tid,
                  char* smem, Epi epi, int ksa = 64) {
  constexpr int NBUF = (MT == 8) ? 3 : 4;
  constexpr int BUFSZ = 2048 * MT + 8192;
  constexpr int LA = NBUF - 1;
  const int lane = tid & 63, w = tid >> 6, wm = w >> 1, wn = w & 1;
  const int lr = lane & 15, lg = lane >> 4;
  const int nks = nk * 2;
  f32x4 acc[MT][4];
#pragma unroll
  for (int i = 0; i < MT; ++i)
#pragma unroll
    for (int j = 0; j < 4; ++j) acc[i][j] = f32x4{0.f, 0.f, 0.f, 0.f};
#pragma unroll
  for (int s = 0; s < LA; ++s) g_issue<MT>(Ap, lda, Bp, ldb, s, ksa, tid, smem + s * BUFSZ);
  int bi = 0, bn = LA;
  for (int st = 0; st < nks; ++st) {
    if (MT == 8) {
      if (st + 1 < nks) asm volatile("s_waitcnt vmcnt(6)" ::: "memory");
      else asm volatile("s_waitcnt vmcnt(0)" ::: "memory");
    } else {
      if (st + 2 < nks) asm volatile("s_waitcnt vmcnt(8)" ::: "memory");
      else if (st + 1 < nks) asm volatile("s_waitcnt vmcnt(4)" ::: "memory");
      else asm volatile("s_waitcnt vmcnt(0)" ::: "memory");
    }
    RAW_BARRIER();
    if (st + LA < nks) g_issue<MT>(Ap, lda, Bp, ldb, st + LA, ksa, tid, smem + bn * BUFSZ);
    g_compute<SWAP, MT>(smem + bi * BUFSZ, acc, wm, wn, lr, lg);
    bi = (bi + 1 == NBUF) ? 0 : bi + 1;
    bn = (bn + 1 == NBUF) ? 0 : bn + 1;
  }
  RAW_BARRIER();
  epi(SWAP, tm, tn, wm, wn, lr, lg, acc);
}

template <int MT, class AB, class Sel, class Epi>
DI void gemm_phase_g(AB abase, int lda, int ksa, const u16* __restrict__ Bt, int ldb, int ntm, int ntn, int K, int vb, int nvb,
                     char* smem, Sel swapsel, Epi epi, bool rev = false) {
  if (vb < 0 || vb >= nvb) return;
  const int ntiles = ntm * ntn;
  const int nk = K / 64;
  const int nbx = nvb >> 3;
  const int x = vb & 7, lb = vb >> 3;
  const int rgt = 4 * ntn;
  const int per_xcd = (ntm >> 5) * rgt;
  for (int ql = lb; ql < per_xcd; ql += nbx) {
    const int rg0 = ql / rgt;
    const int i = ql - rg0 * rgt;
    const int rgi = rev ? ((ntm >> 5) - 1 - rg0) : rg0;
    const int tn = i >> 2;
    const int tm = (x + 8 * rgi) * 4 + (i & 3);
    const u16* Ap = abase(tm);
    const u16* Bp = Bt + (size_t)tn * 128 * ldb;
    const int tid = otid();
    if (swapsel(tn)) gemm_tile<true, MT>(Ap, lda, Bp, ldb, nk, tm, tn, tid, smem, epi, ksa);
    else gemm_tile<false, MT>(Ap, lda, Bp, ldb, nk, tm, tn, tid, smem, epi, ksa);
  }
}
template <int MT, class Sel, class Epi>
DI void gemm_phase(const u16* __restrict__ A, int lda, const u16* __restrict__ Bt, int ldb, int ntm, int ntn, int K,
                   int vb, int nvb, char* smem, Sel swapsel, Epi epi, bool rev = false) {
  auto ab = [=](int tm) { return A + (size_t)tm * (32 * MT) * lda; };
  gemm_phase_g<MT>(ab, lda, 64, Bt, ldb, ntm, ntn, K, vb, nvb, smem, swapsel, epi, rev);
}
template <class Epi, class Post>
DI void gemm_rowblock_phase(const u16* __restrict__ A, int lda, const u16* __restrict__ Bt, int ldb, int ntm, int ntn, int K,
                            int vb, int nvb, char* smem, Epi epi, Post post) {
  const int nk = K / 64;
  for (int tm = vb; tm < ntm; tm += nvb) {
    const u16* Ap = A + (size_t)tm * 128 * lda;
    for (int tn = 0; tn < ntn; ++tn) {
      const int tid = otid();
      gemm_tile<true, 4>(Ap, lda, Bt + (size_t)tn * 128 * ldb, ldb, nk, tm, tn, tid, smem, epi, 64);
    }
    asm volatile("s_waitcnt vmcnt(0)" ::: "memory");
    __syncthreads();
    post(tm);
  }
}

DI void ln_rows(float* buf, const float* __restrict__ g, const float* __restrict__ bt, const float* __restrict__ modl,
                int sh_off, int sc_off, u16* H, float* stats, bool write_x, bool topdown) {
  const int tid_ = otid();
  const int lane = tid_ & 63, w = tid_ >> 6;
  constexpr int NR = 4;
  for (int rq = (blockIdx.x * 4 + w) * NR; rq < TOK; rq += gridDim.x * 4 * NR) {
    const int r0 = topdown ? (TOK - NR - rq) : rq;
    f32x4 v[NR][4];
#pragma unroll
    for (int rr = 0; rr < NR; ++rr) {
      const f32x4* rp = (const f32x4*)(buf + (size_t)(r0 + rr) * 1024);
#pragma unroll
      for (int i = 0; i < 4; ++i) v[rr][i] = __builtin_nontemporal_load(rp + lane + 64 * i);
    }
    float s[NR], q[NR];
#pragma unroll
    for (int rr = 0; rr < NR; ++rr) {
      s[rr] = 0.f;
#pragma unroll
      for (int i = 0; i < 4; ++i) s[rr] += v[rr][i][0] + v[rr][i][1] + v[rr][i][2] + v[rr][i][3];
    }
#pragma unroll
    for (int o = 32; o >= 1; o >>= 1) {
#pragma unroll
      for (int rr = 0; rr < NR; ++rr) s[rr] += __shfl_xor(s[rr], o);
    }
#pragma unroll
    for (int rr = 0; rr < NR; ++rr) {
      const float mu = s[rr] * (1.f / 1024.f);
      q[rr] = 0.f;
#pragma unroll
      for (int i = 0; i < 4; ++i)
#pragma unroll
        for (int k = 0; k < 4; ++k) { const float a = v[rr][i][k] - mu; q[rr] += a * a; }
    }
#pragma unroll
    for (int o = 32; o >= 1; o >>= 1) {
#pragma unroll
      for (int rr = 0; rr < NR; ++rr) q[rr] += __shfl_xor(q[rr], o);
    }
    const int b = r0 >> 13;
#pragma unroll
    for (int rr = 0; rr < NR; ++rr) {
      const int row = r0 + rr;
      const float mu = s[rr] * (1.f / 1024.f);
      const float rs = rsqrtf(q[rr] * (1.f / 1024.f) + EPS);
      if (stats && lane == 0) *(float2*)(stats + (size_t)row * 2) = make_float2(mu, rs);
      f32x4* rp = (f32x4*)(buf + (size_t)row * 1024);
#pragma unroll
      for (int i = 0; i < 4; ++i) {
        const int col = (lane + 64 * i) * 4;
        const float4 gg = *(const float4*)(g + col), bb = *(const float4*)(bt + col);
        f32x4 y;
        y[0] = (v[rr][i][0] - mu) * rs * gg.x + bb.x;
        y[1] = (v[rr][i][1] - mu) * rs * gg.y + bb.y;
        y[2] = (v[rr][i][2] - mu) * rs * gg.z + bb.z;
        y[3] = (v[rr][i][3] - mu) * rs * gg.w + bb.w;
        if (write_x) rp[lane + 64 * i] = y;
        if (H) {
          const float4 sh = *(const float4*)(modl + (size_t)b * 6144 + sh_off + col);
          const float4 sc = *(const float4*)(modl + (size_t)b * 6144 + sc_off + col);
          uint2 o2;
          o2.x = pack2(y[0] * (1.f + sc.x) + sh.x, y[1] * (1.f + sc.y) + sh.y);
          o2.y = pack2(y[2] * (1.f + sc.z) + sh.z, y[3] * (1.f + sc.w) + sh.w);
          *(uint2*)(H + (size_t)row * 1024 + col) = o2;
        }
      }
    }
  }
}

DI void ln_block(float* buf, int row0, const float* __restrict__ g, const float* __restrict__ bt,
                 const float* __restrict__ modl, int sh_off, int sc_off, u16* H) {
  const int tid_ = otid();
  const int lane = tid_ & 63, w = tid_ >> 6;
  for (int rr = 0; rr < 32; ++rr) {
    const int row = row0 + w * 32 + rr;
    f32x4* rp = (f32x4*)(buf + (size_t)row * 1024);
    f32x4 v[4];
    float s = 0.f;
#pragma unroll
    for (int i = 0; i < 4; ++i) { v[i] = __builtin_nontemporal_load(rp + lane + 64 * i); s += v[i][0] + v[i][1] + v[i][2] + v[i][3]; }
#pragma unroll
    for (int o = 32; o >= 1; o >>= 1) s += __shfl_xor(s, o);
    const float mu = s * (1.f / 1024.f);
    float q = 0.f;
#pragma unroll
    for (int i = 0; i < 4; ++i)
#pragma unroll
      for (int k = 0; k < 4; ++k) { float a = v[i][k] - mu; q += a * a; }
#pragma unroll
    for (int o = 32; o >= 1; o >>= 1) q += __shfl_xor(q, o);
    const float rs = rsqrtf(q * (1.f / 1024.f) + EPS);
    const int b = row >> 13;
#pragma unroll
    for (int i = 0; i < 4; ++i) {
      const int col = (lane + 64 * i) * 4;
      const float4 gg = *(const float4*)(g + col), bb = *(const float4*)(bt + col);
      f32x4 y;
      y[0] = (v[i][0] - mu) * rs * gg.x + bb.x;
      y[1] = (v[i][1] - mu) * rs * gg.y + bb.y;
      y[2] = (v[i][2] - mu) * rs * gg.z + bb.z;
      y[3] = (v[i][3] - mu) * rs * gg.w + bb.w;
      rp[lane + 64 * i] = y;
      if (H) {
        const float4 sh = *(const float4*)(modl + (size_t)b * 6144 + sh_off + col);
        const float4 sc = *(const float4*)(modl + (size_t)b * 6144 + sc_off + col);
        uint2 o2;
        o2.x = pack2(y[0] * (1.f + sc.x) + sh.x, y[1] * (1.f + sc.y) + sh.y);
        o2.y = pack2(y[2] * (1.f + sc.z) + sh.z, y[3] * (1.f + sc.w) + sh.w);
        *(uint2*)(H + (size_t)row * 1024 + col) = o2;
      }
    }
  }
}

DI void gmlp_item(const Params& p, int l, int item) {
  const int b = item >> 9, c = (item >> 3) & 63, grp = item & 7;
  const int tid_ = otid();
  const int lane = tid_ & 63, w = tid_ >> 6, lr = lane & 15, lg = lane >> 4;
  const float* wsp = p.w_s + (size_t)(l * 8 + grp) * 128 * 128;
  const u16* vgt = (const u16*)(p.ws + OFF_A + A_VGT) + (size_t)(b * 8 + grp) * 64 * S + c * 128;
  const u16* U = (const u16*)(p.ws + OFF_A + A_U);
  u16* OM = (u16*)(p.ws + OFF_H);
  f32x4 acc[4][2];
#pragma unroll
  for (int i = 0; i < 4; ++i)
#pragma unroll
    for (int j = 0; j < 2; ++j) acc[i][j] = f32x4{0.f, 0.f, 0.f, 0.f};
#pragma unroll
  for (int ks = 0; ks < 4; ++ks) {
    const int s0 = ks * 32 + lg * 8;
    bf16x8 af[4];
#pragma unroll
    for (int dt = 0; dt < 4; ++dt) af[dt] = *(const bf16x8*)(vgt + (size_t)(dt * 16 + lr) * S + s0);
#pragma unroll
    for (int nt = 0; nt < 2; ++nt) {
      const int t = w * 32 + nt * 16 + lr;
      const float4* wp = (const float4*)(wsp + t * 128 + s0);
      float4 a0 = wp[0], a1 = wp[1];
      unsigned pw[4];
      pw[0] = pack2((s0 + 0 <= t) ? a0.x : 0.f, (s0 + 1 <= t) ? a0.y : 0.f);
      pw[1] = pack2((s0 + 2 <= t) ? a0.z : 0.f, (s0 + 3 <= t) ? a0.w : 0.f);
      pw[2] = pack2((s0 + 4 <= t) ? a1.x : 0.f, (s0 + 5 <= t) ? a1.y : 0.f);
      pw[3] = pack2((s0 + 6 <= t) ? a1.z : 0.f, (s0 + 7 <= t) ? a1.w : 0.f);
      bf16x8 bw = __builtin_bit_cast(bf16x8, make_uint4(pw[0], pw[1], pw[2], pw[3]));
#pragma unroll
      for (int dt = 0; dt < 4; ++dt) acc[dt][nt] = MFMA16(af[dt], bw, acc[dt][nt]);
    }
  }
#pragma unroll
  for (int nt = 0; nt < 2; ++nt) {
    const int t = w * 32 + nt * 16 + lr;
    const size_t tok = (size_t)b * S + c * 128 + t;
    const float bias = p.b_s[(l * 8 + grp) * 128 + t];
    float val[4][4];
    float ss = 0.f;
#pragma unroll
    for (int dt = 0; dt < 4; ++dt) {
      const int d = dt * 16 + lg * 4;
      const uint2 uu = *(const uint2*)(U + tok * 512 + grp * 64 + d);
      const float u0 = bf2f(uu.x & 0xffff), u1 = bf2f(uu.x >> 16), u2 = bf2f(uu.y & 0xffff), u3 = bf2f(uu.y >> 16);
      val[dt][0] = u0 * (acc[dt][nt][0] + bias);
      val[dt][1] = u1 * (acc[dt][nt][1] + bias);
      val[dt][2] = u2 * (acc[dt][nt][2] + bias);
      val[dt][3] = u3 * (acc[dt][nt][3] + bias);
#pragma unroll
      for (int j = 0; j < 4; ++j) ss += val[dt][j] * val[dt][j];
    }
    ss = rows_sum(ss);
    const float r = rsqrtf(ss * (1.f / 64.f) + EPS);
#pragma unroll
    for (int dt = 0; dt < 4; ++dt) {
      const int d = dt * 16 + lg * 4;
      const float4 gg = *(const float4*)(p.out_g + l * 1024 + 512 + grp * 64 + d);
      uint2 st;
      st.x = pack2(val[dt][0] * r * gg.x, val[dt][1] * r * gg.y);
      st.y = pack2(val[dt][2] * r * gg.z, val[dt][3] * r * gg.w);
      *(uint2*)(OM + tok * 1024 + 512 + grp * 64 + d) = st;
    }
  }
}

constexpr int SM_K = 0, SM_V = 8192, SM_IMP = 8192 + 8704, SM_SEL = SM_IMP + 64 * 132 * 4, SM_UNI = SM_SEL + 1024;

struct KVr { u32x4 k0, k1, v0, v1; };
DI void kv_load_k(KVr& t, const u16* __restrict__ src, int stride, int tid) {
  const int r = tid >> 3, ch = tid & 7;
  t.k0 = *(const u32x4*)(src + (size_t)r * stride + ch * 8);
  t.k1 = *(const u32x4*)(src + (size_t)(r + 32) * stride + ch * 8);
}
DI void kv_load_v(KVr& t, const u16* __restrict__ src, int stride, int tid) {
  const int d = tid >> 3, ch = tid & 7;
  t.v0 = *(const u32x4*)(src + (size_t)d * stride + ch * 8);
  t.v1 = *(const u32x4*)(src + (size_t)(d + 32) * stride + ch * 8);
}
DI void kv_store_k(const KVr& t, char* sK, int tid) {
  const int r = tid >> 3, ch = tid & 7;
  char* pk = sK + r * 128 + ((ch ^ (r & 7)) << 4);
  *(u32x4*)(pk) = t.k0;
  *(u32x4*)(pk + 4096) = t.k1;
}
DI void kv_store_v(const KVr& t, char* sV, int tid) {
  const int d = tid >> 3, ch = tid & 7;
  uint2* d0 = (uint2*)(sV + d * 136 + ch * 16);
  d0[0] = make_uint2(t.v0[0], t.v0[1]);
  d0[1] = make_uint2(t.v0[2], t.v0[3]);
  uint2* d1 = (uint2*)(sV + (d + 32) * 136 + ch * 16);
  d1[0] = make_uint2(t.v1[0], t.v1[1]);
  d1[1] = make_uint2(t.v1[2], t.v1[3]);
}
DI int prev_set_bit(const unsigned* uni, int from) {
  int res = -1;
#pragma unroll
  for (int wd = 0; wd < 4; ++wd) {
    unsigned mw = uni[wd];
    const int hi = from - wd * 32;
    if (hi < 0) mw = 0u;
    else if (hi < 31) mw &= (2u << hi) - 1u;
    if (mw) res = wd * 32 + 31 - __clz(mw);
  }
  return __builtin_amdgcn_readfirstlane(res);
}
DI int next_set_bit(const unsigned* uni, int from) {
  int res = 1000;
#pragma unroll
  for (int wd = 3; wd >= 0; --wd) {
    unsigned mw = uni[wd];
    const int lo = from - wd * 32;
    if (lo >= 32) mw = 0u;
    else if (lo > 0) mw &= (~0u) << lo;
    if (mw) res = wd * 32 + __ffs(mw) - 1;
  }
  return __builtin_amdgcn_readfirstlane(res);
}

template <int MODE, bool MASKED, int WS>
DI void half_step(const char* sK, const char* sV, int half, int lr, int lg, const bf16x8 (&qf)[2][2], const unsigned (&sw)[2],
                  const float (&tb)[2], float (&m)[2], float (&lsum)[2], f32x4 (&o)[2][4], const bool (&valid)[2][4],
                  float (&psum)[2][4]) {
  bf16x8 kf[2][2], kw[2];
#pragma unroll
  for (int kt2 = 0; kt2 < 2; ++kt2) {
    const int r = half * 32 + kt2 * 16 + lr;
    kf[kt2][0] = *(const bf16x8*)(sK + r * 128 + (((lg) ^ (r & 7)) << 4));
    kf[kt2][1] = *(const bf16x8*)(sK + r * 128 + (((4 + lg) ^ (r & 7)) << 4));
    const float wv = (float)(WS * r);
    const unsigned pw = (lg == 0) ? pack2(wv, wv) : 0u;
    kw[kt2] = __builtin_bit_cast(bf16x8, make_uint4(pw, 0u, 0u, 0u));
  }
  if (MODE == 1) {
#pragma unroll
    for (int a = 0; a < 2; ++a)
#pragma unroll
      for (int j = 0; j < 4; ++j) psum[a][j] = 0.f;
  }
  bf16x8 pf[2];
  f32x4 sall[2][2];
#pragma unroll
  for (int h = 0; h < 2; ++h)
#pragma unroll
    for (int kt2 = 0; kt2 < 2; ++kt2) {
      f32x4 z = f32x4{0.f, 0.f, 0.f, 0.f};
      z = MFMA16(kw[kt2], __builtin_bit_cast(bf16x8, make_uint4(sw[h], 0u, 0u, 0u)), z);
      z = MFMA16(kf[kt2][0], qf[h][0], z);
      z = MFMA16(kf[kt2][1], qf[h][1], z);
      sall[h][kt2] = z;
    }
#pragma unroll
  for (int h = 0; h < 2; ++h) {
    f32x4 s[2] = {sall[h][0], sall[h][1]};
    float mx = NEGB;
#pragma unroll
    for (int kt2 = 0; kt2 < 2; ++kt2)
#pragma unroll
      for (int j = 0; j < 4; ++j) {
        float v = s[kt2][j];
        if (MASKED) v = valid[kt2][j] ? v : NEGB;
        s[kt2][j] = v;
        mx = fmaxf(mx, v);
      }
    if (MODE != 1) {
      mx = rows_max(mx);
      const float mn = fmaxf(m[h], mx + tb[h]);
      const float mm = mn - tb[h];
      float ps = 0.f;
#pragma unroll
      for (int kt2 = 0; kt2 < 2; ++kt2)
#pragma unroll
        for (int j = 0; j < 4; ++j) {
          float pv = ex2(s[kt2][j] - mm);
          s[kt2][j] = pv;
          ps += pv;
        }
      if (__ballot(mn != m[h]) != 0ull) {
        const float alpha = ex2(m[h] - mn);
        m[h] = mn;
        lsum[h] = lsum[h] * alpha + ps;
        if (MODE == 2) {
#pragma unroll
          for (int dt = 0; dt < 4; ++dt) o[h][dt] *= alpha;
        }
      } else {
        lsum[h] += ps;
      }
    } else {
#pragma unroll
      for (int kt2 = 0; kt2 < 2; ++kt2)
#pragma unroll
        for (int j = 0; j < 4; ++j) {
          float pv = ex2(s[kt2][j] - (m[h] - tb[h])) * lsum[h];
          s[kt2][j] = pv;
          psum[kt2][j] += pv;
        }
    }
    if (MODE != 0) {
      uint4 pk = make_uint4(pack2(s[0][0], s[0][1]), pack2(s[0][2], s[0][3]), pack2(s[1][0], s[1][1]), pack2(s[1][2], s[1][3]));
      pf[h] = __builtin_bit_cast(bf16x8, pk);
    }
  }
  if (MODE != 0) {
#pragma unroll
    for (int dt = 0; dt < 4; ++dt) {
      const char* base = sV + (dt * 16 + lr) * 136 + half * 64 + lg * 8;
      uint2 a = *(const uint2*)(base);
      uint2 c = *(const uint2*)(base + 32);
      bf16x8 vf = __builtin_bit_cast(bf16x8, make_uint4(a.x, a.y, c.x, c.y));
#pragma unroll
      for (int h = 0; h < 2; ++h) o[h][dt] = MFMA16(vf, pf[h], o[h][dt]);
    }
  }
}

DI void attn_item(const Params& p, int l, int b, int kvh, int qh, char* smem) {
  char* sK = smem + SM_K;
  char* sV = smem + SM_V;
  float* sImp = (float*)(smem + SM_IMP);
  unsigned* sSel = (unsigned*)(smem + SM_SEL);
  unsigned* sUni = (unsigned*)(smem + SM_UNI);
  const char* wsA = p.ws + OFF_A;
  const u16* Q = (const u16*)(wsA + A_Q);
  const u16* KS = (const u16*)(wsA + A_KS);
  const u16* VST = (const u16*)(wsA + A_VST);
  const u16* KW = (const u16*)(wsA + A_KW);
  const u16* VWT = (const u16*)(wsA + A_VWT);
  const float* G = (const float*)(wsA + A_G);
  const u16* KCMP = (const u16*)(p.ws + OFF_KCMP);
  const u16* VCMPT = (const u16*)(p.ws + OFF_VCMPT);
  u16* OM = (u16*)(p.ws + OFF_H);

  const int tid = otid(), lane = tid & 63, w = tid >> 6, lr = lane & 15, lg = lane >> 4;
  const int hp = w >> 1;
  const int t0 = qh * 32;
  const int cur = qh >> 1;
  const int tql = 16 * (w & 1) + lr;
  const size_t tokq = (size_t)b * S + t0 + tql;
  const int bk = b * 2 + kvh;
  const int hg0 = kvh * 4 + hp * 2;

  bf16x8 qf[2][2];
  float slope[2];
  unsigned qs[2];
#pragma unroll
  for (int h = 0; h < 2; ++h) {
    const u16* qp = Q + tokq * 512 + (hg0 + h) * 64 + lg * 8;
    qf[h][0] = *(const bf16x8*)qp;
    qf[h][1] = *(const bf16x8*)(qp + 32);
    slope[h] = ex2(-(float)(hg0 + h + 1)) * LOG2E;
    const float shi = bf2f(f2bf(slope[h]));
    qs[h] = (lg == 0) ? pack2(shi, slope[h] - shi) : 0u;
  }
  float m[2], ls[2];
  f32x4 o[2][4], otot[2][4];
  float psum[2][4];
#pragma unroll
  for (int h = 0; h < 2; ++h) {
    m[h] = MINIT;
    ls[h] = 0.f;
#pragma unroll
    for (int dt = 0; dt < 4; ++dt) o[h][dt] = f32x4{0.f, 0.f, 0.f, 0.f};
  }

  const int amax = qh >> 5;
  const u16* kc_base = KCMP + (size_t)bk * 512 * 64;
  const u16* vc_base = VCMPT + (size_t)bk * 64 * 512;
  KVr tl;
  kv_load_k(tl, kc_base, 64, tid);
  for (int a = 0; a <= amax; ++a) {
    __syncthreads();
    kv_store_k(tl, sK, tid);
    __syncthreads();
    if (a < amax) kv_load_k(tl, kc_base + (size_t)(a + 1) * 64 * 64, 64, tid);
    else { kv_load_k(tl, kc_base, 64, tid); kv_load_v(tl, vc_base, 512, tid); }
#pragma unroll
    for (int half = 0; half < 2; ++half) {
      float posf[2][4];
      bool valid[2][4];
#pragma unroll
      for (int kt2 = 0; kt2 < 2; ++kt2)
#pragma unroll
        for (int j = 0; j < 4; ++j) {
          int n = a * 64 + half * 32 + kt2 * 16 + lg * 4 + j;
          int rel = 16 * n + 31 - t0;
          posf[kt2][j] = (float)rel;
          valid[kt2][j] = rel <= tql;
        }
      const float tb[2] = {slope[0] * (float)(1024 * a + 31 - t0), slope[1] * (float)(1024 * a + 31 - t0)};
      half_step<0, true, 16>(sK, sV, half, lr, lg, qf, qs, tb, m, ls, o, valid, psum);
    }
  }
#pragma unroll
  for (int h = 0; h < 2; ++h) {
    float x = ls[h];
    x = rows_sum(x);
    ls[h] = x > 0.f ? 1.f / x : 0.f;
  }
  float carry = 0.f;
  float* myImp = sImp + hp * (32 * 132);
  for (int a = 0; a <= amax; ++a) {
    __syncthreads();
    kv_store_k(tl, sK, tid);
    kv_store_v(tl, sV, tid);
    __syncthreads();
    if (a < amax) {
      kv_load_k(tl, kc_base + (size_t)(a + 1) * 64 * 64, 64, tid);
      kv_load_v(tl, vc_base + (a + 1) * 64, 512, tid);
    }
#pragma unroll
    for (int half = 0; half < 2; ++half) {
      float posf[2][4];
      bool valid[2][4];
#pragma unroll
      for (int kt2 = 0; kt2 < 2; ++kt2)
#pragma unroll
        for (int j = 0; j < 4; ++j) {
          int n = a * 64 + half * 32 + kt2 * 16 + lg * 4 + j;
          int rel = 16 * n + 31 - t0;
          posf[kt2][j] = (float)rel;
          valid[kt2][j] = rel <= tql;
        }
      const float tb[2] = {slope[0] * (float)(1024 * a + 31 - t0), slope[1] * (float)(1024 * a + 31 - t0)};
      half_step<1, true, 16>(sK, sV, half, lr, lg, qf, qs, tb, m, ls, o, valid, psum);
      float prev = carry;
#pragma unroll
      for (int kt2 = 0; kt2 < 2; ++kt2) {
        float sum4 = psum[kt2][0] + psum[kt2][1] + psum[kt2][2] + psum[kt2][3];
        float p3 = psum[kt2][3];
        float up = __shfl(p3, (lane + 48) & 63);
        float wrap = __shfl(prev, (lane + 48) & 63);
        float spill = lg > 0 ? up : wrap;
        int j = a * 16 + half * 8 + kt2 * 4 + lg;
        myImp[tql * 132 + j] = sum4 + spill;
        prev = p3;
      }
      carry = prev;
    }
  }
  const size_t tokq_a = (size_t)b * S + t0 + 16 * ((otid() >> 6) & 1) + (otid() & 15);
#pragma unroll
  for (int h = 0; h < 2; ++h) {
    const float g0 = G[tokq_a * 24 + (hg0 + h) * 3 + 0];
#pragma unroll
    for (int dt = 0; dt < 4; ++dt) {
      otot[h][dt] = o[h][dt] * g0;
      o[h][dt] = f32x4{0.f, 0.f, 0.f, 0.f};
    }
    m[h] = MINIT;
    ls[h] = 0.f;
  }
  if (tid < 4) sUni[tid] = 0u;
  __syncthreads();
  if (tid < 128) {
    const int q = tid >> 2, sub = tid & 3;
    unsigned mk[4] = {0u, 0u, 0u, 0u};
    if (cur < 16) {
      mk[0] = (1u << (cur + 1)) - 1u;
    } else {
      float v[32];
#pragma unroll
      for (int i = 0; i < 32; ++i) {
        int j = sub + 4 * i;
        v[i] = (j >= 1 && j <= cur - 2) ? (sImp[q * 132 + j] + sImp[32 * 132 + q * 132 + j]) : -1.f;
      }
      for (int round = 0; round < 13; ++round) {
        float bv = v[0];
        int bi = 0;
#pragma unroll
        for (int i = 1; i < 32; ++i)
          if (v[i] > bv) { bv = v[i]; bi = i; }
        int bj = sub + 4 * bi;
#pragma unroll
        for (int off = 1; off <= 2; off <<= 1) {
          float ov = __shfl_xor(bv, off);
          int oj = __shfl_xor(bj, off);
          if (ov > bv || (ov == bv && oj < bj)) { bv = ov; bj = oj; }
        }
#pragma unroll
        for (int i = 0; i < 32; ++i)
          if (sub + 4 * i == bj) v[i] = -2.f;
#pragma unroll
        for (int wd = 0; wd < 4; ++wd) mk[wd] |= ((bj >> 5) == wd) ? (1u << (bj & 31)) : 0u;
      }
      const int f1 = cur, f2 = cur - 1;
      mk[0] |= 1u;
#pragma unroll
      for (int wd = 0; wd < 4; ++wd) {
        mk[wd] |= ((f1 >> 5) == wd) ? (1u << (f1 & 31)) : 0u;
        mk[wd] |= ((f2 >> 5) == wd) ? (1u << (f2 & 31)) : 0u;
      }
    }
    if (sub == 0) {
#pragma unroll
      for (int wd = 0; wd < 4; ++wd) {
        sSel[q * 4 + wd] = mk[wd];
        atomicOr(&sUni[wd], mk[wd]);
      }
    }
  }
  __syncthreads();
  const int jw0 = (cur >= 8 ? cur - 8 : 0);
  {
    int j = cur;
    kv_load_k(tl, KS + ((size_t)b * S + j * 64) * 128 + kvh * 64, 128, tid);
    kv_load_v(tl, VST + (size_t)bk * 64 * S + j * 64, S, tid);
    while (j >= 0) {
      __syncthreads();
      kv_store_k(tl, sK, tid);
      kv_store_v(tl, sV, tid);
      __syncthreads();
      const int jn = prev_set_bit(sUni, j - 1);
      if (jn >= 0) {
        kv_load_k(tl, KS + ((size_t)b * S + jn * 64) * 128 + kvh * 64, 128, tid);
        kv_load_v(tl, VST + (size_t)bk * 64 * S + jn * 64, S, tid);
      } else {
        kv_load_k(tl, KW + ((size_t)b * S + cur * 64) * 128 + kvh * 64, 128, tid);
        kv_load_v(tl, VWT + (size_t)bk * 64 * S + cur * 64, S, tid);
      }
      const bool selbit = (sSel[tql * 4 + (j >> 5)] >> (j & 31)) & 1u;
      const unsigned long long bal = __ballot(selbit);
      if (bal != 0ull) {
        const bool full = (j < cur) && (bal == ~0ull);
#pragma unroll
        for (int half = 0; half < 2; ++half) {
          float posf[2][4];
          bool valid[2][4];
#pragma unroll
          for (int kt2 = 0; kt2 < 2; ++kt2)
#pragma unroll
            for (int jj = 0; jj < 4; ++jj) {
              int rel = j * 64 - t0 + half * 32 + kt2 * 16 + lg * 4 + jj;
              posf[kt2][jj] = (float)rel;
              valid[kt2][jj] = selbit && (rel <= tql);
            }
          const float tb[2] = {slope[0] * (float)(j * 64 - t0), slope[1] * (float)(j * 64 - t0)};
          half_step<2, true, 1>(sK, sV, half, lr, lg, qf, qs, tb, m, ls, o, valid, psum);
        }
      }
      j = jn;
    }
  }
  const size_t tokq_b = (size_t)b * S + t0 + 16 * ((otid() >> 6) & 1) + (otid() & 15);
#pragma unroll
  for (int h = 0; h < 2; ++h) {
    float x = ls[h];
    x = rows_sum(x);
    const float f = (x > 0.f ? 1.f / x : 0.f) * G[tokq_b * 24 + (hg0 + h) * 3 + 1];
#pragma unroll
    for (int dt = 0; dt < 4; ++dt) {
      otot[h][dt] += o[h][dt] * f;
      o[h][dt] = f32x4{0.f, 0.f, 0.f, 0.f};
    }
    m[h] = MINIT;
    ls[h] = 0.f;
  }
  for (int j = cur; j >= jw0; --j) {
    __syncthreads();
    kv_store_k(tl, sK, tid);
    kv_store_v(tl, sV, tid);
    __syncthreads();
    if (j > jw0) {
      kv_load_k(tl, KW + ((size_t)b * S + (j - 1) * 64) * 128 + kvh * 64, 128, tid);
      kv_load_v(tl, VWT + (size_t)bk * 64 * S + (j - 1) * 64, S, tid);
    }
    const bool full = (j * 64 + 63 <= t0) && (t0 + 31 - j * 64 <= 511);
#pragma unroll
    for (int half = 0; half < 2; ++half) {
      float posf[2][4];
      bool valid[2][4];
#pragma unroll
      for (int kt2 = 0; kt2 < 2; ++kt2)
#pragma unroll
        for (int jj = 0; jj < 4; ++jj) {
          int rel = j * 64 - t0 + half * 32 + kt2 * 16 + lg * 4 + jj;
          posf[kt2][jj] = (float)rel;
          valid[kt2][jj] = (rel <= tql) && (tql - rel < 512);
        }
      const float tb[2] = {slope[0] * (float)(j * 64 - t0), slope[1] * (float)(j * 64 - t0)};
      half_step<2, true, 1>(sK, sV, half, lr, lg, qf, qs, tb, m, ls, o, valid, psum);
    }
  }
  const int tid_c = otid();
  const size_t tokq_c = (size_t)b * S + t0 + 16 * ((tid_c >> 6) & 1) + (tid_c & 15);
  const int hg_c = kvh * 4 + (tid_c >> 7) * 2;
  const int lg_c = (tid_c >> 4) & 3;
#pragma unroll
  for (int h = 0; h < 2; ++h) {
    float x = ls[h];
    x = rows_sum(x);
    const float f = (x > 0.f ? 1.f / x : 0.f) * G[tokq_c * 24 + (hg_c + h) * 3 + 2];
    float ss = 0.f;
#pragma unroll
    for (int dt = 0; dt < 4; ++dt) {
      otot[h][dt] += o[h][dt] * f;
#pragma unroll
      for (int jj = 0; jj < 4; ++jj) ss += otot[h][dt][jj] * otot[h][dt][jj];
    }
    ss = rows_sum(ss);
    const float r = rsqrtf(ss * (1.f / 64.f) + EPS);
#pragma unroll
    for (int dt = 0; dt < 4; ++dt) {
      const int d = dt * 16 + lg_c * 4;
      const float4 gg = *(const float4*)(p.out_g + l * 1024 + (hg_c + h) * 64 + d);
      uint2 st;
      st.x = pack2(otot[h][dt][0] * r * gg.x, otot[h][dt][1] * r * gg.y);
      st.y = pack2(otot[h][dt][2] * r * gg.z, otot[h][dt][3] * r * gg.w);
      *(uint2*)(OM + tokq_c * 1024 + (hg_c + h) * 64 + d) = st;
    }
  }
}

#define XB_TMO      128
#define XB_XCNT(j)  (256  + 64 * (j))
#define XB_XSUB(j)  (1280 + 64 * (j))
#define XB_XGEN(j)  (2304 + 64 * (j))
#define XB_TOP      3328
#define XB_TOPGEN   3392
#define XCD_BAR_WORDS 3456
#define XB_SPIN_CAP (1u << 20)
DI unsigned xb_ld(unsigned* p) { return __hip_atomic_load(p, __ATOMIC_RELAXED, __HIP_MEMORY_SCOPE_AGENT); }
DI unsigned xb_add(unsigned* p, unsigned v) { return __hip_atomic_fetch_add(p, v, __ATOMIC_RELAXED, __HIP_MEMORY_SCOPE_AGENT); }
DI unsigned xb_xcc_id() { return (unsigned)__builtin_amdgcn_s_getreg((3 << 11) | 20) & 0xFu; }
#define XB_SPIN(cond, bar) do { unsigned _sp = 0; while (cond) { __builtin_amdgcn_s_sleep(1); \
    if ((++_sp & 255u) == 0u) { if (xb_ld(&(bar)[XB_TMO])) break; if (_sp > XB_SPIN_CAP) { atomicAdd(&(bar)[XB_TMO], 1u); break; } } } } while (0)

struct XcdBarrier { unsigned* bar; unsigned x; volatile unsigned* st; };

DI void xcd_barrier_complete(unsigned* bar, unsigned x, unsigned& nloc, unsigned& nx) {
  const unsigned G = gridDim.x;
  unsigned sum, cnt, mine, sp = 0u;
  for (;;) {
    sum = 0u; cnt = 0u; mine = 0u;
#pragma unroll
    for (unsigned j = 0; j < 16; ++j) { const unsigned c = xb_ld(&bar[XB_XCNT(j)]); sum += c; cnt += (c > 0u) ? 1u : 0u; mine = (j == x) ? c : mine; }
    if (sum == G) break;
    __builtin_amdgcn_s_sleep(1);
    if ((++sp & 255u) == 0u) { if (xb_ld(&bar[XB_TMO])) break; if (sp > XB_SPIN_CAP) { atomicAdd(&bar[XB_TMO], 1u); break; } }
  }
  nloc = mine > 0u ? mine : 1u; nx = cnt > 0u ? cnt : 1u;
}

DI void gsync(const XcdBarrier& b0) {
  asm volatile("s_waitcnt vmcnt(0)" ::: "memory");
  __syncthreads();
  if (threadIdx.x == 0) {
    XcdBarrier b;
    b.bar = b0.bar;
    b.st = b0.st;
    b.x = xb_xcc_id();
    unsigned* bar = b.bar;
    __builtin_amdgcn_s_waitcnt(0);
    unsigned nloc = b.st[0], nx = b.st[1];
    if (nloc == 0u) { xcd_barrier_complete(bar, b.x, nloc, nx); b.st[0] = nloc; b.st[1] = nx; }
    const unsigned old = xb_add(&bar[XB_XSUB(b.x)], 1u);
    const unsigned gen = old / nloc;
    if (old + 1u == (gen + 1u) * nloc) {
      __builtin_amdgcn_fence(__ATOMIC_RELEASE, "agent");
      asm volatile("s_waitcnt vmcnt(0)" ::: "memory");
      const unsigned og = xb_add(&bar[XB_TOP], 1u);
      const unsigned tg = og / nx;
      if (og + 1u == (tg + 1u) * nx) xb_add(&bar[XB_TOPGEN], 1u);
      else XB_SPIN(xb_ld(&bar[XB_TOPGEN]) == tg, bar);
      __builtin_amdgcn_fence(__ATOMIC_ACQUIRE, "agent");
      xb_add(&bar[XB_XGEN(b.x)], 1u);
      asm volatile("s_waitcnt vmcnt(0)" ::: "memory");
    } else {
      XB_SPIN(xb_ld(&bar[XB_XGEN(b.x)]) == gen, bar);
      __builtin_amdgcn_fence(__ATOMIC_ACQUIRE, "agent");
      asm volatile("s_waitcnt vmcnt(0)" ::: "memory");
    }
  }
  __syncthreads();
}

#ifndef STOP_AFTER
#define STOP_AFTER 0
#endif
#define DUMP_BF16_AND_STOP(ptr)                                                                   \
  {                                                                                               \
    const u16* s_ = (const u16*)(ptr);                                                            \
    for (size_t i = (size_t)bid * 256 + threadIdx.x; i < (size_t)TOK * 1024; i += (size_t)nb * 256) \
      p.out[i] = bf2f(s_[i]);                                                                     \
    return;                                                                                       \
  }
#define DUMP_F32_AND_STOP(ptr)                                                                    \
  {                                                                                               \
    const float* s_ = (const float*)(ptr);                                                        \
    for (size_t i = (size_t)bid * 256 + threadIdx.x; i < (size_t)TOK * 1024; i += (size_t)nb * 256) \
      p.out[i] = s_[i];                                                                           \
    return;                                                                                       \
  }
__global__ void __launch_bounds__(256, 2) mega(Params p) {
  extern __shared__ __attribute__((aligned(16))) char smem[];
  char* ws = p.ws;
  const int nb = gridDim.x, bid = blockIdx.x;
  if (ws == nullptr) cg::this_grid().sync();
  volatile unsigned* xst = (volatile unsigned*)(smem + 73728);
  if (threadIdx.x == 0) { xst[0] = 0u; xst[1] = 0u; }
  __syncthreads();
  if (threadIdx.x == 0) (void)xb_add(&((unsigned*)(ws + OFF_BAR))[XB_XCNT(xb_xcc_id())], 1u);
#define grid (XcdBarrier{(unsigned*)(p.ws + OFF_BAR), 0u, (volatile unsigned*)(smem + 73728)})
  float* X1 = (float*)(ws + OFF_X1);
  u16* H = (u16*)(ws + OFF_H);
  char* wsA = ws + OFF_A;
  const float* mod = (const float*)(ws + OFF_MOD);

#ifdef ZERO_WS
  {
    uint4* z = (uint4*)ws;
    const size_t n16 = (OFF_A + A_END) / 16;
    for (size_t i = (size_t)bid * 256 + threadIdx.x; i < n16; i += (size_t)nb * 256) z[i] = make_uint4(0, 0, 0, 0);
    uint4* zo = (uint4*)p.out;
    const size_t m16 = (size_t)TOK * 1024 * 4 / 16;
    for (size_t i = (size_t)bid * 256 + threadIdx.x; i < m16; i += (size_t)nb * 256) zo[i] = make_uint4(0, 0, 0, 0);
  }
  gsync(grid);
#endif
  phase0a(p, smem);
  gsync(grid);
  phase0b(p);
  gsync(grid);
  phase_mod_x(p);
  gsync(grid);

  for (int l = 0; l < 2; ++l) {
    const float* modl = mod + (size_t)l * 8 * 6144;
    const float* xin = (l == 0) ? p.x : p.out;
    {
      u16* Qo = (u16*)(wsA + A_Q);
      u16* KCo = (u16*)(wsA + A_KC);
      u16* VCo = (u16*)(wsA + A_VC);
      u16* KSo = (u16*)(wsA + A_KS);
      u16* VSTo = (u16*)(wsA + A_VST);
      u16* KWo = (u16*)(wsA + A_KW);
      u16* VWTo = (u16*)(wsA + A_VWT);
      float* Go = (float*)(wsA + A_G);
      u16* Uo = (u16*)(wsA + A_U);
      u16* VGTo = (u16*)(wsA + A_VGT);
      const float* vng = p.vn_g + l * 512;
      const float* vnb = p.vn_b + l * 512;
      auto sel1 = [](int tn) { return !(tn == 7 || tn == 9 || (tn >= 14 && tn < 18)); };
      auto epi = [&](bool swp, int tm, int tn, int wm, int wn, int lr, int lg, auto& acc) {
        constexpr int MT = sizeof(acc) / sizeof(acc[0]);
        const int row0 = tm * (32 * MT) + wm * (16 * MT);
        const int b = row0 >> 13;
        const int s0 = row0 & (S - 1);
        if (swp) {
          if (tn == 18) {
            if (wn == 0) {
#pragma unroll
              for (int mi = 0; mi < MT; ++mi)
#pragma unroll
                for (int ni = 0; ni < 2; ++ni) {
                  const int c = ni * 16 + lg * 4;
                  const size_t row = (size_t)row0 + mi * 16 + lr;
                  if (c < 24)
                    *(float4*)(Go + row * 24 + c) =
                        make_float4(sigm(acc[mi][ni][0]), sigm(acc[mi][ni][1]), sigm(acc[mi][ni][2]), sigm(acc[mi][ni][3]));
                }
            }
          } else {
            u16* dst;
            int ld, cb;
            float sc = 1.f;
            bool g = false;
            if (tn < 4) { dst = Qo; ld = 512; cb = tn * 128; sc = QSCALE; }
            else if (tn == 4) { dst = KCo; ld = 128; cb = 0; }
            else if (tn == 5) { dst = VCo; ld = 128; cb = 0; }
            else if (tn == 6) { dst = KSo; ld = 128; cb = 0; }
            else if (tn == 8) { dst = KWo; ld = 128; cb = 0; }
            else { dst = Uo; ld = 512; cb = (tn - 10) * 128; g = true; }
#pragma unroll
            for (int mi = 0; mi < MT; ++mi)
#pragma unroll
              for (int ni = 0; ni < 4; ++ni) {
                const size_t row = (size_t)row0 + mi * 16 + lr;
                float v[4];
#pragma unroll
                for (int j = 0; j < 4; ++j) v[j] = g ? gelu_t(acc[mi][ni][j]) : acc[mi][ni][j] * sc;
                uint2 st;
                st.x = pack2(v[0], v[1]);
                st.y = pack2(v[2], v[3]);
                *(uint2*)(dst + row * ld + cb + wn * 64 + ni * 16 + lg * 4) = st;
              }
          }
        } else if (tn == 7 || tn == 9) {
          u16* dst = (tn == 7) ? VSTo : VWTo;
#pragma unroll
          for (int mi = 0; mi < MT; ++mi)
#pragma unroll
            for (int ni = 0; ni < 4; ++ni) {
              const int d = ni * 16 + lr;
              uint2 st;
              st.x = pack2(acc[mi][ni][0], acc[mi][ni][1]);
              st.y = pack2(acc[mi][ni][2], acc[mi][ni][3]);
              *(uint2*)(dst + ((size_t)(b * 2 + wn) * 64 + d) * S + s0 + mi * 16 + lg * 4) = st;
            }
        } else {
          const int grp = (tn - 14) * 2 + wn;
          float vg[4], vb[4];
#pragma unroll
          for (int ni = 0; ni < 4; ++ni) { vg[ni] = vng[grp * 64 + ni * 16 + lr]; vb[ni] = vnb[grp * 64 + ni * 16 + lr]; }
#pragma unroll
          for (int mi = 0; mi < MT; ++mi) {
            float vv[4][4];
#pragma unroll
            for (int ni = 0; ni < 4; ++ni)
#pragma unroll
              for (int j = 0; j < 4; ++j) vv[ni][j] = gelu_t(acc[mi][ni][j]);
#pragma unroll
            for (int j = 0; j < 4; ++j) {
              float s1 = vv[0][j] + vv[1][j] + vv[2][j] + vv[3][j];
              s1 += __shfl_xor(s1, 1); s1 += __shfl_xor(s1, 2); s1 += __shfl_xor(s1, 4); s1 += __shfl_xor(s1, 8);
              const float mu = s1 * (1.f / 64.f);
              float s2 = 0.f;
#pragma unroll
              for (int ni = 0; ni < 4; ++ni) { float dd = vv[ni][j] - mu; s2 += dd * dd; }
              s2 += __shfl_xor(s2, 1); s2 += __shfl_xor(s2, 2); s2 += __shfl_xor(s2, 4); s2 += __shfl_xor(s2, 8);
              const float rs = rsqrtf(s2 * (1.f / 64.f) + EPS);
#pragma unroll
              for (int ni = 0; ni < 4; ++ni) vv[ni][j] = (vv[ni][j] - mu) * rs * vg[ni] + vb[ni];
            }
#pragma unroll
            for (int ni = 0; ni < 4; ++ni) {
              const int d = ni * 16 + lr;
              uint2 st;
              st.x = pack2(vv[ni][0], vv[ni][1]);
              st.y = pack2(vv[ni][2], vv[ni][3]);
              *(uint2*)(VGTo + ((size_t)(b * 8 + grp) * 64 + d) * S + s0 + mi * 16 + lg * 4) = st;
            }
          }
        }
      };
      gemm_phase<8>(H, 1024, (const u16*)(ws + OFF_WTIN + l * SZ_WTIN), 1024, 256, 19, 1024, bid, nb, smem, sel1, epi, l == 1);
    }
    gsync(grid);
    if (STOP_AFTER == 1 && l == 0) DUMP_BF16_AND_STOP(wsA)
    if (STOP_AFTER == 11 && l == 0) DUMP_BF16_AND_STOP(wsA + A_KW)
    if (STOP_AFTER == 12 && l == 0) DUMP_BF16_AND_STOP(wsA + A_U)
    {
      const int ng = (nb >= 256) ? 256 : nb;
      const int half = ng / 2;
      for (int which = 0; which < 2; ++which) {
        u16* HC = (u16*)(wsA + A_HC) + (size_t)which * 8192 * 256;
        const float* cb1 = (const float*)(ws + OFF_CB1) + (l * 2 + which) * 256;
        const u16* src_tok = (const u16*)(wsA + (which ? A_VC : A_KC));
        auto selT = [](int) { return true; };
        auto ab = [=](int tm) {
          const int bk = tm >> 2, n0 = (tm & 3) * 128;
          return src_tok + ((size_t)(bk >> 1) * S + 16 * n0) * 128 + (bk & 1) * 64;
        };
        auto epi = [&](bool swp, int tm, int tn, int wm, int wn, int lr, int lg, auto& acc) {
        constexpr int MT = sizeof(acc) / sizeof(acc[0]);
          const int row0 = tm * (32 * MT) + wm * (16 * MT), col0 = tn * 128 + wn * 64;
#pragma unroll
          for (int ni = 0; ni < 4; ++ni) {
            const float4 cb = *(const float4*)(cb1 + col0 + ni * 16 + lg * 4);
#pragma unroll
            for (int mi = 0; mi < MT; ++mi) {
              uint2 st;
              st.x = pack2(gelu_t(acc[mi][ni][0] + cb.x), gelu_t(acc[mi][ni][1] + cb.y));
              st.y = pack2(gelu_t(acc[mi][ni][2] + cb.z), gelu_t(acc[mi][ni][3] + cb.w));
              *(uint2*)(HC + (size_t)(row0 + mi * 16 + lr) * 256 + col0 + ni * 16 + lg * 4) = st;
            }
          }
        };
        const int vb = (bid < ng) ? (which == 0 ? (bid < half ? bid : -1) : (bid >= half ? bid - half : -1)) : -1;
        gemm_phase_g<4>(ab, 2048, 128, (const u16*)(ws + OFF_WTC1 + (l * 2 + which) * SZ_WTC1), 2048, 64, 2, 2048, vb, half, smem,
                     selT, epi);
      }
      if (bid >= ng) {
        unsigned* gctr = (unsigned*)(ws + OFF_BAR) + (l ? 96 : 32);
        volatile unsigned* slot = (volatile unsigned*)(smem + 73728) + 2;
        for (;;) {
          __syncthreads();
          if (threadIdx.x == 0) *slot = xb_add(gctr, 1u);
          __syncthreads();
          const unsigned idx = (unsigned)__builtin_amdgcn_readfirstlane((int)*slot);
          if (idx >= (unsigned)GMLP_EARLY) break;
          gmlp_item(p, l, (int)idx);
        }
      }
    }
    gsync(grid);
    {
      for (int which = 0; which < 2; ++which) {
        u16* KCMP = (u16*)(ws + OFF_KCMP);
        u16* VCMPT = (u16*)(ws + OFF_VCMPT);
        auto selW = [which](int) { return which == 0; };
        auto epi = [&](bool swp, int tm, int tn, int wm, int wn, int lr, int lg, auto& acc) {
        constexpr int MT = sizeof(acc) / sizeof(acc[0]);
          if (wn != 0) return;
          const int row0 = tm * (32 * MT) + wm * (16 * MT);
#pragma unroll
          for (int mi = 0; mi < MT; ++mi)
#pragma unroll
            for (int ni = 0; ni < 4; ++ni) {
              uint2 st;
              st.x = pack2(acc[mi][ni][0], acc[mi][ni][1]);
              st.y = pack2(acc[mi][ni][2], acc[mi][ni][3]);
              if (swp) {
                *(uint2*)(KCMP + (size_t)(row0 + mi * 16 + lr) * 64 + ni * 16 + lg * 4) = st;
              } else {
                const int d = ni * 16 + lr;
                const int rb = row0 + mi * 16 + lg * 4;
                *(uint2*)(VCMPT + ((size_t)(rb >> 9) * 64 + d) * 512 + (rb & 511)) = st;
              }
            }
        };
        const int vb = (which == 0) ? bid : (bid + nb - 64) % nb;
        gemm_phase<4>((const u16*)(wsA + A_HC) + (size_t)which * 8192 * 256, 256,
                   (const u16*)(ws + OFF_WTC2 + (l * 2 + which) * SZ_WTC2), 256, 64, 1, 256, vb, nb, smem, selW, epi);
      }
    }
    gsync(grid);
    if (STOP_AFTER == 4 && l == 0) DUMP_BF16_AND_STOP(ws + OFF_KCMP)
    {
      unsigned* qctr = (unsigned*)(ws + OFF_BAR) + (l ? 64 : 0);
      volatile unsigned* slot = (volatile unsigned*)(smem + 73728) + 2;
      for (;;) {
        __syncthreads();
        if (threadIdx.x == 0) *slot = xb_add(qctr, 1u);
        __syncthreads();
        const unsigned idx = (unsigned)__builtin_amdgcn_readfirstlane((int)*slot);
        if (idx >= 8192u - (unsigned)GMLP_EARLY) break;
        if (idx < 4096u) {
          const int qh = 255 - (int)(idx >> 4);
          const int rem = (int)(idx & 15u);
          attn_item(p, l, rem >> 1, rem & 1, qh, smem);
        } else {
          gmlp_item(p, l, (int)(idx - 4096u) + GMLP_EARLY);
        }
      }
    }
    gsync(grid);
    if (STOP_AFTER == 5 && l == 0) DUMP_BF16_AND_STOP(H)
    if ((STOP_AFTER == 51 || STOP_AFTER == 52) && l == 0) {
      for (size_t i = (size_t)bid * 256 + threadIdx.x; i < (size_t)TOK * 1024; i += (size_t)nb * 256) {
        const int col = (int)(i & 1023);
        const bool keep = (STOP_AFTER == 51) ? (col < 512) : (col >= 512);
        p.out[i] = keep ? bf2f(H[i]) : 0.f;
      }
      return;
    }
    {
      auto selT = [](int) { return true; };
      auto epi = [&](bool swp, int tm, int tn, int wm, int wn, int lr, int lg, auto& acc) {
        constexpr int MT = sizeof(acc) / sizeof(acc[0]);
        const int row0 = tm * (32 * MT) + wm * (16 * MT), col0 = tn * 128 + wn * 64;
        const int b = row0 >> 13;
#pragma unroll
        for (int ni = 0; ni < 4; ++ni) {
          const int col = col0 + ni * 16 + lg * 4;
          const float4 g1 = *(const float4*)(modl + (size_t)b * 6144 + 2048 + col);
#pragma unroll
          for (int mi = 0; mi < MT; ++mi) {
            const size_t row = (size_t)row0 + mi * 16 + lr;
            float4 xv = *(const float4*)(xin + row * 1024 + col);
            if (l == 1) {
              const float2 st = *(const float2*)((const float*)(ws + OFF_ST2) + row * 2);
              const float4 gg = *(const float4*)(p.ln2_g + col), bb = *(const float4*)(p.ln2_b + col);
              xv.x = (xv.x - st.x) * st.y * gg.x + bb.x;
              xv.y = (xv.y - st.x) * st.y * gg.y + bb.y;
              xv.z = (xv.z - st.x) * st.y * gg.z + bb.z;
              xv.w = (xv.w - st.x) * st.y * gg.w + bb.w;
            }
            float4 o4;
            o4.x = ALPHA * xv.x + (1.f + g1.x) * acc[mi][ni][0];
            o4.y = ALPHA * xv.y + (1.f + g1.y) * acc[mi][ni][1];
            o4.z = ALPHA * xv.z + (1.f + g1.z) * acc[mi][ni][2];
            o4.w = ALPHA * xv.w + (1.f + g1.w) * acc[mi][ni][3];
            *(float4*)(X1 + row * 1024 + col) = o4;
          }
        }
      };
      gemm_phase<8>(H, 1024, (const u16*)(ws + OFF_WTO + l * SZ_WTO), 1024, 256, 8, 1024, bid, nb, smem, selT, epi);
    }
    gsync(grid);
    ln_rows(X1, p.ln1_g + l * 1024, p.ln1_b + l * 1024, modl, 3072, 4096, H, (float*)(ws + OFF_ST1), false, true);
    gsync(grid);
    if (STOP_AFTER == 7 && l == 0) DUMP_F32_AND_STOP(X1)
    {
      u16* HH = (u16*)(wsA);
      auto selT = [](int) { return true; };
      auto epi = [&](bool swp, int tm, int tn, int wm, int wn, int lr, int lg, auto& acc) {
        constexpr int MT = sizeof(acc) / sizeof(acc[0]);
        const int row0 = tm * (32 * MT) + wm * (16 * MT);
        const int cb = tn * 64 + wn * 32;
#pragma unroll
        for (int mi = 0; mi < MT; ++mi)
#pragma unroll
          for (int ni = 0; ni < 2; ++ni) {
            const size_t row = (size_t)row0 + mi * 16 + lr;
            float v[4];
#pragma unroll
            for (int j = 0; j < 4; ++j) {
              const float a = acc[mi][ni][j], bb = acc[mi][ni + 2][j];
              v[j] = a * sigm(a) * bb;
            }
            uint2 st;
            st.x = pack2(v[0], v[1]);
            st.y = pack2(v[2], v[3]);
            *(uint2*)(HH + row * 2816 + cb + ni * 16 + lg * 4) = st;
          }
      };
      gemm_phase<8>(H, 1024, (const u16*)(ws + OFF_WT13 + l * SZ_WT13), 1024, 256, 44, 1024, bid, nb, smem, selT, epi);
    }
    gsync(grid);
    if (STOP_AFTER == 8 && l == 0) DUMP_BF16_AND_STOP(wsA)
    {
      const u16* HH = (const u16*)(wsA);
      float* outp = p.out;
      auto selT = [](int) { return true; };
      auto epi = [&](bool swp, int tm, int tn, int wm, int wn, int lr, int lg, auto& acc) {
        constexpr int MT = sizeof(acc) / sizeof(acc[0]);
        const int row0 = tm * (32 * MT) + wm * (16 * MT), col0 = tn * 128 + wn * 64;
        const int b = row0 >> 13;
#pragma unroll
        for (int ni = 0; ni < 4; ++ni) {
          const int col = col0 + ni * 16 + lg * 4;
          const float4 g2 = *(const float4*)(modl + (size_t)b * 6144 + 5120 + col);
#pragma unroll
          for (int mi = 0; mi < MT; ++mi) {
            const size_t row = (size_t)row0 + mi * 16 + lr;
            float4 xv = *(const float4*)(X1 + row * 1024 + col);
            {
              const float2 st = *(const float2*)((const float*)(ws + OFF_ST1) + row * 2);
              const float4 gg = *(const float4*)(p.ln1_g + l * 1024 + col), bb = *(const float4*)(p.ln1_b + l * 1024 + col);
              xv.x = (xv.x - st.x) * st.y * gg.x + bb.x;
              xv.y = (xv.y - st.x) * st.y * gg.y + bb.y;
              xv.z = (xv.z - st.x) * st.y * gg.z + bb.z;
              xv.w = (xv.w - st.x) * st.y * gg.w + bb.w;
            }
            float4 o4;
            o4.x = ALPHA * xv.x + (1.f + g2.x) * acc[mi][ni][0];
            o4.y = ALPHA * xv.y + (1.f + g2.y) * acc[mi][ni][1];
            o4.z = ALPHA * xv.z + (1.f + g2.z) * acc[mi][ni][2];
            o4.w = ALPHA * xv.w + (1.f + g2.w) * acc[mi][ni][3];
            *(float4*)(outp + row * 1024 + col) = o4;
          }
        }
      };
      gemm_phase<8>(HH, 2816, (const u16*)(ws + OFF_WT2 + l * SZ_WT2), 2816, 256, 8, 2816, bid, nb, smem, selT, epi, true);
    }
    gsync(grid);
    if (l == 0) {
      ln_rows(p.out, p.ln2_g, p.ln2_b, mod + (size_t)8 * 6144, 0, 1024, H, (float*)(ws + OFF_ST2), false, false);
      gsync(grid);
    } else {
      ln_rows(p.out, p.ln2_g + 1024, p.ln2_b + 1024, nullptr, 0, 0, nullptr, nullptr, true, false);
    }
  }
}

extern "C" void kernel_launch(void* const* d_in, const int* in_sizes, int n_in, void* d_out, int out_size, void* d_ws,
                              size_t ws_size, hipStream_t stream) {
  static int grid_blocks = 0;
  if (!grid_blocks) {
    int dev = 0, cus = 0, per_cu = 0;
    (void)hipGetDevice(&dev);
    (void)hipDeviceGetAttribute(&cus, hipDeviceAttributeMultiprocessorCount, dev);
    (void)hipFuncSetAttribute((const void*)mega, hipFuncAttributeMaxDynamicSharedMemorySize, LDS_BYTES);
    (void)hipOccupancyMaxActiveBlocksPerMultiprocessor(&per_cu, mega, 256, LDS_BYTES);
    if (per_cu > 2) per_cu = 2;
    if (per_cu < 1) per_cu = 1;
    grid_blocks = cus * per_cu;
  }
  Params p{};
  const float* const* in = (const float* const*)d_in;
  p.x = in[0]; p.c = in[1]; p.w_ada = in[2]; p.b_ada = in[3]; p.w_in = in[4]; p.cmp_pos = in[5]; p.cmp_w1 = in[6];
  p.cmp_w2 = in[7]; p.vn_g = in[8]; p.vn_b = in[9]; p.w_s = in[10]; p.b_s = in[11]; p.out_g = in[12]; p.w_o = in[13];
  p.ln1_g = in[14]; p.ln1_b = in[15]; p.w1 = in[16]; p.w3 = in[17]; p.w2 = in[18]; p.ln2_g = in[19]; p.ln2_b = in[20];
  p.out = (float*)d_out;
  p.ws = (char*)d_ws;
  (void)hipMemsetAsync((char*)d_ws + OFF_BAR, 0, XCD_BAR_WORDS * sizeof(unsigned), stream);
  void* args[] = {&p};
  hipError_t e = hipLaunchCooperativeKernel((void*)mega, dim3(grid_blocks), dim3(256), args, LDS_BYTES, stream);
  if (e != hipSuccess) fprintf(stderr, "cooperative launch failed: %s (grid %d)\n", hipGetErrorString(e), grid_blocks);
}
```
